# Optimizing an MI355X kernel written in HIP

```python
import math
import jax
import jax.numpy as jnp
from jax import lax
import numpy as np

D_MODEL = 1024
BATCH = 16
SEQ = 2048
DEPTH = 4

GRID_W = 64
CTX_LEN = 256
N_MIXERS = 2
N_S5_LAYERS = (DEPTH + N_MIXERS - 1) // N_MIXERS
N_MLA_LAYERS = DEPTH // N_MIXERS
EPS = 1e-6
ADA_CHUNKS = 6

S5_GROUP_CH = 16
S5_GROUPS = D_MODEL // S5_GROUP_CH
S5_STATE = 64
S5_DT_MIN = 1e-3
S5_DT_MAX = 1e-1

MLA_HEADS = 8
MLA_Q_RANK = 384
MLA_KV_RANK = 256
MLA_NOPE = 128
MLA_ROPE = 64
MLA_V = 128
Q_BLOCK = 128
ROPE_THETA = 10000.0

MOE_GROUPS = 4
MOE_EXPERTS = 8
MOE_TOP_K = 2
MOE_HIDDEN = 512
MOE_N_EXPERTS = MOE_GROUPS * MOE_EXPERTS

kernel_name = 'hybrid_s5_mla_hmoe_dit'


def _rmsnorm(h, g):
    h32 = h.astype(jnp.float32)
    y = h32 * lax.rsqrt(jnp.mean(h32 * h32, axis=-1, keepdims=True) + EPS)
    return (y * g.astype(jnp.float32)).astype(h.dtype)


def _modulate(h, shift, scale):
    return h * (1 + scale) + shift


def _axial_rope_tables(rows, dtype):
    half = MLA_ROPE // 2
    inv_freq = 1.0 / (ROPE_THETA ** (jnp.arange(0, half, 2, dtype=jnp.float32) / half))
    r = jnp.broadcast_to(jnp.arange(rows, dtype=jnp.float32)[:, None], (rows, GRID_W)).reshape(-1)
    col = jnp.broadcast_to(jnp.arange(GRID_W, dtype=jnp.float32)[None, :], (rows, GRID_W)).reshape(-1)
    ang_r = r[:, None] * inv_freq
    ang_c = col[:, None] * inv_freq
    ang = jnp.concatenate([ang_r, ang_r, ang_c, ang_c], axis=-1)
    return jnp.cos(ang).astype(dtype), jnp.sin(ang).astype(dtype)


def _rope2d(t, cos, sin):
    a1, a2, b1, b2 = jnp.split(t, 4, axis=-1)
    rot = jnp.concatenate([-a2, a1, -b2, b1], axis=-1)
    return t * cos + rot * sin


def _complex_linear_combine(e1, e2):
    a1r, a1i, b1r, b1i = e1
    a2r, a2i, b2r, b2i = e2
    return (a2r * a1r - a2i * a1i,
            a2r * a1i + a2i * a1r,
            a2r * b1r - a2i * b1i + b2r,
            a2r * b1i + a2i * b1r + b2i)


def _s5_discretize(a_re, a_im, log_dt, b_re, b_im):
    dt = jnp.exp(log_dt.astype(jnp.float32))[:, None]
    ar = a_re.astype(jnp.float32)
    ai = a_im.astype(jnp.float32)
    ldr, ldi = ar * dt, ai * dt
    mag = jnp.exp(ldr)
    abar_re, abar_im = mag * jnp.cos(ldi), mag * jnp.sin(ldi)
    nr, ni = abar_re - 1.0, abar_im
    den = ar * ar + ai * ai
    qr = (nr * ar + ni * ai) / den
    qi = (ni * ar - nr * ai) / den
    br = b_re.astype(jnp.float32)
    bi = b_im.astype(jnp.float32)
    bbar_re = qr[..., None] * br - qi[..., None] * bi
    bbar_im = qr[..., None] * bi + qi[..., None] * br
    return abar_re, abar_im, bbar_re, bbar_im, ldr, ldi


def _s5_scan(u, abar_re, abar_im, bbar_re, bbar_im, ldr, ldi, reverse, h0):
    n_pos = u.shape[0]
    bu_re = jnp.einsum('lbgc,gpc->lbgp', u, bbar_re)
    bu_im = jnp.einsum('lbgc,gpc->lbgp', u, bbar_im)
    a_re = jnp.broadcast_to(abar_re, (n_pos, 1) + abar_re.shape)
    a_im = jnp.broadcast_to(abar_im, (n_pos, 1) + abar_im.shape)
    _, _, h_re, h_im = lax.associative_scan(
        _complex_linear_combine, (a_re, a_im, bu_re, bu_im), reverse=reverse, axis=0)
    if h0 is not None:
        steps = jnp.arange(n_pos, dtype=jnp.float32)
        n = (n_pos - steps) if reverse else (steps + 1.0)
        n = n[:, None, None, None]
        mag = jnp.exp(ldr * n)
        ang = ldi * n
        p_re, p_im = mag * jnp.cos(ang), mag * jnp.sin(ang)
        h0_re, h0_im = h0
        h_re = h_re + p_re * h0_re - p_im * h0_im
        h_im = h_im + p_re * h0_im + p_im * h0_re
    return h_re, h_im


def _s5_readout(h_re, h_im, c_re, c_im):
    return (jnp.einsum('lbgp,gcp->lbgc', h_re, c_re.astype(jnp.float32))
            - jnp.einsum('lbgp,gcp->lbgc', h_im, c_im.astype(jnp.float32)))


def _s5_mixer(hx, hc, a_re, a_im, log_dt, b_re, b_im, c_re, c_im, d, w_glu, need_ctx_out):
    bsz = hx.shape[0]

    def to_groups(h):
        return jnp.moveaxis(h.astype(jnp.float32).reshape(bsz, h.shape[1], S5_GROUPS, S5_GROUP_CH), 1, 0)

    def from_groups(y):
        return jnp.moveaxis(y, 0, 1).reshape(bsz, y.shape[0], D_MODEL)

    def glu(y, h):
        z = jax.nn.gelu(y + d.astype(jnp.float32) * h.astype(jnp.float32)).astype(h.dtype)
        val, gate = jnp.split(z @ w_glu, 2, axis=-1)
        return val * jax.nn.sigmoid(gate)

    uc, ux = to_groups(hc), to_groups(hx)
    ys_x, ys_c = [], []
    for r, reverse in enumerate((False, True)):
        abr, abi, bbr, bbi, ldr, ldi = _s5_discretize(a_re[r], a_im[r], log_dt[r], b_re[r], b_im[r])
        hc_re, hc_im = _s5_scan(uc, abr, abi, bbr, bbi, ldr, ldi, reverse, None)
        end = 0 if reverse else -1
        hx_re, hx_im = _s5_scan(ux, abr, abi, bbr, bbi, ldr, ldi, reverse, (hc_re[end], hc_im[end]))
        ys_x.append(_s5_readout(hx_re, hx_im, c_re[r], c_im[r]))
        if need_ctx_out:
            ys_c.append(_s5_readout(hc_re, hc_im, c_re[r], c_im[r]))
    out_x = glu(from_groups(ys_x[0] + ys_x[1]), hx)
    out_c = glu(from_groups(ys_c[0] + ys_c[1]), hc) if need_ctx_out else None
    return out_x, out_c


def _attend(qn, qr, kn, kr, v):
    s = jnp.einsum('bqhd,bkhd->bhqk', qn, kn) + jnp.einsum('bqhr,bkr->bhqk', qr, kr)
    p = jax.nn.softmax(s.astype(jnp.float32), axis=-1).astype(v.dtype)
    return jnp.einsum('bhqk,bkhd->bqhd', p, v)


def _attend_blocked(qn, qr, kn, kr, v):
    bsz, n = qn.shape[:2]
    nb = n // Q_BLOCK

    def blocks(q):
        return jnp.moveaxis(q.reshape((bsz, nb, Q_BLOCK) + q.shape[2:]), 1, 0)

    o = lax.map(lambda qs: _attend(qs[0], qs[1], kn, kr, v), (blocks(qn), blocks(qr)))
    return jnp.moveaxis(o, 0, 1).reshape((bsz, n) + o.shape[3:])


def _mla_mixer(hx, hc, w_in, g_q, g_kv, w_uq, w_ukv, w_o, cos, sin, need_ctx_out):
    scale = 1.0 / math.sqrt(MLA_NOPE + MLA_ROPE)
    px, pc = hx @ w_in, hc @ w_in

    def queries(p):
        bsz, n = p.shape[:2]
        cq = _rmsnorm(p[..., :MLA_Q_RANK], g_q)
        q = (cq @ w_uq).reshape(bsz, n, MLA_HEADS, MLA_NOPE + MLA_ROPE)
        return q[..., :MLA_NOPE] * scale, q[..., MLA_NOPE:] * scale

    def keys_values(p):
        bsz, n = p.shape[:2]
        ckv = _rmsnorm(p[..., MLA_Q_RANK:MLA_Q_RANK + MLA_KV_RANK], g_kv)
        kv = (ckv @ w_ukv).reshape(bsz, n, MLA_HEADS, MLA_NOPE + MLA_V)
        return kv[..., :MLA_NOPE], p[..., MLA_Q_RANK + MLA_KV_RANK:], kv[..., MLA_NOPE:]

    kn_c, kr_c, v_c = keys_values(pc)
    kn_x, kr_x, v_x = keys_values(px)
    kr_x = _rope2d(kr_x, cos, sin)
    qn_x, qr_x = queries(px)
    qr_x = _rope2d(qr_x, cos[:, None], sin[:, None])
    kn = jnp.concatenate([kn_c, kn_x], axis=1)
    kr = jnp.concatenate([kr_c, kr_x], axis=1)
    v = jnp.concatenate([v_c, v_x], axis=1)
    o_x = _attend_blocked(qn_x, qr_x, kn, kr, v)
    bsz, n = hx.shape[:2]
    out_x = o_x.reshape(bsz, n, MLA_HEADS * MLA_V) @ w_o
    out_c = None
    if need_ctx_out:
        qn_c, qr_c = queries(pc)
        o_c = _attend(qn_c, qr_c, kn_c, kr_c, v_c)
        out_c = o_c.reshape(bsz, hc.shape[1], MLA_HEADS * MLA_V) @ w_o
    return out_x, out_c


def _hier_moe(h, w_group, b_group, w_expert, b_expert, w_gate_up, w_down):
    shape = h.shape
    t = h.reshape(-1, shape[-1])
    p_group = jax.nn.softmax((t @ w_group + b_group).astype(jnp.float32), axis=-1)
    p_g, g_idx = lax.top_k(p_group, 1)
    logits_e = jnp.einsum('td,gde->tge', t, w_expert) + b_expert
    logits_e = jnp.take_along_axis(logits_e, g_idx[:, :, None], axis=1)[:, 0]
    p_e, e_idx = lax.top_k(jax.nn.softmax(logits_e.astype(jnp.float32), axis=-1), MOE_TOP_K)
    p_e = p_e / jnp.sum(p_e, axis=-1, keepdims=True)
    weights = p_g * p_e
    flat = g_idx * MOE_EXPERTS + e_idx
    combine = jnp.sum(jax.nn.one_hot(flat, MOE_N_EXPERTS, dtype=jnp.float32) * weights[..., None],
                      axis=1).astype(t.dtype)
    y = jnp.zeros_like(t)
    for e in range(MOE_N_EXPERTS):
        gate, up = jnp.split(t @ w_gate_up[e], 2, axis=-1)
        y = y + combine[:, e:e + 1] * ((jax.nn.silu(gate) * up) @ w_down[e])
    return y.reshape(shape)


def setup_inputs(seed: int = 0) -> dict:
    key = jax.random.key(seed)
    ks = iter(jax.random.split(key, 40))
    f32 = jnp.float32

    def nrm(shape, scale):
        return jax.random.normal(next(ks), shape, f32) * scale

    D = D_MODEL
    nA, nB = N_S5_LAYERS, N_MLA_LAYERS
    G, P, C = S5_GROUPS, S5_STATE, S5_GROUP_CH
    H = MLA_HEADS
    inp = {}
    inp['x'] = nrm((BATCH, SEQ, D), 1.0)
    inp['c'] = nrm((BATCH, D), 1.0)
    inp['ctx'] = nrm((BATCH, CTX_LEN, D), 1.0)
    inp['c_ctx'] = nrm((D,), 1.0)
    inp['ada_w'] = nrm((DEPTH, D, ADA_CHUNKS * D), 0.5 * D ** -0.5)
    inp['ada_b'] = nrm((DEPTH, ADA_CHUNKS * D), 0.02)
    inp['norm_mix_g'] = 1.0 + nrm((DEPTH, D), 0.05)
    inp['norm_ffn_g'] = 1.0 + nrm((DEPTH, D), 0.05)
    inp['s5_a_re'] = -0.5 + nrm((nA, 2, G, P), 0.01)
    inp['s5_a_im'] = jnp.broadcast_to(math.pi * jnp.arange(P, dtype=f32), (nA, 2, G, P))
    inp['s5_log_dt'] = jax.random.uniform(next(ks), (nA, 2, G), f32,
                                          math.log(S5_DT_MIN), math.log(S5_DT_MAX))
    inp['s5_b_re'] = nrm((nA, 2, G, P, C), (2 * C) ** -0.5)
    inp['s5_b_im'] = nrm((nA, 2, G, P, C), (2 * C) ** -0.5)
    inp['s5_c_re'] = nrm((nA, 2, G, C, P), P ** -0.5)
    inp['s5_c_im'] = nrm((nA, 2, G, C, P), P ** -0.5)
    inp['s5_d'] = nrm((nA, D), 1.0)
    inp['s5_w_glu'] = nrm((nA, D, 2 * D), D ** -0.5)
    inp['mla_w_in'] = nrm((nB, D, MLA_Q_RANK + MLA_KV_RANK + MLA_ROPE), D ** -0.5)
    inp['mla_g_q'] = 1.0 + nrm((nB, MLA_Q_RANK), 0.05)
    inp['mla_g_kv'] = 1.0 + nrm((nB, MLA_KV_RANK), 0.05)
    inp['mla_w_uq'] = nrm((nB, MLA_Q_RANK, H * (MLA_NOPE + MLA_ROPE)), MLA_Q_RANK ** -0.5)
    inp['mla_w_ukv'] = nrm((nB, MLA_KV_RANK, H * (MLA_NOPE + MLA_V)), MLA_KV_RANK ** -0.5)
    inp['mla_w_o'] = nrm((nB, H * MLA_V, D), (H * MLA_V) ** -0.5)
    inp['moe_w_group'] = nrm((DEPTH, D, MOE_GROUPS), D ** -0.5)
    inp['moe_b_group'] = nrm((DEPTH, MOE_GROUPS), 0.01)
    inp['moe_w_expert'] = nrm((DEPTH, MOE_GROUPS, D, MOE_EXPERTS), D ** -0.5)
    inp['moe_b_expert'] = nrm((DEPTH, MOE_GROUPS, MOE_EXPERTS), 0.01)
    inp['moe_w_gate_up'] = nrm((DEPTH, MOE_N_EXPERTS, D, 2 * MOE_HIDDEN), D ** -0.5)
    inp['moe_w_down'] = nrm((DEPTH, MOE_N_EXPERTS, MOE_HIDDEN, D), MOE_HIDDEN ** -0.5)
    inp['final_g'] = 1.0 + nrm((D,), 0.05)
    return inp


def reference(x, c, ctx, c_ctx, ada_w, ada_b, norm_mix_g, norm_ffn_g,
              s5_a_re, s5_a_im, s5_log_dt, s5_b_re, s5_b_im, s5_c_re, s5_c_im, s5_d, s5_w_glu,
              mla_w_in, mla_g_q, mla_g_kv, mla_w_uq, mla_w_ukv, mla_w_o,
              moe_w_group, moe_b_group, moe_w_expert, moe_b_expert, moe_w_gate_up, moe_w_down,
              final_g):
    seq = x.shape[1]
    rows = seq // GRID_W
    cos, sin = _axial_rope_tables(rows, x.dtype)
    silu_c = jax.nn.silu(c)
    silu_cc = jax.nn.silu(c_ctx)
    for i in range(DEPTH):
        last = i == DEPTH - 1
        mod_x = (silu_c @ ada_w[i] + ada_b[i])[:, None, :]
        mod_c = silu_cc @ ada_w[i] + ada_b[i]
        sh1, sc1, g1, sh2, sc2, g2 = jnp.split(mod_x, ADA_CHUNKS, axis=-1)
        sh1c, sc1c, g1c, sh2c, sc2c, g2c = jnp.split(mod_c, ADA_CHUNKS, axis=-1)
        hx = _modulate(_rmsnorm(x, norm_mix_g[i]), sh1, sc1)
        hc = _modulate(_rmsnorm(ctx, norm_mix_g[i]), sh1c, sc1c)
        j = i // N_MIXERS
        if i % N_MIXERS == 0:
            ox, oc = _s5_mixer(hx, hc, s5_a_re[j], s5_a_im[j], s5_log_dt[j], s5_b_re[j], s5_b_im[j],
                               s5_c_re[j], s5_c_im[j], s5_d[j], s5_w_glu[j], not last)
        else:
            ox, oc = _mla_mixer(hx, hc, mla_w_in[j], mla_g_q[j], mla_g_kv[j], mla_w_uq[j],
                                mla_w_ukv[j], mla_w_o[j], cos, sin, not last)
        x = x + g1 * ox
        hx = _modulate(_rmsnorm(x, norm_ffn_g[i]), sh2, sc2)
        moe_params = (moe_w_group[i], moe_b_group[i], moe_w_expert[i], moe_b_expert[i],
                      moe_w_gate_up[i], moe_w_down[i])
        if last:
            x = x + g2 * _hier_moe(hx, *moe_params)
        else:
            ctx = ctx + g1c * oc
            hc = _modulate(_rmsnorm(ctx, norm_ffn_g[i]), sh2c, sc2c)
            n_ctx = hc.shape[1]
            y = _hier_moe(jnp.concatenate([hc, hx], axis=1), *moe_params)
            ctx = ctx + g2c * y[:, :n_ctx]
            x = x + g2 * y[:, n_ctx:]
    return _rmsnorm(x, final_g)
```

```cpp
#include <hip/hip_runtime.h>
#include <cstdio>
#include <cstdint>

typedef unsigned short u16;
typedef unsigned short bf16_t;

constexpr int D = 1024, NB = 16, SEQ = 2048, CTXL = 256, LTOT = 2304, T = NB * LTOT;
constexpr int SG = 64, SP = 64, SC = 16;
constexpr int QR = 384, KVR = 256, NH = 8, QKD = 192;
constexpr int NE = 32;
constexpr int MAXSLOT = 81920;
constexpr float EPS = 1e-6f;

constexpr size_t al256(size_t x) { return (x + 255) / 256 * 256; }
constexpr size_t WS_CTL = 0;
constexpr size_t CTL_BYTES = 65536;
constexpr size_t WS_MOD = WS_CTL + CTL_BYTES;
constexpr size_t WS_ROPE = WS_MOD + al256((size_t)4 * 17 * 6144 * 4);
constexpr size_t WS_X = WS_ROPE + al256((size_t)2048 * 32 * 8);
constexpr size_t WS_HX = WS_X + (size_t)T * D * 4;
constexpr size_t WS_ZO = WS_HX + (size_t)T * D * 2;
constexpr size_t WS_CQ = WS_ZO + (size_t)T * D * 2;
constexpr size_t WS_CKV = WS_CQ + (size_t)T * QR * 2;
constexpr size_t WS_SELI = WS_CKV + (size_t)T * KVR * 2;
constexpr size_t WS_SELW = WS_SELI + (size_t)T * 16;
constexpr size_t WS_LIST = WS_SELW + (size_t)T * 8;
constexpr size_t WS_SLOTROW = WS_LIST + (size_t)NE * T * 4;
constexpr size_t WS_TILEEXP = WS_SLOTROW + (size_t)MAXSLOT * 4;
constexpr size_t WS_R1 = WS_TILEEXP + 4096;
constexpr size_t R1_BYTES = (size_t)MAXSLOT * 1024 * 4;
constexpr size_t WS_YB = WS_R1 + R1_BYTES;
constexpr size_t WS_WB = WS_YB + (size_t)MAXSLOT * 1024 * 2;
constexpr size_t R1_QT = 0;
constexpr size_t R1_KT = R1_QT + (size_t)NB * NH * LTOT * QKD * 2;
constexpr size_t R1_VT = R1_KT + (size_t)NB * NH * LTOT * QKD * 2;
constexpr size_t R1_ACT = 0;
constexpr int CW_CNT = 8192;

__device__ __forceinline__ float bf2f(u16 v) { return __uint_as_float(((unsigned)v) << 16); }
__device__ __forceinline__ u16 f2bf(float f) { unsigned u = __float_as_uint(f); u += 0x7FFFu + ((u >> 16) & 1u); return (u16)(u >> 16); }
__device__ __forceinline__ float silu_f(float x) { return x / (1.f + __expf(-x)); }
__device__ __forceinline__ float sigmoid_f(float x) { return 1.f / (1.f + __expf(-x)); }
__device__ __forceinline__ float gelu_tanh(float x) { const float u = 0.7978845608028654f * (x + 0.044715f * x * x * x); const float e = __expf(2.f * u); const float t = 1.f - 2.f / (e + 1.f); return 0.5f * x * (1.f + t); }
__device__ __forceinline__ float wave_sum(float v) {
#pragma unroll
    for (int o = 32; o > 0; o >>= 1) v += __shfl_xor(v, o);
    return v;
}

struct Ptrs { const float* in[30]; float* out; unsigned char* ws; };

__global__ __launch_bounds__(256) void k_mod(Ptrs P) {
    __shared__ float sc[17][64];
    const int i = blockIdx.y, col = blockIdx.x * 256 + threadIdx.x, tid = threadIdx.x;
    const float* W = P.in[4] + (size_t)i * 1024 * 6144;
    float acc[17];
#pragma unroll
    for (int r = 0; r < 17; ++r) acc[r] = 0.f;
    for (int k0 = 0; k0 < 1024; k0 += 64) {
        __syncthreads();
        for (int idx = tid; idx < 17 * 64; idx += 256) { const int r = idx >> 6, kk = idx & 63; const float v = r < 16 ? P.in[1][r * 1024 + k0 + kk] : P.in[3][k0 + kk]; sc[r][kk] = silu_f(v); }
        __syncthreads();
#pragma unroll 8
        for (int kk = 0; kk < 64; ++kk) { const float w = W[(size_t)(k0 + kk) * 6144 + col];
#pragma unroll
            for (int r = 0; r < 17; ++r) acc[r] += sc[r][kk] * w; }
    }
    float* mod = (float*)(P.ws + WS_MOD);
    const float bb = P.in[5][i * 6144 + col];
#pragma unroll
    for (int r = 0; r < 17; ++r) mod[(size_t)(i * 17 + r) * 6144 + col] = acc[r] + bb;
}
__global__ __launch_bounds__(256) void k_init(Ptrs P) {
    float4* X = (float4*)(P.ws + WS_X);
    const size_t n4 = (size_t)T * D / 4;
    for (size_t i = (size_t)blockIdx.x * 256 + threadIdx.x; i < n4; i += (size_t)gridDim.x * 256) {
        const size_t row = i / 256, c4 = i % 256; const int b = (int)(row / LTOT), pos = (int)(row % LTOT);
        X[i] = pos < CTXL ? ((const float4*)P.in[2])[((size_t)b * CTXL + pos) * 256 + c4] : ((const float4*)P.in[0])[((size_t)b * SEQ + (pos - CTXL)) * 256 + c4];
    }
    float2* rope = (float2*)(P.ws + WS_ROPE);
    for (int i = blockIdx.x * 256 + threadIdx.x; i < 2048 * 32; i += gridDim.x * 256) {
        const int s = i >> 5, k = i & 31, f = k & 15; const float invf = exp2f(-(float)f * (13.287712379549449f / 16.f));
        const float ang = (float)(k < 16 ? (s >> 6) : (s & 63)) * invf;
        rope[i] = make_float2(__cosf(ang), __sinf(ang));
    }
}

template <int MODE>
__device__ __forceinline__ void norm_rows(const Ptrs& P, int li, int which, int nwaves_blk) {
    const int lane = threadIdx.x & 63, wave = threadIdx.x >> 6;
    float* X = (float*)(P.ws + WS_X);
    const float* mod = (const float*)(P.ws + WS_MOD);
    __shared__ int s_base[33];
    if (MODE & 1) {
        if (threadIdx.x == 0) { const unsigned* cnt = (const unsigned*)(P.ws + WS_CTL) + CW_CNT + (li - 1) * 32; int a = 0; for (int e = 0; e < 32; ++e) { s_base[e] = a; a += (int)((cnt[e] + 255u) / 256u); } s_base[32] = a; }
        __syncthreads();
    }
    const bool lastl = (li == 3);
    for (int row = blockIdx.x * nwaves_blk + wave; row < T; row += gridDim.x * nwaves_blk) {
        const int b = row / LTOT, pos = row % LTOT; const bool isctx = pos < CTXL; const int r = isctx ? 16 : b;
        if ((MODE & 16) && isctx) continue;
        if ((MODE & 8) && lastl && isctx) continue;
        float4 v[4];
#pragma unroll
        for (int q = 0; q < 4; ++q) v[q] = *(const float4*)(X + (size_t)row * D + q * 256 + lane * 4);
        if (MODE & 1) {
            const bool skip = (li - 1 == 3) && isctx;
            if (!skip) {
                const int4 si = *(const int4*)(P.ws + WS_SELI + (size_t)row * 16); const float2 sw = *(const float2*)(P.ws + WS_SELW + (size_t)row * 8);
                const size_t g1 = (size_t)s_base[si.x] * 256 + si.y, g2 = (size_t)s_base[si.z] * 256 + si.w;
                const u16* YB = (const u16*)(P.ws + WS_YB);
                const float* gate = mod + (size_t)((li - 1) * 17 + r) * 6144 + 5 * 1024;
#pragma unroll
                for (int q = 0; q < 4; ++q) { const int c = q * 256 + lane * 4;
                    const uint2 ya = *(const uint2*)(YB + g1 * 1024 + c), yb = *(const uint2*)(YB + g2 * 1024 + c); const float4 gg = *(const float4*)(gate + c);
                    v[q].x += gg.x * (sw.x * bf2f((u16)(ya.x & 0xffff)) + sw.y * bf2f((u16)(yb.x & 0xffff)));
                    v[q].y += gg.y * (sw.x * bf2f((u16)(ya.x >> 16)) + sw.y * bf2f((u16)(yb.x >> 16)));
                    v[q].z += gg.z * (sw.x * bf2f((u16)(ya.y & 0xffff)) + sw.y * bf2f((u16)(yb.y & 0xffff)));
                    v[q].w += gg.w * (sw.x * bf2f((u16)(ya.y >> 16)) + sw.y * bf2f((u16)(yb.y >> 16)));
                    if (!(MODE & 16)) *(float4*)(X + (size_t)row * D + c) = v[q]; }
            }
        }
        float ss = 0.f;
#pragma unroll
        for (int q = 0; q < 4; ++q) ss += v[q].x * v[q].x + v[q].y * v[q].y + v[q].z * v[q].z + v[q].w * v[q].w;
        ss = wave_sum(ss);
        const float rstd = rsqrtf(ss * (1.f / 1024.f) + EPS);
        if (MODE & 16) {
            float* out = P.out + ((size_t)b * SEQ + (pos - CTXL)) * D;
#pragma unroll
            for (int q = 0; q < 4; ++q) { const int c = q * 256 + lane * 4; const float4 g = *(const float4*)(P.in[29] + c);
                *(float4*)(out + c) = make_float4(v[q].x * rstd * g.x, v[q].y * rstd * g.y, v[q].z * rstd * g.z, v[q].w * rstd * g.w); }
            continue;
        }
        const float* gv = P.in[which ? 7 : 6] + li * 1024;
        const float* sh = mod + (size_t)(li * 17 + r) * 6144 + (which ? 3 : 0) * 1024; const float* scl = sh + 1024;
        float h[16];
#pragma unroll
        for (int q = 0; q < 4; ++q) { const int c = q * 256 + lane * 4; const float4 g = *(const float4*)(gv + c), s4 = *(const float4*)(sh + c), c4 = *(const float4*)(scl + c);
            h[q * 4 + 0] = v[q].x * rstd * g.x * (1.f + c4.x) + s4.x; h[q * 4 + 1] = v[q].y * rstd * g.y * (1.f + c4.y) + s4.y;
            h[q * 4 + 2] = v[q].z * rstd * g.z * (1.f + c4.z) + s4.z; h[q * 4 + 3] = v[q].w * rstd * g.w * (1.f + c4.w) + s4.w; }
        if (MODE & 2) {
            u16* HX = (u16*)(P.ws + WS_HX);
#pragma unroll
            for (int q = 0; q < 4; ++q) { uint2 w; w.x = (unsigned)f2bf(h[q * 4]) | ((unsigned)f2bf(h[q * 4 + 1]) << 16); w.y = (unsigned)f2bf(h[q * 4 + 2]) | ((unsigned)f2bf(h[q * 4 + 3]) << 16);
                *(uint2*)(HX + (size_t)row * D + q * 256 + lane * 4) = w; }
        }
        if (MODE & 8) {
            const float* wg = P.in[23] + (size_t)li * 1024 * 4;
            float lg[4] = {0.f, 0.f, 0.f, 0.f};
#pragma unroll
            for (int q = 0; q < 4; ++q)
#pragma unroll
                for (int j = 0; j < 4; ++j) { const int k = q * 256 + lane * 4 + j; const float4 w = *(const float4*)(wg + k * 4); const float hv = h[q * 4 + j];
                    lg[0] += hv * w.x; lg[1] += hv * w.y; lg[2] += hv * w.z; lg[3] += hv * w.w; }
#pragma unroll
            for (int g = 0; g < 4; ++g) lg[g] = wave_sum(lg[g]) + P.in[24][li * 4 + g];
            int gi = 0; float best = lg[0];
#pragma unroll
            for (int g = 1; g < 4; ++g) if (lg[g] > best) { best = lg[g]; gi = g; }
            float den = 0.f;
#pragma unroll
            for (int g = 0; g < 4; ++g) den += __expf(lg[g] - best);
            const float pg = 1.f / den;
            const float* we = P.in[25] + ((size_t)li * 4 + gi) * 1024 * 8;
            float le[8];
#pragma unroll
            for (int e = 0; e < 8; ++e) le[e] = 0.f;
#pragma unroll
            for (int q = 0; q < 4; ++q)
#pragma unroll
                for (int j = 0; j < 4; ++j) { const int k = q * 256 + lane * 4 + j; const float4 w0 = *(const float4*)(we + k * 8), w1 = *(const float4*)(we + k * 8 + 4); const float hv = h[q * 4 + j];
                    le[0] += hv * w0.x; le[1] += hv * w0.y; le[2] += hv * w0.z; le[3] += hv * w0.w; le[4] += hv * w1.x; le[5] += hv * w1.y; le[6] += hv * w1.z; le[7] += hv * w1.w; }
#pragma unroll
            for (int e = 0; e < 8; ++e) le[e] = wave_sum(le[e]) + P.in[26][(li * 4 + gi) * 8 + e];
            int i1 = 0; float b1 = le[0];
#pragma unroll
            for (int e = 1; e < 8; ++e) if (le[e] > b1) { b1 = le[e]; i1 = e; }
            int i2 = -1; float b2 = -3.0e38f;
#pragma unroll
            for (int e = 0; e < 8; ++e) if (e != i1 && le[e] > b2) { b2 = le[e]; i2 = e; }
            if (lane == 0) {
                const float ex = __expf(b2 - b1); const float w1 = 1.f / (1.f + ex), w2 = ex / (1.f + ex);
                unsigned* cnt = (unsigned*)(P.ws + WS_CTL) + CW_CNT + li * 32; int* list = (int*)(P.ws + WS_LIST);
                const int e1 = gi * 8 + i1, e2 = gi * 8 + i2;
                const int s1 = (int)atomicAdd(&cnt[e1], 1u), s2 = (int)atomicAdd(&cnt[e2], 1u);
                list[(size_t)e1 * T + s1] = row; list[(size_t)e2 * T + s2] = row;
                *(int4*)(P.ws + WS_SELI + (size_t)row * 16) = make_int4(e1, s1, e2, s2);
                *(float2*)(P.ws + WS_SELW + (size_t)row * 8) = make_float2(pg * w1, pg * w2);
            }
        }
    }
}
template <int MODE> __global__ __launch_bounds__(256) void k_norm(Ptrs P, int li, int which) { norm_rows<MODE>(P, li, which, 4); }

struct NG { const void* A; int lda; const int* rowidx; const float* B; int ldb; long bstride; const int* tileexp; const int* mdyn; float* C; int ldc; int M, N, K, pad; };
template <int ABF> __global__ __launch_bounds__(256) void n_gemm(NG g) {
    __shared__ float As[16][68], Bs[16][68];
    const int tm = blockIdx.y, tn = blockIdx.x, tid = threadIdx.x, tx = tid & 15, ty = tid >> 4;
    const int M = g.mdyn ? (*g.mdyn) * 256 : g.M;
    if (tm * 64 >= M) return;
    const float* B = g.B; if (g.tileexp) B += (long)g.tileexp[(tm * 64) / 256] * g.bstride;
    float acc[4][4];
#pragma unroll
    for (int i = 0; i < 4; ++i)
#pragma unroll
        for (int j = 0; j < 4; ++j) acc[i][j] = 0.f;
    const int arow = tm * 64 + (tid >> 2), ak = (tid & 3) * 4; long asrc = -1;
    if (arow < M) { const int r = g.rowidx ? g.rowidx[arow] : arow; if (r >= 0) asrc = (long)r * g.lda; }
    for (int k0 = 0; k0 < g.K; k0 += 16) {
        float a[4] = {0.f, 0.f, 0.f, 0.f};
        if (asrc >= 0) {
            if (ABF) { const uint2 w = *(const uint2*)((const u16*)g.A + asrc + k0 + ak); a[0] = bf2f((u16)(w.x & 0xffff)); a[1] = bf2f((u16)(w.x >> 16)); a[2] = bf2f((u16)(w.y & 0xffff)); a[3] = bf2f((u16)(w.y >> 16)); }
            else { const float4 w = *(const float4*)((const float*)g.A + asrc + k0 + ak); a[0] = w.x; a[1] = w.y; a[2] = w.z; a[3] = w.w; }
        }
        const float4 bv = *(const float4*)(B + (size_t)(k0 + (tid >> 4)) * g.ldb + tn * 64 + (tid & 15) * 4);
        __syncthreads();
#pragma unroll
        for (int i = 0; i < 4; ++i) As[ak + i][tid >> 2] = a[i];
        *(float4*)&Bs[tid >> 4][(tid & 15) * 4] = bv;
        __syncthreads();
#pragma unroll
        for (int kk = 0; kk < 16; ++kk) { const float4 a4 = *(const float4*)&As[kk][ty * 4], b4 = *(const float4*)&Bs[kk][tx * 4];
            const float av[4] = {a4.x, a4.y, a4.z, a4.w}, bw[4] = {b4.x, b4.y, b4.z, b4.w};
#pragma unroll
            for (int i = 0; i < 4; ++i)
#pragma unroll
                for (int j = 0; j < 4; ++j) acc[i][j] += av[i] * bw[j]; }
    }
#pragma unroll
    for (int i = 0; i < 4; ++i) { const int row = tm * 64 + ty * 4 + i; if (row < M) *(float4*)(g.C + (size_t)row * g.ldc + tn * 64 + tx * 4) = make_float4(acc[i][0], acc[i][1], acc[i][2], acc[i][3]); }
}
__device__ __forceinline__ int row_r(int row) { return (row % LTOT) < CTXL ? 16 : row / LTOT; }
__global__ __launch_bounds__(256) void n_post_glu(Ptrs P, int li) {
    float* X = (float*)(P.ws + WS_X); const float* TMP = (const float*)(P.ws + WS_R1); const float* mod = (const float*)(P.ws + WS_MOD);
    for (size_t i = (size_t)blockIdx.x * 256 + threadIdx.x; i < (size_t)T * D; i += (size_t)gridDim.x * 256) { const int row = (int)(i >> 10), c = (int)(i & 1023); const int r = row_r(row);
        const float val = TMP[(size_t)row * 2048 + c], gt = TMP[(size_t)row * 2048 + 1024 + c]; X[i] += mod[(size_t)(li * 17 + r) * 6144 + 2048 + c] * val * sigmoid_f(gt); }
}
__global__ __launch_bounds__(256) void n_post_wo(Ptrs P, int li) {
    float* X = (float*)(P.ws + WS_X); const float* TMP = (const float*)(P.ws + WS_R1); const float* mod = (const float*)(P.ws + WS_MOD);
    for (size_t i = (size_t)blockIdx.x * 256 + threadIdx.x; i < (size_t)T * D; i += (size_t)gridDim.x * 256) { const int row = (int)(i >> 10), c = (int)(i & 1023); const int r = row_r(row);
        X[i] += mod[(size_t)(li * 17 + r) * 6144 + 2048 + c] * TMP[i]; }
}
__global__ __launch_bounds__(256) void n_post_win(Ptrs P, int j) {
    const int lane = threadIdx.x & 63, wave = threadIdx.x >> 6;
    const float* TMP = (const float*)(P.ws + WS_YB); u16* CQ = (u16*)(P.ws + WS_CQ); u16* CKV = (u16*)(P.ws + WS_CKV); u16* KT = (u16*)(P.ws + WS_R1 + R1_KT);
    const float2* rope = (const float2*)(P.ws + WS_ROPE);
    for (int row = blockIdx.x * 4 + wave; row < T; row += gridDim.x * 4) {
        const float* t = TMP + (size_t)row * 704; const int b = row / LTOT, pos = row % LTOT;
        float q[6]; float ss = 0.f;
#pragma unroll
        for (int i = 0; i < 6; ++i) { q[i] = t[i * 64 + lane]; ss += q[i] * q[i]; }
        ss = wave_sum(ss); float rstd = rsqrtf(ss * (1.f / 384.f) + EPS);
#pragma unroll
        for (int i = 0; i < 6; ++i) CQ[(size_t)row * QR + i * 64 + lane] = f2bf(q[i] * rstd * P.in[18][j * QR + i * 64 + lane]);
        float k[4]; ss = 0.f;
#pragma unroll
        for (int i = 0; i < 4; ++i) { k[i] = t[384 + i * 64 + lane]; ss += k[i] * k[i]; }
        ss = wave_sum(ss); rstd = rsqrtf(ss * (1.f / 256.f) + EPS);
#pragma unroll
        for (int i = 0; i < 4; ++i) CKV[(size_t)row * KVR + i * 64 + lane] = f2bf(k[i] * rstd * P.in[19][j * KVR + i * 64 + lane]);
        float v = t[640 + lane];
        if (pos >= CTXL) { const float pv = t[640 + (lane ^ 16)]; const float2 cs = rope[(size_t)(pos - CTXL) * 32 + (lane >> 5) * 16 + (lane & 15)];
            v = (lane & 16) ? v * cs.x + pv * cs.y : v * cs.x - pv * cs.y; }
        const u16 kb = f2bf(v);
#pragma unroll
        for (int h = 0; h < NH; ++h) KT[(((size_t)b * NH + h) * LTOT + pos) * QKD + 128 + lane] = kb;
    }
}
__global__ __launch_bounds__(256) void n_post_q(Ptrs P) {
    const float* TMP = (const float*)(P.ws + WS_YB); u16* QT = (u16*)(P.ws + WS_R1 + R1_QT); const float2* rope = (const float2*)(P.ws + WS_ROPE);
    const float scale = 0.07216878364870322f;
    for (size_t i = (size_t)blockIdx.x * 256 + threadIdx.x; i < (size_t)T * 1536; i += (size_t)gridDim.x * 256) { const int row = (int)(i / 1536), c = (int)(i % 1536); const int h = c / 192, dd = c % 192;
        const int b = row / LTOT, pos = row % LTOT; float v = TMP[i];
        if (dd >= 128 && pos >= CTXL) { const int l = dd - 128; const float pv = TMP[(size_t)row * 1536 + h * 192 + 128 + (l ^ 16)]; const float2 cs = rope[(size_t)(pos - CTXL) * 32 + (l >> 5) * 16 + (l & 15)];
            v = (l & 16) ? v * cs.x + pv * cs.y : v * cs.x - pv * cs.y; }
        QT[(((size_t)b * NH + h) * LTOT + pos) * QKD + dd] = f2bf(v * scale); }
}
__global__ __launch_bounds__(256) void n_post_kv(Ptrs P) {
    const float* TMP = (const float*)(P.ws + WS_YB); u16* KT = (u16*)(P.ws + WS_R1 + R1_KT); u16* VT = (u16*)(P.ws + WS_R1 + R1_VT);
    for (size_t i = (size_t)blockIdx.x * 256 + threadIdx.x; i < (size_t)T * 2048; i += (size_t)gridDim.x * 256) { const int row = (int)(i >> 11), c = (int)(i & 2047); const int h = c >> 8, dd = c & 255;
        const int b = row / LTOT, pos = row % LTOT; const u16 v = f2bf(TMP[i]);
        if (dd < 128) KT[(((size_t)b * NH + h) * LTOT + pos) * QKD + dd] = v; else VT[(((size_t)b * NH + h) * LTOT + pos) * 128 + dd - 128] = v; }
}
__global__ __launch_bounds__(256) void n_attn(Ptrs P) {
    __shared__ float Ks[32][192], Vs[32][128];
    const int qt = blockIdx.x, h = blockIdx.y, b = blockIdx.z, tid = threadIdx.x, ql = tid >> 2, part = tid & 3;
    const u16* QT = (const u16*)(P.ws + WS_R1 + R1_QT) + ((size_t)b * NH + h) * LTOT * QKD; const u16* KT = (const u16*)(P.ws + WS_R1 + R1_KT) + ((size_t)b * NH + h) * LTOT * QKD;
    const u16* VT = (const u16*)(P.ws + WS_R1 + R1_VT) + ((size_t)b * NH + h) * LTOT * 128; u16* O = (u16*)(P.ws + WS_ZO);
    const int pos = qt * 64 + ql; const int nk = (qt * 64 < CTXL) ? CTXL : LTOT;
    float q[48], o[32];
#pragma unroll
    for (int i = 0; i < 48; ++i) q[i] = bf2f(QT[(size_t)pos * QKD + part * 48 + i]);
#pragma unroll
    for (int i = 0; i < 32; ++i) o[i] = 0.f;
    float m = -1e30f, l = 0.f;
    for (int k0 = 0; k0 < nk; k0 += 32) {
        __syncthreads();
        for (int i = tid; i < 32 * 192; i += 256) Ks[i / 192][i % 192] = bf2f(KT[(size_t)k0 * QKD + i]);
        for (int i = tid; i < 32 * 128; i += 256) Vs[i / 128][i % 128] = bf2f(VT[(size_t)k0 * 128 + i]);
        __syncthreads();
        for (int kk = 0; kk < 32; ++kk) {
            float s = 0.f;
#pragma unroll
            for (int i = 0; i < 48; ++i) s += q[i] * Ks[kk][part * 48 + i];
            s += __shfl_xor(s, 1); s += __shfl_xor(s, 2);
            const float mn = fmaxf(m, s), al = __expf(m - mn), p = __expf(s - mn);
            l = l * al + p; m = mn;
#pragma unroll
            for (int i = 0; i < 32; ++i) o[i] = o[i] * al + p * Vs[kk][part * 32 + i];
        }
    }
    const float rl = 1.f / l;
#pragma unroll
    for (int i = 0; i < 32; ++i) O[((size_t)b * LTOT + pos) * D + h * 128 + part * 32 + i] = f2bf(o[i] * rl);
}
__global__ __launch_bounds__(128) void n_s5(Ptrs P, int j) {
    __shared__ float us[2][16], hre[2][64], him[2][64], Cre[2][16][64], Cim[2][16][64];
    const int b = blockIdx.x >> 6, g = blockIdx.x & 63, tid = threadIdx.x, dir = tid >> 6, p = tid & 63;
    const size_t gd = ((size_t)j * 2 + dir) * SG + g;
    const float dt = __expf(P.in[10][gd]); const float ar = P.in[8][gd * SP + p], ai = P.in[9][gd * SP + p];
    const float ldr = ar * dt, ldi = ai * dt, mag = __expf(ldr); const float abr = mag * __cosf(ldi), abi = mag * __sinf(ldi);
    const float nr = abr - 1.f, ni = abi, den = ar * ar + ai * ai; const float qr = (nr * ar + ni * ai) / den, qi = (ni * ar - nr * ai) / den;
    float bbr[16], bbi[16];
#pragma unroll
    for (int c = 0; c < 16; ++c) { const float br = P.in[11][(gd * SP + p) * SC + c], bi = P.in[12][(gd * SP + p) * SC + c]; bbr[c] = qr * br - qi * bi; bbi[c] = qr * bi + qi * br; }
    for (int i = tid; i < 2 * 16 * 64; i += 128) { const int d2 = i >> 10, c = (i >> 6) & 15, pp = i & 63; const size_t o = ((((size_t)j * 2 + d2) * SG + g) * SC + c) * SP + pp; Cre[d2][c][pp] = P.in[13][o]; Cim[d2][c][pp] = P.in[14][o]; }
    const u16* HX = (const u16*)(P.ws + WS_HX); float* Yf = (float*)(P.ws + WS_R1); float* Yr = Yf + (size_t)T * D;
    float hr = 0.f, hi = 0.f;
    for (int t = 0; t < LTOT; ++t) {
        __syncthreads();
        if (tid < 32) { const int d2 = tid >> 4, c = tid & 15; const int ps = d2 ? (t < CTXL ? CTXL - 1 - t : LTOT - 1 - (t - CTXL)) : t; us[d2][c] = bf2f(HX[((size_t)b * LTOT + ps) * D + g * 16 + c]); }
        __syncthreads();
        float bur = 0.f, bui = 0.f;
#pragma unroll
        for (int c = 0; c < 16; ++c) { bur += bbr[c] * us[dir][c]; bui += bbi[c] * us[dir][c]; }
        const float nhr = abr * hr - abi * hi + bur, nhi = abr * hi + abi * hr + bui; hr = nhr; hi = nhi;
        hre[dir][p] = hr; him[dir][p] = hi;
        __syncthreads();
        if (tid < 32) { const int d2 = tid >> 4, c = tid & 15; const int ps = d2 ? (t < CTXL ? CTXL - 1 - t : LTOT - 1 - (t - CTXL)) : t; float y = 0.f;
            for (int pp = 0; pp < 64; ++pp) y += Cre[d2][c][pp] * hre[d2][pp] - Cim[d2][c][pp] * him[d2][pp];
            (d2 ? Yr : Yf)[((size_t)b * LTOT + ps) * D + g * 16 + c] = y; }
    }
}
__global__ __launch_bounds__(256) void n_post_s5(Ptrs P, int j) {
    const float* Yf = (const float*)(P.ws + WS_R1); const float* Yr = Yf + (size_t)T * D; const u16* HX = (const u16*)(P.ws + WS_HX); u16* Z = (u16*)(P.ws + WS_ZO);
    for (size_t i = (size_t)blockIdx.x * 256 + threadIdx.x; i < (size_t)T * D; i += (size_t)gridDim.x * 256) { const int c = (int)(i & 1023);
        Z[i] = f2bf(gelu_tanh(Yf[i] + Yr[i] + P.in[15][j * 1024 + c] * bf2f(HX[i]))); }
}
__global__ __launch_bounds__(256) void n_build(Ptrs P, int li) {
    __shared__ int base[33];
    const unsigned* cnt = (const unsigned*)(P.ws + WS_CTL) + CW_CNT + li * 32; int* tileexp = (int*)(P.ws + WS_TILEEXP); int* slotrow = (int*)(P.ws + WS_SLOTROW); const int* list = (const int*)(P.ws + WS_LIST);
    if (threadIdx.x == 0) { int a = 0; for (int e = 0; e < 32; ++e) { base[e] = a; a += (int)((cnt[e] + 255u) / 256u); } base[32] = a; tileexp[512] = a; }
    __syncthreads();
    for (int e = 0; e < 32; ++e) { const int nt = base[e + 1] - base[e];
        for (int t = threadIdx.x; t < nt; t += 256) tileexp[base[e] + t] = e;
        for (int s = threadIdx.x; s < nt * 256; s += 256) slotrow[base[e] * 256 + s] = s < (int)cnt[e] ? list[(size_t)e * T + s] : -1; }
}
__global__ __launch_bounds__(256) void n_post_act2(Ptrs P, u16* ACT) {
    const float* TMP = (const float*)(P.ws + WS_R1); const int ntot = ((const int*)(P.ws + WS_TILEEXP))[512];
    for (size_t i = (size_t)blockIdx.x * 256 + threadIdx.x; i < (size_t)ntot * 256 * 512; i += (size_t)gridDim.x * 256) { const size_t gs = i >> 9; const int c = (int)(i & 511);
        ACT[i] = f2bf(silu_f(TMP[gs * 1024 + c]) * TMP[gs * 1024 + 512 + c]); }
}
__global__ __launch_bounds__(256) void n_post_y(Ptrs P) {
    const float* TMP = (const float*)(P.ws + WS_R1); u16* YB = (u16*)(P.ws + WS_YB); const int ntot = ((const int*)(P.ws + WS_TILEEXP))[512];
    for (size_t i = (size_t)blockIdx.x * 256 + threadIdx.x; i < (size_t)ntot * 256 * 1024; i += (size_t)gridDim.x * 256) YB[i] = f2bf(TMP[i]);
}

static void gemm_naive(hipStream_t st, bool abf, const void* A, int lda, const int* rowidx, const float* B, int ldb, long bstride, const int* tileexp, const int* mdyn, float* C, int ldc, int M, int N, int K) {
    NG g{}; g.A = A; g.lda = lda; g.rowidx = rowidx; g.B = B; g.ldb = ldb; g.bstride = bstride; g.tileexp = tileexp; g.mdyn = mdyn; g.C = C; g.ldc = ldc; g.M = M; g.N = N; g.K = K; g.pad = 0;
    dim3 grid(N / 64, (M + 63) / 64);
    if (abf) hipLaunchKernelGGL(n_gemm<1>, grid, dim3(256), 0, st, g); else hipLaunchKernelGGL(n_gemm<0>, grid, dim3(256), 0, st, g);
}

extern "C" void kernel_launch(void* const* d_in, const int* in_sizes, int n_in, void* d_out, int out_size, void* d_ws, size_t ws_size, hipStream_t stream) {
    if (n_in != 30 || out_size != NB * SEQ * D || ws_size < WS_WB) { fprintf(stderr, "kernel_launch: unexpected shapes n_in %d out %d ws %zu (need %zu)\n", n_in, out_size, ws_size, (size_t)WS_WB); return; }
    Ptrs P{}; for (int i = 0; i < 30; ++i) P.in[i] = (const float*)d_in[i]; P.out = (float*)d_out; P.ws = (unsigned char*)d_ws;
    unsigned char* ws = P.ws;
    hipMemsetAsync(ws + WS_CTL, 0, CTL_BYTES, stream);
    hipLaunchKernelGGL(k_mod, dim3(24, 4), dim3(256), 0, stream, P);
    hipLaunchKernelGGL(k_init, dim3(2048), dim3(256), 0, stream, P);
    const int NG_ = 4096;
    for (int li = 0; li < 4; ++li) {
        const int j = li >> 1;
        if (li == 0) hipLaunchKernelGGL(k_norm<2>, dim3(2048), dim3(256), 0, stream, P, li, 0);
        else hipLaunchKernelGGL(k_norm<3>, dim3(2048), dim3(256), 0, stream, P, li, 0);
        if ((li & 1) == 0) {
            hipLaunchKernelGGL(n_s5, dim3(NB * SG), dim3(128), 0, stream, P, j);
            hipLaunchKernelGGL(n_post_s5, dim3(NG_), dim3(256), 0, stream, P, j);
            gemm_naive(stream, true, ws + WS_ZO, D, nullptr, P.in[16] + (size_t)j * 1024 * 2048, 2048, 0, nullptr, nullptr, (float*)(ws + WS_R1), 2048, T, 2048, 1024);
            hipLaunchKernelGGL(n_post_glu, dim3(NG_), dim3(256), 0, stream, P, li);
        } else {
            float* TMP2 = (float*)(ws + WS_YB);
            gemm_naive(stream, true, ws + WS_HX, D, nullptr, P.in[17] + (size_t)j * 1024 * 704, 704, 0, nullptr, nullptr, TMP2, 704, T, 704, 1024);
            hipLaunchKernelGGL(n_post_win, dim3(2048), dim3(256), 0, stream, P, j);
            gemm_naive(stream, true, ws + WS_CQ, QR, nullptr, P.in[20] + (size_t)j * 384 * 1536, 1536, 0, nullptr, nullptr, TMP2, 1536, T, 1536, 384);
            hipLaunchKernelGGL(n_post_q, dim3(NG_), dim3(256), 0, stream, P);
            gemm_naive(stream, true, ws + WS_CKV, KVR, nullptr, P.in[21] + (size_t)j * 256 * 2048, 2048, 0, nullptr, nullptr, TMP2, 2048, T, 2048, 256);
            hipLaunchKernelGGL(n_post_kv, dim3(NG_), dim3(256), 0, stream, P);
            hipLaunchKernelGGL(n_attn, dim3(LTOT / 64, NH, NB), dim3(256), 0, stream, P);
            gemm_naive(stream, true, ws + WS_ZO, D, nullptr, P.in[22] + (size_t)j * 1024 * 1024, 1024, 0, nullptr, nullptr, (float*)(ws + WS_R1), 1024, T, 1024, 1024);
            hipLaunchKernelGGL(n_post_wo, dim3(NG_), dim3(256), 0, stream, P, li);
        }
        hipLaunchKernelGGL(k_norm<10>, dim3(2048), dim3(256), 0, stream, P, li, 1);
        hipLaunchKernelGGL(n_build, dim3(1), dim3(256), 0, stream, P, li);
        const int* tileexp = (const int*)(ws + WS_TILEEXP);
        gemm_naive(stream, true, ws + WS_HX, D, (const int*)(ws + WS_SLOTROW), P.in[27] + (size_t)li * 32 * 1024 * 1024, 1024, 1024L * 1024, tileexp, tileexp + 512, (float*)(ws + WS_R1), 1024, MAXSLOT, 1024, 1024);
        u16* ACT = (u16*)(ws + WS_ZO);
        hipLaunchKernelGGL(n_post_act2, dim3(NG_), dim3(256), 0, stream, P, ACT);
        gemm_naive(stream, true, ACT, 512, nullptr, P.in[28] + (size_t)li * 32 * 512 * 1024, 1024, 512L * 1024, tileexp, tileexp + 512, (float*)(ws + WS_R1), 1024, MAXSLOT, 1024, 512);
        hipLaunchKernelGGL(n_post_y, dim3(NG_), dim3(256), 0, stream, P);
    }
    hipLaunchKernelGGL(k_norm<17>, dim3(2048), dim3(256), 0, stream, P, 4, 0);
}
```

```cpp
#include <hip/hip_runtime.h>
#include <cstdio>
#include <cstdint>

typedef unsigned short u16;
typedef unsigned short bf16_t;

constexpr int D = 1024, NB = 16, SEQ = 2048, CTXL = 256, LTOT = 2304, T = NB * LTOT;
constexpr int SG = 64, SP = 64, SC = 16;
constexpr int QR = 384, KVR = 256, NH = 8, QKD = 192;
constexpr int NE = 32;
constexpr int MAXSLOT = 81920;
constexpr float EPS = 1e-6f;

constexpr size_t al256(size_t x) { return (x + 255) / 256 * 256; }
constexpr size_t WS_CTL = 0;
constexpr size_t CTL_BYTES = 65536;
constexpr size_t WS_MOD = WS_CTL + CTL_BYTES;
constexpr size_t MOD_BYTES = al256((size_t)4 * 17 * 6144 * 4);
constexpr size_t ZERO_BYTES = CTL_BYTES;
constexpr size_t WS_ROPE = WS_MOD + MOD_BYTES;
constexpr size_t WS_SMALL = WS_ROPE + al256((size_t)2048 * 32 * 8);
constexpr int SM_GMIX = 0, SM_GFFN = 4096, SM_S5D = 8192, SM_GQ = 10240, SM_GKV = 11008, SM_FINALG = 11520, SM_BGROUP = 12544, SM_BEXP = 12560, SM_WGROUP = 12800, SM_WEXP = 29184, SM_END = 160256;
constexpr size_t WS_X = WS_SMALL + al256((size_t)SM_END * 4);
constexpr size_t WS_HX = WS_X + (size_t)T * D * 4;
constexpr size_t WS_ZO = WS_HX + (size_t)T * D * 2;
constexpr size_t WS_CQ = WS_ZO + (size_t)T * D * 2;
constexpr size_t WS_CKV = WS_CQ + (size_t)T * QR * 2;
constexpr size_t WS_SELI = WS_CKV + (size_t)T * KVR * 2;
constexpr size_t WS_SELW = WS_SELI + (size_t)T * 16;
constexpr size_t WS_LIST = WS_SELW + (size_t)T * 8;
constexpr size_t WS_SLOTROW = WS_LIST + (size_t)NE * T * 4;
constexpr size_t WS_TILEEXP = WS_SLOTROW + (size_t)MAXSLOT * 4;
constexpr size_t WS_R1 = WS_TILEEXP + 4096;
constexpr size_t R1_BYTES = (size_t)MAXSLOT * 1024 * 4;
constexpr size_t WS_YB = WS_R1 + R1_BYTES;
constexpr size_t WS_WB = WS_YB + (size_t)MAXSLOT * 1024 * 2;
constexpr size_t R1_QT = 0;
constexpr size_t R1_KT = R1_QT + (size_t)NB * NH * LTOT * QKD * 2;
constexpr size_t R1_VT = R1_KT + (size_t)NB * NH * LTOT * QKD * 2;
constexpr size_t R1_ACT = 0;
constexpr size_t R1_S = 0;
constexpr size_t R1_UH = (size_t)64 * 2304 * 256 * 4;
constexpr size_t WB_GLU = 0;
constexpr size_t WB_WIN = WB_GLU + (size_t)2 * 2048 * 1024 * 2;
constexpr size_t WB_UQ = WB_WIN + (size_t)2 * 768 * 1024 * 2;
constexpr size_t WB_UKV = WB_UQ + (size_t)2 * 1536 * 384 * 2;
constexpr size_t WB_WO = WB_UKV + (size_t)2 * 2048 * 256 * 2;
constexpr size_t WB_GU = WB_WO + (size_t)2 * 1024 * 1024 * 2;
constexpr size_t WB_DN = WB_GU + (size_t)128 * 1024 * 1024 * 2;
constexpr size_t WB_W1 = WB_DN + (size_t)128 * 1024 * 512 * 2;
constexpr size_t WB_W2 = WB_W1 + (size_t)128 * 256 * 256 * 2;
constexpr size_t WB_AT = WB_W2 + (size_t)128 * 256 * 512 * 2;
constexpr size_t WB_END = WB_AT + (size_t)2 * 2 * 64 * 64 * 8;
constexpr size_t WS_END = WS_WB + WB_END;
constexpr size_t WS_NTMP = al256(WS_END);
constexpr size_t WS_NEND = WS_NTMP + (size_t)MAXSLOT * 1024 * 4;
static_assert(R1_UH + (size_t)64 * 2304 * 512 * 2 <= R1_BYTES, "R1");
static_assert(R1_VT + (size_t)NB * NH * LTOT * 128 * 2 <= R1_BYTES, "R1");
constexpr int CW_CNT = 14336;

__device__ __forceinline__ float bf2f(u16 v) { return __uint_as_float(((unsigned)v) << 16); }
__device__ __forceinline__ u16 f2bf(float f) { unsigned u = __float_as_uint(f); u += 0x7FFFu + ((u >> 16) & 1u); return (u16)(u >> 16); }
__device__ __forceinline__ float silu_f(float x) { return x / (1.f + __expf(-x)); }
__device__ __forceinline__ float sigmoid_f(float x) { return 1.f / (1.f + __expf(-x)); }
__device__ __forceinline__ float gelu_tanh(float x) { const float u = 0.7978845608028654f * (x + 0.044715f * x * x * x); const float e = __expf(2.f * u); const float t = 1.f - 2.f / (e + 1.f); return 0.5f * x * (1.f + t); }
__device__ __forceinline__ float wave_sum(float v) {
#pragma unroll
    for (int o = 32; o > 0; o >>= 1) v += __shfl_xor(v, o);
    return v;
}

struct Ptrs { const float* in[30]; float* out; unsigned char* ws; };
__device__ __forceinline__ int tid_opaque(int wv) { int l; asm volatile("v_mbcnt_lo_u32_b32 %0, -1, 0\n\tv_mbcnt_hi_u32_b32 %0, -1, %0" : "=v"(l)); return (wv << 6) | l; }
__device__ __forceinline__ float wave_sum_l(float v, int lane) {
#pragma unroll
    for (int o = 32; o > 0; o >>= 1) v += __int_as_float(__builtin_amdgcn_ds_bpermute((lane ^ o) << 2, __float_as_int(v)));
    return v;
}

__global__ __launch_bounds__(256) void k_mod(Ptrs P) {
    __shared__ float sc[17][64];
    const int i = blockIdx.y, col = blockIdx.x * 256 + threadIdx.x, tid = threadIdx.x;
    const float* W = P.in[4] + (size_t)i * 1024 * 6144;
    float acc[17];
#pragma unroll
    for (int r = 0; r < 17; ++r) acc[r] = 0.f;
    for (int k0 = 0; k0 < 1024; k0 += 64) {
        __syncthreads();
        for (int idx = tid; idx < 17 * 64; idx += 256) { const int r = idx >> 6, kk = idx & 63; const float v = r < 16 ? P.in[1][r * 1024 + k0 + kk] : P.in[3][k0 + kk]; sc[r][kk] = silu_f(v); }
        __syncthreads();
#pragma unroll 8
        for (int kk = 0; kk < 64; ++kk) { const float w = W[(size_t)(k0 + kk) * 6144 + col];
#pragma unroll
            for (int r = 0; r < 17; ++r) acc[r] += sc[r][kk] * w; }
    }
    float* mod = (float*)(P.ws + WS_MOD);
    const float bb = P.in[5][i * 6144 + col];
#pragma unroll
    for (int r = 0; r < 17; ++r) mod[(size_t)(i * 17 + r) * 6144 + col] = acc[r] + bb;
}
__device__ __forceinline__ void copy_small(const Ptrs& P, int t0, int nt) {
    float* sm = (float*)(P.ws + WS_SMALL);
    for (int i = t0; i < 4096; i += nt) { sm[SM_GMIX + i] = P.in[6][i]; sm[SM_GFFN + i] = P.in[7][i]; }
    for (int i = t0; i < 2048; i += nt) sm[SM_S5D + i] = P.in[15][i];
    for (int i = t0; i < 768; i += nt) sm[SM_GQ + i] = P.in[18][i];
    for (int i = t0; i < 512; i += nt) sm[SM_GKV + i] = P.in[19][i];
    for (int i = t0; i < 1024; i += nt) sm[SM_FINALG + i] = P.in[29][i];
    for (int i = t0; i < 16; i += nt) sm[SM_BGROUP + i] = P.in[24][i];
    for (int i = t0; i < 128; i += nt) sm[SM_BEXP + i] = P.in[26][i];
    for (int i = t0; i < 16384; i += nt) sm[SM_WGROUP + i] = P.in[23][i];
    for (int i = t0; i < 131072; i += nt) sm[SM_WEXP + i] = P.in[25][i];
}
__global__ __launch_bounds__(256) void k_init(Ptrs P) {
    copy_small(P, blockIdx.x * 256 + threadIdx.x, gridDim.x * 256);
    float4* X = (float4*)(P.ws + WS_X);
    const size_t n4 = (size_t)T * D / 4;
    for (size_t i = (size_t)blockIdx.x * 256 + threadIdx.x; i < n4; i += (size_t)gridDim.x * 256) {
        const size_t row = i / 256, c4 = i % 256; const int b = (int)(row / LTOT), pos = (int)(row % LTOT);
        X[i] = pos < CTXL ? ((const float4*)P.in[2])[((size_t)b * CTXL + pos) * 256 + c4] : ((const float4*)P.in[0])[((size_t)b * SEQ + (pos - CTXL)) * 256 + c4];
    }
    float2* rope = (float2*)(P.ws + WS_ROPE);
    for (int i = blockIdx.x * 256 + threadIdx.x; i < 2048 * 32; i += gridDim.x * 256) {
        const int s = i >> 5, k = i & 31, f = k & 15; const float invf = exp2f(-(float)f * (13.287712379549449f / 16.f));
        const float ang = (float)(k < 16 ? (s >> 6) : (s & 63)) * invf;
        rope[i] = make_float2(__cosf(ang), __sinf(ang));
    }
}

template <int MODE>
__device__ __forceinline__ void norm_rows(unsigned char* wsp, float* outp, int li, int which, int nwaves_blk, int* s_base, int wv) {
    struct { unsigned char* ws; float* out; } P{wsp, outp}; const float* sm = (const float*)(wsp + WS_SMALL);
    const int tidn = tid_opaque(wv); const int lane = tidn & 63, wave = tidn >> 6;
    float* X = (float*)(P.ws + WS_X);
    const float* mod = (const float*)(P.ws + WS_MOD);
    if (MODE & 1) {
        if (tidn == 0) { const unsigned* cnt = (const unsigned*)(P.ws + WS_CTL) + CW_CNT + (li - 1) * 32; int a = 0; for (int e = 0; e < 32; ++e) { s_base[e] = a; a += (int)((cnt[e] + 255u) / 256u); } s_base[32] = a; }
        __syncthreads();
    }
    const bool lastl = (li == 3);
    for (int row = blockIdx.x * nwaves_blk + wave; row < T; row += gridDim.x * nwaves_blk) {
        const int b = row / LTOT, pos = row % LTOT; const bool isctx = pos < CTXL; const int r = isctx ? 16 : b;
        if ((MODE & 16) && isctx) continue;
        if ((MODE & 8) && lastl && isctx) continue;
        float4 v[4];
#pragma unroll
        for (int q = 0; q < 4; ++q) v[q] = *(const float4*)(X + (size_t)row * D + q * 256 + lane * 4);
        if (MODE & 1) {
            const bool skip = (li - 1 == 3) && isctx;
            if (!skip) {
                const int4 si = *(const int4*)(P.ws + WS_SELI + (size_t)row * 16); const float2 sw = *(const float2*)(P.ws + WS_SELW + (size_t)row * 8);
                const size_t g1 = (size_t)s_base[si.x] * 256 + si.y, g2 = (size_t)s_base[si.z] * 256 + si.w;
                const u16* YB = (const u16*)(P.ws + WS_YB);
                const float* gate = mod + (size_t)((li - 1) * 17 + r) * 6144 + 5 * 1024;
#pragma unroll
                for (int q = 0; q < 4; ++q) { const int c = q * 256 + lane * 4;
                    const uint2 ya = *(const uint2*)(YB + g1 * 1024 + c), yb = *(const uint2*)(YB + g2 * 1024 + c); const float4 gg = *(const float4*)(gate + c);
                    v[q].x += gg.x * (sw.x * bf2f((u16)(ya.x & 0xffff)) + sw.y * bf2f((u16)(yb.x & 0xffff)));
                    v[q].y += gg.y * (sw.x * bf2f((u16)(ya.x >> 16)) + sw.y * bf2f((u16)(yb.x >> 16)));
                    v[q].z += gg.z * (sw.x * bf2f((u16)(ya.y & 0xffff)) + sw.y * bf2f((u16)(yb.y & 0xffff)));
                    v[q].w += gg.w * (sw.x * bf2f((u16)(ya.y >> 16)) + sw.y * bf2f((u16)(yb.y >> 16)));
                    if (!(MODE & 16)) *(float4*)(X + (size_t)row * D + c) = v[q]; }
            }
        }
        float ss = 0.f;
#pragma unroll
        for (int q = 0; q < 4; ++q) ss += v[q].x * v[q].x + v[q].y * v[q].y + v[q].z * v[q].z + v[q].w * v[q].w;
        ss = wave_sum_l(ss, lane);
        const float rstd = rsqrtf(ss * (1.f / 1024.f) + EPS);
        if (MODE & 16) {
            float* out = P.out + ((size_t)b * SEQ + (pos - CTXL)) * D;
#pragma unroll
            for (int q = 0; q < 4; ++q) { const int c = q * 256 + lane * 4; const float4 g = *(const float4*)(sm + SM_FINALG + c);
                *(float4*)(out + c) = make_float4(v[q].x * rstd * g.x, v[q].y * rstd * g.y, v[q].z * rstd * g.z, v[q].w * rstd * g.w); }
            continue;
        }
        const float* gv = sm + (which ? SM_GFFN : SM_GMIX) + li * 1024;
        const float* sh = mod + (size_t)(li * 17 + r) * 6144 + (which ? 3 : 0) * 1024; const float* scl = sh + 1024;
        float h[16];
#pragma unroll
        for (int q = 0; q < 4; ++q) { const int c = q * 256 + lane * 4; const float4 g = *(const float4*)(gv + c), s4 = *(const float4*)(sh + c), c4 = *(const float4*)(scl + c);
            h[q * 4 + 0] = v[q].x * rstd * g.x * (1.f + c4.x) + s4.x; h[q * 4 + 1] = v[q].y * rstd * g.y * (1.f + c4.y) + s4.y;
            h[q * 4 + 2] = v[q].z * rstd * g.z * (1.f + c4.z) + s4.z; h[q * 4 + 3] = v[q].w * rstd * g.w * (1.f + c4.w) + s4.w; }
        if (MODE & 2) {
            u16* HX = (u16*)(P.ws + WS_HX);
#pragma unroll
            for (int q = 0; q < 4; ++q) { uint2 w; w.x = (unsigned)f2bf(h[q * 4]) | ((unsigned)f2bf(h[q * 4 + 1]) << 16); w.y = (unsigned)f2bf(h[q * 4 + 2]) | ((unsigned)f2bf(h[q * 4 + 3]) << 16);
                *(uint2*)(HX + (size_t)row * D + q * 256 + lane * 4) = w; }
        }
        if (MODE & 4) {
            u16* UH = (u16*)(P.ws + WS_R1 + R1_UH);
#pragma unroll
            for (int q = 0; q < 4; ++q) { const int c = q * 256 + lane * 4; const int g = c >> 4, ch = c & 15;
                uint2 w; w.x = (unsigned)f2bf(h[q * 4]) | ((unsigned)f2bf(h[q * 4 + 1]) << 16); w.y = (unsigned)f2bf(h[q * 4 + 2]) | ((unsigned)f2bf(h[q * 4 + 3]) << 16);
                *(uint2*)(UH + ((size_t)g * 2304 + b * 144 + (pos >> 4)) * 512 + (pos & 15) * 16 + ch) = w; }
        }
        if (MODE & 8) {
            const float* wg = sm + SM_WGROUP + (size_t)li * 1024 * 4;
            float lg[4] = {0.f, 0.f, 0.f, 0.f};
#pragma unroll
            for (int q = 0; q < 4; ++q)
#pragma unroll
                for (int j = 0; j < 4; ++j) { const int k = q * 256 + lane * 4 + j; const float4 w = *(const float4*)(wg + k * 4); const float hv = h[q * 4 + j];
                    lg[0] += hv * w.x; lg[1] += hv * w.y; lg[2] += hv * w.z; lg[3] += hv * w.w; }
#pragma unroll
            for (int g = 0; g < 4; ++g) lg[g] = wave_sum_l(lg[g], lane) + sm[SM_BGROUP + li * 4 + g];
            int gi = 0; float best = lg[0];
#pragma unroll
            for (int g = 1; g < 4; ++g) if (lg[g] > best) { best = lg[g]; gi = g; }
            float den = 0.f;
#pragma unroll
            for (int g = 0; g < 4; ++g) den += __expf(lg[g] - best);
            const float pg = 1.f / den;
            const float* we = sm + SM_WEXP + ((size_t)li * 4 + gi) * 1024 * 8;
            float le[8];
#pragma unroll
            for (int e = 0; e < 8; ++e) le[e] = 0.f;
#pragma unroll
            for (int q = 0; q < 4; ++q)
#pragma unroll
                for (int j = 0; j < 4; ++j) { const int k = q * 256 + lane * 4 + j; const float4 w0 = *(const float4*)(we + k * 8), w1 = *(const float4*)(we + k * 8 + 4); const float hv = h[q * 4 + j];
                    le[0] += hv * w0.x; le[1] += hv * w0.y; le[2] += hv * w0.z; le[3] += hv * w0.w; le[4] += hv * w1.x; le[5] += hv * w1.y; le[6] += hv * w1.z; le[7] += hv * w1.w; }
#pragma unroll
            for (int e = 0; e < 8; ++e) le[e] = wave_sum_l(le[e], lane) + sm[SM_BEXP + (li * 4 + gi) * 8 + e];
            int i1 = 0; float b1 = le[0];
#pragma unroll
            for (int e = 1; e < 8; ++e) if (le[e] > b1) { b1 = le[e]; i1 = e; }
            int i2 = -1; float b2 = -3.0e38f;
#pragma unroll
            for (int e = 0; e < 8; ++e) if (e != i1 && le[e] > b2) { b2 = le[e]; i2 = e; }
            if (lane == 0) {
                const float ex = __expf(b2 - b1); const float w1 = 1.f / (1.f + ex), w2 = ex / (1.f + ex);
                unsigned* cnt = (unsigned*)(P.ws + WS_CTL) + CW_CNT + li * 32; int* list = (int*)(P.ws + WS_LIST);
                const int e1 = gi * 8 + i1, e2 = gi * 8 + i2;
                const int s1 = (int)atomicAdd(&cnt[e1], 1u), s2 = (int)atomicAdd(&cnt[e2], 1u);
                list[(size_t)e1 * T + s1] = row; list[(size_t)e2 * T + s2] = row;
                *(int4*)(P.ws + WS_SELI + (size_t)row * 16) = make_int4(e1, s1, e2, s2);
                *(float2*)(P.ws + WS_SELW + (size_t)row * 8) = make_float2(pg * w1, pg * w2);
            }
        }
    }
}
template <int MODE> __global__ __launch_bounds__(256) void k_norm(Ptrs P, int li, int which) { __shared__ int sb[36]; norm_rows<MODE>(P.ws, P.out, li, which, 4, sb, __builtin_amdgcn_readfirstlane(threadIdx.x >> 6)); }

struct NG { const void* A; int lda; const int* rowidx; const float* B; int ldb; long bstride; const int* tileexp; const int* mdyn; float* C; int ldc; int M, N, K, pad; };
template <int ABF> __global__ __launch_bounds__(256) void n_gemm(NG g) {
    __shared__ float As[16][68], Bs[16][68];
    const int tm = blockIdx.y, tn = blockIdx.x, tid = threadIdx.x, tx = tid & 15, ty = tid >> 4;
    const int M = g.mdyn ? (*g.mdyn) * 256 : g.M;
    if (tm * 64 >= M) return;
    const float* B = g.B; if (g.tileexp) B += (long)g.tileexp[(tm * 64) / 256] * g.bstride;
    float acc[4][4];
#pragma unroll
    for (int i = 0; i < 4; ++i)
#pragma unroll
        for (int j = 0; j < 4; ++j) acc[i][j] = 0.f;
    const int arow = tm * 64 + (tid >> 2), ak = (tid & 3) * 4; long asrc = -1;
    if (arow < M) { const int r = g.rowidx ? g.rowidx[arow] : arow; if (r >= 0) asrc = (long)r * g.lda; }
    for (int k0 = 0; k0 < g.K; k0 += 16) {
        float a[4] = {0.f, 0.f, 0.f, 0.f};
        if (asrc >= 0) {
            if (ABF) { const uint2 w = *(const uint2*)((const u16*)g.A + asrc + k0 + ak); a[0] = bf2f((u16)(w.x & 0xffff)); a[1] = bf2f((u16)(w.x >> 16)); a[2] = bf2f((u16)(w.y & 0xffff)); a[3] = bf2f((u16)(w.y >> 16)); }
            else { const float4 w = *(const float4*)((const float*)g.A + asrc + k0 + ak); a[0] = w.x; a[1] = w.y; a[2] = w.z; a[3] = w.w; }
        }
        const float4 bv = *(const float4*)(B + (size_t)(k0 + (tid >> 4)) * g.ldb + tn * 64 + (tid & 15) * 4);
        __syncthreads();
#pragma unroll
        for (int i = 0; i < 4; ++i) As[ak + i][tid >> 2] = a[i];
        *(float4*)&Bs[tid >> 4][(tid & 15) * 4] = bv;
        __syncthreads();
#pragma unroll
        for (int kk = 0; kk < 16; ++kk) { const float4 a4 = *(const float4*)&As[kk][ty * 4], b4 = *(const float4*)&Bs[kk][tx * 4];
            const float av[4] = {a4.x, a4.y, a4.z, a4.w}, bw[4] = {b4.x, b4.y, b4.z, b4.w};
#pragma unroll
            for (int i = 0; i < 4; ++i)
#pragma unroll
                for (int j = 0; j < 4; ++j) acc[i][j] += av[i] * bw[j]; }
    }
#pragma unroll
    for (int i = 0; i < 4; ++i) { const int row = tm * 64 + ty * 4 + i; if (row < M) *(float4*)(g.C + (size_t)row * g.ldc + tn * 64 + tx * 4) = make_float4(acc[i][0], acc[i][1], acc[i][2], acc[i][3]); }
}
__device__ __forceinline__ int row_r(int row) { return (row % LTOT) < CTXL ? 16 : row / LTOT; }
__global__ __launch_bounds__(256) void n_post_glu(Ptrs P, int li) {
    float* X = (float*)(P.ws + WS_X); const float* TMP = (const float*)(P.ws + WS_NTMP); const float* mod = (const float*)(P.ws + WS_MOD);
    for (size_t i = (size_t)blockIdx.x * 256 + threadIdx.x; i < (size_t)T * D; i += (size_t)gridDim.x * 256) { const int row = (int)(i >> 10), c = (int)(i & 1023); const int r = row_r(row);
        const float val = TMP[(size_t)row * 2048 + c], gt = TMP[(size_t)row * 2048 + 1024 + c]; X[i] += mod[(size_t)(li * 17 + r) * 6144 + 2048 + c] * val * sigmoid_f(gt); }
}
__global__ __launch_bounds__(256) void n_post_wo(Ptrs P, int li) {
    float* X = (float*)(P.ws + WS_X); const float* TMP = (const float*)(P.ws + WS_NTMP); const float* mod = (const float*)(P.ws + WS_MOD);
    for (size_t i = (size_t)blockIdx.x * 256 + threadIdx.x; i < (size_t)T * D; i += (size_t)gridDim.x * 256) { const int row = (int)(i >> 10), c = (int)(i & 1023); const int r = row_r(row);
        X[i] += mod[(size_t)(li * 17 + r) * 6144 + 2048 + c] * TMP[i]; }
}
__global__ __launch_bounds__(256) void n_post_q(Ptrs P) {
    const float* TMP = (const float*)(P.ws + WS_NTMP); u16* QT = (u16*)(P.ws + WS_R1 + R1_QT); const float2* rope = (const float2*)(P.ws + WS_ROPE);
    const float scale = 0.07216878364870322f;
    for (size_t i = (size_t)blockIdx.x * 256 + threadIdx.x; i < (size_t)T * 1536; i += (size_t)gridDim.x * 256) { const int row = (int)(i / 1536), c = (int)(i % 1536); const int h = c / 192, dd = c % 192;
        const int b = row / LTOT, pos = row % LTOT; float v = TMP[i];
        if (dd >= 128 && pos >= CTXL) { const int l = dd - 128; const float pv = TMP[(size_t)row * 1536 + h * 192 + 128 + (l ^ 16)]; const float2 cs = rope[(size_t)(pos - CTXL) * 32 + (l >> 5) * 16 + (l & 15)];
            v = (l & 16) ? v * cs.x + pv * cs.y : v * cs.x - pv * cs.y; }
        QT[(((size_t)b * NH + h) * LTOT + pos) * QKD + dd] = f2bf(v * scale); }
}
__global__ __launch_bounds__(256) void n_post_kv(Ptrs P) {
    const float* TMP = (const float*)(P.ws + WS_NTMP); u16* KT = (u16*)(P.ws + WS_R1 + R1_KT); u16* VT = (u16*)(P.ws + WS_R1 + R1_VT);
    for (size_t i = (size_t)blockIdx.x * 256 + threadIdx.x; i < (size_t)T * 2048; i += (size_t)gridDim.x * 256) { const int row = (int)(i >> 11), c = (int)(i & 2047); const int h = c >> 8, dd = c & 255;
        const int b = row / LTOT, pos = row % LTOT; const u16 v = f2bf(TMP[i]);
        if (dd < 128) KT[(((size_t)b * NH + h) * LTOT + pos) * QKD + dd] = v; else VT[(((size_t)b * NH + h) * LTOT + pos) * 128 + dd - 128] = v; }
}
__global__ __launch_bounds__(256) void n_attn(Ptrs P) {
    __shared__ float Ks[32][192], Vs[32][128];
    const int qt = blockIdx.x, h = blockIdx.y, b = blockIdx.z, tid = threadIdx.x, ql = tid >> 2, part = tid & 3;
    const u16* QT = (const u16*)(P.ws + WS_R1 + R1_QT) + ((size_t)b * NH + h) * LTOT * QKD; const u16* KT = (const u16*)(P.ws + WS_R1 + R1_KT) + ((size_t)b * NH + h) * LTOT * QKD;
    const u16* VT = (const u16*)(P.ws + WS_R1 + R1_VT) + ((size_t)b * NH + h) * LTOT * 128; u16* O = (u16*)(P.ws + WS_ZO);
    const int pos = qt * 64 + ql; const int nk = (qt * 64 < CTXL) ? CTXL : LTOT;
    float q[48], o[32];
#pragma unroll
    for (int i = 0; i < 48; ++i) q[i] = bf2f(QT[(size_t)pos * QKD + part * 48 + i]);
#pragma unroll
    for (int i = 0; i < 32; ++i) o[i] = 0.f;
    float m = -1e30f, l = 0.f;
    for (int k0 = 0; k0 < nk; k0 += 32) {
        __syncthreads();
        for (int i = tid; i < 32 * 192; i += 256) Ks[i / 192][i % 192] = bf2f(KT[(size_t)k0 * QKD + i]);
        for (int i = tid; i < 32 * 128; i += 256) Vs[i / 128][i % 128] = bf2f(VT[(size_t)k0 * 128 + i]);
        __syncthreads();
        for (int kk = 0; kk < 32; ++kk) {
            float s = 0.f;
#pragma unroll
            for (int i = 0; i < 48; ++i) s += q[i] * Ks[kk][part * 48 + i];
            s += __shfl_xor(s, 1); s += __shfl_xor(s, 2);
            const float mn = fmaxf(m, s), al = __expf(m - mn), p = __expf(s - mn);
            l = l * al + p; m = mn;
#pragma unroll
            for (int i = 0; i < 32; ++i) o[i] = o[i] * al + p * Vs[kk][part * 32 + i];
        }
    }
    const float rl = 1.f / l;
#pragma unroll
    for (int i = 0; i < 32; ++i) O[((size_t)b * LTOT + pos) * D + h * 128 + part * 32 + i] = f2bf(o[i] * rl);
}
__global__ __launch_bounds__(128) void n_s5(Ptrs P, int j) {
    __shared__ float us[2][16], hre[2][64], him[2][64], Cre[2][16][64], Cim[2][16][64];
    const int b = blockIdx.x >> 6, g = blockIdx.x & 63, tid = threadIdx.x, dir = tid >> 6, p = tid & 63;
    const size_t gd = ((size_t)j * 2 + dir) * SG + g;
    const float dt = __expf(P.in[10][gd]); const float ar = P.in[8][gd * SP + p], ai = P.in[9][gd * SP + p];
    const float ldr = ar * dt, ldi = ai * dt, mag = __expf(ldr); const float abr = mag * __cosf(ldi), abi = mag * __sinf(ldi);
    const float nr = abr - 1.f, ni = abi, den = ar * ar + ai * ai; const float qr = (nr * ar + ni * ai) / den, qi = (ni * ar - nr * ai) / den;
    float bbr[16], bbi[16];
#pragma unroll
    for (int c = 0; c < 16; ++c) { const float br = P.in[11][(gd * SP + p) * SC + c], bi = P.in[12][(gd * SP + p) * SC + c]; bbr[c] = qr * br - qi * bi; bbi[c] = qr * bi + qi * br; }
    for (int i = tid; i < 2 * 16 * 64; i += 128) { const int d2 = i >> 10, c = (i >> 6) & 15, pp = i & 63; const size_t o = ((((size_t)j * 2 + d2) * SG + g) * SC + c) * SP + pp; Cre[d2][c][pp] = P.in[13][o]; Cim[d2][c][pp] = P.in[14][o]; }
    const u16* HX = (const u16*)(P.ws + WS_HX); float* Yf = (float*)(P.ws + WS_NTMP); float* Yr = Yf + (size_t)T * D;
    float hr = 0.f, hi = 0.f;
    for (int t = 0; t < LTOT; ++t) {
        __syncthreads();
        if (tid < 32) { const int d2 = tid >> 4, c = tid & 15; const int ps = d2 ? (t < CTXL ? CTXL - 1 - t : LTOT - 1 - (t - CTXL)) : t; us[d2][c] = bf2f(HX[((size_t)b * LTOT + ps) * D + g * 16 + c]); }
        __syncthreads();
        float bur = 0.f, bui = 0.f;
#pragma unroll
        for (int c = 0; c < 16; ++c) { bur += bbr[c] * us[dir][c]; bui += bbi[c] * us[dir][c]; }
        const float nhr = abr * hr - abi * hi + bur, nhi = abr * hi + abi * hr + bui; hr = nhr; hi = nhi;
        hre[dir][p] = hr; him[dir][p] = hi;
        __syncthreads();
        if (tid < 32) { const int d2 = tid >> 4, c = tid & 15; const int ps = d2 ? (t < CTXL ? CTXL - 1 - t : LTOT - 1 - (t - CTXL)) : t; float y = 0.f;
            for (int pp = 0; pp < 64; ++pp) y += Cre[d2][c][pp] * hre[d2][pp] - Cim[d2][c][pp] * him[d2][pp];
            (d2 ? Yr : Yf)[((size_t)b * LTOT + ps) * D + g * 16 + c] = y; }
    }
}
__global__ __launch_bounds__(256) void n_post_s5(Ptrs P, int j) {
    const float* Yf = (const float*)(P.ws + WS_NTMP); const float* Yr = Yf + (size_t)T * D; const u16* HX = (const u16*)(P.ws + WS_HX); u16* Z = (u16*)(P.ws + WS_ZO);
    for (size_t i = (size_t)blockIdx.x * 256 + threadIdx.x; i < (size_t)T * D; i += (size_t)gridDim.x * 256) { const int c = (int)(i & 1023);
        Z[i] = f2bf(gelu_tanh(Yf[i] + Yr[i] + P.in[15][j * 1024 + c] * bf2f(HX[i]))); }
}
__global__ __launch_bounds__(256) void n_build(Ptrs P, int li) {
    __shared__ int base[33];
    const unsigned* cnt = (const unsigned*)(P.ws + WS_CTL) + CW_CNT + li * 32; int* tileexp = (int*)(P.ws + WS_TILEEXP); int* slotrow = (int*)(P.ws + WS_SLOTROW); const int* list = (const int*)(P.ws + WS_LIST);
    if (threadIdx.x == 0) { int a = 0; for (int e = 0; e < 32; ++e) { base[e] = a; a += (int)((cnt[e] + 255u) / 256u); } base[32] = a; tileexp[512] = a; }
    __syncthreads();
    for (int e = 0; e < 32; ++e) { const int nt = base[e + 1] - base[e];
        for (int t = threadIdx.x; t < nt; t += 256) tileexp[base[e] + t] = e;
        for (int s = threadIdx.x; s < nt * 256; s += 256) slotrow[base[e] * 256 + s] = s < (int)cnt[e] ? list[(size_t)e * T + s] : -1; }
}
__global__ __launch_bounds__(256) void n_post_act2(Ptrs P, u16* ACT) {
    const float* TMP = (const float*)(P.ws + WS_NTMP); const int ntot = ((const int*)(P.ws + WS_TILEEXP))[512];
    for (size_t i = (size_t)blockIdx.x * 256 + threadIdx.x; i < (size_t)ntot * 256 * 512; i += (size_t)gridDim.x * 256) { const size_t gs = i >> 9; const int c = (int)(i & 511);
        ACT[i] = f2bf(silu_f(TMP[gs * 1024 + c]) * TMP[gs * 1024 + 512 + c]); }
}
__global__ __launch_bounds__(256) void n_post_y(Ptrs P) {
    const float* TMP = (const float*)(P.ws + WS_NTMP); u16* YB = (u16*)(P.ws + WS_YB); const int ntot = ((const int*)(P.ws + WS_TILEEXP))[512];
    for (size_t i = (size_t)blockIdx.x * 256 + threadIdx.x; i < (size_t)ntot * 256 * 1024; i += (size_t)gridDim.x * 256) YB[i] = f2bf(TMP[i]);
}

#define LAS __attribute__((address_space(3)))
typedef short bf16x8 __attribute__((ext_vector_type(8)));
typedef float f32x4 __attribute__((ext_vector_type(4)));
typedef unsigned u32x4 __attribute__((ext_vector_type(4)));
typedef unsigned u32x2 __attribute__((ext_vector_type(2)));
namespace g8 {
constexpr int BM = 256, BK = 64, HALF = 128, HTB = HALF * BK * 2, STAGE_BYTES = 8 * HTB, NXCD = 8, WGM = 8;
__host__ __device__ __forceinline__ int lds_byte(int r, int c) { const int st = (r >> 4) * 2 + (c >> 5), rr = r & 15, cc = c & 31, ob = rr * 64 + cc * 2; return st * 1024 + (ob ^ (((ob >> 9) & 1) << 5)); }
__host__ __device__ __forceinline__ void stage_rc(int b, int& R, int& C) { const int st = b / 1024, sb = b % 1024, swz = sb ^ (((sb >> 9) & 1) << 5); R = (st >> 1) * 16 + swz / 64; C = (st & 1) * 32 + (swz % 64) / 2; }
__host__ __device__ __forceinline__ int perm32(int rho) { const int n = rho >> 4, i = rho & 15; return 8 * (i >> 2) + 4 * n + (i & 3); }
struct Unit { int pm, pn, aux; };
struct Order {
    int nM, nN, nwg, G, c;
    __device__ __forceinline__ void init(int nM_, int nN_, int G_, int c_) { nM = nM_; nN = nN_; nwg = nM * nN; G = G_; c = c_; }
    __device__ __forceinline__ bool next(int i, int& pm, int& pn) const {
        const long L = (long)i * G + c; if (L >= nwg) return false;
        int wgid = (int)L; { const int q = nwg / NXCD, r = nwg % NXCD, xcd = wgid % NXCD, off = wgid / NXCD; wgid = (xcd < r ? xcd * (q + 1) : r * (q + 1) + (xcd - r) * q) + off; }
        const int nig = WGM * nN, gid = wgid / nig, fm = gid * WGM, gsz = (nM - fm) < WGM ? (nM - fm) : WGM;
        pm = fm + ((wgid % nig) % gsz); pn = (wgid % nig) / gsz; return true;
    }
};
__device__ __forceinline__ unsigned cvt_pk_bf16(float lo, float hi) { unsigned r; asm volatile("v_cvt_pk_bf16_f32 %0, %1, %2" : "=v"(r) : "v"(lo), "v"(hi)); return r; }

template <class Epi, class Sched>
__device__ __forceinline__ void gemm_phase(LAS unsigned char* lds, const int K, const Sched& S, const Epi& E, const int wv) {
    const int tid = tid_opaque(wv), wid = wv, lane = tid & 63, wr = wid >> 2, wc = wid & 3, fr = lane & 15, fq = lane >> 4;
    const int nt = K / BK;
    int R0, C0; stage_rc(tid * 16, R0, C0);
    unsigned voffB[2];
    { const int Rb0 = Epi::PERM ? ((R0 & ~31) + perm32(R0 & 31)) : R0;
      voffB[0] = (unsigned)(Rb0 * K + C0) * 2u; voffB[1] = voffB[0] + (unsigned)(64 * K) * 2u; }
    const size_t kstepB = (size_t)(BK * 2), hstepB = (size_t)HALF * K * 2;
    const size_t kstepA = S.a_kstep();
    const unsigned ldsw = (unsigned)wid * 1024u;
    const int aoff = lds_byte(wr * 64 + fr, fq * 8), boff = lds_byte(wc * 32 + fr, fq * 8);
#define G8_SA(b, h) (((b) * 2 + (h)) * HTB)
#define G8_SB(b, h) ((4 + (b) * 2 + (h)) * HTB)
#define G8_STAGE_B(bufoff, gbase) do { _Pragma("unroll") for (int _i = 0; _i < 2; ++_i) \
        __builtin_amdgcn_global_load_lds((const unsigned*)((const char*)(gbase) + voffB[_i]), (LAS unsigned*)(lds + (bufoff) + ldsw + _i * 8192), 16, 0, 0); } while (0)
#define G8_VI(h, i) ((Sched::NV == 1) ? 0 : ((h) * 2 + (i)))
#define G8_STAGE_A(bufoff, U, V, h, kb) do { \
        __builtin_amdgcn_global_load_lds((const unsigned*)(S.a_uptr(U, h, 0) + (size_t)(kb) + (V)[G8_VI(h, 0)]), (LAS unsigned*)(lds + (bufoff) + ldsw), 16, 0, 0); \
        __builtin_amdgcn_global_load_lds((const unsigned*)(S.a_uptr(U, h, 1) + (size_t)(kb) + (V)[G8_VI(h, 1)]), (LAS unsigned*)(lds + (bufoff) + ldsw + 8192), 16, 0, 0); } while (0)
#define G8_LDA(dst, b, h) do { _Pragma("unroll") for (int m = 0; m < 4; ++m) _Pragma("unroll") for (int k = 0; k < 2; ++k) dst[m][k] = *(const LAS bf16x8*)(lds + G8_SA(b, h) + aoff + m * 2048 + k * 1024); } while (0)
#define G8_LDB(dst, b, h) do { _Pragma("unroll") for (int n = 0; n < 2; ++n) _Pragma("unroll") for (int k = 0; k < 2; ++k) dst[n][k] = *(const LAS bf16x8*)(lds + G8_SB(b, h) + boff + n * 2048 + k * 1024); } while (0)
#define G8_MMA(ai, bj, At, Bt) do { __builtin_amdgcn_s_setprio(1); _Pragma("unroll") for (int m = 0; m < 4; ++m) _Pragma("unroll") for (int n = 0; n < 2; ++n) _Pragma("unroll") for (int k = 0; k < 2; ++k) \
        acc[ai][bj][m][n] = __builtin_amdgcn_mfma_f32_16x16x32_bf16(Bt[n][k], At[m][k], acc[ai][bj][m][n], 0, 0, 0); __builtin_amdgcn_s_setprio(0); } while (0)
#define G8_WAIT_V(n) asm volatile("s_waitcnt vmcnt(" #n ")" ::: "memory")
#define G8_WAIT_L(n) asm volatile("s_waitcnt lgkmcnt(" #n ")" ::: "memory")
#define G8_BAR __builtin_amdgcn_s_barrier()
#define G8_SCHED __builtin_amdgcn_sched_barrier(0)
    Unit cur, nxt; int ui = 0;
    if (!S.next(0, cur)) return;
    f32x4 acc[2][2][4][2];
#pragma unroll
    for (int a = 0; a < 2; ++a)
#pragma unroll
        for (int b = 0; b < 2; ++b)
#pragma unroll
            for (int m = 0; m < 4; ++m)
#pragma unroll
                for (int n = 0; n < 2; ++n) acc[a][b][m][n] = (f32x4){0.f, 0.f, 0.f, 0.f};
    bf16x8 At[4][2], B0[2][2], B1[2][2];
    unsigned cO[4], nO[4];
    S.a_voff(cur, R0, C0, cO);
    const char* cB = S.b_ptr(cur);
    G8_STAGE_B(G8_SB(0, 0), cB); G8_STAGE_A(G8_SA(0, 0), cur, cO, 0, 0); G8_STAGE_B(G8_SB(0, 1), cB + hstepB); G8_STAGE_A(G8_SA(0, 1), cur, cO, 1, 0);
    if (wr == 1) G8_BAR;
    G8_WAIT_V(4); G8_BAR;
    G8_STAGE_B(G8_SB(1, 0), cB + kstepB); G8_STAGE_A(G8_SA(1, 0), cur, cO, 0, kstepA); G8_STAGE_B(G8_SB(1, 1), cB + hstepB + kstepB);
    G8_WAIT_V(6); G8_BAR;
    for (;;) {
        const bool has_next = S.next(ui + 1, nxt);
        const char* nB = cB;
        if (has_next) { S.a_voff(nxt, R0, C0, nO); nB = S.b_ptr(nxt); }
        else { nxt = cur;
#pragma unroll
            for (int q = 0; q < 4; ++q) nO[q] = cO[q]; }
        for (int t = 0; t < nt; t += 2) {
            const bool last = (t == nt - 2);
            const size_t k1 = (size_t)(t + 1) * kstepA;
            const size_t k2 = last ? 0 : (size_t)(t + 2) * kstepA, k3 = k2 + kstepA;
            unsigned pV[4]; g8::Unit pU;
            if (last) { pU = nxt; pV[0] = nO[0]; pV[1] = nO[1]; pV[2] = nO[2]; pV[3] = nO[3]; } else { pU = cur; pV[0] = cO[0]; pV[1] = cO[1]; pV[2] = cO[2]; pV[3] = cO[3]; }
            const char* b2 = last ? nB : cB + (size_t)(t + 2) * kstepB; const char* b3 = b2 + kstepB;
            G8_LDB(B0, 0, 0); G8_SCHED; G8_LDA(At, 0, 0); G8_STAGE_A(G8_SA(1, 1), cur, cO, 1, k1);
            G8_WAIT_L(8); G8_BAR; G8_WAIT_L(0); G8_MMA(0, 0, At, B0); G8_BAR; G8_SCHED;
            G8_LDB(B1, 0, 1); G8_STAGE_B(G8_SB(0, 0), b2);
            G8_BAR; G8_WAIT_L(0); G8_MMA(0, 1, At, B1); G8_BAR;
            G8_LDA(At, 0, 1); G8_STAGE_A(G8_SA(0, 0), pU, pV, 0, k2);
            G8_BAR; G8_WAIT_L(0); G8_MMA(1, 0, At, B0); G8_BAR; G8_SCHED;
            G8_STAGE_B(G8_SB(0, 1), b2 + hstepB);
            G8_WAIT_V(6); G8_BAR; G8_MMA(1, 1, At, B1); G8_BAR;
            G8_LDB(B0, 1, 0); G8_SCHED; G8_LDA(At, 1, 0); G8_STAGE_A(G8_SA(0, 1), pU, pV, 1, k2);
            G8_WAIT_L(8); G8_BAR; G8_WAIT_L(0); G8_MMA(0, 0, At, B0); G8_BAR; G8_SCHED;
            G8_LDB(B1, 1, 1); G8_STAGE_B(G8_SB(1, 0), b3);
            G8_BAR; G8_WAIT_L(0); G8_MMA(0, 1, At, B1); G8_BAR;
            G8_LDA(At, 1, 1); G8_STAGE_A(G8_SA(1, 0), pU, pV, 0, k3);
            G8_BAR; G8_WAIT_L(0); G8_MMA(1, 0, At, B0); G8_BAR; G8_SCHED;
            G8_STAGE_B(G8_SB(1, 1), b3 + hstepB);
            G8_WAIT_V(6); G8_BAR; G8_MMA(1, 1, At, B1); G8_BAR;
        }
        E(acc, cur, wr, wc, fr, fq);
        if (!has_next) break;
#pragma unroll
        for (int a = 0; a < 2; ++a)
#pragma unroll
            for (int b = 0; b < 2; ++b)
#pragma unroll
                for (int m = 0; m < 4; ++m)
#pragma unroll
                    for (int n = 0; n < 2; ++n) acc[a][b][m][n] = (f32x4){0.f, 0.f, 0.f, 0.f};
        cur = nxt; cB = nB; ++ui;
#pragma unroll
        for (int q = 0; q < 4; ++q) cO[q] = nO[q];
    }
    G8_WAIT_V(0);
    if (wr == 0) G8_BAR;
    G8_BAR;
#undef G8_SA
#undef G8_SB
#undef G8_STAGE_A
#undef G8_VI
#undef G8_STAGE_B
#undef G8_LDA
#undef G8_LDB
#undef G8_MMA
#undef G8_WAIT_V
#undef G8_WAIT_L
#undef G8_BAR
#undef G8_SCHED
}
}
struct SchedDense {
    g8::Order ord; const char* A; unsigned lda2; const char* Bt; int K;
    __device__ __forceinline__ void init(const void* A_, int lda, const void* Bt_, int M, int N, int K_) { A = (const char*)A_; lda2 = (unsigned)lda * 2u; Bt = (const char*)Bt_; K = K_; ord.init(M / 256, N / 256, (int)gridDim.x, (int)blockIdx.x); }
    __device__ __forceinline__ bool next(int i, g8::Unit& u) const { u.aux = 0; return ord.next(i, u.pm, u.pn); }
    static constexpr int NV = 1;
    __device__ __forceinline__ size_t a_kstep() const { return 128; }
    __device__ __forceinline__ const char* a_uptr(const g8::Unit& u, int h, int i) const { return A + (size_t)(u.pm * 256 + h * 128 + i * 64) * lda2; }
    __device__ __forceinline__ void a_voff(const g8::Unit& u, int R0, int C0, unsigned (&o)[4]) const { o[0] = (unsigned)R0 * lda2 + C0 * 2; }
    __device__ __forceinline__ const char* b_ptr(const g8::Unit& u) const { return Bt + (size_t)u.pn * 256 * K * 2; }
};
struct SchedS5 {
    g8::Order ord; const char* A; const char* W; int K;
    __device__ __forceinline__ void init(const void* A_, const void* W_, int K_) { A = (const char*)A_; W = (const char*)W_; K = K_; ord.init(576, 1, (int)gridDim.x, (int)blockIdx.x); }
    __device__ __forceinline__ bool next(int i, g8::Unit& u) const { int pmx, pn; if (!ord.next(i, pmx, pn)) return false; u.aux = pmx / 9; u.pm = pmx % 9; u.pn = 0; return true; }
    static constexpr int NV = 1;
    __device__ __forceinline__ size_t a_kstep() const { return 128; }
    __device__ __forceinline__ const char* a_uptr(const g8::Unit& u, int h, int i) const { return A + (size_t)(u.aux * 2304 + u.pm * 256 + h * 128 + i * 64) * 1024; }
    __device__ __forceinline__ void a_voff(const g8::Unit& u, int R0, int C0, unsigned (&o)[4]) const { o[0] = (unsigned)R0 * 1024u + C0 * 2; }
    __device__ __forceinline__ const char* b_ptr(const g8::Unit& u) const { return W + (size_t)u.aux * 256 * K * 2; }
};
template <bool GATHER> struct SchedMoe {
    g8::Order ord; const char* A; const char* W; int K; const int* sbase; const unsigned* cnt; const int* list; size_t wstride;
    __device__ __forceinline__ void init(const void* A_, const void* W_, int K_, const int* sbase_, const unsigned* cnt_, const int* list_) {
        A = (const char*)A_; W = (const char*)W_; K = K_; sbase = sbase_; cnt = cnt_; list = list_; wstride = (size_t)1024 * K * 2; ord.init(sbase_[32], 4, (int)gridDim.x, (int)blockIdx.x); }
    __device__ __forceinline__ bool next(int i, g8::Unit& u) const { if (!ord.next(i, u.pm, u.pn)) return false; int e = 0;
        for (int k = 1; k < 32; ++k) e = (u.pm >= sbase[k]) ? k : e;
        u.aux = e; return true; }
    static constexpr int NV = GATHER ? 4 : 1;
    __device__ __forceinline__ size_t a_kstep() const { return 128; }
    __device__ __forceinline__ const char* a_uptr(const g8::Unit& u, int h, int i) const { return GATHER ? A : A + (size_t)(u.pm * 256 + h * 128 + i * 64) * 1024; }
    __device__ __forceinline__ void a_voff(const g8::Unit& u, int R0, int C0, unsigned (&o)[4]) const {
        if (GATHER) {
            const int e = u.aux; const int s0 = (u.pm - sbase[e]) * 256 + R0; const int n = (int)cnt[e]; const int* l = list + (size_t)e * T;
#pragma unroll
            for (int q = 0; q < 4; ++q) { const int a = s0 + q * 64; o[q] = (unsigned)l[a < n ? a : 0] * 2048u + C0 * 2; }
        } else o[0] = (unsigned)R0 * 1024u + C0 * 2; }
    __device__ __forceinline__ const char* b_ptr(const g8::Unit& u) const { return W + (size_t)u.aux * wstride + (size_t)u.pn * 256 * K * 2; }
};

#define EPI_LOOP_AM for (int ai = 0; ai < 2; ++ai) _Pragma("unroll") for (int m = 0; m < 4; ++m)
struct EpiS5a {
    static constexpr bool PERM = false; float* S;
    __device__ __forceinline__ void operator()(const f32x4 (&acc)[2][2][4][2], const g8::Unit& u, int wr, int wc, int fr, int fq) const {
        float* base = S + ((size_t)u.aux * 2304 + (size_t)u.pm * 256 + wr * 64 + fr) * 256 + wc * 32 + 4 * fq;
#pragma unroll
        EPI_LOOP_AM { float* rowp = base + (size_t)(ai * 128 + m * 16) * 256;
#pragma unroll
            for (int bj = 0; bj < 2; ++bj)
#pragma unroll
                for (int n = 0; n < 2; ++n) *(f32x4*)(rowp + bj * 128 + n * 16) = acc[ai][bj][m][n]; }
    }
};
struct EpiS5b {
    static constexpr bool PERM = true; u16* Z; const u16* UH; const float* dvec;
    __device__ __forceinline__ void operator()(const f32x4 (&acc)[2][2][4][2], const g8::Unit& u, int wr, int wc, int fr, int fq) const {
        const int g = u.aux; const int ch0 = (fq & 1) * 8;
        const f32x4 d0 = *(const f32x4*)(dvec + g * 16 + ch0), d1 = *(const f32x4*)(dvec + g * 16 + ch0 + 4);
#pragma unroll
        EPI_LOOP_AM { const int rowin = u.pm * 256 + ai * 128 + wr * 64 + m * 16 + fr;
#pragma unroll
            for (int bj = 0; bj < 2; ++bj) { const int c0 = bj * 128 + wc * 32 + fq * 8; const int t = c0 >> 4;
                const u32x4 uu = *(const u32x4*)(UH + ((size_t)g * 2304 + rowin) * 512 + c0);
                const f32x4 a0 = acc[ai][bj][m][0], a1 = acc[ai][bj][m][1];
                float z[8];
                z[0] = a0[0] + d0[0] * __uint_as_float(uu.x << 16); z[1] = a0[1] + d0[1] * __uint_as_float(uu.x & 0xffff0000u);
                z[2] = a0[2] + d0[2] * __uint_as_float(uu.y << 16); z[3] = a0[3] + d0[3] * __uint_as_float(uu.y & 0xffff0000u);
                z[4] = a1[0] + d1[0] * __uint_as_float(uu.z << 16); z[5] = a1[1] + d1[1] * __uint_as_float(uu.z & 0xffff0000u);
                z[6] = a1[2] + d1[2] * __uint_as_float(uu.w << 16); z[7] = a1[3] + d1[3] * __uint_as_float(uu.w & 0xffff0000u);
#pragma unroll
                for (int q = 0; q < 8; ++q) z[q] = gelu_tanh(z[q]);
                u32x4 w; w.x = g8::cvt_pk_bf16(z[0], z[1]); w.y = g8::cvt_pk_bf16(z[2], z[3]); w.z = g8::cvt_pk_bf16(z[4], z[5]); w.w = g8::cvt_pk_bf16(z[6], z[7]);
                *(u32x4*)(Z + ((size_t)rowin * 16 + t) * 1024 + g * 16 + ch0) = w; } }
    }
};
struct EpiGlu {
    static constexpr bool PERM = false; float* X; const float* mod; int li;
    __device__ __forceinline__ void operator()(const f32x4 (&acc)[2][2][4][2], const g8::Unit& u, int wr, int wc, int fr, int fq) const {
        const int r = (u.pm % 9 == 0) ? 16 : u.pm / 9; const float* gate = mod + (size_t)(li * 17 + r) * 6144 + 2048;
#pragma unroll
        EPI_LOOP_AM { const size_t row = (size_t)u.pm * 256 + ai * 128 + wr * 64 + m * 16 + fr;
#pragma unroll
            for (int bj = 0; bj < 2; ++bj) { const int j0 = u.pn * 128 + bj * 64 + wc * 16 + fq * 4; const f32x4 gg = *(const f32x4*)(gate + j0);
                f32x4 x = *(f32x4*)(X + row * 1024 + j0); const f32x4 v = acc[ai][bj][m][0], t = acc[ai][bj][m][1];
#pragma unroll
                for (int q = 0; q < 4; ++q) x[q] += gg[q] * v[q] * sigmoid_f(t[q]);
                *(f32x4*)(X + row * 1024 + j0) = x; } }
    }
};
struct EpiF32 {
    static constexpr bool PERM = false; float* C; int ldc;
    __device__ __forceinline__ void operator()(const f32x4 (&acc)[2][2][4][2], const g8::Unit& u, int wr, int wc, int fr, int fq) const {
        float* base = C + ((size_t)u.pm * 256 + wr * 64 + fr) * ldc + u.pn * 256 + wc * 32 + 4 * fq;
#pragma unroll
        EPI_LOOP_AM { float* rowp = base + (size_t)(ai * 128 + m * 16) * ldc;
#pragma unroll
            for (int bj = 0; bj < 2; ++bj)
#pragma unroll
                for (int n = 0; n < 2; ++n) *(f32x4*)(rowp + bj * 128 + n * 16) = acc[ai][bj][m][n]; }
    }
};
struct EpiQ {
    static constexpr bool PERM = false; u16* QT; const float2* rope;
    __device__ __forceinline__ void operator()(const f32x4 (&acc)[2][2][4][2], const g8::Unit& u, int wr, int wc, int fr, int fq) const {
        const float scale = 0.07216878364870322f; const int b = u.pm / 9, pt = u.pm % 9;
#pragma unroll
        EPI_LOOP_AM { const int pos = pt * 256 + ai * 128 + wr * 64 + m * 16 + fr;
#pragma unroll
            for (int bj = 0; bj < 2; ++bj) { const int g32 = u.pn * 8 + bj * 4 + wc; const int h = g32 / 6, part = g32 % 6;
                f32x4 a = acc[ai][bj][m][0], bq = acc[ai][bj][m][1];
                if (part >= 4 && pos >= CTXL) { const float2* rp = rope + (size_t)(pos - CTXL) * 32 + (part - 4) * 16 + fq * 4;
#pragma unroll
                    for (int q = 0; q < 4; ++q) { const float2 cs = rp[q]; const float x0 = a[q], x1 = bq[q]; a[q] = x0 * cs.x - x1 * cs.y; bq[q] = x1 * cs.x + x0 * cs.y; } }
                u16* dst = QT + (((size_t)b * NH + h) * LTOT + pos) * QKD + part * 32 + fq * 4;
                u32x2 w0, w1; w0.x = g8::cvt_pk_bf16(a[0] * scale, a[1] * scale); w0.y = g8::cvt_pk_bf16(a[2] * scale, a[3] * scale);
                w1.x = g8::cvt_pk_bf16(bq[0] * scale, bq[1] * scale); w1.y = g8::cvt_pk_bf16(bq[2] * scale, bq[3] * scale);
                *(u32x2*)dst = w0; *(u32x2*)(dst + 16) = w1; } }
    }
};
struct EpiKV {
    static constexpr bool PERM = true; u16* KT; u16* VT;
    __device__ __forceinline__ void operator()(const f32x4 (&acc)[2][2][4][2], const g8::Unit& u, int wr, int wc, int fr, int fq) const {
        const int b = u.pm / 9, pt = u.pm % 9, h = u.pn;
#pragma unroll
        EPI_LOOP_AM { const int pos = pt * 256 + ai * 128 + wr * 64 + m * 16 + fr; const size_t rr = ((size_t)b * NH + h) * LTOT + pos;
#pragma unroll
            for (int bj = 0; bj < 2; ++bj) { const f32x4 a0 = acc[ai][bj][m][0], a1 = acc[ai][bj][m][1];
                u32x4 w; w.x = g8::cvt_pk_bf16(a0[0], a0[1]); w.y = g8::cvt_pk_bf16(a0[2], a0[3]); w.z = g8::cvt_pk_bf16(a1[0], a1[1]); w.w = g8::cvt_pk_bf16(a1[2], a1[3]);
                u16* dst = bj == 0 ? KT + rr * QKD + wc * 32 + fq * 8 : VT + rr * 128 + wc * 32 + fq * 8;
                *(u32x4*)dst = w; } }
    }
};
struct EpiWo {
    static constexpr bool PERM = false; float* X; const float* mod; int li;
    __device__ __forceinline__ void operator()(const f32x4 (&acc)[2][2][4][2], const g8::Unit& u, int wr, int wc, int fr, int fq) const {
        const int r = (u.pm % 9 == 0) ? 16 : u.pm / 9; const float* gate = mod + (size_t)(li * 17 + r) * 6144 + 2048;
#pragma unroll
        EPI_LOOP_AM { const size_t row = (size_t)u.pm * 256 + ai * 128 + wr * 64 + m * 16 + fr;
#pragma unroll
            for (int bj = 0; bj < 2; ++bj)
#pragma unroll
                for (int n = 0; n < 2; ++n) { const int c = u.pn * 256 + bj * 128 + wc * 32 + n * 16 + fq * 4; const f32x4 gg = *(const f32x4*)(gate + c);
                    f32x4 x = *(f32x4*)(X + row * 1024 + c); x += gg * acc[ai][bj][m][n]; *(f32x4*)(X + row * 1024 + c) = x; } }
    }
};
struct EpiMoe1 {
    static constexpr bool PERM = false; u16* ACT;
    __device__ __forceinline__ void operator()(const f32x4 (&acc)[2][2][4][2], const g8::Unit& u, int wr, int wc, int fr, int fq) const {
#pragma unroll
        EPI_LOOP_AM { const size_t gs = (size_t)u.pm * 256 + ai * 128 + wr * 64 + m * 16 + fr;
#pragma unroll
            for (int bj = 0; bj < 2; ++bj) { const int j0 = u.pn * 128 + bj * 64 + wc * 16 + fq * 4; const f32x4 gt = acc[ai][bj][m][0], up = acc[ai][bj][m][1];
                u32x2 w; w.x = g8::cvt_pk_bf16(silu_f(gt[0]) * up[0], silu_f(gt[1]) * up[1]); w.y = g8::cvt_pk_bf16(silu_f(gt[2]) * up[2], silu_f(gt[3]) * up[3]);
                *(u32x2*)(ACT + gs * 512 + j0) = w; } }
    }
};
struct EpiMoe2 {
    static constexpr bool PERM = true; u16* YB;
    __device__ __forceinline__ void operator()(const f32x4 (&acc)[2][2][4][2], const g8::Unit& u, int wr, int wc, int fr, int fq) const {
#pragma unroll
        EPI_LOOP_AM { const size_t gs = (size_t)u.pm * 256 + ai * 128 + wr * 64 + m * 16 + fr;
#pragma unroll
            for (int bj = 0; bj < 2; ++bj) { const f32x4 a0 = acc[ai][bj][m][0], a1 = acc[ai][bj][m][1];
                u32x4 w; w.x = g8::cvt_pk_bf16(a0[0], a0[1]); w.y = g8::cvt_pk_bf16(a0[2], a0[3]); w.z = g8::cvt_pk_bf16(a1[0], a1[1]); w.w = g8::cvt_pk_bf16(a1[2], a1[3]);
                *(u32x4*)(YB + gs * 1024 + u.pn * 256 + bj * 128 + wc * 32 + fq * 8) = w; } }
    }
};
namespace at {
typedef short s16x4 __attribute__((ext_vector_type(4)));
typedef float f32x16 __attribute__((ext_vector_type(16)));
constexpr int KVBLK = 64, QBLK = 32, NW = 8;
constexpr int SHM_V = KVBLK * 128 * 2, SHM_K = KVBLK * QKD * 2, SHM_ATTN = 2 * SHM_V + 2 * SHM_K + NW * 64 * 4;
constexpr float SCALE = 1.0f;
constexpr float THR = 8.f;
#define KSWZ(row, colB) ((row) * 384 + ((colB) ^ (((row) & 7) << 4)))
#define SBAR() __builtin_amdgcn_sched_barrier(0)
__device__ __forceinline__ int crow(int r, int hi) { return (r & 3) + 8 * (r >> 2) + 4 * hi; }
__device__ __forceinline__ unsigned cvtpk(float lo, float hi) { unsigned r; asm volatile("v_cvt_pk_bf16_f32 %0, %1, %2" : "=v"(r) : "v"(lo), "v"(hi)); return r; }
__device__ __forceinline__ void partialSM(f32x16& p0, f32x16& p1, float& m_reg, float& mn, float& alpha) {
    constexpr float C = SCALE * 1.4426950408889634f;
    float pmax = p0[0];
#pragma unroll
    for (int r = 1; r < 16; ++r) pmax = fmaxf(pmax, p0[r]);
#pragma unroll
    for (int r = 0; r < 16; ++r) pmax = fmaxf(pmax, p1[r]);
    { auto rr = __builtin_amdgcn_permlane32_swap(__float_as_uint(pmax), __float_as_uint(pmax), false, false); pmax = fmaxf(__uint_as_float(rr[0]), __uint_as_float(rr[1])); }
    if (__builtin_expect(__all(pmax - m_reg <= THR / SCALE), 1)) { mn = m_reg; alpha = 1.f; }
    else { mn = fmaxf(m_reg, pmax); alpha = __builtin_amdgcn_exp2f((m_reg - mn) * C); m_reg = mn; }
    const float mnC = -mn * C;
#pragma unroll
    for (int r = 0; r < 16; ++r) p0[r] = fmaf(p0[r], C, mnC);
#pragma unroll
    for (int r = 0; r < 16; ++r) p1[r] = fmaf(p1[r], C, mnC);
#pragma unroll
    for (int r = 0; r < 16; ++r) p0[r] = __builtin_amdgcn_exp2f(p0[r]);
}
__device__ __forceinline__ void finishSM(f32x16& p0, f32x16& p1, float alpha, float& l_reg, bf16x8& pa0, bf16x8& pa1, bf16x8& pa2, bf16x8& pa3) {
#pragma unroll
    for (int r = 0; r < 16; ++r) p1[r] = __builtin_amdgcn_exp2f(p1[r]);
    float ps = 0;
#pragma unroll
    for (int r = 0; r < 16; ++r) ps += p0[r];
#pragma unroll
    for (int r = 0; r < 16; ++r) ps += p1[r];
    { auto rr = __builtin_amdgcn_permlane32_swap(__float_as_uint(ps), __float_as_uint(ps), false, false); ps = __uint_as_float(rr[0]) + __uint_as_float(rr[1]); }
    l_reg = l_reg * alpha + ps;
#define PK4(P, BASE, OUT) do { unsigned a0 = cvtpk(P[BASE + 0], P[BASE + 1]), a1 = cvtpk(P[BASE + 2], P[BASE + 3]);   \
    unsigned b0 = cvtpk(P[BASE + 4], P[BASE + 5]), b1 = cvtpk(P[BASE + 6], P[BASE + 7]);                              \
    auto r0 = __builtin_amdgcn_permlane32_swap(a0, b0, false, false); auto r1 = __builtin_amdgcn_permlane32_swap(a1, b1, false, false); \
    u32x4 w = {r0[0], r1[0], r0[1], r1[1]}; OUT = *reinterpret_cast<bf16x8*>(&w); } while (0)
    PK4(p0, 0, pa0); PK4(p0, 8, pa1); PK4(p1, 0, pa2); PK4(p1, 8, pa3);
#undef PK4
}
__device__ __forceinline__ void qkt(f32x16& p0, f32x16& p1, const char* Ks, const bf16x8* qr, int r32, int hi) {
    p0 = f32x16{}; p1 = f32x16{};
#pragma unroll
    for (int d0 = 0; d0 < 12; ++d0) { const int cb = (d0 * 16 + hi * 8) * 2;
        const bf16x8 b0 = *reinterpret_cast<const bf16x8*>(Ks + KSWZ(r32, cb));
        const bf16x8 b1 = *reinterpret_cast<const bf16x8*>(Ks + KSWZ(32 + r32, cb));
        p0 = __builtin_amdgcn_mfma_f32_32x32x16_bf16(b0, qr[d0], p0, 0, 0, 0);
        p1 = __builtin_amdgcn_mfma_f32_32x32x16_bf16(b1, qr[d0], p1, 0, 0, 0); }
}
__device__ __forceinline__ int v_st(int k, int c) { const int kk = (k & ~0xC) | ((k & 4) << 1) | ((k & 8) >> 1); return ((kk >> 3) * 4 + (c >> 5)) * 512 + ((kk & 7) * 32 + (c & 31)) * 2; }
__device__ __forceinline__ int v_rd_base(int lane) { return ((lane & 3) << 3) | (((lane >> 2) & 3) << 6) | (((lane >> 4) & 1) << 5) | (((lane >> 5) & 1) << 8); }
constexpr int v_rd_off(int d0, int ks, int half) { return d0 * 512 + ks * 4096 + half * 2048; }
template <int OFF> __device__ __forceinline__ s16x4 tr_read(int vb) { s16x4 r; asm volatile("ds_read_b64_tr_b16 %0, %1 offset:%2" : "=&v"(r) : "v"(vb), "i"(OFF) : "memory"); return r; }
template <int D0> __device__ __forceinline__ void pv_one(f32x16& od, int vb, bf16x8 pa0, bf16x8 pa1, bf16x8 pa2, bf16x8 pa3) {
    const s16x4 l0 = tr_read<v_rd_off(D0, 0, 0)>(vb), h0 = tr_read<v_rd_off(D0, 0, 1)>(vb), l1 = tr_read<v_rd_off(D0, 1, 0)>(vb), h1 = tr_read<v_rd_off(D0, 1, 1)>(vb);
    const s16x4 l2 = tr_read<v_rd_off(D0, 2, 0)>(vb), h2 = tr_read<v_rd_off(D0, 2, 1)>(vb), l3 = tr_read<v_rd_off(D0, 3, 0)>(vb), h3 = tr_read<v_rd_off(D0, 3, 1)>(vb);
    asm volatile("s_waitcnt lgkmcnt(0)" ::: "memory"); SBAR();
#define PK(L, H) (bf16x8){L[0], L[1], L[2], L[3], H[0], H[1], H[2], H[3]}
    od = __builtin_amdgcn_mfma_f32_32x32x16_bf16(pa0, PK(l0, h0), od, 0, 0, 0);
    od = __builtin_amdgcn_mfma_f32_32x32x16_bf16(pa1, PK(l1, h1), od, 0, 0, 0);
    od = __builtin_amdgcn_mfma_f32_32x32x16_bf16(pa2, PK(l2, h2), od, 0, 0, 0);
    od = __builtin_amdgcn_mfma_f32_32x32x16_bf16(pa3, PK(l3, h3), od, 0, 0, 0);
#undef PK
}
__device__ __forceinline__ void pv_d0(f32x16* o, int vb, bf16x8 pa0, bf16x8 pa1, bf16x8 pa2, bf16x8 pa3) {
    pv_one<0>(o[0], vb, pa0, pa1, pa2, pa3); pv_one<1>(o[1], vb, pa0, pa1, pa2, pa3); pv_one<2>(o[2], vb, pa0, pa1, pa2, pa3); pv_one<3>(o[3], vb, pa0, pa1, pa2, pa3);
}
__device__ __forceinline__ void attn_body(const u16* __restrict__ Qb, const u16* __restrict__ Kh, const u16* __restrict__ Vh, u16* __restrict__ Ob, int ldo, int seq, char* lds, int wv) {
    const int tid = tid_opaque(wv), wid = wv, lane = tid & 63, r32 = lane & 31, hi = lane >> 5;
    char* V_lds = lds; char* K_lds = lds + 2 * SHM_V;
    float* ws = (float*)(lds + 2 * SHM_V + 2 * SHM_K) + wid * 64; float* li_l = ws; float* al_l = ws + 32;
    float m_reg = -1e30f, l_reg = 0; f32x16 o[4] = {}; bf16x8 qr[12];
    const u16* Qw = Qb + (long)(wid * QBLK + r32) * QKD + hi * 8;
#pragma unroll
    for (int d0 = 0; d0 < 12; ++d0) qr[d0] = *reinterpret_cast<const bf16x8*>(Qw + d0 * 16);
    const int sr = tid >> 4, sc = (tid & 15) * 8, vst0 = v_st(sr, sc), vst1 = v_st(32 + sr, sc);
    const int kr0 = tid / 24, kc0 = tid % 24, kr1 = (tid + 512) / 24, kc1 = (tid + 512) % 24, kr2 = (tid + 1024) / 24, kc2 = (tid + 1024) % 24;
    const int kst0 = KSWZ(kr0, kc0 * 16), kst1 = KSWZ(kr1, kc1 * 16), kst2 = KSWZ(kr2, kc2 * 16);
    const int vb0 = (int)(uintptr_t)V_lds + v_rd_base(lane);
    bf16x8 vs0, vs1, ks0, ks1, ks2;
#define SLOAD(k0) do { vs0 = *reinterpret_cast<const bf16x8*>(&Vh[(long)((k0) + sr) * 128 + sc]); vs1 = *reinterpret_cast<const bf16x8*>(&Vh[(long)((k0) + 32 + sr) * 128 + sc]); \
    ks0 = *reinterpret_cast<const bf16x8*>(&Kh[(long)((k0) + kr0) * QKD + kc0 * 8]); ks1 = *reinterpret_cast<const bf16x8*>(&Kh[(long)((k0) + kr1) * QKD + kc1 * 8]); \
    ks2 = *reinterpret_cast<const bf16x8*>(&Kh[(long)((k0) + kr2) * QKD + kc2 * 8]); } while (0)
#define SWRITE(b) do { *(bf16x8*)(V_lds + (b) * SHM_V + vst0) = vs0; *(bf16x8*)(V_lds + (b) * SHM_V + vst1) = vs1; \
    *(bf16x8*)(K_lds + (b) * SHM_K + kst0) = ks0; *(bf16x8*)(K_lds + (b) * SHM_K + kst1) = ks1; *(bf16x8*)(K_lds + (b) * SHM_K + kst2) = ks2; } while (0)
#define SWAIT() asm volatile("s_waitcnt vmcnt(0)" ::: "memory")
#define RESC(a) do { if (__any((a) < 1.f)) { if (hi == 0) al_l[r32] = (a); asm volatile("s_waitcnt lgkmcnt(0)" ::: "memory"); \
    _Pragma("unroll") for (int d = 0; d < 4; ++d) _Pragma("unroll") for (int r = 0; r < 16; ++r) o[d][r] *= al_l[crow(r, hi)]; } } while (0)
    f32x16 p0, p1; float mn, al; bf16x8 pa0, pa1, pa2, pa3; const int NT = seq / KVBLK;
    SLOAD(0); SWAIT(); SWRITE(0); __syncthreads();
    for (int j = 0; j < NT; ++j) {
        const int cb = j & 1;
        if (j + 1 < NT) SLOAD((j + 1) * KVBLK);
        SBAR(); qkt(p0, p1, K_lds + cb * SHM_K, qr, r32, hi);
        partialSM(p0, p1, m_reg, mn, al); RESC(al);
        finishSM(p0, p1, al, l_reg, pa0, pa1, pa2, pa3); SBAR();
        pv_d0(o, vb0 + cb * SHM_V, pa0, pa1, pa2, pa3);
        if (j + 1 < NT) { SWAIT(); SWRITE(cb ^ 1); }
        __syncthreads();
    }
    if (hi == 0) li_l[r32] = l_reg; asm volatile("s_waitcnt lgkmcnt(0)" ::: "memory");
    float rli[16];
#pragma unroll
    for (int r = 0; r < 16; ++r) rli[r] = __builtin_amdgcn_rcpf(li_l[crow(r, hi)]);
    u16* Ow = Ob + (long)(wid * QBLK) * ldo;
#pragma unroll
    for (int r = 0; r < 16; ++r) { const int orow = crow(r, hi);
#pragma unroll
        for (int d0 = 0; d0 < 4; ++d0) Ow[(long)orow * ldo + d0 * 32 + r32] = f2bf(o[d0][r] * rli[r]); }
    __syncthreads();
#undef SLOAD
#undef SWRITE
#undef SWAIT
#undef RESC
}
#undef KSWZ
#undef SBAR
}
#define XB_TMO      128
#define XB_XCNT(j)  (256  + 64 * (j))
#define XB_XSUB(j)  (1280 + 64 * (j))
#define XB_XGEN(j)  (2304 + 64 * (j))
#define XB_TOP      3328
#define XB_TOPGEN   3392
#define XCD_BAR_WORDS 3456
#define XB_SPIN_CAP (1u << 18)
__device__ __forceinline__ unsigned xb_ld(unsigned* p)              { return __hip_atomic_load(p, __ATOMIC_RELAXED, __HIP_MEMORY_SCOPE_AGENT); }
__device__ __forceinline__ unsigned xb_add(unsigned* p, unsigned v) { return __hip_atomic_fetch_add(p, v, __ATOMIC_RELAXED, __HIP_MEMORY_SCOPE_AGENT); }
__device__ __forceinline__ unsigned xb_xcc_id() { return (unsigned)__builtin_amdgcn_s_getreg((3 << 11) | 20) & 0xFu; }
#define XB_SPIN(cond, bar) do { unsigned _sp = 0; while (cond) { __builtin_amdgcn_s_sleep(1); \
    if ((++_sp & 255u) == 0u) { if (xb_ld(&(bar)[XB_TMO])) break; if (_sp > XB_SPIN_CAP) { atomicAdd(&(bar)[XB_TMO], 1u); break; } } } } while (0)
struct XcdBarrier { unsigned* bar; unsigned x; volatile LAS unsigned* st; };
__device__ __forceinline__ XcdBarrier xcd_barrier_post(unsigned* bar, volatile LAS unsigned* st) {
    XcdBarrier b; b.bar = bar; b.x = xb_xcc_id(); b.st = st;
    if (threadIdx.x == 0) (void)xb_add(&bar[XB_XCNT(b.x)], 1u);
    return b;
}
__device__ __forceinline__ void xcd_barrier_complete(unsigned* bar, unsigned x, unsigned& nloc, unsigned& nx) {
    const unsigned G = gridDim.x * gridDim.y * gridDim.z;
    unsigned sum, cnt, mine, sp = 0u;
    for (;;) {
        sum = 0u; cnt = 0u; mine = 0u;
#pragma unroll
        for (unsigned j = 0; j < 16; ++j) { const unsigned c = xb_ld(&bar[XB_XCNT(j)]); sum += c; cnt += (c > 0u) ? 1u : 0u; mine = (j == x) ? c : mine; }
        if (sum == G) break;
        __builtin_amdgcn_s_sleep(1);
        if ((++sp & 255u) == 0u) { if (xb_ld(&bar[XB_TMO])) break; if (sp > XB_SPIN_CAP) { atomicAdd(&bar[XB_TMO], 1u); break; } }
    }
    nloc = mine > 0u ? mine : 1u; nx = cnt > 0u ? cnt : 1u;
}
__device__ __forceinline__ void xcd_barrier(const XcdBarrier& b, const int tid) {
    asm volatile("s_waitcnt vmcnt(0)" ::: "memory");
    __syncthreads();
    if (tid == 0) {
        unsigned* bar = b.bar;
        __builtin_amdgcn_s_waitcnt(0);
        unsigned nloc = b.st[0], nx = b.st[1];
        if (nloc == 0u) { xcd_barrier_complete(bar, b.x, nloc, nx); b.st[0] = nloc; b.st[1] = nx; }
        const unsigned old = xb_add(&bar[XB_XSUB(b.x)], 1u);
        const unsigned gen = old / nloc;
        if (old + 1u == (gen + 1u) * nloc) {
            __builtin_amdgcn_fence(__ATOMIC_RELEASE, "agent");
            asm volatile("s_waitcnt vmcnt(0)" ::: "memory");
            const unsigned og = xb_add(&bar[XB_TOP], 1u);
            const unsigned tg = og / nx;
            if (og + 1u == (tg + 1u) * nx) xb_add(&bar[XB_TOPGEN], 1u);
            else XB_SPIN(xb_ld(&bar[XB_TOPGEN]) == tg, bar);
            __builtin_amdgcn_fence(__ATOMIC_ACQUIRE, "agent");
            xb_add(&bar[XB_XGEN(b.x)], 1u);
            asm volatile("s_waitcnt vmcnt(0)" ::: "memory");
        } else {
            XB_SPIN(xb_ld(&bar[XB_XGEN(b.x)]) == gen, bar);
            __builtin_amdgcn_fence(__ATOMIC_ACQUIRE, "agent");
            asm volatile("s_waitcnt vmcnt(0)" ::: "memory");
        }
    }
    __syncthreads();
}

template <int MAP> __device__ __forceinline__ void cvt_w(const float* __restrict__ src, u16* __restrict__ dst, int nmat, int K, int N, int NP, int wv, int nwv) {
    const int lane = threadIdx.x & 63; const int kt_n = K / 64, nt_n = N / 64, per = kt_n * nt_n;
    for (int t = wv; t < nmat * per; t += nwv) {
        const int mat = t / per, rem = t % per, nt = rem / kt_n, kt = rem % kt_n;
        const float* s = src + ((size_t)mat * K + (size_t)kt * 64) * N + nt * 64 + lane;
        float v[64];
#pragma unroll
        for (int k = 0; k < 64; ++k) v[k] = s[(size_t)k * N];
        const int n = nt * 64 + lane; int np = n;
        if (MAP == 1) { const int half = N / 2; const int which = n >= half ? 1 : 0; const int j = n - which * half; np = (j / 128) * 256 + ((j % 128) / 64) * 128 + ((j % 64) / 16) * 32 + which * 16 + (j % 16); }
        u16* d = dst + ((size_t)mat * NP + np) * K + kt * 64;
#pragma unroll
        for (int q = 0; q < 8; ++q) { u32x4 w; w.x = g8::cvt_pk_bf16(v[q * 8], v[q * 8 + 1]); w.y = g8::cvt_pk_bf16(v[q * 8 + 2], v[q * 8 + 3]); w.z = g8::cvt_pk_bf16(v[q * 8 + 4], v[q * 8 + 5]); w.w = g8::cvt_pk_bf16(v[q * 8 + 6], v[q * 8 + 7]);
            *(u32x4*)(d + q * 8) = w; }
    }
}
__device__ __forceinline__ void mod_tasks(const Ptrs& P, char* lds) {
    float* sc = (float*)lds;
    float* red = sc + 17 * 1024;
    float* mod = (float*)(P.ws + WS_MOD);
    const int tid = threadIdx.x, cl = tid & 127, kg = tid >> 7;
    __syncthreads();
    for (int idx = tid; idx < 17 * 1024; idx += 512) { const int r = idx >> 10, kk = idx & 1023; const float v = r < 16 ? P.in[1][r * 1024 + kk] : P.in[3][kk]; sc[idx] = silu_f(v); }
    __syncthreads();
    for (int task = blockIdx.x; task < 4 * 48; task += gridDim.x) {
        const int i = task / 48, cc = task % 48; const int col = cc * 128 + cl;
        const float* W = P.in[4] + ((size_t)i * 1024 + kg * 256) * 6144 + col;
        float acc[17];
#pragma unroll
        for (int r = 0; r < 17; ++r) acc[r] = 0.f;
#pragma unroll 8
        for (int kk = 0; kk < 256; ++kk) { const float w = W[(size_t)kk * 6144];
#pragma unroll
            for (int r = 0; r < 17; ++r) acc[r] += sc[r * 1024 + kg * 256 + kk] * w; }
#pragma unroll
        for (int r = 0; r < 17; ++r) red[(kg * 17 + r) * 128 + cl] = acc[r];
        __syncthreads();
        if (kg == 0) { const float bb = P.in[5][i * 6144 + col];
#pragma unroll
            for (int r = 0; r < 17; ++r) mod[(size_t)(i * 17 + r) * 6144 + col] = ((red[r * 128 + cl] + red[(17 + r) * 128 + cl]) + (red[(34 + r) * 128 + cl] + red[(51 + r) * 128 + cl])) + bb; }
        __syncthreads();
    }
}
__device__ __forceinline__ void s5_prep(const Ptrs& P, int j, int g, char* lds) {
    float2* Apow = (float2*)lds;
    float2* Bb = Apow + 2 * 64 * 17;
    float2* Cc = Bb + 2 * 64 * 16;
    float* Kt = (float*)(Cc + 2 * 16 * 64);
    const int tid = threadIdx.x;
    __syncthreads();
    if (tid < 128) { const int dir = tid >> 6, p = tid & 63; const size_t gd = ((size_t)j * 2 + dir) * SG + g;
        const float dt = __expf(P.in[10][gd]); const float ar = P.in[8][gd * SP + p], ai = P.in[9][gd * SP + p]; const float ldr = ar * dt, ldi = ai * dt;
        for (int tau = 0; tau <= 16; ++tau) { const float mag = __expf(ldr * (float)tau), ang = ldi * (float)tau; Apow[(dir * 64 + p) * 17 + tau] = make_float2(mag * __cosf(ang), mag * __sinf(ang)); }
        const float2 ab = Apow[(dir * 64 + p) * 17 + 1]; const float nr = ab.x - 1.f, ni = ab.y, den = ar * ar + ai * ai; const float qr = (nr * ar + ni * ai) / den, qi = (ni * ar - nr * ai) / den;
        for (int c = 0; c < 16; ++c) { const float br = P.in[11][(gd * SP + p) * SC + c], bi = P.in[12][(gd * SP + p) * SC + c]; Bb[(dir * 64 + p) * 16 + c] = make_float2(qr * br - qi * bi, qr * bi + qi * br); }
        ((float2*)(P.ws + WS_WB + WB_AT))[gd * SP + p] = Apow[(dir * 64 + p) * 17 + 16];
    }
    for (int i = tid; i < 2 * 16 * 64; i += 512) { const int d2 = i >> 10, c = (i >> 6) & 15, pp = i & 63; const size_t o = ((((size_t)j * 2 + d2) * SG + g) * SC + c) * SP + pp; Cc[i] = make_float2(P.in[13][o], P.in[14][o]); }
    __syncthreads();
    for (int idx = tid; idx < 8192; idx += 512) { const int dir = idx >> 12, tau = (idx >> 8) & 15, c = (idx >> 4) & 15, c2 = idx & 15; float s = 0.f;
        for (int p = 0; p < 64; ++p) { const float2 cc = Cc[(dir * 16 + c) * 64 + p], aa = Apow[(dir * 64 + p) * 17 + tau], bb = Bb[(dir * 64 + p) * 16 + c2];
            const float xr = aa.x * bb.x - aa.y * bb.y, xi = aa.x * bb.y + aa.y * bb.x; s += cc.x * xr - cc.y * xi; }
        Kt[idx] = s; }
    __syncthreads();
    u16* W1 = (u16*)(P.ws + WS_WB + WB_W1) + ((size_t)j * 64 + g) * 256 * 256; u16* W2 = (u16*)(P.ws + WS_WB + WB_W2) + ((size_t)j * 64 + g) * 256 * 512;
    for (int idx = tid; idx < 256 * 32; idx += 512) { const int row = idx >> 5, s8 = idx & 31; const int t = row >> 4, c = row & 15, s = s8 >> 1, cb = (s8 & 1) * 8;
        float v[8];
#pragma unroll
        for (int q = 0; q < 8; ++q) { const int c2 = cb + q;
            v[q] = s < t ? Kt[((0 * 16 + (t - s)) * 16 + c) * 16 + c2] : s > t ? Kt[((1 * 16 + (s - t)) * 16 + c) * 16 + c2] : Kt[((0 * 16 + 0) * 16 + c) * 16 + c2] + Kt[((1 * 16 + 0) * 16 + c) * 16 + c2]; }
        u32x4 w; w.x = g8::cvt_pk_bf16(v[0], v[1]); w.y = g8::cvt_pk_bf16(v[2], v[3]); w.z = g8::cvt_pk_bf16(v[4], v[5]); w.w = g8::cvt_pk_bf16(v[6], v[7]);
        *(u32x4*)(W2 + (size_t)row * 512 + s8 * 8) = w; }
    for (int idx = tid; idx < 256 * 128; idx += 512) { const int row = idx >> 7, dp = idx & 127; const int dir = dp >> 6, p = dp & 63, t = row >> 4, c = row & 15;
        const float2 cc = Cc[(dir * 16 + c) * 64 + p], aa = Apow[(dir * 64 + p) * 17 + (dir ? 16 - t : t + 1)];
        const float gr = cc.x * aa.x - cc.y * aa.y, gi = cc.x * aa.y + cc.y * aa.x;
        *(unsigned*)(W2 + (size_t)row * 512 + 256 + dir * 128 + 2 * p) = g8::cvt_pk_bf16(gr, -gi); }
    for (int idx = tid; idx < 256 * 32; idx += 512) { const int n = idx >> 5, s8 = idx & 31; const int dir = n >> 7, p = (n >> 1) & 63, ri = n & 1, s = s8 >> 1, cb = (s8 & 1) * 8;
        const float2 aa = Apow[(dir * 64 + p) * 17 + (dir ? s : 15 - s)];
        float v[8];
#pragma unroll
        for (int q = 0; q < 8; ++q) { const float2 bb = Bb[(dir * 64 + p) * 16 + cb + q]; v[q] = ri ? aa.x * bb.y + aa.y * bb.x : aa.x * bb.x - aa.y * bb.y; }
        u32x4 w; w.x = g8::cvt_pk_bf16(v[0], v[1]); w.y = g8::cvt_pk_bf16(v[2], v[3]); w.z = g8::cvt_pk_bf16(v[4], v[5]); w.w = g8::cvt_pk_bf16(v[6], v[7]);
        *(u32x4*)(W1 + (size_t)n * 256 + s8 * 8) = w; }
    __syncthreads();
}
__device__ __forceinline__ void prologue_phase(const Ptrs& P, char* lds) {
    const int gw = blockIdx.x * 8 + (threadIdx.x >> 6), nw = gridDim.x * 8;
    copy_small(P, blockIdx.x * 512 + threadIdx.x, gridDim.x * 512);
    { float4* X = (float4*)(P.ws + WS_X); const size_t n4 = (size_t)T * D / 4;
      for (size_t i = (size_t)blockIdx.x * 512 + threadIdx.x; i < n4; i += (size_t)gridDim.x * 512) { const size_t row = i / 256, c4 = i % 256; const int b = (int)(row / LTOT), pos = (int)(row % LTOT);
          X[i] = pos < CTXL ? ((const float4*)P.in[2])[((size_t)b * CTXL + pos) * 256 + c4] : ((const float4*)P.in[0])[((size_t)b * SEQ + (pos - CTXL)) * 256 + c4]; }
      float2* rope = (float2*)(P.ws + WS_ROPE);
      for (int i = blockIdx.x * 512 + threadIdx.x; i < 2048 * 32; i += gridDim.x * 512) { const int s = i >> 5, k = i & 31, f = k & 15; const float invf = exp2f(-(float)f * (13.287712379549449f / 16.f));
          const float ang = (float)(k < 16 ? (s >> 6) : (s & 63)) * invf; rope[i] = make_float2(__cosf(ang), __sinf(ang)); } }
    mod_tasks(P, lds);
    for (int idx = blockIdx.x; idx < 128; idx += gridDim.x) s5_prep(P, idx >> 6, idx & 63, lds);
    unsigned char* wb = P.ws + WS_WB;
    cvt_w<1>(P.in[16], (u16*)(wb + WB_GLU), 2, 1024, 2048, 2048, gw, nw);
    cvt_w<0>(P.in[17], (u16*)(wb + WB_WIN), 2, 1024, 704, 768, gw, nw);
    for (int i = blockIdx.x * 512 + threadIdx.x; i < 2 * 64 * 1024 / 8; i += gridDim.x * 512) { const int mat = i / 8192, r = i % 8192; *(u32x4*)((u16*)(wb + WB_WIN) + ((size_t)mat * 768 + 704) * 1024 + (size_t)r * 8) = (u32x4){0u, 0u, 0u, 0u}; }
    cvt_w<0>(P.in[20], (u16*)(wb + WB_UQ), 2, 384, 1536, 1536, gw, nw);
    cvt_w<0>(P.in[21], (u16*)(wb + WB_UKV), 2, 256, 2048, 2048, gw, nw);
    cvt_w<0>(P.in[22], (u16*)(wb + WB_WO), 2, 1024, 1024, 1024, gw, nw);
    cvt_w<1>(P.in[27], (u16*)(wb + WB_GU), 128, 1024, 1024, 1024, gw, nw);
    cvt_w<0>(P.in[28], (u16*)(wb + WB_DN), 128, 512, 1024, 1024, gw, nw);
}
__device__ __forceinline__ void s5_scan_phase(unsigned char* wsp, int j, int wv) {
    struct { unsigned char* ws; } P{wsp};
    const int tids = tid_opaque(wv); const int lane = tids & 63;
    const float* S = (const float*)(P.ws + WS_R1 + R1_S); u16* UH = (u16*)(P.ws + WS_R1 + R1_UH); const float2* AT = (const float2*)(P.ws + WS_WB + WB_AT);
    for (int task = blockIdx.x * 8 + (tids >> 6); task < 2048; task += gridDim.x * 8) {
        const int g = task >> 5, b = (task >> 1) & 15, dir = task & 1;
        const float2 a = AT[(((size_t)j * 2 + dir) * SG + g) * SP + lane];
        const float* sp = S + ((size_t)g * 2304 + b * 144) * 256 + dir * 128 + 2 * lane; u16* hp = UH + ((size_t)g * 2304 + b * 144) * 512 + 256 + dir * 128 + 2 * lane;
        float hr = 0.f, hi = 0.f;
        for (int s0 = 0; s0 < 144; s0 += 16) {
            float2 sv[16];
#pragma unroll
            for (int k = 0; k < 16; ++k) { const int st = s0 + k; const int n = dir ? (st < 16 ? 15 - st : 159 - st) : st; sv[k] = *(const float2*)(sp + (size_t)n * 256); }
#pragma unroll
            for (int k = 0; k < 16; ++k) { const int st = s0 + k; const int n = dir ? (st < 16 ? 15 - st : 159 - st) : st;
                *(unsigned*)(hp + (size_t)n * 512) = g8::cvt_pk_bf16(hr, hi);
                const float nr = a.x * hr - a.y * hi + sv[k].x, ni = a.x * hi + a.y * hr + sv[k].y; hr = nr; hi = ni; }
        }
    }
}
__device__ __forceinline__ void mla_post_rows(unsigned char* wsp, int j, const float* Pm, int stride, int nwaves_blk, int wv) {
    struct { unsigned char* ws; } P{wsp}; const float* sm = (const float*)(wsp + WS_SMALL);
    const int tidp = tid_opaque(wv); const int lane = tidp & 63, wave = tidp >> 6;
    u16* CQ = (u16*)(P.ws + WS_CQ); u16* CKV = (u16*)(P.ws + WS_CKV); u16* KT = (u16*)(P.ws + WS_R1 + R1_KT); const float2* rope = (const float2*)(P.ws + WS_ROPE);
    for (int row = blockIdx.x * nwaves_blk + wave; row < T; row += gridDim.x * nwaves_blk) {
        const float* t = Pm + (size_t)row * stride; const int b = row / LTOT, pos = row % LTOT;
        float q[6]; float ss = 0.f;
#pragma unroll
        for (int i = 0; i < 6; ++i) { q[i] = t[i * 64 + lane]; ss += q[i] * q[i]; }
        ss = wave_sum_l(ss, lane); float rstd = rsqrtf(ss * (1.f / 384.f) + EPS);
#pragma unroll
        for (int i = 0; i < 6; ++i) CQ[(size_t)row * QR + i * 64 + lane] = f2bf(q[i] * rstd * sm[SM_GQ + j * QR + i * 64 + lane]);
        float k[4]; ss = 0.f;
#pragma unroll
        for (int i = 0; i < 4; ++i) { k[i] = t[384 + i * 64 + lane]; ss += k[i] * k[i]; }
        ss = wave_sum_l(ss, lane); rstd = rsqrtf(ss * (1.f / 256.f) + EPS);
#pragma unroll
        for (int i = 0; i < 4; ++i) CKV[(size_t)row * KVR + i * 64 + lane] = f2bf(k[i] * rstd * sm[SM_GKV + j * KVR + i * 64 + lane]);
        float v = t[640 + lane];
        if (pos >= CTXL) { const float pv = t[640 + (lane ^ 16)]; const float2 cs = rope[(size_t)(pos - CTXL) * 32 + (lane >> 5) * 16 + (lane & 15)];
            v = (lane & 16) ? v * cs.x + pv * cs.y : v * cs.x - pv * cs.y; }
        const u16 kb = f2bf(v);
#pragma unroll
        for (int h = 0; h < NH; ++h) KT[(((size_t)b * NH + h) * LTOT + pos) * QKD + 128 + lane] = kb;
    }
}
__device__ __forceinline__ void attn_phase(unsigned char* wsp, bool ctx_out, char* lds, int wv) {
    struct { unsigned char* ws; } P{wsp};
    const u16* QT = (const u16*)(P.ws + WS_R1 + R1_QT); const u16* KT = (const u16*)(P.ws + WS_R1 + R1_KT); const u16* VT = (const u16*)(P.ws + WS_R1 + R1_VT); u16* O = (u16*)(P.ws + WS_ZO);
    const int nunits = ctx_out ? 1152 : 1024;
    for (int u = blockIdx.x; u < nunits; u += gridDim.x) {
        int bh, qt, seq;
        if (u < 1024) { const int xcd = u & 7, k = u >> 3; bh = xcd * 16 + (k >> 3); qt = 1 + (k & 7); seq = LTOT; } else { bh = u - 1024; qt = 0; seq = CTXL; }
        const int b = bh >> 3, h = bh & 7;
        at::attn_body(QT + ((size_t)bh * LTOT + qt * 256) * QKD, KT + (size_t)bh * LTOT * QKD, VT + (size_t)bh * LTOT * 128, O + ((size_t)b * LTOT + qt * 256) * D + h * 128, D, seq, lds, wv);
    }
}
constexpr int LDS_MISC = g8::STAGE_BYTES;
constexpr int LDS_BYTES = g8::STAGE_BYTES + 1024;
constexpr int NPHASE = 42;
struct MkArgs { Ptrs P; int lo, hi, bar_region, pad; };
__global__ void __launch_bounds__(512, 2) mk(MkArgs a) {
    extern __shared__ __attribute__((aligned(16))) unsigned char lds[];
    LAS unsigned char* ldsl = (LAS unsigned char*)lds;
    volatile LAS unsigned* misc = (volatile LAS unsigned*)(ldsl + LDS_MISC);
    int* sbase = (int*)(lds + LDS_MISC + 64);
    const int wv = __builtin_amdgcn_readfirstlane(threadIdx.x >> 6);
    if (threadIdx.x < 4) misc[threadIdx.x] = 0u;
    __syncthreads();
    const bool use_bar = (a.hi - a.lo) > 1;
    unsigned char* ws = a.P.ws; float* outp = a.P.out;
    XcdBarrier bar; bar.bar = (unsigned*)(ws + WS_CTL) + a.bar_region * XCD_BAR_WORDS; bar.x = 0; bar.st = misc;
    if (use_bar) bar = xcd_barrier_post((unsigned*)(ws + WS_CTL) + a.bar_region * XCD_BAR_WORDS, misc);
    const int lo = a.lo, hi = a.hi;
#define IN(k) (lo <= (k) && (k) < hi)
#define SEAM(k) do { if (IN((k) + 1)) xcd_barrier(bar, tid_opaque(wv)); } while (0)
    unsigned char* const ws0 = ws;
    if (IN(0)) { prologue_phase(a.P, (char*)lds); SEAM(0); }
    for (int li = 0; li < 4; ++li) {
        const int base = 1 + li * 10, j = li >> 1;
#define PH_BEGIN size_t zoff_ = 0; asm volatile("" : "+s"(zoff_)); unsigned char* ws = ws0 + zoff_; unsigned char* wb = ws + WS_WB; const float* sm = (const float*)(ws + WS_SMALL); float* X = (float*)(ws + WS_X); const float* mod = (const float*)(ws + WS_MOD); (void)wb; (void)sm; (void)X; (void)mod;
        if ((li & 1) == 0) {
            if (IN(base + 0)) { PH_BEGIN if (li == 0) norm_rows<4>(ws, outp, li, 0, 8, sbase, wv); else norm_rows<5>(ws, outp, li, 0, 8, sbase, wv); SEAM(base + 0); }
            if (IN(base + 1)) { PH_BEGIN SchedS5 S; S.init(ws + WS_R1 + R1_UH, wb + WB_W1 + (size_t)j * 64 * 256 * 256 * 2, 256); EpiS5a E{(float*)(ws + WS_R1 + R1_S)};
                g8::gemm_phase<EpiS5a, SchedS5>(ldsl, 256, S, E, wv); SEAM(base + 1); }
            if (IN(base + 2)) { PH_BEGIN s5_scan_phase(ws, j, wv); SEAM(base + 2); }
            if (IN(base + 3)) { PH_BEGIN SchedS5 S; S.init(ws + WS_R1 + R1_UH, wb + WB_W2 + (size_t)j * 64 * 256 * 512 * 2, 512); EpiS5b E{(u16*)(ws + WS_ZO), (const u16*)(ws + WS_R1 + R1_UH), sm + SM_S5D + j * 1024};
                g8::gemm_phase<EpiS5b, SchedS5>(ldsl, 512, S, E, wv); SEAM(base + 3); }
            if (IN(base + 4)) { PH_BEGIN SchedDense S; S.init(ws + WS_ZO, 1024, wb + WB_GLU + (size_t)j * 2048 * 1024 * 2, T, 2048, 1024); EpiGlu E{X, mod, li};
                g8::gemm_phase<EpiGlu, SchedDense>(ldsl, 1024, S, E, wv); SEAM(base + 4); }
        } else {
            if (IN(base + 0)) { PH_BEGIN norm_rows<3>(ws, outp, li, 0, 8, sbase, wv); SEAM(base + 0); }
            if (IN(base + 1)) { PH_BEGIN SchedDense S; S.init(ws + WS_HX, 1024, wb + WB_WIN + (size_t)j * 768 * 1024 * 2, T, 768, 1024); EpiF32 E{(float*)(ws + WS_YB), 768};
                g8::gemm_phase<EpiF32, SchedDense>(ldsl, 1024, S, E, wv); SEAM(base + 1); }
            if (IN(base + 2)) { PH_BEGIN mla_post_rows(ws, j, (const float*)(ws + WS_YB), 768, 8, wv); SEAM(base + 2); }
            if (IN(base + 3)) { PH_BEGIN
                { SchedDense S; S.init(ws + WS_CQ, QR, wb + WB_UQ + (size_t)j * 1536 * 384 * 2, T, 1536, 384); EpiQ E{(u16*)(ws + WS_R1 + R1_QT), (const float2*)(ws + WS_ROPE)};
                  g8::gemm_phase<EpiQ, SchedDense>(ldsl, 384, S, E, wv); }
                { SchedDense S; S.init(ws + WS_CKV, KVR, wb + WB_UKV + (size_t)j * 2048 * 256 * 2, T, 2048, 256); EpiKV E{(u16*)(ws + WS_R1 + R1_KT), (u16*)(ws + WS_R1 + R1_VT)};
                  int kk_ = 256; asm volatile("" : "+s"(kk_)); g8::gemm_phase<EpiKV, SchedDense>(ldsl, kk_, S, E, wv); }
                SEAM(base + 3); }
            if (IN(base + 4)) { PH_BEGIN attn_phase(ws, li != 3, (char*)lds, wv); SEAM(base + 4); }
            if (IN(base + 5)) { PH_BEGIN SchedDense S; S.init(ws + WS_ZO, 1024, wb + WB_WO + (size_t)j * 1024 * 1024 * 2, T, 1024, 1024); EpiWo E{X, mod, li};
                g8::gemm_phase<EpiWo, SchedDense>(ldsl, 1024, S, E, wv); SEAM(base + 5); }
        }
        if (IN(base + 6)) { PH_BEGIN norm_rows<10>(ws, outp, li, 1, 8, sbase, wv); SEAM(base + 6); }
        if (IN(base + 7) || IN(base + 8)) {
            const unsigned* cnt = (const unsigned*)(ws0 + WS_CTL) + CW_CNT + li * 32;
            __syncthreads();
            if (tid_opaque(wv) == 0) { int acc = 0; for (int e = 0; e < 32; ++e) { sbase[e] = acc; acc += (int)((cnt[e] + 255u) / 256u); } sbase[32] = acc; }
            __syncthreads();
            if (IN(base + 7)) { PH_BEGIN SchedMoe<true> S; S.init(ws + WS_HX, wb + WB_GU + (size_t)li * 32 * 1024 * 1024 * 2, 1024, sbase, cnt, (const int*)(ws + WS_LIST)); EpiMoe1 E{(u16*)(ws + WS_R1 + R1_ACT)};
                g8::gemm_phase<EpiMoe1, SchedMoe<true>>(ldsl, 1024, S, E, wv); SEAM(base + 7); }
            if (IN(base + 8)) { PH_BEGIN SchedMoe<false> S; S.init(ws + WS_R1 + R1_ACT, wb + WB_DN + (size_t)li * 32 * 1024 * 512 * 2, 512, sbase, cnt, (const int*)(ws + WS_LIST)); EpiMoe2 E{(u16*)(ws + WS_YB)};
                g8::gemm_phase<EpiMoe2, SchedMoe<false>>(ldsl, 512, S, E, wv); SEAM(base + 8); }
        }
    }
    if (IN(41)) norm_rows<17>(ws0, outp, 4, 0, 8, sbase, wv);
#undef PH_BEGIN
#undef IN
#undef SEAM
}
__global__ __launch_bounds__(256) void n_post_win(Ptrs P, int j) { mla_post_rows(P.ws, j, (const float*)(P.ws + WS_YB), 768, 4, __builtin_amdgcn_readfirstlane(threadIdx.x >> 6)); }
static void gemm_naive(hipStream_t st, const void* A, int lda, const int* rowidx, const float* B, int ldb, long bstride, const int* tileexp, const int* mdyn, float* C, int ldc, int M, int N, int K) {
    NG g{}; g.A = A; g.lda = lda; g.rowidx = rowidx; g.B = B; g.ldb = ldb; g.bstride = bstride; g.tileexp = tileexp; g.mdyn = mdyn; g.C = C; g.ldc = ldc; g.M = M; g.N = N; g.K = K; g.pad = 0;
    hipLaunchKernelGGL(n_gemm<1>, dim3(N / 64, (M + 63) / 64), dim3(256), 0, st, g);
}
#ifndef REALMASK_STR
#define REALMASK_STR "111111111111111111111111111111111111111111"
#endif
extern "C" void kernel_launch(void* const* d_in, const int* in_sizes, int n_in, void* d_out, int out_size, void* d_ws, size_t ws_size, hipStream_t stream) {
    static int grid = 0;
    static const char* realmask = REALMASK_STR;
    if (grid == 0) {
        if (n_in != 30 || out_size != NB * SEQ * D || ws_size < WS_NEND) { fprintf(stderr, "kernel_launch: unexpected shapes n_in %d out %d ws %zu (need %zu)\n", n_in, out_size, ws_size, (size_t)WS_NEND); grid = -1; return; }
        int dev = 0, cus = 0, per_cu = 0;
        if (hipGetDevice(&dev) != hipSuccess || hipDeviceGetAttribute(&cus, hipDeviceAttributeMultiprocessorCount, dev) != hipSuccess) { grid = -1; return; }
        if (hipFuncSetAttribute((const void*)mk, hipFuncAttributeMaxDynamicSharedMemorySize, LDS_BYTES) != hipSuccess) { fprintf(stderr, "kernel_launch: hipFuncSetAttribute failed\n"); grid = -1; return; }
        if (hipOccupancyMaxActiveBlocksPerMultiprocessor(&per_cu, (const void*)mk, 512, LDS_BYTES) != hipSuccess || per_cu < 1) { fprintf(stderr, "kernel_launch: occupancy query says %d\n", per_cu); }
        (void)hipGetLastError();
        grid = cus;
    }
    if (grid < 0) return;
    Ptrs P{}; for (int i = 0; i < 30; ++i) P.in[i] = (const float*)d_in[i]; P.out = (float*)d_out; P.ws = (unsigned char*)d_ws;
    unsigned char* ws = P.ws;
    (void)hipMemsetAsync(ws + WS_CTL, 0, ZERO_BYTES, stream);
    int nreg = 0;
    auto real = [&](int p) { return realmask[p] == '1'; };
    auto run_mk = [&](int lo, int hi) { MkArgs a{}; a.P = P; a.lo = lo; a.hi = hi; a.bar_region = (hi - lo > 1) ? nreg++ : 0; a.pad = 0; hipLaunchKernelGGL(mk, dim3(grid), dim3(512), LDS_BYTES, stream, a); };
    const int NG_ = 4096; float* NTMP = (float*)(ws + WS_NTMP);
    int p = 0;
    while (p < NPHASE) {
        if (real(p)) { int q = p; while (q < NPHASE && real(q)) ++q; run_mk(p, q); p = q; continue; }
        if (p == 0) { hipLaunchKernelGGL(k_mod, dim3(24, 4), dim3(256), 0, stream, P); hipLaunchKernelGGL(k_init, dim3(2048), dim3(256), 0, stream, P); }
        else if (p == 41) hipLaunchKernelGGL(k_norm<17>, dim3(2048), dim3(256), 0, stream, P, 4, 0);
        else {
            const int li = (p - 1) / 10, k = (p - 1) % 10, j = li >> 1; const bool s5 = (li & 1) == 0;
            if (k == 0) { if (li == 0) hipLaunchKernelGGL(k_norm<2>, dim3(2048), dim3(256), 0, stream, P, li, 0); else hipLaunchKernelGGL(k_norm<3>, dim3(2048), dim3(256), 0, stream, P, li, 0); }
            else if (s5 && k == 1) { hipLaunchKernelGGL(n_s5, dim3(NB * SG), dim3(128), 0, stream, P, j); }
            else if (s5 && k == 3) { hipLaunchKernelGGL(n_post_s5, dim3(NG_), dim3(256), 0, stream, P, j); }
            else if (s5 && k == 4) { gemm_naive(stream, ws + WS_ZO, D, nullptr, P.in[16] + (size_t)j * 1024 * 2048, 2048, 0, nullptr, nullptr, NTMP, 2048, T, 2048, 1024); hipLaunchKernelGGL(n_post_glu, dim3(NG_), dim3(256), 0, stream, P, li); }
            else if (!s5 && k == 1) { gemm_naive(stream, ws + WS_HX, D, nullptr, P.in[17] + (size_t)j * 1024 * 704, 704, 0, nullptr, nullptr, (float*)(ws + WS_YB), 768, T, 704, 1024); }
            else if (!s5 && k == 2) { hipLaunchKernelGGL(n_post_win, dim3(2048), dim3(256), 0, stream, P, j); }
            else if (!s5 && k == 3) {
                gemm_naive(stream, ws + WS_CQ, QR, nullptr, P.in[20] + (size_t)j * 384 * 1536, 1536, 0, nullptr, nullptr, NTMP, 1536, T, 1536, 384); hipLaunchKernelGGL(n_post_q, dim3(NG_), dim3(256), 0, stream, P);
                gemm_naive(stream, ws + WS_CKV, KVR, nullptr, P.in[21] + (size_t)j * 256 * 2048, 2048, 0, nullptr, nullptr, NTMP, 2048, T, 2048, 256); hipLaunchKernelGGL(n_post_kv, dim3(NG_), dim3(256), 0, stream, P); }
            else if (!s5 && k == 4) { hipLaunchKernelGGL(n_attn, dim3(LTOT / 64, NH, NB), dim3(256), 0, stream, P); }
            else if (!s5 && k == 5) { gemm_naive(stream, ws + WS_ZO, D, nullptr, P.in[22] + (size_t)j * 1024 * 1024, 1024, 0, nullptr, nullptr, NTMP, 1024, T, 1024, 1024); hipLaunchKernelGGL(n_post_wo, dim3(NG_), dim3(256), 0, stream, P, li); }
            else if (k == 6) { hipLaunchKernelGGL(k_norm<10>, dim3(2048), dim3(256), 0, stream, P, li, 1); }
            else if (k == 7 || k == 8) {
                const int* tileexp = (const int*)(ws + WS_TILEEXP);
                hipLaunchKernelGGL(n_build, dim3(1), dim3(256), 0, stream, P, li);
                if (k == 7) { gemm_naive(stream, ws + WS_HX, D, (const int*)(ws + WS_SLOTROW), P.in[27] + (size_t)li * 32 * 1024 * 1024, 1024, 1024L * 1024, tileexp, tileexp + 512, NTMP, 1024, MAXSLOT, 1024, 1024);
                    hipLaunchKernelGGL(n_post_act2, dim3(NG_), dim3(256), 0, stream, P, (u16*)(ws + WS_R1 + R1_ACT)); }
                else { gemm_naive(stream, ws + WS_R1 + R1_ACT, 512, nullptr, P.in[28] + (size_t)li * 32 * 512 * 1024, 1024, 512L * 1024, tileexp, tileexp + 512, NTMP, 1024, MAXSLOT, 1024, 512);
                    hipLaunchKernelGGL(n_post_y, dim3(NG_), dim3(256), 0, stream, P); }
            }
        }
        ++p;
    }
}
```

```cpp
#define MK_FULL 1
#include <hip/hip_runtime.h>
#include <cstdio>
#include <cstdint>

typedef unsigned short u16;
typedef unsigned short bf16_t;

constexpr int D = 1024, NB = 16, SEQ = 2048, CTXL = 256, LTOT = 2304, T = NB * LTOT;
constexpr int SG = 64, SP = 64, SC = 16;
constexpr int QR = 384, KVR = 256, NH = 8, QKD = 192;
constexpr int NE = 32;
constexpr int MAXSLOT = 81920;
constexpr float EPS = 1e-6f;

constexpr size_t al256(size_t x) { return (x + 255) / 256 * 256; }
constexpr size_t WS_CTL = 0;
constexpr size_t CTL_BYTES = 131072;
constexpr size_t WS_MOD = WS_CTL + CTL_BYTES;
constexpr size_t MOD_BYTES = al256((size_t)4 * 17 * 6144 * 4);
constexpr size_t ZERO_BYTES = CTL_BYTES;
constexpr size_t WS_ROPE = WS_MOD + MOD_BYTES;
constexpr size_t WS_SMALL = WS_ROPE + al256((size_t)2048 * 32 * 8);
constexpr int SM_GMIX = 0, SM_GFFN = 4096, SM_S5D = 8192, SM_GQ = 10240, SM_GKV = 11008, SM_FINALG = 11520, SM_BGROUP = 12544, SM_BEXP = 12560, SM_WGROUP = 12800, SM_WEXP = 29184, SM_END = 160256;
constexpr size_t WS_X = WS_SMALL + al256((size_t)SM_END * 4);
constexpr size_t WS_HX = WS_X + (size_t)T * D * 4;
constexpr size_t WS_ZO = WS_HX + (size_t)T * D * 2;
constexpr size_t WS_CQ = WS_ZO + (size_t)T * D * 2;
constexpr size_t WS_CKV = WS_CQ + (size_t)T * QR * 2;
constexpr size_t WS_SELI = WS_CKV + (size_t)T * KVR * 2;
constexpr size_t WS_SELW = WS_SELI + (size_t)T * 16;
constexpr size_t WS_LIST = WS_SELW + (size_t)T * 8;
constexpr size_t WS_SLOTROW = WS_LIST + (size_t)NE * T * 4;
constexpr size_t WS_TILEEXP = WS_SLOTROW + (size_t)MAXSLOT * 4;
constexpr size_t WS_R1 = WS_TILEEXP + 4096;
constexpr size_t R1_BYTES = (size_t)MAXSLOT * 1024 * 4;
constexpr size_t WS_YB = WS_R1 + R1_BYTES;
constexpr size_t WS_WB = WS_YB + (size_t)MAXSLOT * 1024 * 2;
constexpr size_t R1_QT = 0;
constexpr size_t R1_KT = R1_QT + (size_t)NB * NH * LTOT * QKD * 2;
constexpr size_t R1_VT = R1_KT + (size_t)NB * NH * LTOT * QKD * 2;
constexpr size_t R1_ACT = 0;
constexpr size_t R1_S = 0;
constexpr size_t R1_UH = (size_t)64 * 2304 * 256 * 4;
constexpr size_t WB_GLU = 0;
constexpr size_t WB_WIN = WB_GLU + (size_t)2 * 2048 * 1024 * 2;
constexpr size_t WB_UQ = WB_WIN + (size_t)2 * 768 * 1024 * 2;
constexpr size_t WB_UKV = WB_UQ + (size_t)2 * 1536 * 384 * 2;
constexpr size_t WB_WO = WB_UKV + (size_t)2 * 2048 * 256 * 2;
constexpr size_t WB_GU = WB_WO + (size_t)2 * 1024 * 1024 * 2;
constexpr size_t WB_DN = WB_GU + (size_t)128 * 1024 * 1024 * 2;
constexpr size_t WB_W1 = WB_DN + (size_t)128 * 1024 * 512 * 2;
constexpr size_t WB_W2 = WB_W1 + (size_t)128 * 256 * 256 * 2;
constexpr size_t WB_AT = WB_W2 + (size_t)128 * 256 * 512 * 2;
constexpr size_t WB_END = WB_AT + (size_t)2 * 2 * 64 * 64 * 8;
constexpr size_t WS_END = WS_WB + WB_END;
constexpr size_t WS_NTMP = al256(WS_END);
constexpr size_t WS_NEND = WS_NTMP + (size_t)MAXSLOT * 1024 * 4;
static_assert(R1_UH + (size_t)64 * 2304 * 512 * 2 <= R1_BYTES, "R1");
static_assert(R1_VT + (size_t)NB * NH * LTOT * 128 * 2 <= R1_BYTES, "R1");
constexpr int CS = 64;
constexpr int CW_CNT = 8192;
constexpr int CW_CNT_DUMMY = 16384;
constexpr int CW_STAMP64 = 12288;

__device__ __forceinline__ float bf2f(u16 v) { return __uint_as_float(((unsigned)v) << 16); }
__device__ __forceinline__ u16 f2bf(float f) { unsigned u = __float_as_uint(f); u += 0x7FFFu + ((u >> 16) & 1u); return (u16)(u >> 16); }
__device__ __forceinline__ float silu_f(float x) { return x / (1.f + __expf(-x)); }
__device__ __forceinline__ float sigmoid_f(float x) { return 1.f / (1.f + __expf(-x)); }
__device__ __forceinline__ float gelu_tanh(float x) { const float u = 0.7978845608028654f * (x + 0.044715f * x * x * x); const float e = __expf(2.f * u); const float t = 1.f - 2.f / (e + 1.f); return 0.5f * x * (1.f + t); }
__device__ __forceinline__ float wave_sum(float v) {
#pragma unroll
    for (int o = 32; o > 0; o >>= 1) v += __shfl_xor(v, o);
    return v;
}

struct Ptrs { const float* in[30]; float* out; unsigned char* ws; };
__device__ __forceinline__ int tid_opaque(int wv) { int l; asm volatile("v_mbcnt_lo_u32_b32 %0, -1, 0\n\tv_mbcnt_hi_u32_b32 %0, -1, %0" : "=v"(l)); return (wv << 6) | l; }
__device__ __forceinline__ float wave_sum_l(float v, int lane) {
#pragma unroll
    for (int o = 32; o > 0; o >>= 1) v += __int_as_float(__builtin_amdgcn_ds_bpermute((lane ^ o) << 2, __float_as_int(v)));
    return v;
}

__global__ __launch_bounds__(256) void k_mod(Ptrs P) {
    __shared__ float sc[17][64];
    const int i = blockIdx.y, col = blockIdx.x * 256 + threadIdx.x, tid = threadIdx.x;
    const float* W = P.in[4] + (size_t)i * 1024 * 6144;
    float acc[17];
#pragma unroll
    for (int r = 0; r < 17; ++r) acc[r] = 0.f;
    for (int k0 = 0; k0 < 1024; k0 += 64) {
        __syncthreads();
        for (int idx = tid; idx < 17 * 64; idx += 256) { const int r = idx >> 6, kk = idx & 63; const float v = r < 16 ? P.in[1][r * 1024 + k0 + kk] : P.in[3][k0 + kk]; sc[r][kk] = silu_f(v); }
        __syncthreads();
#pragma unroll 8
        for (int kk = 0; kk < 64; ++kk) { const float w = W[(size_t)(k0 + kk) * 6144 + col];
#pragma unroll
            for (int r = 0; r < 17; ++r) acc[r] += sc[r][kk] * w; }
    }
    float* mod = (float*)(P.ws + WS_MOD);
    const float bb = P.in[5][i * 6144 + col];
#pragma unroll
    for (int r = 0; r < 17; ++r) mod[(size_t)(i * 17 + r) * 6144 + col] = acc[r] + bb;
}
__device__ __forceinline__ void copy_small(const Ptrs& P, int t0, int nt) {
    float* sm = (float*)(P.ws + WS_SMALL);
    for (int i = t0; i < 4096; i += nt) { sm[SM_GMIX + i] = P.in[6][i]; sm[SM_GFFN + i] = P.in[7][i]; }
    for (int i = t0; i < 2048; i += nt) sm[SM_S5D + i] = P.in[15][i];
    for (int i = t0; i < 768; i += nt) sm[SM_GQ + i] = P.in[18][i];
    for (int i = t0; i < 512; i += nt) sm[SM_GKV + i] = P.in[19][i];
    for (int i = t0; i < 1024; i += nt) sm[SM_FINALG + i] = P.in[29][i];
    for (int i = t0; i < 16; i += nt) sm[SM_BGROUP + i] = P.in[24][i];
    for (int i = t0; i < 128; i += nt) sm[SM_BEXP + i] = P.in[26][i];
    for (int i = t0; i < 16384; i += nt) sm[SM_WGROUP + i] = P.in[23][i];
    for (int i = t0; i < 131072; i += nt) sm[SM_WEXP + i] = P.in[25][i];
}
__global__ __launch_bounds__(256) void k_init(Ptrs P) {
    copy_small(P, blockIdx.x * 256 + threadIdx.x, gridDim.x * 256);
    float4* X = (float4*)(P.ws + WS_X);
    const size_t n4 = (size_t)T * D / 4;
    for (size_t i = (size_t)blockIdx.x * 256 + threadIdx.x; i < n4; i += (size_t)gridDim.x * 256) {
        const size_t row = i / 256, c4 = i % 256; const int b = (int)(row / LTOT), pos = (int)(row % LTOT);
        X[i] = pos < CTXL ? ((const float4*)P.in[2])[((size_t)b * CTXL + pos) * 256 + c4] : ((const float4*)P.in[0])[((size_t)b * SEQ + (pos - CTXL)) * 256 + c4];
    }
    float2* rope = (float2*)(P.ws + WS_ROPE);
    for (int i = blockIdx.x * 256 + threadIdx.x; i < 2048 * 32; i += gridDim.x * 256) {
        const int s = i >> 5, k = i & 31, f = k & 15; const float invf = exp2f(-(float)f * (13.287712379549449f / 16.f));
        const float ang = (float)(k < 16 ? (s >> 6) : (s & 63)) * invf;
        rope[i] = make_float2(__cosf(ang), __sinf(ang));
    }
}

template <int MODE>
__device__ __forceinline__ void norm_rows(unsigned char* wsp, float* outp, int li, int which, int nwaves_blk, int* s_base, int wv) {
    struct { unsigned char* ws; float* out; } P{wsp, outp}; const float* sm = (const float*)(wsp + WS_SMALL);
    const int tidn = tid_opaque(wv); const int lane = tidn & 63, wave = tidn >> 6;
    float* X = (float*)(P.ws + WS_X);
    const float* mod = (const float*)(P.ws + WS_MOD);
    if (MODE & 1) {
        if (tidn == 0) { const unsigned* cnt = (const unsigned*)(P.ws + WS_CTL) + CW_CNT + (li - 1) * 32 * CS; int a = 0; for (int e = 0; e < 32; ++e) { s_base[e] = a; a += (int)((cnt[e * CS] + 255u) / 256u); } s_base[32] = a; }
        __syncthreads();
    }
    const bool lastl = (li == 3);
    for (int row = blockIdx.x * nwaves_blk + wave; row < T; row += gridDim.x * nwaves_blk) {
        const int b = row / LTOT, pos = row % LTOT; const bool isctx = pos < CTXL; const int r = isctx ? 16 : b;
        if ((MODE & 16) && isctx) continue;
        if ((MODE & 8) && lastl && isctx) continue;
        float4 v[4];
#pragma unroll
        for (int q = 0; q < 4; ++q) v[q] = *(const float4*)(X + (size_t)row * D + q * 256 + lane * 4);
        if (MODE & 1) {
            const bool skip = (li - 1 == 3) && isctx;
            if (!skip) {
                const int4 si = *(const int4*)(P.ws + WS_SELI + (size_t)row * 16); const float2 sw = *(const float2*)(P.ws + WS_SELW + (size_t)row * 8);
                const size_t g1 = (size_t)s_base[si.x] * 256 + si.y, g2 = (size_t)s_base[si.z] * 256 + si.w;
                const u16* YB = (const u16*)(P.ws + WS_YB);
                const float* gate = mod + (size_t)((li - 1) * 17 + r) * 6144 + 5 * 1024;
#pragma unroll
                for (int q = 0; q < 4; ++q) { const int c = q * 256 + lane * 4;
                    const uint2 ya = *(const uint2*)(YB + g1 * 1024 + c), yb = *(const uint2*)(YB + g2 * 1024 + c); const float4 gg = *(const float4*)(gate + c);
                    v[q].x += gg.x * (sw.x * bf2f((u16)(ya.x & 0xffff)) + sw.y * bf2f((u16)(yb.x & 0xffff)));
                    v[q].y += gg.y * (sw.x * bf2f((u16)(ya.x >> 16)) + sw.y * bf2f((u16)(yb.x >> 16)));
                    v[q].z += gg.z * (sw.x * bf2f((u16)(ya.y & 0xffff)) + sw.y * bf2f((u16)(yb.y & 0xffff)));
                    v[q].w += gg.w * (sw.x * bf2f((u16)(ya.y >> 16)) + sw.y * bf2f((u16)(yb.y >> 16)));
                    if (!(MODE & 16)) *(float4*)(X + (size_t)row * D + c) = v[q]; }
            }
        }
        float ss = 0.f;
#pragma unroll
        for (int q = 0; q < 4; ++q) ss += v[q].x * v[q].x + v[q].y * v[q].y + v[q].z * v[q].z + v[q].w * v[q].w;
        ss = wave_sum_l(ss, lane);
        const float rstd = rsqrtf(ss * (1.f / 1024.f) + EPS);
        if (MODE & 16) {
            float* out = P.out + ((size_t)b * SEQ + (pos - CTXL)) * D;
#pragma unroll
            for (int q = 0; q < 4; ++q) { const int c = q * 256 + lane * 4; const float4 g = *(const float4*)(sm + SM_FINALG + c);
                float4 ov = make_float4(v[q].x * rstd * g.x, v[q].y * rstd * g.y, v[q].z * rstd * g.z, v[q].w * rstd * g.w);
#if defined(PROBE_A)
                { const float da = 1.f + ((const float*)s_base)[40]; ov.x *= da; ov.y *= da; ov.z *= da; ov.w *= da; if (row == CTXL && c == 0) ov.x += ((const float*)s_base)[41]; }
#endif
                *(float4*)(out + c) = ov; }
            continue;
        }
        const float* gv = sm + (which ? SM_GFFN : SM_GMIX) + li * 1024;
        const float* sh = mod + (size_t)(li * 17 + r) * 6144 + (which ? 3 : 0) * 1024; const float* scl = sh + 1024;
        float h[16];
#pragma unroll
        for (int q = 0; q < 4; ++q) { const int c = q * 256 + lane * 4; const float4 g = *(const float4*)(gv + c), s4 = *(const float4*)(sh + c), c4 = *(const float4*)(scl + c);
            h[q * 4 + 0] = v[q].x * rstd * g.x * (1.f + c4.x) + s4.x; h[q * 4 + 1] = v[q].y * rstd * g.y * (1.f + c4.y) + s4.y;
            h[q * 4 + 2] = v[q].z * rstd * g.z * (1.f + c4.z) + s4.z; h[q * 4 + 3] = v[q].w * rstd * g.w * (1.f + c4.w) + s4.w; }
        if (MODE & 2) {
            u16* HX = (u16*)(P.ws + WS_HX);
#pragma unroll
            for (int q = 0; q < 4; ++q) { uint2 w; w.x = (unsigned)f2bf(h[q * 4]) | ((unsigned)f2bf(h[q * 4 + 1]) << 16); w.y = (unsigned)f2bf(h[q * 4 + 2]) | ((unsigned)f2bf(h[q * 4 + 3]) << 16);
                *(uint2*)(HX + (size_t)row * D + q * 256 + lane * 4) = w; }
        }
        if (MODE & 4) {
            u16* UH = (u16*)(P.ws + WS_R1 + R1_UH);
#pragma unroll
            for (int q = 0; q < 4; ++q) { const int c = q * 256 + lane * 4; const int g = c >> 4, ch = c & 15;
                uint2 w; w.x = (unsigned)f2bf(h[q * 4]) | ((unsigned)f2bf(h[q * 4 + 1]) << 16); w.y = (unsigned)f2bf(h[q * 4 + 2]) | ((unsigned)f2bf(h[q * 4 + 3]) << 16);
                *(uint2*)(UH + ((size_t)g * 2304 + b * 144 + (pos >> 4)) * 512 + (pos & 15) * 16 + ch) = w; }
        }
        if (MODE & 8) {
            const float* wg = sm + SM_WGROUP + (size_t)li * 1024 * 4;
            float lg[4] = {0.f, 0.f, 0.f, 0.f};
#pragma unroll
            for (int q = 0; q < 4; ++q)
#pragma unroll
                for (int j = 0; j < 4; ++j) { const int k = q * 256 + lane * 4 + j; const float4 w = *(const float4*)(wg + k * 4); const float hv = h[q * 4 + j];
                    lg[0] += hv * w.x; lg[1] += hv * w.y; lg[2] += hv * w.z; lg[3] += hv * w.w; }
#pragma unroll
            for (int g = 0; g < 4; ++g) lg[g] = wave_sum_l(lg[g], lane) + sm[SM_BGROUP + li * 4 + g];
            int gi = 0; float best = lg[0];
#pragma unroll
            for (int g = 1; g < 4; ++g) if (lg[g] > best) { best = lg[g]; gi = g; }
            float den = 0.f;
#pragma unroll
            for (int g = 0; g < 4; ++g) den += __expf(lg[g] - best);
            const float pg = 1.f / den;
            const float* we = sm + SM_WEXP + ((size_t)li * 4 + gi) * 1024 * 8;
            float le[8];
#pragma unroll
            for (int e = 0; e < 8; ++e) le[e] = 0.f;
#pragma unroll
            for (int q = 0; q < 4; ++q)
#pragma unroll
                for (int j = 0; j < 4; ++j) { const int k = q * 256 + lane * 4 + j; const float4 w0 = *(const float4*)(we + k * 8), w1 = *(const float4*)(we + k * 8 + 4); const float hv = h[q * 4 + j];
                    le[0] += hv * w0.x; le[1] += hv * w0.y; le[2] += hv * w0.z; le[3] += hv * w0.w; le[4] += hv * w1.x; le[5] += hv * w1.y; le[6] += hv * w1.z; le[7] += hv * w1.w; }
#pragma unroll
            for (int e = 0; e < 8; ++e) le[e] = wave_sum_l(le[e], lane) + sm[SM_BEXP + (li * 4 + gi) * 8 + e];
            int i1 = 0; float b1 = le[0];
#pragma unroll
            for (int e = 1; e < 8; ++e) if (le[e] > b1) { b1 = le[e]; i1 = e; }
            int i2 = -1; float b2 = -3.0e38f;
#pragma unroll
            for (int e = 0; e < 8; ++e) if (e != i1 && le[e] > b2) { b2 = le[e]; i2 = e; }
            if (lane == 0) {
                const float ex = __expf(b2 - b1); const float w1 = 1.f / (1.f + ex), w2 = ex / (1.f + ex);
                unsigned* cnt = (unsigned*)(P.ws + WS_CTL) + CW_CNT + li * 32 * CS; int* list = (int*)(P.ws + WS_LIST);
                const int e1 = gi * 8 + i1, e2 = gi * 8 + i2;
                const int s1 = (int)atomicAdd(&cnt[e1 * CS], 1u), s2 = (int)atomicAdd(&cnt[e2 * CS], 1u);
                list[(size_t)e1 * T + s1] = row; list[(size_t)e2 * T + s2] = row;
                *(int4*)(P.ws + WS_SELI + (size_t)row * 16) = make_int4(e1, s1, e2, s2);
                *(float2*)(P.ws + WS_SELW + (size_t)row * 8) = make_float2(pg * w1, pg * w2);
            }
        }
    }
}
template <int MODE> __global__ __launch_bounds__(256) void k_norm(Ptrs P, int li, int which) { __shared__ int sb[36]; norm_rows<MODE>(P.ws, P.out, li, which, 4, sb, __builtin_amdgcn_readfirstlane(threadIdx.x >> 6)); }

struct NG { const void* A; int lda; const int* rowidx; const float* B; int ldb; long bstride; const int* tileexp; const int* mdyn; float* C; int ldc; int M, N, K, pad; };
template <int ABF> __global__ __launch_bounds__(256) void n_gemm(NG g) {
    __shared__ float As[16][68], Bs[16][68];
    const int tm = blockIdx.y, tn = blockIdx.x, tid = threadIdx.x, tx = tid & 15, ty = tid >> 4;
    const int M = g.mdyn ? (*g.mdyn) * 256 : g.M;
    if (tm * 64 >= M) return;
    const float* B = g.B; if (g.tileexp) B += (long)g.tileexp[(tm * 64) / 256] * g.bstride;
    float acc[4][4];
#pragma unroll
    for (int i = 0; i < 4; ++i)
#pragma unroll
        for (int j = 0; j < 4; ++j) acc[i][j] = 0.f;
    const int arow = tm * 64 + (tid >> 2), ak = (tid & 3) * 4; long asrc = -1;
    if (arow < M) { const int r = g.rowidx ? g.rowidx[arow] : arow; if (r >= 0) asrc = (long)r * g.lda; }
    for (int k0 = 0; k0 < g.K; k0 += 16) {
        float a[4] = {0.f, 0.f, 0.f, 0.f};
        if (asrc >= 0) {
            if (ABF) { const uint2 w = *(const uint2*)((const u16*)g.A + asrc + k0 + ak); a[0] = bf2f((u16)(w.x & 0xffff)); a[1] = bf2f((u16)(w.x >> 16)); a[2] = bf2f((u16)(w.y & 0xffff)); a[3] = bf2f((u16)(w.y >> 16)); }
            else { const float4 w = *(const float4*)((const float*)g.A + asrc + k0 + ak); a[0] = w.x; a[1] = w.y; a[2] = w.z; a[3] = w.w; }
        }
        const float4 bv = *(const float4*)(B + (size_t)(k0 + (tid >> 4)) * g.ldb + tn * 64 + (tid & 15) * 4);
        __syncthreads();
#pragma unroll
        for (int i = 0; i < 4; ++i) As[ak + i][tid >> 2] = a[i];
        *(float4*)&Bs[tid >> 4][(tid & 15) * 4] = bv;
        __syncthreads();
#pragma unroll
        for (int kk = 0; kk < 16; ++kk) { const float4 a4 = *(const float4*)&As[kk][ty * 4], b4 = *(const float4*)&Bs[kk][tx * 4];
            const float av[4] = {a4.x, a4.y, a4.z, a4.w}, bw[4] = {b4.x, b4.y, b4.z, b4.w};
#pragma unroll
            for (int i = 0; i < 4; ++i)
#pragma unroll
                for (int j = 0; j < 4; ++j) acc[i][j] += av[i] * bw[j]; }
    }
#pragma unroll
    for (int i = 0; i < 4; ++i) { const int row = tm * 64 + ty * 4 + i; if (row < M) *(float4*)(g.C + (size_t)row * g.ldc + tn * 64 + tx * 4) = make_float4(acc[i][0], acc[i][1], acc[i][2], acc[i][3]); }
}
__device__ __forceinline__ int row_r(int row) { return (row % LTOT) < CTXL ? 16 : row / LTOT; }
__global__ __launch_bounds__(256) void n_post_glu(Ptrs P, int li) {
    float* X = (float*)(P.ws + WS_X); const float* TMP = (const float*)(P.ws + WS_NTMP); const float* mod = (const float*)(P.ws + WS_MOD);
    for (size_t i = (size_t)blockIdx.x * 256 + threadIdx.x; i < (size_t)T * D; i += (size_t)gridDim.x * 256) { const int row = (int)(i >> 10), c = (int)(i & 1023); const int r = row_r(row);
        const float val = TMP[(size_t)row * 2048 + c], gt = TMP[(size_t)row * 2048 + 1024 + c]; X[i] += mod[(size_t)(li * 17 + r) * 6144 + 2048 + c] * val * sigmoid_f(gt); }
}
__global__ __launch_bounds__(256) void n_post_wo(Ptrs P, int li) {
    float* X = (float*)(P.ws + WS_X); const float* TMP = (const float*)(P.ws + WS_NTMP); const float* mod = (const float*)(P.ws + WS_MOD);
    for (size_t i = (size_t)blockIdx.x * 256 + threadIdx.x; i < (size_t)T * D; i += (size_t)gridDim.x * 256) { const int row = (int)(i >> 10), c = (int)(i & 1023); const int r = row_r(row);
        X[i] += mod[(size_t)(li * 17 + r) * 6144 + 2048 + c] * TMP[i]; }
}
__global__ __launch_bounds__(256) void n_post_q(Ptrs P) {
    const float* TMP = (const float*)(P.ws + WS_NTMP); u16* QT = (u16*)(P.ws + WS_R1 + R1_QT); const float2* rope = (const float2*)(P.ws + WS_ROPE);
    const float scale = 0.07216878364870322f;
    for (size_t i = (size_t)blockIdx.x * 256 + threadIdx.x; i < (size_t)T * 1536; i += (size_t)gridDim.x * 256) { const int row = (int)(i / 1536), c = (int)(i % 1536); const int h = c / 192, dd = c % 192;
        const int b = row / LTOT, pos = row % LTOT; float v = TMP[i];
        if (dd >= 128 && pos >= CTXL) { const int l = dd - 128; const float pv = TMP[(size_t)row * 1536 + h * 192 + 128 + (l ^ 16)]; const float2 cs = rope[(size_t)(pos - CTXL) * 32 + (l >> 5) * 16 + (l & 15)];
            v = (l & 16) ? v * cs.x + pv * cs.y : v * cs.x - pv * cs.y; }
        QT[(((size_t)b * NH + h) * LTOT + pos) * QKD + dd] = f2bf(v * scale); }
}
__global__ __launch_bounds__(256) void n_post_kv(Ptrs P) {
    const float* TMP = (const float*)(P.ws + WS_NTMP); u16* KT = (u16*)(P.ws + WS_R1 + R1_KT); u16* VT = (u16*)(P.ws + WS_R1 + R1_VT);
    for (size_t i = (size_t)blockIdx.x * 256 + threadIdx.x; i < (size_t)T * 2048; i += (size_t)gridDim.x * 256) { const int row = (int)(i >> 11), c = (int)(i & 2047); const int h = c >> 8, dd = c & 255;
        const int b = row / LTOT, pos = row % LTOT; const u16 v = f2bf(TMP[i]);
        if (dd < 128) KT[(((size_t)b * NH + h) * LTOT + pos) * QKD + dd] = v; else VT[(((size_t)b * NH + h) * LTOT + pos) * 128 + dd - 128] = v; }
}
__global__ __launch_bounds__(256) void n_attn(Ptrs P) {
    __shared__ float Ks[32][192], Vs[32][128];
    const int qt = blockIdx.x, h = blockIdx.y, b = blockIdx.z, tid = threadIdx.x, ql = tid >> 2, part = tid & 3;
    const u16* QT = (const u16*)(P.ws + WS_R1 + R1_QT) + ((size_t)b * NH + h) * LTOT * QKD; const u16* KT = (const u16*)(P.ws + WS_R1 + R1_KT) + ((size_t)b * NH + h) * LTOT * QKD;
    const u16* VT = (const u16*)(P.ws + WS_R1 + R1_VT) + ((size_t)b * NH + h) * LTOT * 128; u16* O = (u16*)(P.ws + WS_ZO);
    const int pos = qt * 64 + ql; const int nk = (qt * 64 < CTXL) ? CTXL : LTOT;
    float q[48], o[32];
#pragma unroll
    for (int i = 0; i < 48; ++i) q[i] = bf2f(QT[(size_t)pos * QKD + part * 48 + i]);
#pragma unroll
    for (int i = 0; i < 32; ++i) o[i] = 0.f;
    float m = -1e30f, l = 0.f;
    for (int k0 = 0; k0 < nk; k0 += 32) {
        __syncthreads();
        for (int i = tid; i < 32 * 192; i += 256) Ks[i / 192][i % 192] = bf2f(KT[(size_t)k0 * QKD + i]);
        for (int i = tid; i < 32 * 128; i += 256) Vs[i / 128][i % 128] = bf2f(VT[(size_t)k0 * 128 + i]);
        __syncthreads();
        for (int kk = 0; kk < 32; ++kk) {
            float s = 0.f;
#pragma unroll
            for (int i = 0; i < 48; ++i) s += q[i] * Ks[kk][part * 48 + i];
            s += __shfl_xor(s, 1); s += __shfl_xor(s, 2);
            const float mn = fmaxf(m, s), al = __expf(m - mn), p = __expf(s - mn);
            l = l * al + p; m = mn;
#pragma unroll
            for (int i = 0; i < 32; ++i) o[i] = o[i] * al + p * Vs[kk][part * 32 + i];
        }
    }
    const float rl = 1.f / l;
#pragma unroll
    for (int i = 0; i < 32; ++i) O[((size_t)b * LTOT + pos) * D + h * 128 + part * 32 + i] = f2bf(o[i] * rl);
}
__global__ __launch_bounds__(128) void n_s5(Ptrs P, int j) {
    __shared__ float us[2][16], hre[2][64], him[2][64], Cre[2][16][64], Cim[2][16][64];
    const int b = blockIdx.x >> 6, g = blockIdx.x & 63, tid = threadIdx.x, dir = tid >> 6, p = tid & 63;
    const size_t gd = ((size_t)j * 2 + dir) * SG + g;
    const float dt = __expf(P.in[10][gd]); const float ar = P.in[8][gd * SP + p], ai = P.in[9][gd * SP + p];
    const float ldr = ar * dt, ldi = ai * dt, mag = __expf(ldr); const float abr = mag * __cosf(ldi), abi = mag * __sinf(ldi);
    const float nr = abr - 1.f, ni = abi, den = ar * ar + ai * ai; const float qr = (nr * ar + ni * ai) / den, qi = (ni * ar - nr * ai) / den;
    float bbr[16], bbi[16];
#pragma unroll
    for (int c = 0; c < 16; ++c) { const float br = P.in[11][(gd * SP + p) * SC + c], bi = P.in[12][(gd * SP + p) * SC + c]; bbr[c] = qr * br - qi * bi; bbi[c] = qr * bi + qi * br; }
    for (int i = tid; i < 2 * 16 * 64; i += 128) { const int d2 = i >> 10, c = (i >> 6) & 15, pp = i & 63; const size_t o = ((((size_t)j * 2 + d2) * SG + g) * SC + c) * SP + pp; Cre[d2][c][pp] = P.in[13][o]; Cim[d2][c][pp] = P.in[14][o]; }
    const u16* HX = (const u16*)(P.ws + WS_HX); float* Yf = (float*)(P.ws + WS_NTMP); float* Yr = Yf + (size_t)T * D;
    float hr = 0.f, hi = 0.f;
    for (int t = 0; t < LTOT; ++t) {
        __syncthreads();
        if (tid < 32) { const int d2 = tid >> 4, c = tid & 15; const int ps = d2 ? (t < CTXL ? CTXL - 1 - t : LTOT - 1 - (t - CTXL)) : t; us[d2][c] = bf2f(HX[((size_t)b * LTOT + ps) * D + g * 16 + c]); }
        __syncthreads();
        float bur = 0.f, bui = 0.f;
#pragma unroll
        for (int c = 0; c < 16; ++c) { bur += bbr[c] * us[dir][c]; bui += bbi[c] * us[dir][c]; }
        const float nhr = abr * hr - abi * hi + bur, nhi = abr * hi + abi * hr + bui; hr = nhr; hi = nhi;
        hre[dir][p] = hr; him[dir][p] = hi;
        __syncthreads();
        if (tid < 32) { const int d2 = tid >> 4, c = tid & 15; const int ps = d2 ? (t < CTXL ? CTXL - 1 - t : LTOT - 1 - (t - CTXL)) : t; float y = 0.f;
            for (int pp = 0; pp < 64; ++pp) y += Cre[d2][c][pp] * hre[d2][pp] - Cim[d2][c][pp] * him[d2][pp];
            (d2 ? Yr : Yf)[((size_t)b * LTOT + ps) * D + g * 16 + c] = y; }
    }
}
__global__ __launch_bounds__(256) void n_post_s5(Ptrs P, int j) {
    const float* Yf = (const float*)(P.ws + WS_NTMP); const float* Yr = Yf + (size_t)T * D; const u16* HX = (const u16*)(P.ws + WS_HX); u16* Z = (u16*)(P.ws + WS_ZO);
    for (size_t i = (size_t)blockIdx.x * 256 + threadIdx.x; i < (size_t)T * D; i += (size_t)gridDim.x * 256) { const int c = (int)(i & 1023);
        Z[i] = f2bf(gelu_tanh(Yf[i] + Yr[i] + P.in[15][j * 1024 + c] * bf2f(HX[i]))); }
}
__global__ __launch_bounds__(256) void n_build(Ptrs P, int li) {
    __shared__ int base[33];
    const unsigned* cnt = (const unsigned*)(P.ws + WS_CTL) + CW_CNT + li * 32 * CS; int* tileexp = (int*)(P.ws + WS_TILEEXP); int* slotrow = (int*)(P.ws + WS_SLOTROW); const int* list = (const int*)(P.ws + WS_LIST);
    if (threadIdx.x == 0) { int a = 0; for (int e = 0; e < 32; ++e) { base[e] = a; a += (int)((cnt[e * CS] + 255u) / 256u); } base[32] = a; tileexp[512] = a; }
    __syncthreads();
    for (int e = 0; e < 32; ++e) { const int nt = base[e + 1] - base[e];
        for (int t = threadIdx.x; t < nt; t += 256) tileexp[base[e] + t] = e;
        for (int s = threadIdx.x; s < nt * 256; s += 256) slotrow[base[e] * 256 + s] = s < (int)cnt[e * CS] ? list[(size_t)e * T + s] : -1; }
}
__global__ __launch_bounds__(256) void n_post_act2(Ptrs P, u16* ACT) {
    const float* TMP = (const float*)(P.ws + WS_NTMP); const int ntot = ((const int*)(P.ws + WS_TILEEXP))[512];
    for (size_t i = (size_t)blockIdx.x * 256 + threadIdx.x; i < (size_t)ntot * 256 * 512; i += (size_t)gridDim.x * 256) { const size_t gs = i >> 9; const int c = (int)(i & 511);
        ACT[i] = f2bf(silu_f(TMP[gs * 1024 + c]) * TMP[gs * 1024 + 512 + c]); }
}
__global__ __launch_bounds__(256) void n_post_y(Ptrs P) {
    const float* TMP = (const float*)(P.ws + WS_NTMP); u16* YB = (u16*)(P.ws + WS_YB); const int ntot = ((const int*)(P.ws + WS_TILEEXP))[512];
    for (size_t i = (size_t)blockIdx.x * 256 + threadIdx.x; i < (size_t)ntot * 256 * 1024; i += (size_t)gridDim.x * 256) YB[i] = f2bf(TMP[i]);
}

#define LAS __attribute__((address_space(3)))
typedef short bf16x8 __attribute__((ext_vector_type(8)));
typedef float f32x4 __attribute__((ext_vector_type(4)));
typedef unsigned u32x4 __attribute__((ext_vector_type(4)));
typedef unsigned u32x2 __attribute__((ext_vector_type(2)));
namespace g8 {
constexpr int BM = 256, BK = 64, HALF = 128, HTB = HALF * BK * 2, STAGE_BYTES = 8 * HTB, NXCD = 8, WGM = 8;
__host__ __device__ __forceinline__ int lds_byte(int r, int c) { const int st = (r >> 4) * 2 + (c >> 5), rr = r & 15, cc = c & 31, ob = rr * 64 + cc * 2; return st * 1024 + (ob ^ (((ob >> 9) & 1) << 5)); }
__host__ __device__ __forceinline__ void stage_rc(int b, int& R, int& C) { const int st = b / 1024, sb = b % 1024, swz = sb ^ (((sb >> 9) & 1) << 5); R = (st >> 1) * 16 + swz / 64; C = (st & 1) * 32 + (swz % 64) / 2; }
__host__ __device__ __forceinline__ int perm32(int rho) { const int n = rho >> 4, i = rho & 15; return 8 * (i >> 2) + 4 * n + (i & 3); }
struct Unit { int pm, pn, aux; };
struct Order {
    int nM, nN, nwg, G, c;
    __device__ __forceinline__ void init(int nM_, int nN_, int G_, int c_) { nM = nM_; nN = nN_; nwg = nM * nN; G = G_; c = c_; }
    __device__ __forceinline__ bool next(int i, int& pm, int& pn) const {
        const long L = (long)i * G + c; if (L >= nwg) return false;
        int wgid = (int)L; { const int q = nwg / NXCD, r = nwg % NXCD, xcd = wgid % NXCD, off = wgid / NXCD; wgid = (xcd < r ? xcd * (q + 1) : r * (q + 1) + (xcd - r) * q) + off; }
        const int nig = WGM * nN, gid = wgid / nig, fm = gid * WGM, gsz = (nM - fm) < WGM ? (nM - fm) : WGM;
        pm = fm + ((wgid % nig) % gsz); pn = (wgid % nig) / gsz; return true;
    }
};
__device__ __forceinline__ unsigned cvt_pk_bf16(float lo, float hi) { unsigned r; asm volatile("v_cvt_pk_bf16_f32 %0, %1, %2" : "=v"(r) : "v"(lo), "v"(hi)); return r; }

template <class Epi, class Sched>
__device__ __forceinline__ void gemm_phase(LAS unsigned char* lds, const int K, const Sched& S, const Epi& E, const int wv) {
    const int tid = tid_opaque(wv), wid = wv, lane = tid & 63, wr = wid >> 2, wc = wid & 3, fr = lane & 15, fq = lane >> 4;
    const int nt = K / BK;
    int R0, C0; stage_rc(tid * 16, R0, C0);
    unsigned voffB[2];
    { const int Rb0 = Epi::PERM ? ((R0 & ~31) + perm32(R0 & 31)) : R0;
      voffB[0] = (unsigned)(Rb0 * K + C0) * 2u; voffB[1] = voffB[0] + (unsigned)(64 * K) * 2u; }
    const size_t kstepB = (size_t)(BK * 2), hstepB = (size_t)HALF * K * 2;
    const size_t kstepA = S.a_kstep();
    const unsigned ldsw = (unsigned)wid * 1024u;
    const int aoff = lds_byte(wr * 64 + fr, fq * 8), boff = lds_byte(wc * 32 + fr, fq * 8);
#define G8_SA(b, h) (((b) * 2 + (h)) * HTB)
#define G8_SB(b, h) ((4 + (b) * 2 + (h)) * HTB)
#define G8_STAGE_B(bufoff, gbase) do { _Pragma("unroll") for (int _i = 0; _i < 2; ++_i) \
        __builtin_amdgcn_global_load_lds((const unsigned*)((const char*)(gbase) + voffB[_i]), (LAS unsigned*)(lds + (bufoff) + ldsw + _i * 8192), 16, 0, 0); } while (0)
#define G8_VI(h, i) ((Sched::NV == 1) ? 0 : ((h) * 2 + (i)))
#define G8_STAGE_A(bufoff, U, V, h, kb) do { \
        __builtin_amdgcn_global_load_lds((const unsigned*)(S.a_uptr(U, h, 0) + (size_t)(kb) + (V)[G8_VI(h, 0)]), (LAS unsigned*)(lds + (bufoff) + ldsw), 16, 0, 0); \
        __builtin_amdgcn_global_load_lds((const unsigned*)(S.a_uptr(U, h, 1) + (size_t)(kb) + (V)[G8_VI(h, 1)]), (LAS unsigned*)(lds + (bufoff) + ldsw + 8192), 16, 0, 0); } while (0)
#define G8_LDA(dst, b, h) do { _Pragma("unroll") for (int m = 0; m < 4; ++m) _Pragma("unroll") for (int k = 0; k < 2; ++k) dst[m][k] = *(const LAS bf16x8*)(lds + G8_SA(b, h) + aoff + m * 2048 + k * 1024); } while (0)
#define G8_LDB(dst, b, h) do { _Pragma("unroll") for (int n = 0; n < 2; ++n) _Pragma("unroll") for (int k = 0; k < 2; ++k) dst[n][k] = *(const LAS bf16x8*)(lds + G8_SB(b, h) + boff + n * 2048 + k * 1024); } while (0)
#define G8_MMA(ai, bj, At, Bt) do { __builtin_amdgcn_s_setprio(1); _Pragma("unroll") for (int m = 0; m < 4; ++m) _Pragma("unroll") for (int n = 0; n < 2; ++n) _Pragma("unroll") for (int k = 0; k < 2; ++k) \
        acc[ai][bj][m][n] = __builtin_amdgcn_mfma_f32_16x16x32_bf16(Bt[n][k], At[m][k], acc[ai][bj][m][n], 0, 0, 0); __builtin_amdgcn_s_setprio(0); } while (0)
#define G8_WAIT_V(n) asm volatile("s_waitcnt vmcnt(" #n ")" ::: "memory")
#define G8_WAIT_L(n) asm volatile("s_waitcnt lgkmcnt(" #n ")" ::: "memory")
#define G8_BAR __builtin_amdgcn_s_barrier()
#define G8_SCHED __builtin_amdgcn_sched_barrier(0)
    Unit cur, nxt; int ui = 0;
    if (!S.next(0, cur)) return;
    f32x4 acc[2][2][4][2];
#pragma unroll
    for (int a = 0; a < 2; ++a)
#pragma unroll
        for (int b = 0; b < 2; ++b)
#pragma unroll
            for (int m = 0; m < 4; ++m)
#pragma unroll
                for (int n = 0; n < 2; ++n) acc[a][b][m][n] = (f32x4){0.f, 0.f, 0.f, 0.f};
    bf16x8 At[4][2], B0[2][2], B1[2][2];
    unsigned cO[4], nO[4];
    S.a_voff(cur, R0, C0, cO);
    const char* cB = S.b_ptr(cur);
    G8_STAGE_B(G8_SB(0, 0), cB); G8_STAGE_A(G8_SA(0, 0), cur, cO, 0, 0); G8_STAGE_B(G8_SB(0, 1), cB + hstepB); G8_STAGE_A(G8_SA(0, 1), cur, cO, 1, 0);
    if (wr == 1) G8_BAR;
    G8_WAIT_V(4); G8_BAR;
    G8_STAGE_B(G8_SB(1, 0), cB + kstepB); G8_STAGE_A(G8_SA(1, 0), cur, cO, 0, kstepA); G8_STAGE_B(G8_SB(1, 1), cB + hstepB + kstepB);
    G8_WAIT_V(6); G8_BAR;
    for (;;) {
        const bool has_next = S.next(ui + 1, nxt);
        const char* nB = cB;
        if (has_next) { S.a_voff(nxt, R0, C0, nO); nB = S.b_ptr(nxt); }
        else { nxt = cur;
#pragma unroll
            for (int q = 0; q < 4; ++q) nO[q] = cO[q]; }
        for (int t = 0; t < nt; t += 2) {
            const bool last = (t == nt - 2);
            const size_t k1 = (size_t)(t + 1) * kstepA;
            const size_t k2 = last ? 0 : (size_t)(t + 2) * kstepA, k3 = k2 + kstepA;
            unsigned pV[4]; g8::Unit pU;
            if (last) { pU = nxt; pV[0] = nO[0]; pV[1] = nO[1]; pV[2] = nO[2]; pV[3] = nO[3]; } else { pU = cur; pV[0] = cO[0]; pV[1] = cO[1]; pV[2] = cO[2]; pV[3] = cO[3]; }
            const char* b2 = last ? nB : cB + (size_t)(t + 2) * kstepB; const char* b3 = b2 + kstepB;
            G8_LDB(B0, 0, 0); G8_SCHED; G8_LDA(At, 0, 0); G8_STAGE_A(G8_SA(1, 1), cur, cO, 1, k1);
            G8_WAIT_L(8); G8_BAR; G8_WAIT_L(0); G8_MMA(0, 0, At, B0); G8_BAR; G8_SCHED;
            G8_LDB(B1, 0, 1); G8_STAGE_B(G8_SB(0, 0), b2);
            G8_BAR; G8_WAIT_L(0); G8_MMA(0, 1, At, B1); G8_BAR;
            G8_LDA(At, 0, 1); G8_STAGE_A(G8_SA(0, 0), pU, pV, 0, k2);
            G8_BAR; G8_WAIT_L(0); G8_MMA(1, 0, At, B0); G8_BAR; G8_SCHED;
            G8_STAGE_B(G8_SB(0, 1), b2 + hstepB);
            G8_WAIT_V(6); G8_BAR; G8_MMA(1, 1, At, B1); G8_BAR;
            G8_LDB(B0, 1, 0); G8_SCHED; G8_LDA(At, 1, 0); G8_STAGE_A(G8_SA(0, 1), pU, pV, 1, k2);
            G8_WAIT_L(8); G8_BAR; G8_WAIT_L(0); G8_MMA(0, 0, At, B0); G8_BAR; G8_SCHED;
            G8_LDB(B1, 1, 1); G8_STAGE_B(G8_SB(1, 0), b3);
            G8_BAR; G8_WAIT_L(0); G8_MMA(0, 1, At, B1); G8_BAR;
            G8_LDA(At, 1, 1); G8_STAGE_A(G8_SA(1, 0), pU, pV, 0, k3);
            G8_BAR; G8_WAIT_L(0); G8_MMA(1, 0, At, B0); G8_BAR; G8_SCHED;
            G8_STAGE_B(G8_SB(1, 1), b3 + hstepB);
            G8_WAIT_V(6); G8_BAR; G8_MMA(1, 1, At, B1); G8_BAR;
        }
        E(acc, cur, wr, wc, fr, fq);
        if (!has_next) break;
#pragma unroll
        for (int a = 0; a < 2; ++a)
#pragma unroll
            for (int b = 0; b < 2; ++b)
#pragma unroll
                for (int m = 0; m < 4; ++m)
#pragma unroll
                    for (int n = 0; n < 2; ++n) acc[a][b][m][n] = (f32x4){0.f, 0.f, 0.f, 0.f};
        cur = nxt; cB = nB; ++ui;
#pragma unroll
        for (int q = 0; q < 4; ++q) cO[q] = nO[q];
    }
    G8_WAIT_V(0);
    if (wr == 0) G8_BAR;
    G8_BAR;
#undef G8_SA
#undef G8_SB
#undef G8_STAGE_A
#undef G8_VI
#undef G8_STAGE_B
#undef G8_LDA
#undef G8_LDB
#undef G8_MMA
#undef G8_WAIT_V
#undef G8_WAIT_L
#undef G8_BAR
#undef G8_SCHED
}
}
struct SchedDense {
    g8::Order ord; const char* A; unsigned lda2; const char* Bt; int K;
    __device__ __forceinline__ void init(const void* A_, int lda, const void* Bt_, int M, int N, int K_) { A = (const char*)A_; lda2 = (unsigned)lda * 2u; Bt = (const char*)Bt_; K = K_; ord.init(M / 256, N / 256, (int)gridDim.x, (int)blockIdx.x); }
    __device__ __forceinline__ bool next(int i, g8::Unit& u) const { u.aux = 0; return ord.next(i, u.pm, u.pn); }
    static constexpr int NV = 1;
    __device__ __forceinline__ size_t a_kstep() const { return 128; }
    __device__ __forceinline__ const char* a_uptr(const g8::Unit& u, int h, int i) const { return A + (size_t)(u.pm * 256 + h * 128 + i * 64) * lda2; }
    __device__ __forceinline__ void a_voff(const g8::Unit& u, int R0, int C0, unsigned (&o)[4]) const { o[0] = (unsigned)R0 * lda2 + C0 * 2; }
    __device__ __forceinline__ const char* b_ptr(const g8::Unit& u) const { return Bt + (size_t)u.pn * 256 * K * 2; }
};
struct SchedS5 {
    g8::Order ord; const char* A; const char* W; int K;
    __device__ __forceinline__ void init(const void* A_, const void* W_, int K_) { A = (const char*)A_; W = (const char*)W_; K = K_; ord.init(576, 1, (int)gridDim.x, (int)blockIdx.x); }
    __device__ __forceinline__ bool next(int i, g8::Unit& u) const { int pmx, pn; if (!ord.next(i, pmx, pn)) return false; u.aux = pmx / 9; u.pm = pmx % 9; u.pn = 0; return true; }
    static constexpr int NV = 1;
    __device__ __forceinline__ size_t a_kstep() const { return 128; }
    __device__ __forceinline__ const char* a_uptr(const g8::Unit& u, int h, int i) const { return A + (size_t)(u.aux * 2304 + u.pm * 256 + h * 128 + i * 64) * 1024; }
    __device__ __forceinline__ void a_voff(const g8::Unit& u, int R0, int C0, unsigned (&o)[4]) const { o[0] = (unsigned)R0 * 1024u + C0 * 2; }
    __device__ __forceinline__ const char* b_ptr(const g8::Unit& u) const { return W + (size_t)u.aux * 256 * K * 2; }
};
template <bool GATHER> struct SchedMoe {
    g8::Order ord; const char* A; const char* W; int K; const int* sbase; const unsigned* cnt; const int* list; size_t wstride;
    __device__ __forceinline__ void init(const void* A_, const void* W_, int K_, const int* sbase_, const unsigned* cnt_, const int* list_) {
        A = (const char*)A_; W = (const char*)W_; K = K_; sbase = sbase_; cnt = cnt_; list = list_; wstride = (size_t)1024 * K * 2; ord.init(sbase_[32], 4, (int)gridDim.x, (int)blockIdx.x); }
    __device__ __forceinline__ bool next(int i, g8::Unit& u) const { if (!ord.next(i, u.pm, u.pn)) return false; int e = 0;
        for (int k = 1; k < 32; ++k) e = (u.pm >= sbase[k]) ? k : e;
        u.aux = e; return true; }
    static constexpr int NV = GATHER ? 4 : 1;
    __device__ __forceinline__ size_t a_kstep() const { return 128; }
    __device__ __forceinline__ const char* a_uptr(const g8::Unit& u, int h, int i) const { return GATHER ? A : A + (size_t)(u.pm * 256 + h * 128 + i * 64) * 1024; }
    __device__ __forceinline__ void a_voff(const g8::Unit& u, int R0, int C0, unsigned (&o)[4]) const {
        if (GATHER) {
            const int e = u.aux; const int s0 = (u.pm - sbase[e]) * 256 + R0; const int n = (int)cnt[e * CS]; const int* l = list + (size_t)e * T;
#pragma unroll
            for (int q = 0; q < 4; ++q) { const int a = s0 + q * 64; o[q] = (unsigned)l[a < n ? a : 0] * 2048u + C0 * 2; }
        } else o[0] = (unsigned)R0 * 1024u + C0 * 2; }
    __device__ __forceinline__ const char* b_ptr(const g8::Unit& u) const { return W + (size_t)u.aux * wstride + (size_t)u.pn * 256 * K * 2; }
};

#define EPI_LOOP_AM for (int ai = 0; ai < 2; ++ai) _Pragma("unroll") for (int m = 0; m < 4; ++m)
struct EpiS5a {
    static constexpr bool PERM = false; float* S;
    __device__ __forceinline__ void operator()(const f32x4 (&acc)[2][2][4][2], const g8::Unit& u, int wr, int wc, int fr, int fq) const {
        float* base = S + ((size_t)u.aux * 2304 + (size_t)u.pm * 256 + wr * 64 + fr) * 256 + wc * 32 + 4 * fq;
#pragma unroll
        EPI_LOOP_AM { float* rowp = base + (size_t)(ai * 128 + m * 16) * 256;
#pragma unroll
            for (int bj = 0; bj < 2; ++bj)
#pragma unroll
                for (int n = 0; n < 2; ++n) *(f32x4*)(rowp + bj * 128 + n * 16) = acc[ai][bj][m][n]; }
    }
};
struct EpiS5b {
    static constexpr bool PERM = true; u16* Z; const u16* UH; const float* dvec;
    __device__ __forceinline__ void operator()(const f32x4 (&acc)[2][2][4][2], const g8::Unit& u, int wr, int wc, int fr, int fq) const {
        const int g = u.aux; const int ch0 = (fq & 1) * 8;
        const f32x4 d0 = *(const f32x4*)(dvec + g * 16 + ch0), d1 = *(const f32x4*)(dvec + g * 16 + ch0 + 4);
#pragma unroll
        EPI_LOOP_AM { const int rowin = u.pm * 256 + ai * 128 + wr * 64 + m * 16 + fr;
#pragma unroll
            for (int bj = 0; bj < 2; ++bj) { const int c0 = bj * 128 + wc * 32 + fq * 8; const int t = c0 >> 4;
                const u32x4 uu = *(const u32x4*)(UH + ((size_t)g * 2304 + rowin) * 512 + c0);
                const f32x4 a0 = acc[ai][bj][m][0], a1 = acc[ai][bj][m][1];
                float z[8];
                z[0] = a0[0] + d0[0] * __uint_as_float(uu.x << 16); z[1] = a0[1] + d0[1] * __uint_as_float(uu.x & 0xffff0000u);
                z[2] = a0[2] + d0[2] * __uint_as_float(uu.y << 16); z[3] = a0[3] + d0[3] * __uint_as_float(uu.y & 0xffff0000u);
                z[4] = a1[0] + d1[0] * __uint_as_float(uu.z << 16); z[5] = a1[1] + d1[1] * __uint_as_float(uu.z & 0xffff0000u);
                z[6] = a1[2] + d1[2] * __uint_as_float(uu.w << 16); z[7] = a1[3] + d1[3] * __uint_as_float(uu.w & 0xffff0000u);
#pragma unroll
                for (int q = 0; q < 8; ++q) z[q] = gelu_tanh(z[q]);
                u32x4 w; w.x = g8::cvt_pk_bf16(z[0], z[1]); w.y = g8::cvt_pk_bf16(z[2], z[3]); w.z = g8::cvt_pk_bf16(z[4], z[5]); w.w = g8::cvt_pk_bf16(z[6], z[7]);
                *(u32x4*)(Z + ((size_t)rowin * 16 + t) * 1024 + g * 16 + ch0) = w; } }
    }
};
struct EpiGlu {
    static constexpr bool PERM = false; u16* DL; const float* mod; int li;
    __device__ __forceinline__ void operator()(const f32x4 (&acc)[2][2][4][2], const g8::Unit& u, int wr, int wc, int fr, int fq) const {
        const int r = (u.pm % 9 == 0) ? 16 : u.pm / 9; const float* gate = mod + (size_t)(li * 17 + r) * 6144 + 2048;
        f32x4 gg[2];
#pragma unroll
        for (int bj = 0; bj < 2; ++bj) gg[bj] = *(const f32x4*)(gate + u.pn * 128 + bj * 64 + wc * 16 + fq * 4);
#pragma unroll
        EPI_LOOP_AM { const size_t row = (size_t)u.pm * 256 + ai * 128 + wr * 64 + m * 16 + fr;
#pragma unroll
            for (int bj = 0; bj < 2; ++bj) { const int j0 = u.pn * 128 + bj * 64 + wc * 16 + fq * 4; const f32x4 v = acc[ai][bj][m][0], t = acc[ai][bj][m][1];
                u32x2 w; w.x = g8::cvt_pk_bf16(gg[bj][0] * v[0] * sigmoid_f(t[0]), gg[bj][1] * v[1] * sigmoid_f(t[1])); w.y = g8::cvt_pk_bf16(gg[bj][2] * v[2] * sigmoid_f(t[2]), gg[bj][3] * v[3] * sigmoid_f(t[3]));
                *(u32x2*)(DL + row * 1024 + j0) = w; } }
    }
};
struct EpiF32 {
    static constexpr bool PERM = false; float* C; int ldc;
    __device__ __forceinline__ void operator()(const f32x4 (&acc)[2][2][4][2], const g8::Unit& u, int wr, int wc, int fr, int fq) const {
        float* base = C + ((size_t)u.pm * 256 + wr * 64 + fr) * ldc + u.pn * 256 + wc * 32 + 4 * fq;
#pragma unroll
        EPI_LOOP_AM { float* rowp = base + (size_t)(ai * 128 + m * 16) * ldc;
#pragma unroll
            for (int bj = 0; bj < 2; ++bj)
#pragma unroll
                for (int n = 0; n < 2; ++n) *(f32x4*)(rowp + bj * 128 + n * 16) = acc[ai][bj][m][n]; }
    }
};
struct EpiQ {
    static constexpr bool PERM = false; u16* QT; const float2* rope;
    __device__ __forceinline__ void operator()(const f32x4 (&acc)[2][2][4][2], const g8::Unit& u, int wr, int wc, int fr, int fq) const {
        const float scale = 0.07216878364870322f; const int b = u.pm / 9, pt = u.pm % 9;
#pragma unroll
        EPI_LOOP_AM { const int pos = pt * 256 + ai * 128 + wr * 64 + m * 16 + fr;
#pragma unroll
            for (int bj = 0; bj < 2; ++bj) { const int g32 = u.pn * 8 + bj * 4 + wc; const int h = g32 / 6, part = g32 % 6;
                f32x4 a = acc[ai][bj][m][0], bq = acc[ai][bj][m][1];
                if (part >= 4 && pos >= CTXL) { const float2* rp = rope + (size_t)(pos - CTXL) * 32 + (part - 4) * 16 + fq * 4;
#pragma unroll
                    for (int q = 0; q < 4; ++q) { const float2 cs = rp[q]; const float x0 = a[q], x1 = bq[q]; a[q] = x0 * cs.x - x1 * cs.y; bq[q] = x1 * cs.x + x0 * cs.y; } }
                u16* dst = QT + (((size_t)b * NH + h) * LTOT + pos) * QKD + part * 32 + fq * 4;
                u32x2 w0, w1; w0.x = g8::cvt_pk_bf16(a[0] * scale, a[1] * scale); w0.y = g8::cvt_pk_bf16(a[2] * scale, a[3] * scale);
                w1.x = g8::cvt_pk_bf16(bq[0] * scale, bq[1] * scale); w1.y = g8::cvt_pk_bf16(bq[2] * scale, bq[3] * scale);
                *(u32x2*)dst = w0; *(u32x2*)(dst + 16) = w1; } }
    }
};
struct EpiKV {
    static constexpr bool PERM = true; u16* KT; u16* VT;
    __device__ __forceinline__ void operator()(const f32x4 (&acc)[2][2][4][2], const g8::Unit& u, int wr, int wc, int fr, int fq) const {
        const int b = u.pm / 9, pt = u.pm % 9, h = u.pn;
#pragma unroll
        EPI_LOOP_AM { const int pos = pt * 256 + ai * 128 + wr * 64 + m * 16 + fr; const size_t rr = ((size_t)b * NH + h) * LTOT + pos;
#pragma unroll
            for (int bj = 0; bj < 2; ++bj) { const f32x4 a0 = acc[ai][bj][m][0], a1 = acc[ai][bj][m][1];
                u32x4 w; w.x = g8::cvt_pk_bf16(a0[0], a0[1]); w.y = g8::cvt_pk_bf16(a0[2], a0[3]); w.z = g8::cvt_pk_bf16(a1[0], a1[1]); w.w = g8::cvt_pk_bf16(a1[2], a1[3]);
                u16* dst = bj == 0 ? KT + rr * QKD + wc * 32 + fq * 8 : VT + rr * 128 + wc * 32 + fq * 8;
                *(u32x4*)dst = w; } }
    }
};
struct EpiWo {
    static constexpr bool PERM = true; u16* DL; const float* mod; int li;
    __device__ __forceinline__ void operator()(const f32x4 (&acc)[2][2][4][2], const g8::Unit& u, int wr, int wc, int fr, int fq) const {
        const int r = (u.pm % 9 == 0) ? 16 : u.pm / 9; const float* gate = mod + (size_t)(li * 17 + r) * 6144 + 2048;
        f32x4 gg[2][2];
#pragma unroll
        for (int bj = 0; bj < 2; ++bj)
#pragma unroll
            for (int n = 0; n < 2; ++n) gg[bj][n] = *(const f32x4*)(gate + u.pn * 256 + bj * 128 + wc * 32 + fq * 8 + n * 4);
#pragma unroll
        EPI_LOOP_AM { const size_t row = (size_t)u.pm * 256 + ai * 128 + wr * 64 + m * 16 + fr;
#pragma unroll
            for (int bj = 0; bj < 2; ++bj) { const f32x4 a0 = acc[ai][bj][m][0] * gg[bj][0], a1 = acc[ai][bj][m][1] * gg[bj][1];
                u32x4 w; w.x = g8::cvt_pk_bf16(a0[0], a0[1]); w.y = g8::cvt_pk_bf16(a0[2], a0[3]); w.z = g8::cvt_pk_bf16(a1[0], a1[1]); w.w = g8::cvt_pk_bf16(a1[2], a1[3]);
                *(u32x4*)(DL + row * 1024 + u.pn * 256 + bj * 128 + wc * 32 + fq * 8) = w; } }
    }
};
struct EpiMoe1 {
    static constexpr bool PERM = false; u16* ACT;
    __device__ __forceinline__ void operator()(const f32x4 (&acc)[2][2][4][2], const g8::Unit& u, int wr, int wc, int fr, int fq) const {
#pragma unroll
        EPI_LOOP_AM { const size_t gs = (size_t)u.pm * 256 + ai * 128 + wr * 64 + m * 16 + fr;
#pragma unroll
            for (int bj = 0; bj < 2; ++bj) { const int j0 = u.pn * 128 + bj * 64 + wc * 16 + fq * 4; const f32x4 gt = acc[ai][bj][m][0], up = acc[ai][bj][m][1];
                u32x2 w; w.x = g8::cvt_pk_bf16(silu_f(gt[0]) * up[0], silu_f(gt[1]) * up[1]); w.y = g8::cvt_pk_bf16(silu_f(gt[2]) * up[2], silu_f(gt[3]) * up[3]);
                *(u32x2*)(ACT + gs * 512 + j0) = w; } }
    }
};
struct EpiMoe2 {
    static constexpr bool PERM = true; u16* YB;
    __device__ __forceinline__ void operator()(const f32x4 (&acc)[2][2][4][2], const g8::Unit& u, int wr, int wc, int fr, int fq) const {
#pragma unroll
        EPI_LOOP_AM { const size_t gs = (size_t)u.pm * 256 + ai * 128 + wr * 64 + m * 16 + fr;
#pragma unroll
            for (int bj = 0; bj < 2; ++bj) { const f32x4 a0 = acc[ai][bj][m][0], a1 = acc[ai][bj][m][1];
                u32x4 w; w.x = g8::cvt_pk_bf16(a0[0], a0[1]); w.y = g8::cvt_pk_bf16(a0[2], a0[3]); w.z = g8::cvt_pk_bf16(a1[0], a1[1]); w.w = g8::cvt_pk_bf16(a1[2], a1[3]);
                *(u32x4*)(YB + gs * 1024 + u.pn * 256 + bj * 128 + wc * 32 + fq * 8) = w; } }
    }
};
namespace at {
typedef short s16x4 __attribute__((ext_vector_type(4)));
typedef float f32x16 __attribute__((ext_vector_type(16)));
constexpr int KVBLK = 64, QBLK = 32, NW = 8;
constexpr int SHM_V = KVBLK * 128 * 2, SHM_K = KVBLK * QKD * 2, SHM_ATTN = 2 * SHM_V + 2 * SHM_K + NW * 64 * 4;
constexpr float SCALE = 1.0f;
constexpr float THR = 8.f;
#define KSWZ(row, colB) ((row) * 384 + ((colB) ^ (((row) & 7) << 4)))
#define SBAR() __builtin_amdgcn_sched_barrier(0)
__device__ __forceinline__ int crow(int r, int hi) { return (r & 3) + 8 * (r >> 2) + 4 * hi; }
__device__ __forceinline__ unsigned cvtpk(float lo, float hi) { unsigned r; asm volatile("v_cvt_pk_bf16_f32 %0, %1, %2" : "=v"(r) : "v"(lo), "v"(hi)); return r; }
__device__ __forceinline__ void partialSM(f32x16& p0, f32x16& p1, float& m_reg, float& mn, float& alpha) {
    constexpr float C = SCALE * 1.4426950408889634f;
    float pmax = p0[0];
#pragma unroll
    for (int r = 1; r < 16; ++r) pmax = fmaxf(pmax, p0[r]);
#pragma unroll
    for (int r = 0; r < 16; ++r) pmax = fmaxf(pmax, p1[r]);
    { auto rr = __builtin_amdgcn_permlane32_swap(__float_as_uint(pmax), __float_as_uint(pmax), false, false); pmax = fmaxf(__uint_as_float(rr[0]), __uint_as_float(rr[1])); }
    if (__builtin_expect(__all(pmax - m_reg <= THR / SCALE), 1)) { mn = m_reg; alpha = 1.f; }
    else { mn = fmaxf(m_reg, pmax); alpha = __builtin_amdgcn_exp2f((m_reg - mn) * C); m_reg = mn; }
    const float mnC = -mn * C;
#pragma unroll
    for (int r = 0; r < 16; ++r) p0[r] = fmaf(p0[r], C, mnC);
#pragma unroll
    for (int r = 0; r < 16; ++r) p1[r] = fmaf(p1[r], C, mnC);
#pragma unroll
    for (int r = 0; r < 16; ++r) p0[r] = __builtin_amdgcn_exp2f(p0[r]);
}
__device__ __forceinline__ void finishSM(f32x16& p0, f32x16& p1, float alpha, float& l_reg, bf16x8& pa0, bf16x8& pa1, bf16x8& pa2, bf16x8& pa3) {
#pragma unroll
    for (int r = 0; r < 16; ++r) p1[r] = __builtin_amdgcn_exp2f(p1[r]);
    float ps = 0;
#pragma unroll
    for (int r = 0; r < 16; ++r) ps += p0[r];
#pragma unroll
    for (int r = 0; r < 16; ++r) ps += p1[r];
    { auto rr = __builtin_amdgcn_permlane32_swap(__float_as_uint(ps), __float_as_uint(ps), false, false); ps = __uint_as_float(rr[0]) + __uint_as_float(rr[1]); }
    l_reg = l_reg * alpha + ps;
#define PK4(P, BASE, OUT) do { unsigned a0 = cvtpk(P[BASE + 0], P[BASE + 1]), a1 = cvtpk(P[BASE + 2], P[BASE + 3]);   \
    unsigned b0 = cvtpk(P[BASE + 4], P[BASE + 5]), b1 = cvtpk(P[BASE + 6], P[BASE + 7]);                              \
    auto r0 = __builtin_amdgcn_permlane32_swap(a0, b0, false, false); auto r1 = __builtin_amdgcn_permlane32_swap(a1, b1, false, false); \
    u32x4 w = {r0[0], r1[0], r0[1], r1[1]}; OUT = *reinterpret_cast<bf16x8*>(&w); } while (0)
    PK4(p0, 0, pa0); PK4(p0, 8, pa1); PK4(p1, 0, pa2); PK4(p1, 8, pa3);
#undef PK4
}
__device__ __forceinline__ void qkt(f32x16& p0, f32x16& p1, const char* Ks, const bf16x8* qr, int r32, int hi) {
    p0 = f32x16{}; p1 = f32x16{};
#pragma unroll
    for (int d0 = 0; d0 < 12; ++d0) { const int cb = (d0 * 16 + hi * 8) * 2;
        const bf16x8 b0 = *reinterpret_cast<const bf16x8*>(Ks + KSWZ(r32, cb));
        const bf16x8 b1 = *reinterpret_cast<const bf16x8*>(Ks + KSWZ(32 + r32, cb));
        p0 = __builtin_amdgcn_mfma_f32_32x32x16_bf16(b0, qr[d0], p0, 0, 0, 0);
        p1 = __builtin_amdgcn_mfma_f32_32x32x16_bf16(b1, qr[d0], p1, 0, 0, 0); }
}
__device__ __forceinline__ int v_st(int k, int c) { const int kk = (k & ~0xC) | ((k & 4) << 1) | ((k & 8) >> 1); return ((kk >> 3) * 4 + (c >> 5)) * 512 + ((kk & 7) * 32 + (c & 31)) * 2; }
__device__ __forceinline__ int v_rd_base(int lane) { return ((lane & 3) << 3) | (((lane >> 2) & 3) << 6) | (((lane >> 4) & 1) << 5) | (((lane >> 5) & 1) << 8); }
constexpr int v_rd_off(int d0, int ks, int half) { return d0 * 512 + ks * 4096 + half * 2048; }
template <int OFF> __device__ __forceinline__ s16x4 tr_read(int vb) { s16x4 r; asm volatile("ds_read_b64_tr_b16 %0, %1 offset:%2" : "=&v"(r) : "v"(vb), "i"(OFF) : "memory"); return r; }
template <int D0> __device__ __forceinline__ void pv_one(f32x16& od, int vb, bf16x8 pa0, bf16x8 pa1, bf16x8 pa2, bf16x8 pa3) {
    const s16x4 l0 = tr_read<v_rd_off(D0, 0, 0)>(vb), h0 = tr_read<v_rd_off(D0, 0, 1)>(vb), l1 = tr_read<v_rd_off(D0, 1, 0)>(vb), h1 = tr_read<v_rd_off(D0, 1, 1)>(vb);
    const s16x4 l2 = tr_read<v_rd_off(D0, 2, 0)>(vb), h2 = tr_read<v_rd_off(D0, 2, 1)>(vb), l3 = tr_read<v_rd_off(D0, 3, 0)>(vb), h3 = tr_read<v_rd_off(D0, 3, 1)>(vb);
    asm volatile("s_waitcnt lgkmcnt(0)" ::: "memory"); SBAR();
#define PK(L, H) (bf16x8){L[0], L[1], L[2], L[3], H[0], H[1], H[2], H[3]}
    od = __builtin_amdgcn_mfma_f32_32x32x16_bf16(pa0, PK(l0, h0), od, 0, 0, 0);
    od = __builtin_amdgcn_mfma_f32_32x32x16_bf16(pa1, PK(l1, h1), od, 0, 0, 0);
    od = __builtin_amdgcn_mfma_f32_32x32x16_bf16(pa2, PK(l2, h2), od, 0, 0, 0);
    od = __builtin_amdgcn_mfma_f32_32x32x16_bf16(pa3, PK(l3, h3), od, 0, 0, 0);
#undef PK
}
__device__ __forceinline__ void pv_d0(f32x16* o, int vb, bf16x8 pa0, bf16x8 pa1, bf16x8 pa2, bf16x8 pa3) {
    pv_one<0>(o[0], vb, pa0, pa1, pa2, pa3); pv_one<1>(o[1], vb, pa0, pa1, pa2, pa3); pv_one<2>(o[2], vb, pa0, pa1, pa2, pa3); pv_one<3>(o[3], vb, pa0, pa1, pa2, pa3);
}
__device__ __forceinline__ void attn_body(const u16* __restrict__ Qb, const u16* __restrict__ Kh, const u16* __restrict__ Vh, u16* __restrict__ Ob, int ldo, int seq, char* lds, int wv) {
    const int tid = tid_opaque(wv), wid = wv, lane = tid & 63, r32 = lane & 31, hi = lane >> 5;
    char* V_lds = lds; char* K_lds = lds + 2 * SHM_V;
    float* ws = (float*)(lds + 2 * SHM_V + 2 * SHM_K) + wid * 64; float* li_l = ws; float* al_l = ws + 32;
    float m_reg = -1e30f, l_reg = 0; f32x16 o[4] = {}; bf16x8 qr[12];
    const u16* Qw = Qb + (long)(wid * QBLK + r32) * QKD + hi * 8;
#pragma unroll
    for (int d0 = 0; d0 < 12; ++d0) qr[d0] = *reinterpret_cast<const bf16x8*>(Qw + d0 * 16);
    const int sr = tid >> 4, sc = (tid & 15) * 8, vst0 = v_st(sr, sc), vst1 = v_st(32 + sr, sc);
    const int kr0 = tid / 24, kc0 = tid % 24, kr1 = (tid + 512) / 24, kc1 = (tid + 512) % 24, kr2 = (tid + 1024) / 24, kc2 = (tid + 1024) % 24;
    const int kst0 = KSWZ(kr0, kc0 * 16), kst1 = KSWZ(kr1, kc1 * 16), kst2 = KSWZ(kr2, kc2 * 16);
    const int vb0 = (int)(uintptr_t)V_lds + v_rd_base(lane);
    bf16x8 vs0, vs1, ks0, ks1, ks2;
#define SLOAD(k0) do { vs0 = *reinterpret_cast<const bf16x8*>(&Vh[(long)((k0) + sr) * 128 + sc]); vs1 = *reinterpret_cast<const bf16x8*>(&Vh[(long)((k0) + 32 + sr) * 128 + sc]); \
    ks0 = *reinterpret_cast<const bf16x8*>(&Kh[(long)((k0) + kr0) * QKD + kc0 * 8]); ks1 = *reinterpret_cast<const bf16x8*>(&Kh[(long)((k0) + kr1) * QKD + kc1 * 8]); \
    ks2 = *reinterpret_cast<const bf16x8*>(&Kh[(long)((k0) + kr2) * QKD + kc2 * 8]); } while (0)
#define SWRITE(b) do { *(bf16x8*)(V_lds + (b) * SHM_V + vst0) = vs0; *(bf16x8*)(V_lds + (b) * SHM_V + vst1) = vs1; \
    *(bf16x8*)(K_lds + (b) * SHM_K + kst0) = ks0; *(bf16x8*)(K_lds + (b) * SHM_K + kst1) = ks1; *(bf16x8*)(K_lds + (b) * SHM_K + kst2) = ks2; } while (0)
#define SWAIT() asm volatile("s_waitcnt vmcnt(0)" ::: "memory")
#define RESC(a) do { if (__any((a) < 1.f)) { if (hi == 0) al_l[r32] = (a); asm volatile("s_waitcnt lgkmcnt(0)" ::: "memory"); \
    _Pragma("unroll") for (int d = 0; d < 4; ++d) _Pragma("unroll") for (int r = 0; r < 16; ++r) o[d][r] *= al_l[crow(r, hi)]; } } while (0)
    f32x16 p0, p1; float mn, al; bf16x8 pa0, pa1, pa2, pa3; const int NT = seq / KVBLK;
    SLOAD(0); SWAIT(); SWRITE(0); __syncthreads();
    for (int j = 0; j < NT; ++j) {
        const int cb = j & 1;
        if (j + 1 < NT) SLOAD((j + 1) * KVBLK);
        SBAR(); qkt(p0, p1, K_lds + cb * SHM_K, qr, r32, hi);
        partialSM(p0, p1, m_reg, mn, al); RESC(al);
        finishSM(p0, p1, al, l_reg, pa0, pa1, pa2, pa3); SBAR();
        pv_d0(o, vb0 + cb * SHM_V, pa0, pa1, pa2, pa3);
        if (j + 1 < NT) { SWAIT(); SWRITE(cb ^ 1); }
        __syncthreads();
    }
    if (hi == 0) li_l[r32] = l_reg; asm volatile("s_waitcnt lgkmcnt(0)" ::: "memory");
    float rli[16];
#pragma unroll
    for (int r = 0; r < 16; ++r) rli[r] = __builtin_amdgcn_rcpf(li_l[crow(r, hi)]);
    u16* Ow = Ob + (long)(wid * QBLK) * ldo;
#pragma unroll
    for (int r = 0; r < 16; ++r) { const int orow = crow(r, hi);
#pragma unroll
        for (int d0 = 0; d0 < 4; ++d0) Ow[(long)orow * ldo + d0 * 32 + r32] = f2bf(o[d0][r] * rli[r]); }
    __syncthreads();
#undef SLOAD
#undef SWRITE
#undef SWAIT
#undef RESC
}
#undef KSWZ
#undef SBAR
}
struct NormDst { float* X; u16* HX; u16* UH; unsigned* cnt; int* list; unsigned char* seli; unsigned char* selw; };
__device__ __forceinline__ NormDst norm_dst_real(unsigned char* ws, int li) {
    NormDst d; d.X = (float*)(ws + WS_X); d.HX = (u16*)(ws + WS_HX); d.UH = (u16*)(ws + WS_R1 + R1_UH); d.cnt = (unsigned*)(ws + WS_CTL) + CW_CNT + li * 32 * CS; d.list = (int*)(ws + WS_LIST); d.seli = ws + WS_SELI; d.selw = ws + WS_SELW; return d; }
__device__ __forceinline__ NormDst norm_dst_dummy(unsigned char* ws) {
    NormDst d; unsigned char* t = ws + WS_NTMP; d.X = (float*)t; d.HX = (u16*)(t + (size_t)T * D * 4); d.UH = d.HX; d.cnt = (unsigned*)(ws + WS_CTL) + CW_CNT_DUMMY; d.list = (int*)(t + (size_t)T * D * 4 + (size_t)64 * 2304 * 512 * 2);
    d.seli = (unsigned char*)(d.list + (size_t)64 * T); d.selw = d.seli + (size_t)T * 16; return d; }
__device__ __forceinline__ float bperm(float v, int srclane) { return __int_as_float(__builtin_amdgcn_ds_bpermute(srclane << 2, __float_as_int(v))); }
template <int MODE>
__device__ __forceinline__ void norm2_rows(unsigned char* ws, float* outp, const NormDst d, int li, int which, int* s_base, char* lds, int wv) {
    const float* sm = (const float*)(ws + WS_SMALL);
    const int tidn = tid_opaque(wv); const int lane = tidn & 63, wave = wv;
    const float* X = (const float*)(ws + WS_X);
    const float* mod = (const float*)(ws + WS_MOD);
    float* WG = (float*)lds;
    u16* WE = (u16*)(lds + 16384);
    __syncthreads();
    if (MODE & 1) { if (tidn == 0) { const unsigned* cnt = (const unsigned*)(ws + WS_CTL) + CW_CNT + (li - 1) * 32 * CS; int a = 0; for (int e = 0; e < 32; ++e) { s_base[e] = a; a += (int)((cnt[e * CS] + 255u) / 256u); } s_base[32] = a; } }
    if (MODE & 8) {
        const float* wg = sm + SM_WGROUP + (size_t)li * 4096; const float* we = sm + SM_WEXP + (size_t)li * 32768;
        for (int i = tidn; i < 4096 / 4; i += 512) *(float4*)(WG + 4 * i) = *(const float4*)(wg + 4 * i);
        for (int i = tidn; i < 32768 / 2; i += 512) { const float2 v = *(const float2*)(we + 2 * i); *(unsigned*)(WE + 2 * i) = g8::cvt_pk_bf16(v.x, v.y); }
    }
    __syncthreads();
    const bool lastl = (li == 3);
    for (int row = blockIdx.x * 8 + wave; row < T; row += gridDim.x * 8) {
        const int b = row / LTOT, pos = row % LTOT; const bool isctx = pos < CTXL; const int r = isctx ? 16 : b;
        if ((MODE & 16) && isctx) continue;
        if ((MODE & 8) && lastl && isctx) continue;
        float4 v[4];
#pragma unroll
        for (int q = 0; q < 4; ++q) v[q] = *(const float4*)(X + (size_t)row * D + q * 256 + lane * 4);
        if (MODE & 1) {
            const bool skip = (li - 1 == 3) && isctx;
            if (!skip) {
                const int4 si = *(const int4*)(ws + WS_SELI + (size_t)row * 16); const float2 sw = *(const float2*)(ws + WS_SELW + (size_t)row * 8);
                const size_t g1 = (size_t)s_base[si.x] * 256 + si.y, g2 = (size_t)s_base[si.z] * 256 + si.w;
                const u16* YB = (const u16*)(ws + WS_YB);
                const float* gate = mod + (size_t)((li - 1) * 17 + r) * 6144 + 5 * 1024;
#pragma unroll
                for (int q = 0; q < 4; ++q) { const int c = q * 256 + lane * 4;
                    const uint2 ya = *(const uint2*)(YB + g1 * 1024 + c), yb = *(const uint2*)(YB + g2 * 1024 + c); const float4 gg = *(const float4*)(gate + c);
                    v[q].x += gg.x * (sw.x * bf2f((u16)(ya.x & 0xffff)) + sw.y * bf2f((u16)(yb.x & 0xffff)));
                    v[q].y += gg.y * (sw.x * bf2f((u16)(ya.x >> 16)) + sw.y * bf2f((u16)(yb.x >> 16)));
                    v[q].z += gg.z * (sw.x * bf2f((u16)(ya.y & 0xffff)) + sw.y * bf2f((u16)(yb.y & 0xffff)));
                    v[q].w += gg.w * (sw.x * bf2f((u16)(ya.y >> 16)) + sw.y * bf2f((u16)(yb.y >> 16)));
                    if (!(MODE & 16)) *(float4*)(d.X + (size_t)row * D + c) = v[q]; }
            }
        }
        if (MODE & 32) {
            const u16* DL = (const u16*)(ws + WS_HX);
#pragma unroll
            for (int q = 0; q < 4; ++q) { const int c = q * 256 + lane * 4; const uint2 dl = *(const uint2*)(DL + (size_t)row * D + c);
                v[q].x += bf2f((u16)(dl.x & 0xffff)); v[q].y += bf2f((u16)(dl.x >> 16)); v[q].z += bf2f((u16)(dl.y & 0xffff)); v[q].w += bf2f((u16)(dl.y >> 16));
                *(float4*)(d.X + (size_t)row * D + c) = v[q]; }
        }
        float ss = 0.f;
#pragma unroll
        for (int q = 0; q < 4; ++q) ss += v[q].x * v[q].x + v[q].y * v[q].y + v[q].z * v[q].z + v[q].w * v[q].w;
        ss = wave_sum_l(ss, lane);
        const float rstd = rsqrtf(ss * (1.f / 1024.f) + EPS);
        if (MODE & 16) {
            float* out = outp + ((size_t)b * SEQ + (pos - CTXL)) * D;
#pragma unroll
            for (int q = 0; q < 4; ++q) { const int c = q * 256 + lane * 4; const float4 g = *(const float4*)(sm + SM_FINALG + c);
                *(float4*)(out + c) = make_float4(v[q].x * rstd * g.x, v[q].y * rstd * g.y, v[q].z * rstd * g.z, v[q].w * rstd * g.w); }
            continue;
        }
        const float* gv = sm + (which ? SM_GFFN : SM_GMIX) + li * 1024;
        const float* sh = mod + (size_t)(li * 17 + r) * 6144 + (which ? 3 : 0) * 1024; const float* scl = sh + 1024;
        float h[16];
#pragma unroll
        for (int q = 0; q < 4; ++q) { const int c = q * 256 + lane * 4; const float4 g = *(const float4*)(gv + c), s4 = *(const float4*)(sh + c), c4 = *(const float4*)(scl + c);
            h[q * 4 + 0] = v[q].x * rstd * g.x * (1.f + c4.x) + s4.x; h[q * 4 + 1] = v[q].y * rstd * g.y * (1.f + c4.y) + s4.y;
            h[q * 4 + 2] = v[q].z * rstd * g.z * (1.f + c4.z) + s4.z; h[q * 4 + 3] = v[q].w * rstd * g.w * (1.f + c4.w) + s4.w; }
        if (MODE & 2) {
#pragma unroll
            for (int q = 0; q < 4; ++q) { uint2 w; w.x = g8::cvt_pk_bf16(h[q * 4], h[q * 4 + 1]); w.y = g8::cvt_pk_bf16(h[q * 4 + 2], h[q * 4 + 3]);
                *(uint2*)(d.HX + (size_t)row * D + q * 256 + lane * 4) = w; }
        }
        if (MODE & 4) {
#pragma unroll
            for (int q = 0; q < 4; ++q) { const int c = q * 256 + lane * 4; const int g = c >> 4, ch = c & 15;
                uint2 w; w.x = g8::cvt_pk_bf16(h[q * 4], h[q * 4 + 1]); w.y = g8::cvt_pk_bf16(h[q * 4 + 2], h[q * 4 + 3]);
                *(uint2*)(d.UH + ((size_t)g * 2304 + b * 144 + (pos >> 4)) * 512 + (pos & 15) * 16 + ch) = w; }
        }
        if (MODE & 8) {
            float lg[4] = {0.f, 0.f, 0.f, 0.f};
#pragma unroll
            for (int q = 0; q < 4; ++q)
#pragma unroll
                for (int j = 0; j < 4; ++j) { const float4 w = *(const float4*)(WG + (q * 256 + lane * 4 + j) * 4); const float hv = h[q * 4 + j];
                    lg[0] += hv * w.x; lg[1] += hv * w.y; lg[2] += hv * w.z; lg[3] += hv * w.w; }
            { const bool hi5 = (lane & 32) != 0; float k0 = hi5 ? lg[2] : lg[0], k1 = hi5 ? lg[3] : lg[1]; const float s0 = hi5 ? lg[0] : lg[2], s1 = hi5 ? lg[1] : lg[3];
              k0 += bperm(s0, lane ^ 32); k1 += bperm(s1, lane ^ 32);
              const bool hi4 = (lane & 16) != 0; float kk = hi4 ? k1 : k0; const float sd = hi4 ? k0 : k1; kk += bperm(sd, lane ^ 16);
              kk += bperm(kk, lane ^ 8); kk += bperm(kk, lane ^ 4); kk += bperm(kk, lane ^ 2); kk += bperm(kk, lane ^ 1);
              lg[0] = __int_as_float(__builtin_amdgcn_readlane(__float_as_int(kk), 0)); lg[1] = __int_as_float(__builtin_amdgcn_readlane(__float_as_int(kk), 16));
              lg[2] = __int_as_float(__builtin_amdgcn_readlane(__float_as_int(kk), 32)); lg[3] = __int_as_float(__builtin_amdgcn_readlane(__float_as_int(kk), 48)); }
#pragma unroll
            for (int g = 0; g < 4; ++g) lg[g] += sm[SM_BGROUP + li * 4 + g];
            int gi = 0; float best = lg[0];
#pragma unroll
            for (int g = 1; g < 4; ++g) if (lg[g] > best) { best = lg[g]; gi = g; }
            float den = 0.f;
#pragma unroll
            for (int g = 0; g < 4; ++g) den += __expf(lg[g] - best);
            const float pg = 1.f / den;
            const u16* wes = WE + (size_t)gi * 8192;
            float le[8];
#pragma unroll
            for (int e = 0; e < 8; ++e) le[e] = 0.f;
#pragma unroll
            for (int q = 0; q < 4; ++q)
#pragma unroll
                for (int j = 0; j < 4; ++j) { const u32x4 w = *(const u32x4*)(wes + (q * 256 + lane * 4 + j) * 8); const float hv = h[q * 4 + j];
                    le[0] += hv * __uint_as_float(w.x << 16); le[1] += hv * __uint_as_float(w.x & 0xffff0000u); le[2] += hv * __uint_as_float(w.y << 16); le[3] += hv * __uint_as_float(w.y & 0xffff0000u);
                    le[4] += hv * __uint_as_float(w.z << 16); le[5] += hv * __uint_as_float(w.z & 0xffff0000u); le[6] += hv * __uint_as_float(w.w << 16); le[7] += hv * __uint_as_float(w.w & 0xffff0000u); }
            { const bool hi5 = (lane & 32) != 0; float k[4]; float s[4];
#pragma unroll
              for (int i = 0; i < 4; ++i) { k[i] = hi5 ? le[4 + i] : le[i]; s[i] = hi5 ? le[i] : le[4 + i]; }
#pragma unroll
              for (int i = 0; i < 4; ++i) k[i] += bperm(s[i], lane ^ 32);
              const bool hi4 = (lane & 16) != 0; float k2[2], s2[2];
#pragma unroll
              for (int i = 0; i < 2; ++i) { k2[i] = hi4 ? k[2 + i] : k[i]; s2[i] = hi4 ? k[i] : k[2 + i]; }
#pragma unroll
              for (int i = 0; i < 2; ++i) k2[i] += bperm(s2[i], lane ^ 16);
              const bool hi3 = (lane & 8) != 0; float kk = hi3 ? k2[1] : k2[0]; const float sd = hi3 ? k2[0] : k2[1]; kk += bperm(sd, lane ^ 8);
              kk += bperm(kk, lane ^ 4); kk += bperm(kk, lane ^ 2); kk += bperm(kk, lane ^ 1);
#pragma unroll
              for (int e = 0; e < 8; ++e) le[e] = __int_as_float(__builtin_amdgcn_readlane(__float_as_int(kk), e * 8)); }
#pragma unroll
            for (int e = 0; e < 8; ++e) le[e] += sm[SM_BEXP + (li * 4 + gi) * 8 + e];
            int i1 = 0; float b1 = le[0];
#pragma unroll
            for (int e = 1; e < 8; ++e) if (le[e] > b1) { b1 = le[e]; i1 = e; }
            int i2 = -1; float b2 = -3.0e38f;
#pragma unroll
            for (int e = 0; e < 8; ++e) if (e != i1 && le[e] > b2) { b2 = le[e]; i2 = e; }
            if (lane == 0) {
                const float ex = __expf(b2 - b1); const float w1 = 1.f / (1.f + ex), w2 = ex / (1.f + ex);
                const int e1 = gi * 8 + i1, e2 = gi * 8 + i2;
                const int s1 = (int)atomicAdd(&d.cnt[e1 * CS], 1u), s2 = (int)atomicAdd(&d.cnt[e2 * CS], 1u);
                d.list[(size_t)e1 * T + s1] = row; d.list[(size_t)e2 * T + s2] = row;
                *(int4*)(d.seli + (size_t)row * 16) = make_int4(e1, s1, e2, s2);
                *(float2*)(d.selw + (size_t)row * 8) = make_float2(pg * w1, pg * w2);
            }
        }
    }
}
#define XB_TMO      128
#define XB_XCNT(j)  (256  + 64 * (j))
#define XB_XSUB(j)  (1280 + 64 * (j))
#define XB_XGEN(j)  (2304 + 64 * (j))
#define XB_TOP      3328
#define XB_TOPGEN   3392
#define XCD_BAR_WORDS 3456
#define XB_SPIN_CAP (1u << 18)
__device__ __forceinline__ unsigned xb_ld(unsigned* p)              { return __hip_atomic_load(p, __ATOMIC_RELAXED, __HIP_MEMORY_SCOPE_AGENT); }
__device__ __forceinline__ unsigned xb_add(unsigned* p, unsigned v) { return __hip_atomic_fetch_add(p, v, __ATOMIC_RELAXED, __HIP_MEMORY_SCOPE_AGENT); }
__device__ __forceinline__ unsigned xb_xcc_id() { return (unsigned)__builtin_amdgcn_s_getreg((3 << 11) | 20) & 0xFu; }
#define XB_SPIN(cond, bar) do { unsigned _sp = 0; while (cond) { __builtin_amdgcn_s_sleep(1); \
    if ((++_sp & 255u) == 0u) { if (xb_ld(&(bar)[XB_TMO])) break; if (_sp > XB_SPIN_CAP) { atomicAdd(&(bar)[XB_TMO], 1u); break; } } } } while (0)
struct XcdBarrier { unsigned* bar; unsigned x; volatile LAS unsigned* st; };
__device__ __forceinline__ XcdBarrier xcd_barrier_post(unsigned* bar, volatile LAS unsigned* st) {
    XcdBarrier b; b.bar = bar; b.x = xb_xcc_id(); b.st = st;
    if (threadIdx.x == 0) (void)xb_add(&bar[XB_XCNT(b.x)], 1u);
    return b;
}
__device__ __forceinline__ void xcd_barrier_complete(unsigned* bar, unsigned x, unsigned& nloc, unsigned& nx) {
    const unsigned G = gridDim.x * gridDim.y * gridDim.z;
    unsigned sum, cnt, mine, sp = 0u;
    for (;;) {
        sum = 0u; cnt = 0u; mine = 0u;
#pragma unroll
        for (unsigned j = 0; j < 16; ++j) { const unsigned c = xb_ld(&bar[XB_XCNT(j)]); sum += c; cnt += (c > 0u) ? 1u : 0u; mine = (j == x) ? c : mine; }
        if (sum == G) break;
        __builtin_amdgcn_s_sleep(1);
        if ((++sp & 255u) == 0u) { if (xb_ld(&bar[XB_TMO])) break; if (sp > XB_SPIN_CAP) { atomicAdd(&bar[XB_TMO], 1u); break; } }
    }
    nloc = mine > 0u ? mine : 1u; nx = cnt > 0u ? cnt : 1u;
}
__device__ __forceinline__ void xcd_barrier(const XcdBarrier& b, const int tid) {
    asm volatile("s_waitcnt vmcnt(0)" ::: "memory");
    __syncthreads();
    if (tid == 0) {
        unsigned* bar = b.bar;
        __builtin_amdgcn_s_waitcnt(0);
        unsigned nloc = b.st[0], nx = b.st[1];
        if (nloc == 0u) { xcd_barrier_complete(bar, b.x, nloc, nx); b.st[0] = nloc; b.st[1] = nx; }
        const unsigned old = xb_add(&bar[XB_XSUB(b.x)], 1u);
        const unsigned gen = old / nloc;
        if (old + 1u == (gen + 1u) * nloc) {
            __builtin_amdgcn_fence(__ATOMIC_RELEASE, "agent");
            asm volatile("s_waitcnt vmcnt(0)" ::: "memory");
            const unsigned og = xb_add(&bar[XB_TOP], 1u);
            const unsigned tg = og / nx;
            if (og + 1u == (tg + 1u) * nx) xb_add(&bar[XB_TOPGEN], 1u);
            else XB_SPIN(xb_ld(&bar[XB_TOPGEN]) == tg, bar);
            __builtin_amdgcn_fence(__ATOMIC_ACQUIRE, "agent");
            xb_add(&bar[XB_XGEN(b.x)], 1u);
            asm volatile("s_waitcnt vmcnt(0)" ::: "memory");
        } else {
            XB_SPIN(xb_ld(&bar[XB_XGEN(b.x)]) == gen, bar);
            __builtin_amdgcn_fence(__ATOMIC_ACQUIRE, "agent");
            asm volatile("s_waitcnt vmcnt(0)" ::: "memory");
        }
    }
    __syncthreads();
}

template <int MAP> __device__ __forceinline__ void cvt_w(const float* __restrict__ src, u16* __restrict__ dst, int nmat, int K, int N, int NP, int wv, int nwv) {
    const int lane = threadIdx.x & 63; const int kt_n = K / 64, nt_n = N / 64, per = kt_n * nt_n;
    for (int t = wv; t < nmat * per; t += nwv) {
        const int mat = t / per, rem = t % per, nt = rem / kt_n, kt = rem % kt_n;
        const float* s = src + ((size_t)mat * K + (size_t)kt * 64) * N + nt * 64 + lane;
        float v[64];
#pragma unroll
        for (int k = 0; k < 64; ++k) v[k] = s[(size_t)k * N];
        const int n = nt * 64 + lane; int np = n;
        if (MAP == 1) { const int half = N / 2; const int which = n >= half ? 1 : 0; const int j = n - which * half; np = (j / 128) * 256 + ((j % 128) / 64) * 128 + ((j % 64) / 16) * 32 + which * 16 + (j % 16); }
        u16* d = dst + ((size_t)mat * NP + np) * K + kt * 64;
#pragma unroll
        for (int q = 0; q < 8; ++q) { u32x4 w; w.x = g8::cvt_pk_bf16(v[q * 8], v[q * 8 + 1]); w.y = g8::cvt_pk_bf16(v[q * 8 + 2], v[q * 8 + 3]); w.z = g8::cvt_pk_bf16(v[q * 8 + 4], v[q * 8 + 5]); w.w = g8::cvt_pk_bf16(v[q * 8 + 6], v[q * 8 + 7]);
            *(u32x4*)(d + q * 8) = w; }
    }
}
__device__ __forceinline__ void mod_tasks(const Ptrs& P, char* lds) {
    float* sc = (float*)lds;
    float* red = sc + 17 * 1024;
    float* mod = (float*)(P.ws + WS_MOD);
    const int tid = threadIdx.x, cl = tid & 127, kg = tid >> 7;
    __syncthreads();
    for (int idx = tid; idx < 17 * 1024; idx += 512) { const int r = idx >> 10, kk = idx & 1023; const float v = r < 16 ? P.in[1][r * 1024 + kk] : P.in[3][kk]; sc[idx] = silu_f(v); }
    __syncthreads();
    for (int task = blockIdx.x; task < 4 * 48; task += gridDim.x) {
        const int i = task / 48, cc = task % 48; const int col = cc * 128 + cl;
        const float* W = P.in[4] + ((size_t)i * 1024 + kg * 256) * 6144 + col;
        float acc[17];
#pragma unroll
        for (int r = 0; r < 17; ++r) acc[r] = 0.f;
#pragma unroll 8
        for (int kk = 0; kk < 256; ++kk) { const float w = W[(size_t)kk * 6144];
#pragma unroll
            for (int r = 0; r < 17; ++r) acc[r] += sc[r * 1024 + kg * 256 + kk] * w; }
#pragma unroll
        for (int r = 0; r < 17; ++r) red[(kg * 17 + r) * 128 + cl] = acc[r];
        __syncthreads();
        if (kg == 0) { const float bb = P.in[5][i * 6144 + col];
#pragma unroll
            for (int r = 0; r < 17; ++r) mod[(size_t)(i * 17 + r) * 6144 + col] = ((red[r * 128 + cl] + red[(17 + r) * 128 + cl]) + (red[(34 + r) * 128 + cl] + red[(51 + r) * 128 + cl])) + bb; }
        __syncthreads();
    }
}
__device__ __forceinline__ void s5_prep(const Ptrs& P, int j, int g, char* lds) {
    float2* Apow = (float2*)lds;
    float2* Bb = Apow + 2 * 64 * 17;
    float2* Cc = Bb + 2 * 64 * 16;
    float* Kt = (float*)(Cc + 2 * 16 * 64);
    const int tid = threadIdx.x;
    __syncthreads();
    if (tid < 128) { const int dir = tid >> 6, p = tid & 63; const size_t gd = ((size_t)j * 2 + dir) * SG + g;
        const float dt = __expf(P.in[10][gd]); const float ar = P.in[8][gd * SP + p], ai = P.in[9][gd * SP + p]; const float ldr = ar * dt, ldi = ai * dt;
        for (int tau = 0; tau <= 16; ++tau) { const float mag = __expf(ldr * (float)tau), ang = ldi * (float)tau; Apow[(dir * 64 + p) * 17 + tau] = make_float2(mag * __cosf(ang), mag * __sinf(ang)); }
        const float2 ab = Apow[(dir * 64 + p) * 17 + 1]; const float nr = ab.x - 1.f, ni = ab.y, den = ar * ar + ai * ai; const float qr = (nr * ar + ni * ai) / den, qi = (ni * ar - nr * ai) / den;
        for (int c = 0; c < 16; ++c) { const float br = P.in[11][(gd * SP + p) * SC + c], bi = P.in[12][(gd * SP + p) * SC + c]; Bb[(dir * 64 + p) * 16 + c] = make_float2(qr * br - qi * bi, qr * bi + qi * br); }
        ((float2*)(P.ws + WS_WB + WB_AT))[gd * SP + p] = Apow[(dir * 64 + p) * 17 + 16];
    }
    for (int i = tid; i < 2 * 16 * 64; i += 512) { const int d2 = i >> 10, c = (i >> 6) & 15, pp = i & 63; const size_t o = ((((size_t)j * 2 + d2) * SG + g) * SC + c) * SP + pp; Cc[i] = make_float2(P.in[13][o], P.in[14][o]); }
    __syncthreads();
    for (int idx = tid; idx < 8192; idx += 512) { const int dir = idx >> 12, tau = (idx >> 8) & 15, c = (idx >> 4) & 15, c2 = idx & 15; float s = 0.f;
        for (int p = 0; p < 64; ++p) { const float2 cc = Cc[(dir * 16 + c) * 64 + p], aa = Apow[(dir * 64 + p) * 17 + tau], bb = Bb[(dir * 64 + p) * 16 + c2];
            const float xr = aa.x * bb.x - aa.y * bb.y, xi = aa.x * bb.y + aa.y * bb.x; s += cc.x * xr - cc.y * xi; }
        Kt[idx] = s; }
    __syncthreads();
    u16* W1 = (u16*)(P.ws + WS_WB + WB_W1) + ((size_t)j * 64 + g) * 256 * 256; u16* W2 = (u16*)(P.ws + WS_WB + WB_W2) + ((size_t)j * 64 + g) * 256 * 512;
    for (int idx = tid; idx < 256 * 32; idx += 512) { const int row = idx >> 5, s8 = idx & 31; const int t = row >> 4, c = row & 15, s = s8 >> 1, cb = (s8 & 1) * 8;
        float v[8];
#pragma unroll
        for (int q = 0; q < 8; ++q) { const int c2 = cb + q;
            v[q] = s < t ? Kt[((0 * 16 + (t - s)) * 16 + c) * 16 + c2] : s > t ? Kt[((1 * 16 + (s - t)) * 16 + c) * 16 + c2] : Kt[((0 * 16 + 0) * 16 + c) * 16 + c2] + Kt[((1 * 16 + 0) * 16 + c) * 16 + c2]; }
        u32x4 w; w.x = g8::cvt_pk_bf16(v[0], v[1]); w.y = g8::cvt_pk_bf16(v[2], v[3]); w.z = g8::cvt_pk_bf16(v[4], v[5]); w.w = g8::cvt_pk_bf16(v[6], v[7]);
        *(u32x4*)(W2 + (size_t)row * 512 + s8 * 8) = w; }
    for (int idx = tid; idx < 256 * 128; idx += 512) { const int row = idx >> 7, dp = idx & 127; const int dir = dp >> 6, p = dp & 63, t = row >> 4, c = row & 15;
        const float2 cc = Cc[(dir * 16 + c) * 64 + p], aa = Apow[(dir * 64 + p) * 17 + (dir ? 16 - t : t + 1)];
        const float gr = cc.x * aa.x - cc.y * aa.y, gi = cc.x * aa.y + cc.y * aa.x;
        *(unsigned*)(W2 + (size_t)row * 512 + 256 + dir * 128 + 2 * p) = g8::cvt_pk_bf16(gr, -gi); }
    for (int idx = tid; idx < 256 * 32; idx += 512) { const int n = idx >> 5, s8 = idx & 31; const int dir = n >> 7, p = (n >> 1) & 63, ri = n & 1, s = s8 >> 1, cb = (s8 & 1) * 8;
        const float2 aa = Apow[(dir * 64 + p) * 17 + (dir ? s : 15 - s)];
        float v[8];
#pragma unroll
        for (int q = 0; q < 8; ++q) { const float2 bb = Bb[(dir * 64 + p) * 16 + cb + q]; v[q] = ri ? aa.x * bb.y + aa.y * bb.x : aa.x * bb.x - aa.y * bb.y; }
        u32x4 w; w.x = g8::cvt_pk_bf16(v[0], v[1]); w.y = g8::cvt_pk_bf16(v[2], v[3]); w.z = g8::cvt_pk_bf16(v[4], v[5]); w.w = g8::cvt_pk_bf16(v[6], v[7]);
        *(u32x4*)(W1 + (size_t)n * 256 + s8 * 8) = w; }
    __syncthreads();
}
__device__ __forceinline__ void prologue_phase(const Ptrs& P, char* lds) {
    const int gw = blockIdx.x * 8 + (threadIdx.x >> 6), nw = gridDim.x * 8;
    copy_small(P, blockIdx.x * 512 + threadIdx.x, gridDim.x * 512);
    { float4* X = (float4*)(P.ws + WS_X); const size_t n4 = (size_t)T * D / 4;
      for (size_t i = (size_t)blockIdx.x * 512 + threadIdx.x; i < n4; i += (size_t)gridDim.x * 512) { const size_t row = i / 256, c4 = i % 256; const int b = (int)(row / LTOT), pos = (int)(row % LTOT);
          X[i] = pos < CTXL ? ((const float4*)P.in[2])[((size_t)b * CTXL + pos) * 256 + c4] : ((const float4*)P.in[0])[((size_t)b * SEQ + (pos - CTXL)) * 256 + c4]; }
      float2* rope = (float2*)(P.ws + WS_ROPE);
      for (int i = blockIdx.x * 512 + threadIdx.x; i < 2048 * 32; i += gridDim.x * 512) { const int s = i >> 5, k = i & 31, f = k & 15; const float invf = exp2f(-(float)f * (13.287712379549449f / 16.f));
          const float ang = (float)(k < 16 ? (s >> 6) : (s & 63)) * invf; rope[i] = make_float2(__cosf(ang), __sinf(ang)); } }
    mod_tasks(P, lds);
    for (int idx = blockIdx.x; idx < 128; idx += gridDim.x) s5_prep(P, idx >> 6, idx & 63, lds);
    unsigned char* wb = P.ws + WS_WB;
    cvt_w<1>(P.in[16], (u16*)(wb + WB_GLU), 2, 1024, 2048, 2048, gw, nw);
    cvt_w<0>(P.in[17], (u16*)(wb + WB_WIN), 2, 1024, 704, 768, gw, nw);
    for (int i = blockIdx.x * 512 + threadIdx.x; i < 2 * 64 * 1024 / 8; i += gridDim.x * 512) { const int mat = i / 8192, r = i % 8192; *(u32x4*)((u16*)(wb + WB_WIN) + ((size_t)mat * 768 + 704) * 1024 + (size_t)r * 8) = (u32x4){0u, 0u, 0u, 0u}; }
    cvt_w<0>(P.in[20], (u16*)(wb + WB_UQ), 2, 384, 1536, 1536, gw, nw);
    cvt_w<0>(P.in[21], (u16*)(wb + WB_UKV), 2, 256, 2048, 2048, gw, nw);
    cvt_w<0>(P.in[22], (u16*)(wb + WB_WO), 2, 1024, 1024, 1024, gw, nw);
    cvt_w<1>(P.in[27], (u16*)(wb + WB_GU), 128, 1024, 1024, 1024, gw, nw);
    cvt_w<0>(P.in[28], (u16*)(wb + WB_DN), 128, 512, 1024, 1024, gw, nw);
}
__device__ __forceinline__ void s5_scan_phase(unsigned char* wsp, int j, int wv) {
    struct { unsigned char* ws; } P{wsp};
    const int tids = tid_opaque(wv); const int lane = tids & 63;
    const float* S = (const float*)(P.ws + WS_R1 + R1_S); u16* UH = (u16*)(P.ws + WS_R1 + R1_UH); const float2* AT = (const float2*)(P.ws + WS_WB + WB_AT);
    for (int task = blockIdx.x * 8 + (tids >> 6); task < 2048; task += gridDim.x * 8) {
        const int g = task >> 5, b = (task >> 1) & 15, dir = task & 1;
        const float2 a = AT[(((size_t)j * 2 + dir) * SG + g) * SP + lane];
        const float* sp = S + ((size_t)g * 2304 + b * 144) * 256 + dir * 128 + 2 * lane; u16* hp = UH + ((size_t)g * 2304 + b * 144) * 512 + 256 + dir * 128 + 2 * lane;
        float hr = 0.f, hi = 0.f;
        for (int s0 = 0; s0 < 144; s0 += 16) {
            float2 sv[16];
#pragma unroll
            for (int k = 0; k < 16; ++k) { const int st = s0 + k; const int n = dir ? (st < 16 ? 15 - st : 159 - st) : st; sv[k] = *(const float2*)(sp + (size_t)n * 256); }
#pragma unroll
            for (int k = 0; k < 16; ++k) { const int st = s0 + k; const int n = dir ? (st < 16 ? 15 - st : 159 - st) : st;
                *(unsigned*)(hp + (size_t)n * 512) = g8::cvt_pk_bf16(hr, hi);
                const float nr = a.x * hr - a.y * hi + sv[k].x, ni = a.x * hi + a.y * hr + sv[k].y; hr = nr; hi = ni; }
        }
    }
}
__device__ __forceinline__ void mla_post_rows(unsigned char* wsp, int j, const float* Pm, int stride, int nwaves_blk, int wv) {
    struct { unsigned char* ws; } P{wsp}; const float* sm = (const float*)(wsp + WS_SMALL);
    const int tidp = tid_opaque(wv); const int lane = tidp & 63, wave = tidp >> 6;
    u16* CQ = (u16*)(P.ws + WS_CQ); u16* CKV = (u16*)(P.ws + WS_CKV); u16* KT = (u16*)(P.ws + WS_R1 + R1_KT); const float2* rope = (const float2*)(P.ws + WS_ROPE);
    for (int row = blockIdx.x * nwaves_blk + wave; row < T; row += gridDim.x * nwaves_blk) {
        const float* t = Pm + (size_t)row * stride; const int b = row / LTOT, pos = row % LTOT;
        float q[6]; float ss = 0.f;
#pragma unroll
        for (int i = 0; i < 6; ++i) { q[i] = t[i * 64 + lane]; ss += q[i] * q[i]; }
        ss = wave_sum_l(ss, lane); float rstd = rsqrtf(ss * (1.f / 384.f) + EPS);
#pragma unroll
        for (int i = 0; i < 6; ++i) CQ[(size_t)row * QR + i * 64 + lane] = f2bf(q[i] * rstd * sm[SM_GQ + j * QR + i * 64 + lane]);
        float k[4]; ss = 0.f;
#pragma unroll
        for (int i = 0; i < 4; ++i) { k[i] = t[384 + i * 64 + lane]; ss += k[i] * k[i]; }
        ss = wave_sum_l(ss, lane); rstd = rsqrtf(ss * (1.f / 256.f) + EPS);
#pragma unroll
        for (int i = 0; i < 4; ++i) CKV[(size_t)row * KVR + i * 64 + lane] = f2bf(k[i] * rstd * sm[SM_GKV + j * KVR + i * 64 + lane]);
        float v = t[640 + lane];
        if (pos >= CTXL) { const float pv = t[640 + (lane ^ 16)]; const float2 cs = rope[(size_t)(pos - CTXL) * 32 + (lane >> 5) * 16 + (lane & 15)];
            v = (lane & 16) ? v * cs.x + pv * cs.y : v * cs.x - pv * cs.y; }
        const u16 kb = f2bf(v);
#pragma unroll
        for (int h = 0; h < NH; ++h) KT[(((size_t)b * NH + h) * LTOT + pos) * QKD + 128 + lane] = kb;
    }
}
__device__ __forceinline__ void attn_phase(unsigned char* wsp, bool ctx_out, char* lds, int wv) {
    struct { unsigned char* ws; } P{wsp};
    const u16* QT = (const u16*)(P.ws + WS_R1 + R1_QT); const u16* KT = (const u16*)(P.ws + WS_R1 + R1_KT); const u16* VT = (const u16*)(P.ws + WS_R1 + R1_VT); u16* O = (u16*)(P.ws + WS_ZO);
    const int nunits = ctx_out ? 1152 : 1024;
    for (int u = blockIdx.x; u < nunits; u += gridDim.x) {
        int bh, qt, seq;
        if (u < 1024) { const int xcd = u & 7, k = u >> 3; bh = xcd * 16 + (k >> 3); qt = 1 + (k & 7); seq = LTOT; } else { bh = u - 1024; qt = 0; seq = CTXL; }
        const int b = bh >> 3, h = bh & 7;
        at::attn_body(QT + ((size_t)bh * LTOT + qt * 256) * QKD, KT + (size_t)bh * LTOT * QKD, VT + (size_t)bh * LTOT * 128, O + ((size_t)b * LTOT + qt * 256) * D + h * 128, D, seq, lds, wv);
    }
}
constexpr int LDS_MISC = g8::STAGE_BYTES;
constexpr int LDS_BYTES = g8::STAGE_BYTES + 1024;
constexpr int NPHASE = 42;
struct MkArgs { Ptrs P; int lo, hi, bar_region, pad; };
__device__ __forceinline__ int lo_opq(int v) { asm volatile("" : "+s"(v)); return v; }
__global__ void __launch_bounds__(512, 2) mk(MkArgs a) {
    extern __shared__ __attribute__((aligned(16))) unsigned char lds[];
    LAS unsigned char* ldsl = (LAS unsigned char*)lds;
    volatile LAS unsigned* misc = (volatile LAS unsigned*)(ldsl + LDS_MISC);
    int* sbase = (int*)(lds + LDS_MISC + 64);
    const int wv = __builtin_amdgcn_readfirstlane(threadIdx.x >> 6);
    if (threadIdx.x < 4) misc[threadIdx.x] = 0u;
    __syncthreads();
#if defined(MK_FULL)
    const bool use_bar = true;
#else
    const bool use_bar = (a.hi - a.lo) > 1;
#endif
    unsigned char* ws = a.P.ws; float* outp = a.P.out;
    XcdBarrier bar; bar.bar = (unsigned*)(ws + WS_CTL) + a.bar_region * XCD_BAR_WORDS; bar.x = 0; bar.st = misc;
    if (use_bar) bar = xcd_barrier_post((unsigned*)(ws + WS_CTL) + a.bar_region * XCD_BAR_WORDS, misc);
    const int lo = a.lo, hi = a.hi;
#if defined(MK_FULL)
#define IN(k) (true)
#else
#define IN(k) (lo_opq(lo) <= (k) && (k) < lo_opq(hi))
#endif
#ifndef REP_GROUP
#define REP_GROUP (-1)
#define REP_N 1
#endif
#define NDST(li, g) (((g) == REP_GROUP && rep_ + 1 < REP_N) ? norm_dst_dummy(ws) : norm_dst_real(ws, li))
#define REP(g) for (int rep_ = 0; rep_ < ((g) == REP_GROUP ? REP_N : 1); ++rep_)
#if defined(PROBE_A)
#define STAMP(s) do { if (blockIdx.x == 0 && tid_opaque(wv) == 0) ((unsigned long long*)(ws0 + WS_CTL))[CW_STAMP64 + (s)] = __builtin_amdgcn_s_memrealtime(); } while (0)
#else
#define STAMP(s) do { } while (0)
#endif
#define SEAM(k) do { if (IN((k) + 1)) xcd_barrier(bar, tid_opaque(wv)); STAMP((k) + 1); } while (0)
    unsigned char* const ws0 = ws;
    STAMP(0);
    if (IN(0)) REP(0) { prologue_phase(a.P, (char*)lds); SEAM(0); }

    {
        constexpr int li = 0; constexpr int base = 1 + li * 10, j = li >> 1;
#define PH_BEGIN size_t zoff_ = 0; asm volatile("" : "+s"(zoff_)); unsigned char* ws = ws0 + zoff_; unsigned char* wb = ws + WS_WB; const float* sm = (const float*)(ws + WS_SMALL); float* X = (float*)(ws + WS_X); const float* mod = (const float*)(ws + WS_MOD); (void)wb; (void)sm; (void)X; (void)mod;
        if ((li & 1) == 0) {
            if (IN(base + 0)) REP(1) { PH_BEGIN const NormDst nd = NDST(li, 1); if (li == 0) norm2_rows<4>(ws, outp, nd, li, 0, sbase, (char*)lds, wv); else norm2_rows<5>(ws, outp, nd, li, 0, sbase, (char*)lds, wv); SEAM(base + 0); }
            if (IN(base + 1)) REP(3) { PH_BEGIN SchedS5 S; S.init(ws + WS_R1 + R1_UH, wb + WB_W1 + (size_t)j * 64 * 256 * 256 * 2, 256); EpiS5a E{(float*)(ws + WS_R1 + R1_S)};
                g8::gemm_phase<EpiS5a, SchedS5>(ldsl, 256, S, E, wv); SEAM(base + 1); }
            if (IN(base + 2)) REP(3) { PH_BEGIN s5_scan_phase(ws, j, wv); SEAM(base + 2); }
            if (IN(base + 3)) REP(3) { PH_BEGIN SchedS5 S; S.init(ws + WS_R1 + R1_UH, wb + WB_W2 + (size_t)j * 64 * 256 * 512 * 2, 512); EpiS5b E{(u16*)(ws + WS_ZO), (const u16*)(ws + WS_R1 + R1_UH), sm + SM_S5D + j * 1024};
                g8::gemm_phase<EpiS5b, SchedS5>(ldsl, 512, S, E, wv); SEAM(base + 3); }
            if (IN(base + 4)) REP(4) { PH_BEGIN SchedDense S; S.init(ws + WS_ZO, 1024, wb + WB_GLU + (size_t)j * 2048 * 1024 * 2, T, 2048, 1024); EpiGlu E{(u16*)(ws + WS_HX), mod, li};
                g8::gemm_phase<EpiGlu, SchedDense>(ldsl, 1024, S, E, wv); SEAM(base + 4); }
        } else {
            if (IN(base + 0)) REP(1) { PH_BEGIN const NormDst nd = NDST(li, 1); norm2_rows<3>(ws, outp, nd, li, 0, sbase, (char*)lds, wv); SEAM(base + 0); }
            if (IN(base + 1)) REP(5) { PH_BEGIN SchedDense S; S.init(ws + WS_HX, 1024, wb + WB_WIN + (size_t)j * 768 * 1024 * 2, T, 768, 1024); EpiF32 E{(float*)(ws + WS_YB), 768};
                g8::gemm_phase<EpiF32, SchedDense>(ldsl, 1024, S, E, wv); SEAM(base + 1); }
            if (IN(base + 2)) REP(5) { PH_BEGIN mla_post_rows(ws, j, (const float*)(ws + WS_YB), 768, 8, wv); SEAM(base + 2); }
            if (IN(base + 3)) REP(5) { PH_BEGIN
                { SchedDense S; S.init(ws + WS_CQ, QR, wb + WB_UQ + (size_t)j * 1536 * 384 * 2, T, 1536, 384); EpiQ E{(u16*)(ws + WS_R1 + R1_QT), (const float2*)(ws + WS_ROPE)};
                  g8::gemm_phase<EpiQ, SchedDense>(ldsl, 384, S, E, wv); }
                { SchedDense S; S.init(ws + WS_CKV, KVR, wb + WB_UKV + (size_t)j * 2048 * 256 * 2, T, 2048, 256); EpiKV E{(u16*)(ws + WS_R1 + R1_KT), (u16*)(ws + WS_R1 + R1_VT)};
                  int kk_ = 256; asm volatile("" : "+s"(kk_)); g8::gemm_phase<EpiKV, SchedDense>(ldsl, kk_, S, E, wv); }
                SEAM(base + 3); }
            if (IN(base + 4)) REP(6) { PH_BEGIN attn_phase(ws, li != 3, (char*)lds, wv); SEAM(base + 4); }
            if (IN(base + 5)) REP(10) { PH_BEGIN SchedDense S; S.init(ws + WS_ZO, 1024, wb + WB_WO + (size_t)j * 1024 * 1024 * 2, T, 1024, 1024); EpiWo E{(u16*)(ws + WS_HX), mod, li};
                g8::gemm_phase<EpiWo, SchedDense>(ldsl, 1024, S, E, wv); SEAM(base + 5); }
        }
        if (IN(base + 6)) REP(2) { PH_BEGIN const NormDst nd = NDST(li, 2); norm2_rows<42>(ws, outp, nd, li, 1, sbase, (char*)lds, wv); SEAM(base + 6); }
        if (IN(base + 7) || IN(base + 8)) {
            const unsigned* cnt = (const unsigned*)(ws0 + WS_CTL) + CW_CNT + li * 32 * CS;
            __syncthreads();
            if (tid_opaque(wv) == 0) { int acc = 0; for (int e = 0; e < 32; ++e) { sbase[e] = acc; acc += (int)((cnt[e * CS] + 255u) / 256u); } sbase[32] = acc; }
            __syncthreads();
            if (IN(base + 7)) REP(7) { PH_BEGIN SchedMoe<true> S; S.init(ws + WS_HX, wb + WB_GU + (size_t)li * 32 * 1024 * 1024 * 2, 1024, sbase, cnt, (const int*)(ws + WS_LIST)); EpiMoe1 E{(u16*)(ws + WS_R1 + R1_ACT)};
                g8::gemm_phase<EpiMoe1, SchedMoe<true>>(ldsl, 1024, S, E, wv); SEAM(base + 7); }
            if (IN(base + 8)) REP(8) { PH_BEGIN SchedMoe<false> S; S.init(ws + WS_R1 + R1_ACT, wb + WB_DN + (size_t)li * 32 * 1024 * 512 * 2, 512, sbase, cnt, (const int*)(ws + WS_LIST)); EpiMoe2 E{(u16*)(ws + WS_YB)};
                g8::gemm_phase<EpiMoe2, SchedMoe<false>>(ldsl, 512, S, E, wv); SEAM(base + 8); }
        }
    }

    {
        constexpr int li = 1; constexpr int base = 1 + li * 10, j = li >> 1;
#define PH_BEGIN size_t zoff_ = 0; asm volatile("" : "+s"(zoff_)); unsigned char* ws = ws0 + zoff_; unsigned char* wb = ws + WS_WB; const float* sm = (const float*)(ws + WS_SMALL); float* X = (float*)(ws + WS_X); const float* mod = (const float*)(ws + WS_MOD); (void)wb; (void)sm; (void)X; (void)mod;
        if ((li & 1) == 0) {
            if (IN(base + 0)) REP(1) { PH_BEGIN const NormDst nd = NDST(li, 1); if (li == 0) norm2_rows<4>(ws, outp, nd, li, 0, sbase, (char*)lds, wv); else norm2_rows<5>(ws, outp, nd, li, 0, sbase, (char*)lds, wv); SEAM(base + 0); }
            if (IN(base + 1)) REP(3) { PH_BEGIN SchedS5 S; S.init(ws + WS_R1 + R1_UH, wb + WB_W1 + (size_t)j * 64 * 256 * 256 * 2, 256); EpiS5a E{(float*)(ws + WS_R1 + R1_S)};
                g8::gemm_phase<EpiS5a, SchedS5>(ldsl, 256, S, E, wv); SEAM(base + 1); }
            if (IN(base + 2)) REP(3) { PH_BEGIN s5_scan_phase(ws, j, wv); SEAM(base + 2); }
            if (IN(base + 3)) REP(3) { PH_BEGIN SchedS5 S; S.init(ws + WS_R1 + R1_UH, wb + WB_W2 + (size_t)j * 64 * 256 * 512 * 2, 512); EpiS5b E{(u16*)(ws + WS_ZO), (const u16*)(ws + WS_R1 + R1_UH), sm + SM_S5D + j * 1024};
                g8::gemm_phase<EpiS5b, SchedS5>(ldsl, 512, S, E, wv); SEAM(base + 3); }
            if (IN(base + 4)) REP(4) { PH_BEGIN SchedDense S; S.init(ws + WS_ZO, 1024, wb + WB_GLU + (size_t)j * 2048 * 1024 * 2, T, 2048, 1024); EpiGlu E{(u16*)(ws + WS_HX), mod, li};
                g8::gemm_phase<EpiGlu, SchedDense>(ldsl, 1024, S, E, wv); SEAM(base + 4); }
        } else {
            if (IN(base + 0)) REP(1) { PH_BEGIN const NormDst nd = NDST(li, 1); norm2_rows<3>(ws, outp, nd, li, 0, sbase, (char*)lds, wv); SEAM(base + 0); }
            if (IN(base + 1)) REP(5) { PH_BEGIN SchedDense S; S.init(ws + WS_HX, 1024, wb + WB_WIN + (size_t)j * 768 * 1024 * 2, T, 768, 1024); EpiF32 E{(float*)(ws + WS_YB), 768};
                g8::gemm_phase<EpiF32, SchedDense>(ldsl, 1024, S, E, wv); SEAM(base + 1); }
            if (IN(base + 2)) REP(5) { PH_BEGIN mla_post_rows(ws, j, (const float*)(ws + WS_YB), 768, 8, wv); SEAM(base + 2); }
            if (IN(base + 3)) REP(5) { PH_BEGIN
                { SchedDense S; S.init(ws + WS_CQ, QR, wb + WB_UQ + (size_t)j * 1536 * 384 * 2, T, 1536, 384); EpiQ E{(u16*)(ws + WS_R1 + R1_QT), (const float2*)(ws + WS_ROPE)};
                  g8::gemm_phase<EpiQ, SchedDense>(ldsl, 384, S, E, wv); }
                { SchedDense S; S.init(ws + WS_CKV, KVR, wb + WB_UKV + (size_t)j * 2048 * 256 * 2, T, 2048, 256); EpiKV E{(u16*)(ws + WS_R1 + R1_KT), (u16*)(ws + WS_R1 + R1_VT)};
                  int kk_ = 256; asm volatile("" : "+s"(kk_)); g8::gemm_phase<EpiKV, SchedDense>(ldsl, kk_, S, E, wv); }
                SEAM(base + 3); }
            if (IN(base + 4)) REP(6) { PH_BEGIN attn_phase(ws, li != 3, (char*)lds, wv); SEAM(base + 4); }
            if (IN(base + 5)) REP(10) { PH_BEGIN SchedDense S; S.init(ws + WS_ZO, 1024, wb + WB_WO + (size_t)j * 1024 * 1024 * 2, T, 1024, 1024); EpiWo E{(u16*)(ws + WS_HX), mod, li};
                g8::gemm_phase<EpiWo, SchedDense>(ldsl, 1024, S, E, wv); SEAM(base + 5); }
        }
        if (IN(base + 6)) REP(2) { PH_BEGIN const NormDst nd = NDST(li, 2); norm2_rows<42>(ws, outp, nd, li, 1, sbase, (char*)lds, wv); SEAM(base + 6); }
        if (IN(base + 7) || IN(base + 8)) {
            const unsigned* cnt = (const unsigned*)(ws0 + WS_CTL) + CW_CNT + li * 32 * CS;
            __syncthreads();
            if (tid_opaque(wv) == 0) { int acc = 0; for (int e = 0; e < 32; ++e) { sbase[e] = acc; acc += (int)((cnt[e * CS] + 255u) / 256u); } sbase[32] = acc; }
            __syncthreads();
            if (IN(base + 7)) REP(7) { PH_BEGIN SchedMoe<true> S; S.init(ws + WS_HX, wb + WB_GU + (size_t)li * 32 * 1024 * 1024 * 2, 1024, sbase, cnt, (const int*)(ws + WS_LIST)); EpiMoe1 E{(u16*)(ws + WS_R1 + R1_ACT)};
                g8::gemm_phase<EpiMoe1, SchedMoe<true>>(ldsl, 1024, S, E, wv); SEAM(base + 7); }
            if (IN(base + 8)) REP(8) { PH_BEGIN SchedMoe<false> S; S.init(ws + WS_R1 + R1_ACT, wb + WB_DN + (size_t)li * 32 * 1024 * 512 * 2, 512, sbase, cnt, (const int*)(ws + WS_LIST)); EpiMoe2 E{(u16*)(ws + WS_YB)};
                g8::gemm_phase<EpiMoe2, SchedMoe<false>>(ldsl, 512, S, E, wv); SEAM(base + 8); }
        }
    }

    {
        constexpr int li = 2; constexpr int base = 1 + li * 10, j = li >> 1;
#define PH_BEGIN size_t zoff_ = 0; asm volatile("" : "+s"(zoff_)); unsigned char* ws = ws0 + zoff_; unsigned char* wb = ws + WS_WB; const float* sm = (const float*)(ws + WS_SMALL); float* X = (float*)(ws + WS_X); const float* mod = (const float*)(ws + WS_MOD); (void)wb; (void)sm; (void)X; (void)mod;
        if ((li & 1) == 0) {
            if (IN(base + 0)) REP(1) { PH_BEGIN const NormDst nd = NDST(li, 1); if (li == 0) norm2_rows<4>(ws, outp, nd, li, 0, sbase, (char*)lds, wv); else norm2_rows<5>(ws, outp, nd, li, 0, sbase, (char*)lds, wv); SEAM(base + 0); }
            if (IN(base + 1)) REP(3) { PH_BEGIN SchedS5 S; S.init(ws + WS_R1 + R1_UH, wb + WB_W1 + (size_t)j * 64 * 256 * 256 * 2, 256); EpiS5a E{(float*)(ws + WS_R1 + R1_S)};
                g8::gemm_phase<EpiS5a, SchedS5>(ldsl, 256, S, E, wv); SEAM(base + 1); }
            if (IN(base + 2)) REP(3) { PH_BEGIN s5_scan_phase(ws, j, wv); SEAM(base + 2); }
            if (IN(base + 3)) REP(3) { PH_BEGIN SchedS5 S; S.init(ws + WS_R1 + R1_UH, wb + WB_W2 + (size_t)j * 64 * 256 * 512 * 2, 512); EpiS5b E{(u16*)(ws + WS_ZO), (const u16*)(ws + WS_R1 + R1_UH), sm + SM_S5D + j * 1024};
                g8::gemm_phase<EpiS5b, SchedS5>(ldsl, 512, S, E, wv); SEAM(base + 3); }
            if (IN(base + 4)) REP(4) { PH_BEGIN SchedDense S; S.init(ws + WS_ZO, 1024, wb + WB_GLU + (size_t)j * 2048 * 1024 * 2, T, 2048, 1024); EpiGlu E{(u16*)(ws + WS_HX), mod, li};
                g8::gemm_phase<EpiGlu, SchedDense>(ldsl, 1024, S, E, wv); SEAM(base + 4); }
        } else {
            if (IN(base + 0)) REP(1) { PH_BEGIN const NormDst nd = NDST(li, 1); norm2_rows<3>(ws, outp, nd, li, 0, sbase, (char*)lds, wv); SEAM(base + 0); }
            if (IN(base + 1)) REP(5) { PH_BEGIN SchedDense S; S.init(ws + WS_HX, 1024, wb + WB_WIN + (size_t)j * 768 * 1024 * 2, T, 768, 1024); EpiF32 E{(float*)(ws + WS_YB), 768};
                g8::gemm_phase<EpiF32, SchedDense>(ldsl, 1024, S, E, wv); SEAM(base + 1); }
            if (IN(base + 2)) REP(5) { PH_BEGIN mla_post_rows(ws, j, (const float*)(ws + WS_YB), 768, 8, wv); SEAM(base + 2); }
            if (IN(base + 3)) REP(5) { PH_BEGIN
                { SchedDense S; S.init(ws + WS_CQ, QR, wb + WB_UQ + (size_t)j * 1536 * 384 * 2, T, 1536, 384); EpiQ E{(u16*)(ws + WS_R1 + R1_QT), (const float2*)(ws + WS_ROPE)};
                  g8::gemm_phase<EpiQ, SchedDense>(ldsl, 384, S, E, wv); }
                { SchedDense S; S.init(ws + WS_CKV, KVR, wb + WB_UKV + (size_t)j * 2048 * 256 * 2, T, 2048, 256); EpiKV E{(u16*)(ws + WS_R1 + R1_KT), (u16*)(ws + WS_R1 + R1_VT)};
                  int kk_ = 256; asm volatile("" : "+s"(kk_)); g8::gemm_phase<EpiKV, SchedDense>(ldsl, kk_, S, E, wv); }
                SEAM(base + 3); }
            if (IN(base + 4)) REP(6) { PH_BEGIN attn_phase(ws, li != 3, (char*)lds, wv); SEAM(base + 4); }
            if (IN(base + 5)) REP(10) { PH_BEGIN SchedDense S; S.init(ws + WS_ZO, 1024, wb + WB_WO + (size_t)j * 1024 * 1024 * 2, T, 1024, 1024); EpiWo E{(u16*)(ws + WS_HX), mod, li};
                g8::gemm_phase<EpiWo, SchedDense>(ldsl, 1024, S, E, wv); SEAM(base + 5); }
        }
        if (IN(base + 6)) REP(2) { PH_BEGIN const NormDst nd = NDST(li, 2); norm2_rows<42>(ws, outp, nd, li, 1, sbase, (char*)lds, wv); SEAM(base + 6); }
        if (IN(base + 7) || IN(base + 8)) {
            const unsigned* cnt = (const unsigned*)(ws0 + WS_CTL) + CW_CNT + li * 32 * CS;
            __syncthreads();
            if (tid_opaque(wv) == 0) { int acc = 0; for (int e = 0; e < 32; ++e) { sbase[e] = acc; acc += (int)((cnt[e * CS] + 255u) / 256u); } sbase[32] = acc; }
            __syncthreads();
            if (IN(base + 7)) REP(7) { PH_BEGIN SchedMoe<true> S; S.init(ws + WS_HX, wb + WB_GU + (size_t)li * 32 * 1024 * 1024 * 2, 1024, sbase, cnt, (const int*)(ws + WS_LIST)); EpiMoe1 E{(u16*)(ws + WS_R1 + R1_ACT)};
                g8::gemm_phase<EpiMoe1, SchedMoe<true>>(ldsl, 1024, S, E, wv); SEAM(base + 7); }
            if (IN(base + 8)) REP(8) { PH_BEGIN SchedMoe<false> S; S.init(ws + WS_R1 + R1_ACT, wb + WB_DN + (size_t)li * 32 * 1024 * 512 * 2, 512, sbase, cnt, (const int*)(ws + WS_LIST)); EpiMoe2 E{(u16*)(ws + WS_YB)};
                g8::gemm_phase<EpiMoe2, SchedMoe<false>>(ldsl, 512, S, E, wv); SEAM(base + 8); }
        }
    }

    {
        constexpr int li = 3; constexpr int base = 1 + li * 10, j = li >> 1;
#define PH_BEGIN size_t zoff_ = 0; asm volatile("" : "+s"(zoff_)); unsigned char* ws = ws0 + zoff_; unsigned char* wb = ws + WS_WB; const float* sm = (const float*)(ws + WS_SMALL); float* X = (float*)(ws + WS_X); const float* mod = (const float*)(ws + WS_MOD); (void)wb; (void)sm; (void)X; (void)mod;
        if ((li & 1) == 0) {
            if (IN(base + 0)) REP(1) { PH_BEGIN const NormDst nd = NDST(li, 1); if (li == 0) norm2_rows<4>(ws, outp, nd, li, 0, sbase, (char*)lds, wv); else norm2_rows<5>(ws, outp, nd, li, 0, sbase, (char*)lds, wv); SEAM(base + 0); }
            if (IN(base + 1)) REP(3) { PH_BEGIN SchedS5 S; S.init(ws + WS_R1 + R1_UH, wb + WB_W1 + (size_t)j * 64 * 256 * 256 * 2, 256); EpiS5a E{(float*)(ws + WS_R1 + R1_S)};
                g8::gemm_phase<EpiS5a, SchedS5>(ldsl, 256, S, E, wv); SEAM(base + 1); }
            if (IN(base + 2)) REP(3) { PH_BEGIN s5_scan_phase(ws, j, wv); SEAM(base + 2); }
            if (IN(base + 3)) REP(3) { PH_BEGIN SchedS5 S; S.init(ws + WS_R1 + R1_UH, wb + WB_W2 + (size_t)j * 64 * 256 * 512 * 2, 512); EpiS5b E{(u16*)(ws + WS_ZO), (const u16*)(ws + WS_R1 + R1_UH), sm + SM_S5D + j * 1024};
                g8::gemm_phase<EpiS5b, SchedS5>(ldsl, 512, S, E, wv); SEAM(base + 3); }
            if (IN(base + 4)) REP(4) { PH_BEGIN SchedDense S; S.init(ws + WS_ZO, 1024, wb + WB_GLU + (size_t)j * 2048 * 1024 * 2, T, 2048, 1024); EpiGlu E{(u16*)(ws + WS_HX), mod, li};
                g8::gemm_phase<EpiGlu, SchedDense>(ldsl, 1024, S, E, wv); SEAM(base + 4); }
        } else {
            if (IN(base + 0)) REP(1) { PH_BEGIN const NormDst nd = NDST(li, 1); norm2_rows<3>(ws, outp, nd, li, 0, sbase, (char*)lds, wv); SEAM(base + 0); }
            if (IN(base + 1)) REP(5) { PH_BEGIN SchedDense S; S.init(ws + WS_HX, 1024, wb + WB_WIN + (size_t)j * 768 * 1024 * 2, T, 768, 1024); EpiF32 E{(float*)(ws + WS_YB), 768};
                g8::gemm_phase<EpiF32, SchedDense>(ldsl, 1024, S, E, wv); SEAM(base + 1); }
            if (IN(base + 2)) REP(5) { PH_BEGIN mla_post_rows(ws, j, (const float*)(ws + WS_YB), 768, 8, wv); SEAM(base + 2); }
            if (IN(base + 3)) REP(5) { PH_BEGIN
                { SchedDense S; S.init(ws + WS_CQ, QR, wb + WB_UQ + (size_t)j * 1536 * 384 * 2, T, 1536, 384); EpiQ E{(u16*)(ws + WS_R1 + R1_QT), (const float2*)(ws + WS_ROPE)};
                  g8::gemm_phase<EpiQ, SchedDense>(ldsl, 384, S, E, wv); }
                { SchedDense S; S.init(ws + WS_CKV, KVR, wb + WB_UKV + (size_t)j * 2048 * 256 * 2, T, 2048, 256); EpiKV E{(u16*)(ws + WS_R1 + R1_KT), (u16*)(ws + WS_R1 + R1_VT)};
                  int kk_ = 256; asm volatile("" : "+s"(kk_)); g8::gemm_phase<EpiKV, SchedDense>(ldsl, kk_, S, E, wv); }
                SEAM(base + 3); }
            if (IN(base + 4)) REP(6) { PH_BEGIN attn_phase(ws, li != 3, (char*)lds, wv); SEAM(base + 4); }
            if (IN(base + 5)) REP(10) { PH_BEGIN SchedDense S; S.init(ws + WS_ZO, 1024, wb + WB_WO + (size_t)j * 1024 * 1024 * 2, T, 1024, 1024); EpiWo E{(u16*)(ws + WS_HX), mod, li};
                g8::gemm_phase<EpiWo, SchedDense>(ldsl, 1024, S, E, wv); SEAM(base + 5); }
        }
        if (IN(base + 6)) REP(2) { PH_BEGIN const NormDst nd = NDST(li, 2); norm2_rows<42>(ws, outp, nd, li, 1, sbase, (char*)lds, wv); SEAM(base + 6); }
        if (IN(base + 7) || IN(base + 8)) {
            const unsigned* cnt = (const unsigned*)(ws0 + WS_CTL) + CW_CNT + li * 32 * CS;
            __syncthreads();
            if (tid_opaque(wv) == 0) { int acc = 0; for (int e = 0; e < 32; ++e) { sbase[e] = acc; acc += (int)((cnt[e * CS] + 255u) / 256u); } sbase[32] = acc; }
            __syncthreads();
            if (IN(base + 7)) REP(7) { PH_BEGIN SchedMoe<true> S; S.init(ws + WS_HX, wb + WB_GU + (size_t)li * 32 * 1024 * 1024 * 2, 1024, sbase, cnt, (const int*)(ws + WS_LIST)); EpiMoe1 E{(u16*)(ws + WS_R1 + R1_ACT)};
                g8::gemm_phase<EpiMoe1, SchedMoe<true>>(ldsl, 1024, S, E, wv); SEAM(base + 7); }
            if (IN(base + 8)) REP(8) { PH_BEGIN SchedMoe<false> S; S.init(ws + WS_R1 + R1_ACT, wb + WB_DN + (size_t)li * 32 * 1024 * 512 * 2, 512, sbase, cnt, (const int*)(ws + WS_LIST)); EpiMoe2 E{(u16*)(ws + WS_YB)};
                g8::gemm_phase<EpiMoe2, SchedMoe<false>>(ldsl, 512, S, E, wv); SEAM(base + 8); }
        }
    }

#if defined(PROBE_A)
    if (IN(41)) { xcd_barrier(bar, tid_opaque(wv));
        if (tid_opaque(wv) == 0) { const unsigned long long* ts = (const unsigned long long*)(ws0 + WS_CTL) + CW_STAMP64; unsigned long long last = ts[0], sa = 0, sb = 0;
            for (int p = 0; p <= 40; ++p) { const unsigned long long e = ts[p + 1]; if (e == 0) continue; const unsigned long long d = e - last; last = e;
                int grp; if (p == 0) grp = 0; else { const int k = (p - 1) % 10, l = (p - 1) / 10; const bool s5 = (l & 1) == 0;
                    grp = k == 0 ? 1 : k == 6 ? 2 : k == 7 ? 7 : k == 8 ? 8 : s5 ? (k == 4 ? 4 : 3) : (k == 4 ? 6 : 5); }
                if (grp == PROBE_A) sa += d; if (grp == PROBE_B) sb += d; }
            ((float*)sbase)[40] = (float)sa * 1e-5f; ((float*)sbase)[41] = 2.f + (float)sb * (1.f / 2000.f); }
        __syncthreads(); }
#endif
    if (IN(41)) { const NormDst nd = norm_dst_real(ws0, 0); norm2_rows<17>(ws0, outp, nd, 4, 0, sbase, (char*)lds, wv); }
#undef PH_BEGIN
#undef IN
#undef SEAM
}
__global__ __launch_bounds__(256) void n_post_win(Ptrs P, int j) { mla_post_rows(P.ws, j, (const float*)(P.ws + WS_YB), 768, 4, __builtin_amdgcn_readfirstlane(threadIdx.x >> 6)); }
static void gemm_naive(hipStream_t st, const void* A, int lda, const int* rowidx, const float* B, int ldb, long bstride, const int* tileexp, const int* mdyn, float* C, int ldc, int M, int N, int K) {
    NG g{}; g.A = A; g.lda = lda; g.rowidx = rowidx; g.B = B; g.ldb = ldb; g.bstride = bstride; g.tileexp = tileexp; g.mdyn = mdyn; g.C = C; g.ldc = ldc; g.M = M; g.N = N; g.K = K; g.pad = 0;
    hipLaunchKernelGGL(n_gemm<1>, dim3(N / 64, (M + 63) / 64), dim3(256), 0, st, g);
}
#ifndef REALMASK_STR
#define REALMASK_STR "111111111111111111111111111111111111111111"
#endif
extern "C" void kernel_launch(void* const* d_in, const int* in_sizes, int n_in, void* d_out, int out_size, void* d_ws, size_t ws_size, hipStream_t stream) {
    static int grid = 0;
    static const char* realmask = REALMASK_STR;
    if (grid == 0) {
        if (n_in != 30 || out_size != NB * SEQ * D || ws_size < WS_NEND) { fprintf(stderr, "kernel_launch: unexpected shapes n_in %d out %d ws %zu (need %zu)\n", n_in, out_size, ws_size, (size_t)WS_NEND); grid = -1; return; }
        int dev = 0, cus = 0, per_cu = 0;
        if (hipGetDevice(&dev) != hipSuccess || hipDeviceGetAttribute(&cus, hipDeviceAttributeMultiprocessorCount, dev) != hipSuccess) { grid = -1; return; }
        if (hipFuncSetAttribute((const void*)mk, hipFuncAttributeMaxDynamicSharedMemorySize, LDS_BYTES) != hipSuccess) { fprintf(stderr, "kernel_launch: hipFuncSetAttribute failed\n"); grid = -1; return; }
        if (hipOccupancyMaxActiveBlocksPerMultiprocessor(&per_cu, (const void*)mk, 512, LDS_BYTES) != hipSuccess || per_cu < 1) { fprintf(stderr, "kernel_launch: occupancy query says %d\n", per_cu); }
        (void)hipGetLastError();
        grid = cus;
    }
    if (grid < 0) return;
    Ptrs P{}; for (int i = 0; i < 30; ++i) P.in[i] = (const float*)d_in[i]; P.out = (float*)d_out; P.ws = (unsigned char*)d_ws;
    unsigned char* ws = P.ws;
    (void)hipMemsetAsync(ws + WS_CTL, 0, ZERO_BYTES, stream);
    int nreg = 0;
    auto real = [&](int p) { return realmask[p] == '1'; };
    auto run_mk = [&](int lo, int hi) { MkArgs a{}; a.P = P; a.lo = lo; a.hi = hi; a.bar_region = (hi - lo > 1) ? nreg++ : 0; a.pad = 0; hipLaunchKernelGGL(mk, dim3(grid), dim3(512), LDS_BYTES, stream, a); };
    const int NG_ = 4096; float* NTMP = (float*)(ws + WS_NTMP);
    int p = 0;
    while (p < NPHASE) {
        if (real(p)) { int q = p; while (q < NPHASE && real(q)) ++q; run_mk(p, q); p = q; continue; }
        if (p == 0) { hipLaunchKernelGGL(k_mod, dim3(24, 4), dim3(256), 0, stream, P); hipLaunchKernelGGL(k_init, dim3(2048), dim3(256), 0, stream, P); }
        else if (p == 41) hipLaunchKernelGGL(k_norm<17>, dim3(2048), dim3(256), 0, stream, P, 4, 0);
        else {
            const int li = (p - 1) / 10, k = (p - 1) % 10, j = li >> 1; const bool s5 = (li & 1) == 0;
            if (k == 0) { if (li == 0) hipLaunchKernelGGL(k_norm<2>, dim3(2048), dim3(256), 0, stream, P, li, 0); else hipLaunchKernelGGL(k_norm<3>, dim3(2048), dim3(256), 0, stream, P, li, 0); }
            else if (s5 && k == 1) { hipLaunchKernelGGL(n_s5, dim3(NB * SG), dim3(128), 0, stream, P, j); }
            else if (s5 && k == 3) { hipLaunchKernelGGL(n_post_s5, dim3(NG_), dim3(256), 0, stream, P, j); }
            else if (s5 && k == 4) { gemm_naive(stream, ws + WS_ZO, D, nullptr, P.in[16] + (size_t)j * 1024 * 2048, 2048, 0, nullptr, nullptr, NTMP, 2048, T, 2048, 1024); hipLaunchKernelGGL(n_post_glu, dim3(NG_), dim3(256), 0, stream, P, li); }
            else if (!s5 && k == 1) { gemm_naive(stream, ws + WS_HX, D, nullptr, P.in[17] + (size_t)j * 1024 * 704, 704, 0, nullptr, nullptr, (float*)(ws + WS_YB), 768, T, 704, 1024); }
            else if (!s5 && k == 2) { hipLaunchKernelGGL(n_post_win, dim3(2048), dim3(256), 0, stream, P, j); }
            else if (!s5 && k == 3) {
                gemm_naive(stream, ws + WS_CQ, QR, nullptr, P.in[20] + (size_t)j * 384 * 1536, 1536, 0, nullptr, nullptr, NTMP, 1536, T, 1536, 384); hipLaunchKernelGGL(n_post_q, dim3(NG_), dim3(256), 0, stream, P);
                gemm_naive(stream, ws + WS_CKV, KVR, nullptr, P.in[21] + (size_t)j * 256 * 2048, 2048, 0, nullptr, nullptr, NTMP, 2048, T, 2048, 256); hipLaunchKernelGGL(n_post_kv, dim3(NG_), dim3(256), 0, stream, P); }
            else if (!s5 && k == 4) { hipLaunchKernelGGL(n_attn, dim3(LTOT / 64, NH, NB), dim3(256), 0, stream, P); }
            else if (!s5 && k == 5) { gemm_naive(stream, ws + WS_ZO, D, nullptr, P.in[22] + (size_t)j * 1024 * 1024, 1024, 0, nullptr, nullptr, NTMP, 1024, T, 1024, 1024); hipLaunchKernelGGL(n_post_wo, dim3(NG_), dim3(256), 0, stream, P, li); }
            else if (k == 6) { hipLaunchKernelGGL(k_norm<10>, dim3(2048), dim3(256), 0, stream, P, li, 1); }
            else if (k == 7 || k == 8) {
                const int* tileexp = (const int*)(ws + WS_TILEEXP);
                hipLaunchKernelGGL(n_build, dim3(1), dim3(256), 0, stream, P, li);
                if (k == 7) { gemm_naive(stream, ws + WS_HX, D, (const int*)(ws + WS_SLOTROW), P.in[27] + (size_t)li * 32 * 1024 * 1024, 1024, 1024L * 1024, tileexp, tileexp + 512, NTMP, 1024, MAXSLOT, 1024, 1024);
                    hipLaunchKernelGGL(n_post_act2, dim3(NG_), dim3(256), 0, stream, P, (u16*)(ws + WS_R1 + R1_ACT)); }
                else { gemm_naive(stream, ws + WS_R1 + R1_ACT, 512, nullptr, P.in[28] + (size_t)li * 32 * 512 * 1024, 1024, 512L * 1024, tileexp, tileexp + 512, NTMP, 1024, MAXSLOT, 1024, 512);
                    hipLaunchKernelGGL(n_post_y, dim3(NG_), dim3(256), 0, stream, P); }
            }
        }
        ++p;
    }
}
```

```cpp
#define MK_FULL 1
#include <hip/hip_runtime.h>
#include <cstdio>
#include <cstdint>

typedef unsigned short u16;
typedef unsigned short bf16_t;

constexpr int D = 1024, NB = 16, SEQ = 2048, CTXL = 256, LTOT = 2304, T = NB * LTOT;
constexpr int SG = 64, SP = 64, SC = 16;
constexpr int QR = 384, KVR = 256, NH = 8, QKD = 192;
constexpr int NE = 32;
constexpr int MAXSLOT = 81920;
constexpr float EPS = 1e-6f;

constexpr size_t al256(size_t x) { return (x + 255) / 256 * 256; }
constexpr size_t WS_CTL = 0;
constexpr size_t CTL_BYTES = 131072;
constexpr size_t WS_MOD = WS_CTL + CTL_BYTES;
constexpr size_t MOD_BYTES = al256((size_t)4 * 17 * 6144 * 4);
constexpr size_t ZERO_BYTES = CTL_BYTES;
constexpr size_t WS_ROPE = WS_MOD + MOD_BYTES;
constexpr size_t WS_SMALL = WS_ROPE + al256((size_t)2048 * 32 * 8);
constexpr int SM_GMIX = 0, SM_GFFN = 4096, SM_S5D = 8192, SM_GQ = 10240, SM_GKV = 11008, SM_FINALG = 11520, SM_BGROUP = 12544, SM_BEXP = 12560, SM_WGROUP = 12800, SM_WEXP = 29184, SM_END = 160256;
constexpr size_t WS_X = WS_SMALL + al256((size_t)SM_END * 4);
constexpr size_t WS_HX = WS_X + (size_t)T * D * 4;
constexpr size_t WS_ZO = WS_HX + (size_t)T * D * 2;
constexpr size_t WS_CQ = WS_ZO + (size_t)T * D * 2;
constexpr size_t WS_CKV = WS_CQ + (size_t)T * QR * 2;
constexpr size_t WS_SELI = WS_CKV + (size_t)T * KVR * 2;
constexpr size_t WS_SELW = WS_SELI + (size_t)T * 16;
constexpr size_t WS_LIST = WS_SELW + (size_t)T * 8;
constexpr size_t WS_SLOTROW = WS_LIST + (size_t)NE * T * 4;
constexpr size_t WS_TILEEXP = WS_SLOTROW + (size_t)MAXSLOT * 4;
constexpr size_t WS_R1 = WS_TILEEXP + 4096;
constexpr size_t R1_BYTES = (size_t)MAXSLOT * 1024 * 4;
constexpr size_t WS_YB = WS_R1 + R1_BYTES;
constexpr size_t WS_WB = WS_YB + (size_t)MAXSLOT * 1024 * 2;
constexpr size_t R1_QT = 0;
constexpr size_t R1_KT = R1_QT + (size_t)NB * NH * LTOT * QKD * 2;
constexpr size_t R1_VT = R1_KT + (size_t)NB * NH * LTOT * QKD * 2;
constexpr size_t R1_ACT = 0;
constexpr size_t R1_S = 0;
constexpr size_t R1_UH = (size_t)64 * 2304 * 256 * 4;
constexpr size_t WB_GLU = 0;
constexpr size_t WB_WIN = WB_GLU + (size_t)2 * 2048 * 1024 * 2;
constexpr size_t WB_UQ = WB_WIN + (size_t)2 * 768 * 1024 * 2;
constexpr size_t WB_UKV = WB_UQ + (size_t)2 * 1536 * 384 * 2;
constexpr size_t WB_WO = WB_UKV + (size_t)2 * 2048 * 256 * 2;
constexpr size_t WB_GU = WB_WO + (size_t)2 * 1024 * 1024 * 2;
constexpr size_t WB_DN = WB_GU + (size_t)128 * 1024 * 1024 * 2;
constexpr size_t WB_W1 = WB_DN + (size_t)128 * 1024 * 512 * 2;
constexpr size_t WB_W2 = WB_W1 + (size_t)128 * 256 * 256 * 2;
constexpr size_t WB_AT = WB_W2 + (size_t)128 * 256 * 512 * 2;
constexpr size_t WB_END = WB_AT + (size_t)2 * 2 * 64 * 64 * 8;
constexpr size_t WS_END = WS_WB + WB_END;
constexpr size_t WS_NTMP = al256(WS_END);
constexpr size_t WS_NEND = WS_NTMP + (size_t)MAXSLOT * 1024 * 4;
static_assert(R1_UH + (size_t)64 * 2304 * 512 * 2 <= R1_BYTES, "R1");
static_assert(R1_VT + (size_t)NB * NH * LTOT * 128 * 2 <= R1_BYTES, "R1");
constexpr int CS = 64;
constexpr int CW_CNT = 8192;
constexpr int CW_QUEUE = 7168;
constexpr int CW_CNT_DUMMY = 16384;
constexpr int CW_STAMP64 = 12288;

__device__ __forceinline__ float bf2f(u16 v) { return __uint_as_float(((unsigned)v) << 16); }
__device__ __forceinline__ u16 f2bf(float f) { unsigned u = __float_as_uint(f); u += 0x7FFFu + ((u >> 16) & 1u); return (u16)(u >> 16); }
__device__ __forceinline__ float silu_f(float x) { return x / (1.f + __expf(-x)); }
__device__ __forceinline__ float sigmoid_f(float x) { return 1.f / (1.f + __expf(-x)); }
__device__ __forceinline__ float gelu_tanh(float x) { const float u = 0.7978845608028654f * (x + 0.044715f * x * x * x); const float e = __expf(2.f * u); const float t = 1.f - 2.f / (e + 1.f); return 0.5f * x * (1.f + t); }
__device__ __forceinline__ float wave_sum(float v) {
#pragma unroll
    for (int o = 32; o > 0; o >>= 1) v += __shfl_xor(v, o);
    return v;
}

struct Ptrs { const float* in[30]; float* out; unsigned char* ws; };
__device__ __forceinline__ int tid_opaque(int wv) { int l; asm volatile("v_mbcnt_lo_u32_b32 %0, -1, 0\n\tv_mbcnt_hi_u32_b32 %0, -1, %0" : "=v"(l)); return (wv << 6) | l; }
__device__ __forceinline__ float wave_sum_l(float v, int lane) {
#pragma unroll
    for (int o = 32; o > 0; o >>= 1) v += __int_as_float(__builtin_amdgcn_ds_bpermute((lane ^ o) << 2, __float_as_int(v)));
    return v;
}

__global__ __launch_bounds__(256) void k_mod(Ptrs P) {
    __shared__ float sc[17][64];
    const int i = blockIdx.y, col = blockIdx.x * 256 + threadIdx.x, tid = threadIdx.x;
    const float* W = P.in[4] + (size_t)i * 1024 * 6144;
    float acc[17];
#pragma unroll
    for (int r = 0; r < 17; ++r) acc[r] = 0.f;
    for (int k0 = 0; k0 < 1024; k0 += 64) {
        __syncthreads();
        for (int idx = tid; idx < 17 * 64; idx += 256) { const int r = idx >> 6, kk = idx & 63; const float v = r < 16 ? P.in[1][r * 1024 + k0 + kk] : P.in[3][k0 + kk]; sc[r][kk] = silu_f(v); }
        __syncthreads();
#pragma unroll 8
        for (int kk = 0; kk < 64; ++kk) { const float w = W[(size_t)(k0 + kk) * 6144 + col];
#pragma unroll
            for (int r = 0; r < 17; ++r) acc[r] += sc[r][kk] * w; }
    }
    float* mod = (float*)(P.ws + WS_MOD);
    const float bb = P.in[5][i * 6144 + col];
#pragma unroll
    for (int r = 0; r < 17; ++r) mod[(size_t)(i * 17 + r) * 6144 + col] = acc[r] + bb;
}
__device__ __forceinline__ void copy_small(const Ptrs& P, int t0, int nt) {
    float* sm = (float*)(P.ws + WS_SMALL);
    for (int i = t0; i < 4096; i += nt) { sm[SM_GMIX + i] = P.in[6][i]; sm[SM_GFFN + i] = P.in[7][i]; }
    for (int i = t0; i < 2048; i += nt) sm[SM_S5D + i] = P.in[15][i];
    for (int i = t0; i < 768; i += nt) sm[SM_GQ + i] = P.in[18][i];
    for (int i = t0; i < 512; i += nt) sm[SM_GKV + i] = P.in[19][i];
    for (int i = t0; i < 1024; i += nt) sm[SM_FINALG + i] = P.in[29][i];
    for (int i = t0; i < 16; i += nt) sm[SM_BGROUP + i] = P.in[24][i];
    for (int i = t0; i < 128; i += nt) sm[SM_BEXP + i] = P.in[26][i];
    for (int i = t0; i < 16384; i += nt) sm[SM_WGROUP + i] = P.in[23][i];
    for (int i = t0; i < 131072; i += nt) sm[SM_WEXP + i] = P.in[25][i];
}
__global__ __launch_bounds__(256) void k_init(Ptrs P) {
    copy_small(P, blockIdx.x * 256 + threadIdx.x, gridDim.x * 256);
    float4* X = (float4*)(P.ws + WS_X);
    const size_t n4 = (size_t)T * D / 4;
    for (size_t i = (size_t)blockIdx.x * 256 + threadIdx.x; i < n4; i += (size_t)gridDim.x * 256) {
        const size_t row = i / 256, c4 = i % 256; const int b = (int)(row / LTOT), pos = (int)(row % LTOT);
        X[i] = pos < CTXL ? ((const float4*)P.in[2])[((size_t)b * CTXL + pos) * 256 + c4] : ((const float4*)P.in[0])[((size_t)b * SEQ + (pos - CTXL)) * 256 + c4];
    }
    float2* rope = (float2*)(P.ws + WS_ROPE);
    for (int i = blockIdx.x * 256 + threadIdx.x; i < 2048 * 32; i += gridDim.x * 256) {
        const int s = i >> 5, k = i & 31, f = k & 15; const float invf = exp2f(-(float)f * (13.287712379549449f / 16.f));
        const float ang = (float)(k < 16 ? (s >> 6) : (s & 63)) * invf;
        rope[i] = make_float2(__cosf(ang), __sinf(ang));
    }
}

template <int MODE>
__device__ __forceinline__ void norm_rows(unsigned char* wsp, float* outp, int li, int which, int nwaves_blk, int* s_base, int wv) {
    struct { unsigned char* ws; float* out; } P{wsp, outp}; const float* sm = (const float*)(wsp + WS_SMALL);
    const int tidn = tid_opaque(wv); const int lane = tidn & 63, wave = tidn >> 6;
    float* X = (float*)(P.ws + WS_X);
    const float* mod = (const float*)(P.ws + WS_MOD);
    if (MODE & 1) {
        if (tidn == 0) { const unsigned* cnt = (const unsigned*)(P.ws + WS_CTL) + CW_CNT + (li - 1) * 32 * CS; int a = 0; for (int e = 0; e < 32; ++e) { s_base[e] = a; a += (int)((cnt[e * CS] + 255u) / 256u); } s_base[32] = a; }
        __syncthreads();
    }
    const bool lastl = (li == 3);
    for (int row = blockIdx.x * nwaves_blk + wave; row < T; row += gridDim.x * nwaves_blk) {
        const int b = row / LTOT, pos = row % LTOT; const bool isctx = pos < CTXL; const int r = isctx ? 16 : b;
        if ((MODE & 16) && isctx) continue;
        if ((MODE & 8) && lastl && isctx) continue;
        float4 v[4];
#pragma unroll
        for (int q = 0; q < 4; ++q) v[q] = *(const float4*)(X + (size_t)row * D + q * 256 + lane * 4);
        if (MODE & 1) {
            const bool skip = (li - 1 == 3) && isctx;
            if (!skip) {
                const int4 si = *(const int4*)(P.ws + WS_SELI + (size_t)row * 16); const float2 sw = *(const float2*)(P.ws + WS_SELW + (size_t)row * 8);
                const size_t g1 = (size_t)s_base[si.x] * 256 + si.y, g2 = (size_t)s_base[si.z] * 256 + si.w;
                const u16* YB = (const u16*)(P.ws + WS_YB);
                const float* gate = mod + (size_t)((li - 1) * 17 + r) * 6144 + 5 * 1024;
#pragma unroll
                for (int q = 0; q < 4; ++q) { const int c = q * 256 + lane * 4;
                    const uint2 ya = *(const uint2*)(YB + g1 * 1024 + c), yb = *(const uint2*)(YB + g2 * 1024 + c); const float4 gg = *(const float4*)(gate + c);
                    v[q].x += gg.x * (sw.x * bf2f((u16)(ya.x & 0xffff)) + sw.y * bf2f((u16)(yb.x & 0xffff)));
                    v[q].y += gg.y * (sw.x * bf2f((u16)(ya.x >> 16)) + sw.y * bf2f((u16)(yb.x >> 16)));
                    v[q].z += gg.z * (sw.x * bf2f((u16)(ya.y & 0xffff)) + sw.y * bf2f((u16)(yb.y & 0xffff)));
                    v[q].w += gg.w * (sw.x * bf2f((u16)(ya.y >> 16)) + sw.y * bf2f((u16)(yb.y >> 16)));
                    if (!(MODE & 16)) *(float4*)(X + (size_t)row * D + c) = v[q]; }
            }
        }
        float ss = 0.f;
#pragma unroll
        for (int q = 0; q < 4; ++q) ss += v[q].x * v[q].x + v[q].y * v[q].y + v[q].z * v[q].z + v[q].w * v[q].w;
        ss = wave_sum_l(ss, lane);
        const float rstd = rsqrtf(ss * (1.f / 1024.f) + EPS);
        if (MODE & 16) {
            float* out = P.out + ((size_t)b * SEQ + (pos - CTXL)) * D;
#pragma unroll
            for (int q = 0; q < 4; ++q) { const int c = q * 256 + lane * 4; const float4 g = *(const float4*)(sm + SM_FINALG + c);
                float4 ov = make_float4(v[q].x * rstd * g.x, v[q].y * rstd * g.y, v[q].z * rstd * g.z, v[q].w * rstd * g.w);
#if defined(PROBE_A)
                { const float da = 1.f + ((const float*)s_base)[40]; ov.x *= da; ov.y *= da; ov.z *= da; ov.w *= da; if (row == CTXL && c == 0) ov.x += ((const float*)s_base)[41]; }
#endif
                *(float4*)(out + c) = ov; }
            continue;
        }
        const float* gv = sm + (which ? SM_GFFN : SM_GMIX) + li * 1024;
        const float* sh = mod + (size_t)(li * 17 + r) * 6144 + (which ? 3 : 0) * 1024; const float* scl = sh + 1024;
        float h[16];
#pragma unroll
        for (int q = 0; q < 4; ++q) { const int c = q * 256 + lane * 4; const float4 g = *(const float4*)(gv + c), s4 = *(const float4*)(sh + c), c4 = *(const float4*)(scl + c);
            h[q * 4 + 0] = v[q].x * rstd * g.x * (1.f + c4.x) + s4.x; h[q * 4 + 1] = v[q].y * rstd * g.y * (1.f + c4.y) + s4.y;
            h[q * 4 + 2] = v[q].z * rstd * g.z * (1.f + c4.z) + s4.z; h[q * 4 + 3] = v[q].w * rstd * g.w * (1.f + c4.w) + s4.w; }
        if (MODE & 2) {
            u16* HX = (u16*)(P.ws + WS_HX);
#pragma unroll
            for (int q = 0; q < 4; ++q) { uint2 w; w.x = (unsigned)f2bf(h[q * 4]) | ((unsigned)f2bf(h[q * 4 + 1]) << 16); w.y = (unsigned)f2bf(h[q * 4 + 2]) | ((unsigned)f2bf(h[q * 4 + 3]) << 16);
                *(uint2*)(HX + (size_t)row * D + q * 256 + lane * 4) = w; }
        }
        if (MODE & 4) {
            u16* UH = (u16*)(P.ws + WS_R1 + R1_UH);
#pragma unroll
            for (int q = 0; q < 4; ++q) { const int c = q * 256 + lane * 4; const int g = c >> 4, ch = c & 15;
                uint2 w; w.x = (unsigned)f2bf(h[q * 4]) | ((unsigned)f2bf(h[q * 4 + 1]) << 16); w.y = (unsigned)f2bf(h[q * 4 + 2]) | ((unsigned)f2bf(h[q * 4 + 3]) << 16);
                *(uint2*)(UH + ((size_t)g * 2304 + b * 144 + (pos >> 4)) * 512 + (pos & 15) * 16 + ch) = w; }
        }
        if (MODE & 8) {
            const float* wg = sm + SM_WGROUP + (size_t)li * 1024 * 4;
            float lg[4] = {0.f, 0.f, 0.f, 0.f};
#pragma unroll
            for (int q = 0; q < 4; ++q)
#pragma unroll
                for (int j = 0; j < 4; ++j) { const int k = q * 256 + lane * 4 + j; const float4 w = *(const float4*)(wg + k * 4); const float hv = h[q * 4 + j];
                    lg[0] += hv * w.x; lg[1] += hv * w.y; lg[2] += hv * w.z; lg[3] += hv * w.w; }
#pragma unroll
            for (int g = 0; g < 4; ++g) lg[g] = wave_sum_l(lg[g], lane) + sm[SM_BGROUP + li * 4 + g];
            int gi = 0; float best = lg[0];
#pragma unroll
            for (int g = 1; g < 4; ++g) if (lg[g] > best) { best = lg[g]; gi = g; }
            float den = 0.f;
#pragma unroll
            for (int g = 0; g < 4; ++g) den += __expf(lg[g] - best);
            const float pg = 1.f / den;
            const float* we = sm + SM_WEXP + ((size_t)li * 4 + gi) * 1024 * 8;
            float le[8];
#pragma unroll
            for (int e = 0; e < 8; ++e) le[e] = 0.f;
#pragma unroll
            for (int q = 0; q < 4; ++q)
#pragma unroll
                for (int j = 0; j < 4; ++j) { const int k = q * 256 + lane * 4 + j; const float4 w0 = *(const float4*)(we + k * 8), w1 = *(const float4*)(we + k * 8 + 4); const float hv = h[q * 4 + j];
                    le[0] += hv * w0.x; le[1] += hv * w0.y; le[2] += hv * w0.z; le[3] += hv * w0.w; le[4] += hv * w1.x; le[5] += hv * w1.y; le[6] += hv * w1.z; le[7] += hv * w1.w; }
#pragma unroll
            for (int e = 0; e < 8; ++e) le[e] = wave_sum_l(le[e], lane) + sm[SM_BEXP + (li * 4 + gi) * 8 + e];
            int i1 = 0; float b1 = le[0];
#pragma unroll
            for (int e = 1; e < 8; ++e) if (le[e] > b1) { b1 = le[e]; i1 = e; }
            int i2 = -1; float b2 = -3.0e38f;
#pragma unroll
            for (int e = 0; e < 8; ++e) if (e != i1 && le[e] > b2) { b2 = le[e]; i2 = e; }
            if (lane == 0) {
                const float ex = __expf(b2 - b1); const float w1 = 1.f / (1.f + ex), w2 = ex / (1.f + ex);
                unsigned* cnt = (unsigned*)(P.ws + WS_CTL) + CW_CNT + li * 32 * CS; int* list = (int*)(P.ws + WS_LIST);
                const int e1 = gi * 8 + i1, e2 = gi * 8 + i2;
                const int s1 = (int)atomicAdd(&cnt[e1 * CS], 1u), s2 = (int)atomicAdd(&cnt[e2 * CS], 1u);
                list[(size_t)e1 * T + s1] = row; list[(size_t)e2 * T + s2] = row;
                *(int4*)(P.ws + WS_SELI + (size_t)row * 16) = make_int4(e1, s1, e2, s2);
                *(float2*)(P.ws + WS_SELW + (size_t)row * 8) = make_float2(pg * w1, pg * w2);
            }
        }
    }
}
template <int MODE> __global__ __launch_bounds__(256) void k_norm(Ptrs P, int li, int which) { __shared__ int sb[36]; norm_rows<MODE>(P.ws, P.out, li, which, 4, sb, __builtin_amdgcn_readfirstlane(threadIdx.x >> 6)); }

struct NG { const void* A; int lda; const int* rowidx; const float* B; int ldb; long bstride; const int* tileexp; const int* mdyn; float* C; int ldc; int M, N, K, pad; };
template <int ABF> __global__ __launch_bounds__(256) void n_gemm(NG g) {
    __shared__ float As[16][68], Bs[16][68];
    const int tm = blockIdx.y, tn = blockIdx.x, tid = threadIdx.x, tx = tid & 15, ty = tid >> 4;
    const int M = g.mdyn ? (*g.mdyn) * 256 : g.M;
    if (tm * 64 >= M) return;
    const float* B = g.B; if (g.tileexp) B += (long)g.tileexp[(tm * 64) / 256] * g.bstride;
    float acc[4][4];
#pragma unroll
    for (int i = 0; i < 4; ++i)
#pragma unroll
        for (int j = 0; j < 4; ++j) acc[i][j] = 0.f;
    const int arow = tm * 64 + (tid >> 2), ak = (tid & 3) * 4; long asrc = -1;
    if (arow < M) { const int r = g.rowidx ? g.rowidx[arow] : arow; if (r >= 0) asrc = (long)r * g.lda; }
    for (int k0 = 0; k0 < g.K; k0 += 16) {
        float a[4] = {0.f, 0.f, 0.f, 0.f};
        if (asrc >= 0) {
            if (ABF) { const uint2 w = *(const uint2*)((const u16*)g.A + asrc + k0 + ak); a[0] = bf2f((u16)(w.x & 0xffff)); a[1] = bf2f((u16)(w.x >> 16)); a[2] = bf2f((u16)(w.y & 0xffff)); a[3] = bf2f((u16)(w.y >> 16)); }
            else { const float4 w = *(const float4*)((const float*)g.A + asrc + k0 + ak); a[0] = w.x; a[1] = w.y; a[2] = w.z; a[3] = w.w; }
        }
        const float4 bv = *(const float4*)(B + (size_t)(k0 + (tid >> 4)) * g.ldb + tn * 64 + (tid & 15) * 4);
        __syncthreads();
#pragma unroll
        for (int i = 0; i < 4; ++i) As[ak + i][tid >> 2] = a[i];
        *(float4*)&Bs[tid >> 4][(tid & 15) * 4] = bv;
        __syncthreads();
#pragma unroll
        for (int kk = 0; kk < 16; ++kk) { const float4 a4 = *(const float4*)&As[kk][ty * 4], b4 = *(const float4*)&Bs[kk][tx * 4];
            const float av[4] = {a4.x, a4.y, a4.z, a4.w}, bw[4] = {b4.x, b4.y, b4.z, b4.w};
#pragma unroll
            for (int i = 0; i < 4; ++i)
#pragma unroll
                for (int j = 0; j < 4; ++j) acc[i][j] += av[i] * bw[j]; }
    }
#pragma unroll
    for (int i = 0; i < 4; ++i) { const int row = tm * 64 + ty * 4 + i; if (row < M) *(float4*)(g.C + (size_t)row * g.ldc + tn * 64 + tx * 4) = make_float4(acc[i][0], acc[i][1], acc[i][2], acc[i][3]); }
}
__device__ __forceinline__ int row_r(int row) { return (row % LTOT) < CTXL ? 16 : row / LTOT; }
__global__ __launch_bounds__(256) void n_post_glu(Ptrs P, int li) {
    float* X = (float*)(P.ws + WS_X); const float* TMP = (const float*)(P.ws + WS_NTMP); const float* mod = (const float*)(P.ws + WS_MOD);
    for (size_t i = (size_t)blockIdx.x * 256 + threadIdx.x; i < (size_t)T * D; i += (size_t)gridDim.x * 256) { const int row = (int)(i >> 10), c = (int)(i & 1023); const int r = row_r(row);
        const float val = TMP[(size_t)row * 2048 + c], gt = TMP[(size_t)row * 2048 + 1024 + c]; X[i] += mod[(size_t)(li * 17 + r) * 6144 + 2048 + c] * val * sigmoid_f(gt); }
}
__global__ __launch_bounds__(256) void n_post_wo(Ptrs P, int li) {
    float* X = (float*)(P.ws + WS_X); const float* TMP = (const float*)(P.ws + WS_NTMP); const float* mod = (const float*)(P.ws + WS_MOD);
    for (size_t i = (size_t)blockIdx.x * 256 + threadIdx.x; i < (size_t)T * D; i += (size_t)gridDim.x * 256) { const int row = (int)(i >> 10), c = (int)(i & 1023); const int r = row_r(row);
        X[i] += mod[(size_t)(li * 17 + r) * 6144 + 2048 + c] * TMP[i]; }
}
__global__ __launch_bounds__(256) void n_post_q(Ptrs P) {
    const float* TMP = (const float*)(P.ws + WS_NTMP); u16* QT = (u16*)(P.ws + WS_R1 + R1_QT); const float2* rope = (const float2*)(P.ws + WS_ROPE);
    const float scale = 0.07216878364870322f;
    for (size_t i = (size_t)blockIdx.x * 256 + threadIdx.x; i < (size_t)T * 1536; i += (size_t)gridDim.x * 256) { const int row = (int)(i / 1536), c = (int)(i % 1536); const int h = c / 192, dd = c % 192;
        const int b = row / LTOT, pos = row % LTOT; float v = TMP[i];
        if (dd >= 128 && pos >= CTXL) { const int l = dd - 128; const float pv = TMP[(size_t)row * 1536 + h * 192 + 128 + (l ^ 16)]; const float2 cs = rope[(size_t)(pos - CTXL) * 32 + (l >> 5) * 16 + (l & 15)];
            v = (l & 16) ? v * cs.x + pv * cs.y : v * cs.x - pv * cs.y; }
        QT[(((size_t)b * NH + h) * LTOT + pos) * QKD + dd] = f2bf(v * scale); }
}
__global__ __launch_bounds__(256) void n_post_kv(Ptrs P) {
    const float* TMP = (const float*)(P.ws + WS_NTMP); u16* KT = (u16*)(P.ws + WS_R1 + R1_KT); u16* VT = (u16*)(P.ws + WS_R1 + R1_VT);
    for (size_t i = (size_t)blockIdx.x * 256 + threadIdx.x; i < (size_t)T * 2048; i += (size_t)gridDim.x * 256) { const int row = (int)(i >> 11), c = (int)(i & 2047); const int h = c >> 8, dd = c & 255;
        const int b = row / LTOT, pos = row % LTOT; const u16 v = f2bf(TMP[i]);
        if (dd < 128) KT[(((size_t)b * NH + h) * LTOT + pos) * QKD + dd] = v; else VT[(((size_t)b * NH + h) * LTOT + pos) * 128 + dd - 128] = v; }
}
__global__ __launch_bounds__(256) void n_attn(Ptrs P) {
    __shared__ float Ks[32][192], Vs[32][128];
    const int qt = blockIdx.x, h = blockIdx.y, b = blockIdx.z, tid = threadIdx.x, ql = tid >> 2, part = tid & 3;
    const u16* QT = (const u16*)(P.ws + WS_R1 + R1_QT) + ((size_t)b * NH + h) * LTOT * QKD; const u16* KT = (const u16*)(P.ws + WS_R1 + R1_KT) + ((size_t)b * NH + h) * LTOT * QKD;
    const u16* VT = (const u16*)(P.ws + WS_R1 + R1_VT) + ((size_t)b * NH + h) * LTOT * 128; u16* O = (u16*)(P.ws + WS_ZO);
    const int pos = qt * 64 + ql; const int nk = (qt * 64 < CTXL) ? CTXL : LTOT;
    float q[48], o[32];
#pragma unroll
    for (int i = 0; i < 48; ++i) q[i] = bf2f(QT[(size_t)pos * QKD + part * 48 + i]);
#pragma unroll
    for (int i = 0; i < 32; ++i) o[i] = 0.f;
    float m = -1e30f, l = 0.f;
    for (int k0 = 0; k0 < nk; k0 += 32) {
        __syncthreads();
        for (int i = tid; i < 32 * 192; i += 256) Ks[i / 192][i % 192] = bf2f(KT[(size_t)k0 * QKD + i]);
        for (int i = tid; i < 32 * 128; i += 256) Vs[i / 128][i % 128] = bf2f(VT[(size_t)k0 * 128 + i]);
        __syncthreads();
        for (int kk = 0; kk < 32; ++kk) {
            float s = 0.f;
#pragma unroll
            for (int i = 0; i < 48; ++i) s += q[i] * Ks[kk][part * 48 + i];
            s += __shfl_xor(s, 1); s += __shfl_xor(s, 2);
            const float mn = fmaxf(m, s), al = __expf(m - mn), p = __expf(s - mn);
            l = l * al + p; m = mn;
#pragma unroll
            for (int i = 0; i < 32; ++i) o[i] = o[i] * al + p * Vs[kk][part * 32 + i];
        }
    }
    const float rl = 1.f / l;
#pragma unroll
    for (int i = 0; i < 32; ++i) O[((size_t)b * LTOT + pos) * D + h * 128 + part * 32 + i] = f2bf(o[i] * rl);
}
__global__ __launch_bounds__(128) void n_s5(Ptrs P, int j) {
    __shared__ float us[2][16], hre[2][64], him[2][64], Cre[2][16][64], Cim[2][16][64];
    const int b = blockIdx.x >> 6, g = blockIdx.x & 63, tid = threadIdx.x, dir = tid >> 6, p = tid & 63;
    const size_t gd = ((size_t)j * 2 + dir) * SG + g;
    const float dt = __expf(P.in[10][gd]); const float ar = P.in[8][gd * SP + p], ai = P.in[9][gd * SP + p];
    const float ldr = ar * dt, ldi = ai * dt, mag = __expf(ldr); const float abr = mag * __cosf(ldi), abi = mag * __sinf(ldi);
    const float nr = abr - 1.f, ni = abi, den = ar * ar + ai * ai; const float qr = (nr * ar + ni * ai) / den, qi = (ni * ar - nr * ai) / den;
    float bbr[16], bbi[16];
#pragma unroll
    for (int c = 0; c < 16; ++c) { const float br = P.in[11][(gd * SP + p) * SC + c], bi = P.in[12][(gd * SP + p) * SC + c]; bbr[c] = qr * br - qi * bi; bbi[c] = qr * bi + qi * br; }
    for (int i = tid; i < 2 * 16 * 64; i += 128) { const int d2 = i >> 10, c = (i >> 6) & 15, pp = i & 63; const size_t o = ((((size_t)j * 2 + d2) * SG + g) * SC + c) * SP + pp; Cre[d2][c][pp] = P.in[13][o]; Cim[d2][c][pp] = P.in[14][o]; }
    const u16* HX = (const u16*)(P.ws + WS_HX); float* Yf = (float*)(P.ws + WS_NTMP); float* Yr = Yf + (size_t)T * D;
    float hr = 0.f, hi = 0.f;
    for (int t = 0; t < LTOT; ++t) {
        __syncthreads();
        if (tid < 32) { const int d2 = tid >> 4, c = tid & 15; const int ps = d2 ? (t < CTXL ? CTXL - 1 - t : LTOT - 1 - (t - CTXL)) : t; us[d2][c] = bf2f(HX[((size_t)b * LTOT + ps) * D + g * 16 + c]); }
        __syncthreads();
        float bur = 0.f, bui = 0.f;
#pragma unroll
        for (int c = 0; c < 16; ++c) { bur += bbr[c] * us[dir][c]; bui += bbi[c] * us[dir][c]; }
        const float nhr = abr * hr - abi * hi + bur, nhi = abr * hi + abi * hr + bui; hr = nhr; hi = nhi;
        hre[dir][p] = hr; him[dir][p] = hi;
        __syncthreads();
        if (tid < 32) { const int d2 = tid >> 4, c = tid & 15; const int ps = d2 ? (t < CTXL ? CTXL - 1 - t : LTOT - 1 - (t - CTXL)) : t; float y = 0.f;
            for (int pp = 0; pp < 64; ++pp) y += Cre[d2][c][pp] * hre[d2][pp] - Cim[d2][c][pp] * him[d2][pp];
            (d2 ? Yr : Yf)[((size_t)b * LTOT + ps) * D + g * 16 + c] = y; }
    }
}
__global__ __launch_bounds__(256) void n_post_s5(Ptrs P, int j) {
    const float* Yf = (const float*)(P.ws + WS_NTMP); const float* Yr = Yf + (size_t)T * D; const u16* HX = (const u16*)(P.ws + WS_HX); u16* Z = (u16*)(P.ws + WS_ZO);
    for (size_t i = (size_t)blockIdx.x * 256 + threadIdx.x; i < (size_t)T * D; i += (size_t)gridDim.x * 256) { const int c = (int)(i & 1023);
        Z[i] = f2bf(gelu_tanh(Yf[i] + Yr[i] + P.in[15][j * 1024 + c] * bf2f(HX[i]))); }
}
__global__ __launch_bounds__(256) void n_build(Ptrs P, int li) {
    __shared__ int base[33];
    const unsigned* cnt = (const unsigned*)(P.ws + WS_CTL) + CW_CNT + li * 32 * CS; int* tileexp = (int*)(P.ws + WS_TILEEXP); int* slotrow = (int*)(P.ws + WS_SLOTROW); const int* list = (const int*)(P.ws + WS_LIST);
    if (threadIdx.x == 0) { int a = 0; for (int e = 0; e < 32; ++e) { base[e] = a; a += (int)((cnt[e * CS] + 255u) / 256u); } base[32] = a; tileexp[512] = a; }
    __syncthreads();
    for (int e = 0; e < 32; ++e) { const int nt = base[e + 1] - base[e];
        for (int t = threadIdx.x; t < nt; t += 256) tileexp[base[e] + t] = e;
        for (int s = threadIdx.x; s < nt * 256; s += 256) slotrow[base[e] * 256 + s] = s < (int)cnt[e * CS] ? list[(size_t)e * T + s] : -1; }
}
__global__ __launch_bounds__(256) void n_post_act2(Ptrs P, u16* ACT) {
    const float* TMP = (const float*)(P.ws + WS_NTMP); const int ntot = ((const int*)(P.ws + WS_TILEEXP))[512];
    for (size_t i = (size_t)blockIdx.x * 256 + threadIdx.x; i < (size_t)ntot * 256 * 512; i += (size_t)gridDim.x * 256) { const size_t gs = i >> 9; const int c = (int)(i & 511);
        ACT[i] = f2bf(silu_f(TMP[gs * 1024 + c]) * TMP[gs * 1024 + 512 + c]); }
}
__global__ __launch_bounds__(256) void n_post_y(Ptrs P) {
    const float* TMP = (const float*)(P.ws + WS_NTMP); u16* YB = (u16*)(P.ws + WS_YB); const int ntot = ((const int*)(P.ws + WS_TILEEXP))[512];
    for (size_t i = (size_t)blockIdx.x * 256 + threadIdx.x; i < (size_t)ntot * 256 * 1024; i += (size_t)gridDim.x * 256) YB[i] = f2bf(TMP[i]);
}

#define LAS __attribute__((address_space(3)))
typedef short bf16x8 __attribute__((ext_vector_type(8)));
typedef float f32x4 __attribute__((ext_vector_type(4)));
typedef unsigned u32x4 __attribute__((ext_vector_type(4)));
typedef unsigned u32x2 __attribute__((ext_vector_type(2)));
namespace g8 {
constexpr int BM = 256, BK = 64, HALF = 128, HTB = HALF * BK * 2, STAGE_BYTES = 8 * HTB, NXCD = 8, WGM = 8;
__host__ __device__ __forceinline__ int lds_byte(int r, int c) { const int st = (r >> 4) * 2 + (c >> 5), rr = r & 15, cc = c & 31, ob = rr * 64 + cc * 2; return st * 1024 + (ob ^ (((ob >> 9) & 1) << 5)); }
__host__ __device__ __forceinline__ void stage_rc(int b, int& R, int& C) { const int st = b / 1024, sb = b % 1024, swz = sb ^ (((sb >> 9) & 1) << 5); R = (st >> 1) * 16 + swz / 64; C = (st & 1) * 32 + (swz % 64) / 2; }
__host__ __device__ __forceinline__ int perm32(int rho) { const int n = rho >> 4, i = rho & 15; return 8 * (i >> 2) + 4 * n + (i & 3); }
struct Unit { int pm, pn, aux; };
struct Order {
    int nM, nN, nwg, G, c;
    __device__ __forceinline__ void init(int nM_, int nN_, int G_, int c_) { nM = nM_; nN = nN_; nwg = nM * nN; G = G_; c = c_; }
    __device__ __forceinline__ bool next(int i, int& pm, int& pn) const {
        const long L = (long)i * G + c; if (L >= nwg) return false;
        int wgid = (int)L; { const int q = nwg / NXCD, r = nwg % NXCD, xcd = wgid % NXCD, off = wgid / NXCD; wgid = (xcd < r ? xcd * (q + 1) : r * (q + 1) + (xcd - r) * q) + off; }
        const int nig = WGM * nN, gid = wgid / nig, fm = gid * WGM, gsz = (nM - fm) < WGM ? (nM - fm) : WGM;
        pm = fm + ((wgid % nig) % gsz); pn = (wgid % nig) / gsz; return true;
    }
};
__device__ __forceinline__ unsigned cvt_pk_bf16(float lo, float hi) { unsigned r; asm volatile("v_cvt_pk_bf16_f32 %0, %1, %2" : "=v"(r) : "v"(lo), "v"(hi)); return r; }

template <class Epi, class Sched>
__device__ __forceinline__ void gemm_phase(LAS unsigned char* lds, const int K, const Sched& S, const Epi& E, const int wv) {
    const int tid = tid_opaque(wv), wid = wv, lane = tid & 63, wr = wid >> 2, wc = wid & 3, fr = lane & 15, fq = lane >> 4;
    const int nt = K / BK;
    int R0, C0; stage_rc(tid * 16, R0, C0);
    unsigned voffB[2];
    { const int Rb0 = Epi::PERM ? ((R0 & ~31) + perm32(R0 & 31)) : R0;
      voffB[0] = (unsigned)(Rb0 * K + C0) * 2u; voffB[1] = voffB[0] + (unsigned)(64 * K) * 2u; }
    const size_t kstepB = (size_t)(BK * 2), hstepB = (size_t)HALF * K * 2;
    const size_t kstepA = S.a_kstep();
    const unsigned ldsw = (unsigned)wid * 1024u;
    const int aoff = lds_byte(wr * 64 + fr, fq * 8), boff = lds_byte(wc * 32 + fr, fq * 8);
#define G8_SA(b, h) (((b) * 2 + (h)) * HTB)
#define G8_SB(b, h) ((4 + (b) * 2 + (h)) * HTB)
#define G8_STAGE_B(bufoff, gbase) do { _Pragma("unroll") for (int _i = 0; _i < 2; ++_i) \
        __builtin_amdgcn_global_load_lds((const unsigned*)((const char*)(gbase) + voffB[_i]), (LAS unsigned*)(lds + (bufoff) + ldsw + _i * 8192), 16, 0, 0); } while (0)
#define G8_VI(h, i) ((Sched::NV == 1) ? 0 : ((h) * 2 + (i)))
#define G8_STAGE_A(bufoff, U, V, h, kb) do { \
        __builtin_amdgcn_global_load_lds((const unsigned*)(S.a_uptr(U, h, 0) + (size_t)(kb) + (V)[G8_VI(h, 0)]), (LAS unsigned*)(lds + (bufoff) + ldsw), 16, 0, 0); \
        __builtin_amdgcn_global_load_lds((const unsigned*)(S.a_uptr(U, h, 1) + (size_t)(kb) + (V)[G8_VI(h, 1)]), (LAS unsigned*)(lds + (bufoff) + ldsw + 8192), 16, 0, 0); } while (0)
#define G8_LDA(dst, b, h) do { _Pragma("unroll") for (int m = 0; m < 4; ++m) _Pragma("unroll") for (int k = 0; k < 2; ++k) dst[m][k] = *(const LAS bf16x8*)(lds + G8_SA(b, h) + aoff + m * 2048 + k * 1024); } while (0)
#define G8_LDB(dst, b, h) do { _Pragma("unroll") for (int n = 0; n < 2; ++n) _Pragma("unroll") for (int k = 0; k < 2; ++k) dst[n][k] = *(const LAS bf16x8*)(lds + G8_SB(b, h) + boff + n * 2048 + k * 1024); } while (0)
#define G8_MMA(ai, bj, At, Bt) do { __builtin_amdgcn_s_setprio(1); _Pragma("unroll") for (int m = 0; m < 4; ++m) _Pragma("unroll") for (int n = 0; n < 2; ++n) _Pragma("unroll") for (int k = 0; k < 2; ++k) \
        acc[ai][bj][m][n] = __builtin_amdgcn_mfma_f32_16x16x32_bf16(Bt[n][k], At[m][k], acc[ai][bj][m][n], 0, 0, 0); __builtin_amdgcn_s_setprio(0); } while (0)
#define G8_WAIT_V(n) asm volatile("s_waitcnt vmcnt(" #n ")" ::: "memory")
#define G8_WAIT_L(n) asm volatile("s_waitcnt lgkmcnt(" #n ")" ::: "memory")
#define G8_BAR __builtin_amdgcn_s_barrier()
#define G8_SCHED __builtin_amdgcn_sched_barrier(0)
    Unit cur, nxt; int ui = 0;
    if (!S.next(0, cur)) return;
    f32x4 acc[2][2][4][2];
#pragma unroll
    for (int a = 0; a < 2; ++a)
#pragma unroll
        for (int b = 0; b < 2; ++b)
#pragma unroll
            for (int m = 0; m < 4; ++m)
#pragma unroll
                for (int n = 0; n < 2; ++n) acc[a][b][m][n] = (f32x4){0.f, 0.f, 0.f, 0.f};
    bf16x8 At[4][2], B0[2][2], B1[2][2];
    unsigned cO[4], nO[4];
    S.a_voff(cur, R0, C0, cO);
    const char* cB = S.b_ptr(cur);
    G8_STAGE_B(G8_SB(0, 0), cB); G8_STAGE_A(G8_SA(0, 0), cur, cO, 0, 0); G8_STAGE_B(G8_SB(0, 1), cB + hstepB); G8_STAGE_A(G8_SA(0, 1), cur, cO, 1, 0);
    if (wr == 1) G8_BAR;
    G8_WAIT_V(4); G8_BAR;
    G8_STAGE_B(G8_SB(1, 0), cB + kstepB); G8_STAGE_A(G8_SA(1, 0), cur, cO, 0, kstepA); G8_STAGE_B(G8_SB(1, 1), cB + hstepB + kstepB);
    G8_WAIT_V(6); G8_BAR;
    for (;;) {
        const bool has_next = S.next(ui + 1, nxt);
        const char* nB = cB;
        if (has_next) { S.a_voff(nxt, R0, C0, nO); nB = S.b_ptr(nxt); }
        else { nxt = cur;
#pragma unroll
            for (int q = 0; q < 4; ++q) nO[q] = cO[q]; }
        for (int t = 0; t < nt; t += 2) {
            const bool last = (t == nt - 2);
            const size_t k1 = (size_t)(t + 1) * kstepA;
            const size_t k2 = last ? 0 : (size_t)(t + 2) * kstepA, k3 = k2 + kstepA;
            unsigned pV[4]; g8::Unit pU;
            if (last) { pU = nxt; pV[0] = nO[0]; pV[1] = nO[1]; pV[2] = nO[2]; pV[3] = nO[3]; } else { pU = cur; pV[0] = cO[0]; pV[1] = cO[1]; pV[2] = cO[2]; pV[3] = cO[3]; }
            const char* b2 = last ? nB : cB + (size_t)(t + 2) * kstepB; const char* b3 = b2 + kstepB;
            G8_LDB(B0, 0, 0); G8_SCHED; G8_LDA(At, 0, 0); G8_STAGE_A(G8_SA(1, 1), cur, cO, 1, k1);
            G8_WAIT_L(8); G8_BAR; G8_WAIT_L(0); G8_MMA(0, 0, At, B0); G8_BAR; G8_SCHED;
            G8_LDB(B1, 0, 1); G8_STAGE_B(G8_SB(0, 0), b2);
            G8_BAR; G8_WAIT_L(0); G8_MMA(0, 1, At, B1); G8_BAR;
            G8_LDA(At, 0, 1); G8_STAGE_A(G8_SA(0, 0), pU, pV, 0, k2);
            G8_BAR; G8_WAIT_L(0); G8_MMA(1, 0, At, B0); G8_BAR; G8_SCHED;
            G8_STAGE_B(G8_SB(0, 1), b2 + hstepB);
            G8_WAIT_V(6); G8_BAR; G8_MMA(1, 1, At, B1); G8_BAR;
            G8_LDB(B0, 1, 0); G8_SCHED; G8_LDA(At, 1, 0); G8_STAGE_A(G8_SA(0, 1), pU, pV, 1, k2);
            G8_WAIT_L(8); G8_BAR; G8_WAIT_L(0); G8_MMA(0, 0, At, B0); G8_BAR; G8_SCHED;
            G8_LDB(B1, 1, 1); G8_STAGE_B(G8_SB(1, 0), b3);
            G8_BAR; G8_WAIT_L(0); G8_MMA(0, 1, At, B1); G8_BAR;
            G8_LDA(At, 1, 1); G8_STAGE_A(G8_SA(1, 0), pU, pV, 0, k3);
            G8_BAR; G8_WAIT_L(0); G8_MMA(1, 0, At, B0); G8_BAR; G8_SCHED;
            G8_STAGE_B(G8_SB(1, 1), b3 + hstepB);
            G8_WAIT_V(6); G8_BAR; G8_MMA(1, 1, At, B1); G8_BAR;
        }
        E(acc, cur, wr, wc, fr, fq);
        if (!has_next) break;
#pragma unroll
        for (int a = 0; a < 2; ++a)
#pragma unroll
            for (int b = 0; b < 2; ++b)
#pragma unroll
                for (int m = 0; m < 4; ++m)
#pragma unroll
                    for (int n = 0; n < 2; ++n) acc[a][b][m][n] = (f32x4){0.f, 0.f, 0.f, 0.f};
        cur = nxt; cB = nB; ++ui;
#pragma unroll
        for (int q = 0; q < 4; ++q) cO[q] = nO[q];
    }
    G8_WAIT_V(0);
    if (wr == 0) G8_BAR;
    G8_BAR;
#undef G8_SA
#undef G8_SB
#undef G8_STAGE_A
#undef G8_VI
#undef G8_STAGE_B
#undef G8_LDA
#undef G8_LDB
#undef G8_MMA
#undef G8_WAIT_V
#undef G8_WAIT_L
#undef G8_BAR
#undef G8_SCHED
}
}
struct SchedDense {
    g8::Order ord; const char* A; unsigned lda2; const char* Bt; int K;
    __device__ __forceinline__ void init(const void* A_, int lda, const void* Bt_, int M, int N, int K_) { A = (const char*)A_; lda2 = (unsigned)lda * 2u; Bt = (const char*)Bt_; K = K_; ord.init(M / 256, N / 256, (int)gridDim.x, (int)blockIdx.x); }
    __device__ __forceinline__ bool next(int i, g8::Unit& u) const { u.aux = 0; return ord.next(i, u.pm, u.pn); }
    static constexpr int NV = 1;
    __device__ __forceinline__ size_t a_kstep() const { return 128; }
    __device__ __forceinline__ const char* a_uptr(const g8::Unit& u, int h, int i) const { return A + (size_t)(u.pm * 256 + h * 128 + i * 64) * lda2; }
    __device__ __forceinline__ void a_voff(const g8::Unit& u, int R0, int C0, unsigned (&o)[4]) const { o[0] = (unsigned)R0 * lda2 + C0 * 2; }
    __device__ __forceinline__ const char* b_ptr(const g8::Unit& u) const { return Bt + (size_t)u.pn * 256 * K * 2; }
};
struct SchedS5 {
    g8::Order ord; const char* A; const char* W; int K;
    __device__ __forceinline__ void init(const void* A_, const void* W_, int K_) { A = (const char*)A_; W = (const char*)W_; K = K_; ord.init(576, 1, (int)gridDim.x, (int)blockIdx.x); }
    __device__ __forceinline__ bool next(int i, g8::Unit& u) const { int pmx, pn; if (!ord.next(i, pmx, pn)) return false; u.aux = pmx / 9; u.pm = pmx % 9; u.pn = 0; return true; }
    static constexpr int NV = 1;
    __device__ __forceinline__ size_t a_kstep() const { return 128; }
    __device__ __forceinline__ const char* a_uptr(const g8::Unit& u, int h, int i) const { return A + (size_t)(u.aux * 2304 + u.pm * 256 + h * 128 + i * 64) * 1024; }
    __device__ __forceinline__ void a_voff(const g8::Unit& u, int R0, int C0, unsigned (&o)[4]) const { o[0] = (unsigned)R0 * 1024u + C0 * 2; }
    __device__ __forceinline__ const char* b_ptr(const g8::Unit& u) const { return W + (size_t)u.aux * 256 * K * 2; }
};
template <bool GATHER> struct SchedMoe {
    g8::Order ord; const char* A; const char* W; int K; const int* sbase; const unsigned* cnt; const int* list; size_t wstride;
    __device__ __forceinline__ void init(const void* A_, const void* W_, int K_, const int* sbase_, const unsigned* cnt_, const int* list_) {
        A = (const char*)A_; W = (const char*)W_; K = K_; sbase = sbase_; cnt = cnt_; list = list_; wstride = (size_t)1024 * K * 2; ord.init(sbase_[32], 4, (int)gridDim.x, (int)blockIdx.x); }
    __device__ __forceinline__ bool next(int i, g8::Unit& u) const { if (!ord.next(i, u.pm, u.pn)) return false; int e = 0;
        for (int k = 1; k < 32; ++k) e = (u.pm >= sbase[k]) ? k : e;
        u.aux = e; return true; }
    static constexpr int NV = GATHER ? 4 : 1;
    __device__ __forceinline__ size_t a_kstep() const { return 128; }
    __device__ __forceinline__ const char* a_uptr(const g8::Unit& u, int h, int i) const { return GATHER ? A : A + (size_t)(u.pm * 256 + h * 128 + i * 64) * 1024; }
    __device__ __forceinline__ void a_voff(const g8::Unit& u, int R0, int C0, unsigned (&o)[4]) const {
        if (GATHER) {
            const int e = u.aux; const int s0 = (u.pm - sbase[e]) * 256 + R0; const int n = (int)cnt[e * CS]; const int* l = list + (size_t)e * T;
#pragma unroll
            for (int q = 0; q < 4; ++q) { const int a = s0 + q * 64; o[q] = (unsigned)l[a < n ? a : 0] * 2048u + C0 * 2; }
        } else o[0] = (unsigned)R0 * 1024u + C0 * 2; }
    __device__ __forceinline__ const char* b_ptr(const g8::Unit& u) const { return W + (size_t)u.aux * wstride + (size_t)u.pn * 256 * K * 2; }
};

#define EPI_LOOP_AM for (int ai = 0; ai < 2; ++ai) _Pragma("unroll") for (int m = 0; m < 4; ++m)
struct EpiS5a {
    static constexpr bool PERM = false; float* S;
    __device__ __forceinline__ void operator()(const f32x4 (&acc)[2][2][4][2], const g8::Unit& u, int wr, int wc, int fr, int fq) const {
        float* base = S + ((size_t)u.aux * 2304 + (size_t)u.pm * 256 + wr * 64 + fr) * 256 + wc * 32 + 4 * fq;
#pragma unroll
        EPI_LOOP_AM { float* rowp = base + (size_t)(ai * 128 + m * 16) * 256;
#pragma unroll
            for (int bj = 0; bj < 2; ++bj)
#pragma unroll
                for (int n = 0; n < 2; ++n) *(f32x4*)(rowp + bj * 128 + n * 16) = acc[ai][bj][m][n]; }
    }
};
struct EpiS5b {
    static constexpr bool PERM = true; u16* Z; const u16* UH; const float* dvec;
    __device__ __forceinline__ void operator()(const f32x4 (&acc)[2][2][4][2], const g8::Unit& u, int wr, int wc, int fr, int fq) const {
        const int g = u.aux; const int ch0 = (fq & 1) * 8;
        const f32x4 d0 = *(const f32x4*)(dvec + g * 16 + ch0), d1 = *(const f32x4*)(dvec + g * 16 + ch0 + 4);
#pragma unroll
        EPI_LOOP_AM { const int rowin = u.pm * 256 + ai * 128 + wr * 64 + m * 16 + fr;
#pragma unroll
            for (int bj = 0; bj < 2; ++bj) { const int c0 = bj * 128 + wc * 32 + fq * 8; const int t = c0 >> 4;
                const u32x4 uu = *(const u32x4*)(UH + ((size_t)g * 2304 + rowin) * 512 + c0);
                const f32x4 a0 = acc[ai][bj][m][0], a1 = acc[ai][bj][m][1];
                float z[8];
                z[0] = a0[0] + d0[0] * __uint_as_float(uu.x << 16); z[1] = a0[1] + d0[1] * __uint_as_float(uu.x & 0xffff0000u);
                z[2] = a0[2] + d0[2] * __uint_as_float(uu.y << 16); z[3] = a0[3] + d0[3] * __uint_as_float(uu.y & 0xffff0000u);
                z[4] = a1[0] + d1[0] * __uint_as_float(uu.z << 16); z[5] = a1[1] + d1[1] * __uint_as_float(uu.z & 0xffff0000u);
                z[6] = a1[2] + d1[2] * __uint_as_float(uu.w << 16); z[7] = a1[3] + d1[3] * __uint_as_float(uu.w & 0xffff0000u);
#pragma unroll
                for (int q = 0; q < 8; ++q) z[q] = gelu_tanh(z[q]);
                u32x4 w; w.x = g8::cvt_pk_bf16(z[0], z[1]); w.y = g8::cvt_pk_bf16(z[2], z[3]); w.z = g8::cvt_pk_bf16(z[4], z[5]); w.w = g8::cvt_pk_bf16(z[6], z[7]);
                *(u32x4*)(Z + ((size_t)rowin * 16 + t) * 1024 + g * 16 + ch0) = w; } }
    }
};
struct EpiGlu {
    static constexpr bool PERM = true; u16* DL; const float* mod; int li;
    __device__ __forceinline__ void operator()(const f32x4 (&acc)[2][2][4][2], const g8::Unit& u, int wr, int wc, int fr, int fq) const {
        const int r = (u.pm % 9 == 0) ? 16 : u.pm / 9; const float* gate = mod + (size_t)(li * 17 + r) * 6144 + 2048;
        const int j0 = u.pn * 128 + wc * 32 + fq * 8;
        const f32x4 g0 = *(const f32x4*)(gate + j0), g1 = *(const f32x4*)(gate + j0 + 4);
#pragma unroll
        EPI_LOOP_AM { const size_t row = (size_t)u.pm * 256 + ai * 128 + wr * 64 + m * 16 + fr;
            const f32x4 v0 = acc[ai][0][m][0], v1 = acc[ai][0][m][1], t0 = acc[ai][1][m][0], t1 = acc[ai][1][m][1];
            u32x4 w; w.x = g8::cvt_pk_bf16(g0[0] * v0[0] * sigmoid_f(t0[0]), g0[1] * v0[1] * sigmoid_f(t0[1])); w.y = g8::cvt_pk_bf16(g0[2] * v0[2] * sigmoid_f(t0[2]), g0[3] * v0[3] * sigmoid_f(t0[3]));
            w.z = g8::cvt_pk_bf16(g1[0] * v1[0] * sigmoid_f(t1[0]), g1[1] * v1[1] * sigmoid_f(t1[1])); w.w = g8::cvt_pk_bf16(g1[2] * v1[2] * sigmoid_f(t1[2]), g1[3] * v1[3] * sigmoid_f(t1[3]));
            *(u32x4*)(DL + row * 1024 + j0) = w; }
    }
};
struct EpiF32 {
    static constexpr bool PERM = false; float* C; int ldc;
    __device__ __forceinline__ void operator()(const f32x4 (&acc)[2][2][4][2], const g8::Unit& u, int wr, int wc, int fr, int fq) const {
        float* base = C + ((size_t)u.pm * 256 + wr * 64 + fr) * ldc + u.pn * 256 + wc * 32 + 4 * fq;
#pragma unroll
        EPI_LOOP_AM { float* rowp = base + (size_t)(ai * 128 + m * 16) * ldc;
#pragma unroll
            for (int bj = 0; bj < 2; ++bj)
#pragma unroll
                for (int n = 0; n < 2; ++n) *(f32x4*)(rowp + bj * 128 + n * 16) = acc[ai][bj][m][n]; }
    }
};
struct EpiQ {
    static constexpr bool PERM = false; u16* QT; const float2* rope;
    __device__ __forceinline__ void operator()(const f32x4 (&acc)[2][2][4][2], const g8::Unit& u, int wr, int wc, int fr, int fq) const {
        const float scale = 0.07216878364870322f; const int b = u.pm / 9, pt = u.pm % 9;
#pragma unroll
        EPI_LOOP_AM { const int pos = pt * 256 + ai * 128 + wr * 64 + m * 16 + fr;
#pragma unroll
            for (int bj = 0; bj < 2; ++bj) { const int g32 = u.pn * 8 + bj * 4 + wc; const int h = g32 / 6, part = g32 % 6;
                f32x4 a = acc[ai][bj][m][0], bq = acc[ai][bj][m][1];
                if (part >= 4 && pos >= CTXL) { const float2* rp = rope + (size_t)(pos - CTXL) * 32 + (part - 4) * 16 + fq * 4;
#pragma unroll
                    for (int q = 0; q < 4; ++q) { const float2 cs = rp[q]; const float x0 = a[q], x1 = bq[q]; a[q] = x0 * cs.x - x1 * cs.y; bq[q] = x1 * cs.x + x0 * cs.y; } }
                u16* dst = QT + (((size_t)b * NH + h) * LTOT + pos) * QKD + part * 32 + fq * 4;
                u32x2 w0, w1; w0.x = g8::cvt_pk_bf16(a[0] * scale, a[1] * scale); w0.y = g8::cvt_pk_bf16(a[2] * scale, a[3] * scale);
                w1.x = g8::cvt_pk_bf16(bq[0] * scale, bq[1] * scale); w1.y = g8::cvt_pk_bf16(bq[2] * scale, bq[3] * scale);
                *(u32x2*)dst = w0; *(u32x2*)(dst + 16) = w1; } }
    }
};
struct EpiKV {
    static constexpr bool PERM = true; u16* KT; u16* VT;
    __device__ __forceinline__ void operator()(const f32x4 (&acc)[2][2][4][2], const g8::Unit& u, int wr, int wc, int fr, int fq) const {
        const int b = u.pm / 9, pt = u.pm % 9, h = u.pn;
#pragma unroll
        EPI_LOOP_AM { const int pos = pt * 256 + ai * 128 + wr * 64 + m * 16 + fr; const size_t rr = ((size_t)b * NH + h) * LTOT + pos;
#pragma unroll
            for (int bj = 0; bj < 2; ++bj) { const f32x4 a0 = acc[ai][bj][m][0], a1 = acc[ai][bj][m][1];
                u32x4 w; w.x = g8::cvt_pk_bf16(a0[0], a0[1]); w.y = g8::cvt_pk_bf16(a0[2], a0[3]); w.z = g8::cvt_pk_bf16(a1[0], a1[1]); w.w = g8::cvt_pk_bf16(a1[2], a1[3]);
                u16* dst = bj == 0 ? KT + rr * QKD + wc * 32 + fq * 8 : VT + rr * 128 + wc * 32 + fq * 8;
                *(u32x4*)dst = w; } }
    }
};
struct EpiWo {
    static constexpr bool PERM = true; u16* DL; const float* mod; int li;
    __device__ __forceinline__ void operator()(const f32x4 (&acc)[2][2][4][2], const g8::Unit& u, int wr, int wc, int fr, int fq) const {
        const int r = (u.pm % 9 == 0) ? 16 : u.pm / 9; const float* gate = mod + (size_t)(li * 17 + r) * 6144 + 2048;
        f32x4 gg[2][2];
#pragma unroll
        for (int bj = 0; bj < 2; ++bj)
#pragma unroll
            for (int n = 0; n < 2; ++n) gg[bj][n] = *(const f32x4*)(gate + u.pn * 256 + bj * 128 + wc * 32 + fq * 8 + n * 4);
#pragma unroll
        EPI_LOOP_AM { const size_t row = (size_t)u.pm * 256 + ai * 128 + wr * 64 + m * 16 + fr;
#pragma unroll
            for (int bj = 0; bj < 2; ++bj) { const f32x4 a0 = acc[ai][bj][m][0] * gg[bj][0], a1 = acc[ai][bj][m][1] * gg[bj][1];
                u32x4 w; w.x = g8::cvt_pk_bf16(a0[0], a0[1]); w.y = g8::cvt_pk_bf16(a0[2], a0[3]); w.z = g8::cvt_pk_bf16(a1[0], a1[1]); w.w = g8::cvt_pk_bf16(a1[2], a1[3]);
                *(u32x4*)(DL + row * 1024 + u.pn * 256 + bj * 128 + wc * 32 + fq * 8) = w; } }
    }
};
struct EpiMoe1 {
    static constexpr bool PERM = true; u16* ACT;
    __device__ __forceinline__ void operator()(const f32x4 (&acc)[2][2][4][2], const g8::Unit& u, int wr, int wc, int fr, int fq) const {
        const int j0 = u.pn * 128 + wc * 32 + fq * 8;
#pragma unroll
        EPI_LOOP_AM { const size_t gs = (size_t)u.pm * 256 + ai * 128 + wr * 64 + m * 16 + fr;
            const f32x4 g0 = acc[ai][0][m][0], g1 = acc[ai][0][m][1], u0 = acc[ai][1][m][0], u1 = acc[ai][1][m][1];
            u32x4 w; w.x = g8::cvt_pk_bf16(silu_f(g0[0]) * u0[0], silu_f(g0[1]) * u0[1]); w.y = g8::cvt_pk_bf16(silu_f(g0[2]) * u0[2], silu_f(g0[3]) * u0[3]);
            w.z = g8::cvt_pk_bf16(silu_f(g1[0]) * u1[0], silu_f(g1[1]) * u1[1]); w.w = g8::cvt_pk_bf16(silu_f(g1[2]) * u1[2], silu_f(g1[3]) * u1[3]);
            *(u32x4*)(ACT + gs * 512 + j0) = w; }
    }
};
struct EpiMoe2 {
    static constexpr bool PERM = true; u16* YB;
    __device__ __forceinline__ void operator()(const f32x4 (&acc)[2][2][4][2], const g8::Unit& u, int wr, int wc, int fr, int fq) const {
#pragma unroll
        EPI_LOOP_AM { const size_t gs = (size_t)u.pm * 256 + ai * 128 + wr * 64 + m * 16 + fr;
#pragma unroll
            for (int bj = 0; bj < 2; ++bj) { const f32x4 a0 = acc[ai][bj][m][0], a1 = acc[ai][bj][m][1];
                u32x4 w; w.x = g8::cvt_pk_bf16(a0[0], a0[1]); w.y = g8::cvt_pk_bf16(a0[2], a0[3]); w.z = g8::cvt_pk_bf16(a1[0], a1[1]); w.w = g8::cvt_pk_bf16(a1[2], a1[3]);
                *(u32x4*)(YB + gs * 1024 + u.pn * 256 + bj * 128 + wc * 32 + fq * 8) = w; } }
    }
};
namespace at {
typedef short s16x4 __attribute__((ext_vector_type(4)));
typedef float f32x16 __attribute__((ext_vector_type(16)));
constexpr int KVBLK = 64, QBLK = 32, NW = 8;
constexpr int SHM_V = KVBLK * 128 * 2, SHM_K = KVBLK * QKD * 2, SHM_ATTN = 2 * SHM_V + 2 * SHM_K + NW * 64 * 4;
constexpr float SCALE = 1.0f;
constexpr float THR = 8.f;
#define KSWZ(row, colB) ((row) * 384 + ((colB) ^ (((row) & 7) << 4)))
#define SBAR() __builtin_amdgcn_sched_barrier(0)
__device__ __forceinline__ int crow(int r, int hi) { return (r & 3) + 8 * (r >> 2) + 4 * hi; }
__device__ __forceinline__ unsigned cvtpk(float lo, float hi) { unsigned r; asm volatile("v_cvt_pk_bf16_f32 %0, %1, %2" : "=v"(r) : "v"(lo), "v"(hi)); return r; }
__device__ __forceinline__ void partialSM(f32x16& p0, f32x16& p1, float& m_reg, float& mn, float& alpha) {
    constexpr float C = SCALE * 1.4426950408889634f;
    float pmax = p0[0];
#pragma unroll
    for (int r = 1; r < 16; ++r) pmax = fmaxf(pmax, p0[r]);
#pragma unroll
    for (int r = 0; r < 16; ++r) pmax = fmaxf(pmax, p1[r]);
    { auto rr = __builtin_amdgcn_permlane32_swap(__float_as_uint(pmax), __float_as_uint(pmax), false, false); pmax = fmaxf(__uint_as_float(rr[0]), __uint_as_float(rr[1])); }
    if (__builtin_expect(__all(pmax - m_reg <= THR / SCALE), 1)) { mn = m_reg; alpha = 1.f; }
    else { mn = fmaxf(m_reg, pmax); alpha = __builtin_amdgcn_exp2f((m_reg - mn) * C); m_reg = mn; }
    const float mnC = -mn * C;
#pragma unroll
    for (int r = 0; r < 16; ++r) p0[r] = fmaf(p0[r], C, mnC);
#pragma unroll
    for (int r = 0; r < 16; ++r) p1[r] = fmaf(p1[r], C, mnC);
#pragma unroll
    for (int r = 0; r < 16; ++r) p0[r] = __builtin_amdgcn_exp2f(p0[r]);
}
__device__ __forceinline__ void finishSM(f32x16& p0, f32x16& p1, float alpha, float& l_reg, bf16x8& pa0, bf16x8& pa1, bf16x8& pa2, bf16x8& pa3) {
#pragma unroll
    for (int r = 0; r < 16; ++r) p1[r] = __builtin_amdgcn_exp2f(p1[r]);
    float ps = 0;
#pragma unroll
    for (int r = 0; r < 16; ++r) ps += p0[r];
#pragma unroll
    for (int r = 0; r < 16; ++r) ps += p1[r];
    { auto rr = __builtin_amdgcn_permlane32_swap(__float_as_uint(ps), __float_as_uint(ps), false, false); ps = __uint_as_float(rr[0]) + __uint_as_float(rr[1]); }
    l_reg = l_reg * alpha + ps;
#define PK4(P, BASE, OUT) do { unsigned a0 = cvtpk(P[BASE + 0], P[BASE + 1]), a1 = cvtpk(P[BASE + 2], P[BASE + 3]);   \
    unsigned b0 = cvtpk(P[BASE + 4], P[BASE + 5]), b1 = cvtpk(P[BASE + 6], P[BASE + 7]);                              \
    auto r0 = __builtin_amdgcn_permlane32_swap(a0, b0, false, false); auto r1 = __builtin_amdgcn_permlane32_swap(a1, b1, false, false); \
    u32x4 w = {r0[0], r1[0], r0[1], r1[1]}; OUT = *reinterpret_cast<bf16x8*>(&w); } while (0)
    PK4(p0, 0, pa0); PK4(p0, 8, pa1); PK4(p1, 0, pa2); PK4(p1, 8, pa3);
#undef PK4
}
__device__ __forceinline__ void qkt(f32x16& p0, f32x16& p1, const char* Ks, const bf16x8* qr, int r32, int hi) {
    p0 = f32x16{}; p1 = f32x16{};
#pragma unroll
    for (int d0 = 0; d0 < 12; ++d0) { const int cb = (d0 * 16 + hi * 8) * 2;
        const bf16x8 b0 = *reinterpret_cast<const bf16x8*>(Ks + KSWZ(r32, cb));
        const bf16x8 b1 = *reinterpret_cast<const bf16x8*>(Ks + KSWZ(32 + r32, cb));
        p0 = __builtin_amdgcn_mfma_f32_32x32x16_bf16(b0, qr[d0], p0, 0, 0, 0);
        p1 = __builtin_amdgcn_mfma_f32_32x32x16_bf16(b1, qr[d0], p1, 0, 0, 0); }
}
__device__ __forceinline__ int v_st(int k, int c) { const int kk = (k & ~0xC) | ((k & 4) << 1) | ((k & 8) >> 1); return ((kk >> 3) * 4 + (c >> 5)) * 512 + ((kk & 7) * 32 + (c & 31)) * 2; }
__device__ __forceinline__ int v_rd_base(int lane) { return ((lane & 3) << 3) | (((lane >> 2) & 3) << 6) | (((lane >> 4) & 1) << 5) | (((lane >> 5) & 1) << 8); }
constexpr int v_rd_off(int d0, int ks, int half) { return d0 * 512 + ks * 4096 + half * 2048; }
template <int OFF> __device__ __forceinline__ s16x4 tr_read(int vb) { s16x4 r; asm volatile("ds_read_b64_tr_b16 %0, %1 offset:%2" : "=&v"(r) : "v"(vb), "i"(OFF) : "memory"); return r; }
template <int D0> __device__ __forceinline__ void pv_one(f32x16& od, int vb, bf16x8 pa0, bf16x8 pa1, bf16x8 pa2, bf16x8 pa3) {
    const s16x4 l0 = tr_read<v_rd_off(D0, 0, 0)>(vb), h0 = tr_read<v_rd_off(D0, 0, 1)>(vb), l1 = tr_read<v_rd_off(D0, 1, 0)>(vb), h1 = tr_read<v_rd_off(D0, 1, 1)>(vb);
    const s16x4 l2 = tr_read<v_rd_off(D0, 2, 0)>(vb), h2 = tr_read<v_rd_off(D0, 2, 1)>(vb), l3 = tr_read<v_rd_off(D0, 3, 0)>(vb), h3 = tr_read<v_rd_off(D0, 3, 1)>(vb);
    asm volatile("s_waitcnt lgkmcnt(0)" ::: "memory"); SBAR();
#define PK(L, H) (bf16x8){L[0], L[1], L[2], L[3], H[0], H[1], H[2], H[3]}
    od = __builtin_amdgcn_mfma_f32_32x32x16_bf16(pa0, PK(l0, h0), od, 0, 0, 0);
    od = __builtin_amdgcn_mfma_f32_32x32x16_bf16(pa1, PK(l1, h1), od, 0, 0, 0);
    od = __builtin_amdgcn_mfma_f32_32x32x16_bf16(pa2, PK(l2, h2), od, 0, 0, 0);
    od = __builtin_amdgcn_mfma_f32_32x32x16_bf16(pa3, PK(l3, h3), od, 0, 0, 0);
#undef PK
}
__device__ __forceinline__ void pv_d0(f32x16* o, int vb, bf16x8 pa0, bf16x8 pa1, bf16x8 pa2, bf16x8 pa3) {
    pv_one<0>(o[0], vb, pa0, pa1, pa2, pa3); pv_one<1>(o[1], vb, pa0, pa1, pa2, pa3); pv_one<2>(o[2], vb, pa0, pa1, pa2, pa3); pv_one<3>(o[3], vb, pa0, pa1, pa2, pa3);
}
__device__ __forceinline__ void attn_body(const u16* __restrict__ Qb, const u16* __restrict__ Kh, const u16* __restrict__ Vh, u16* __restrict__ Ob, int ldo, int seq, char* lds, int wv) {
    const int tid = tid_opaque(wv), wid = wv, lane = tid & 63, r32 = lane & 31, hi = lane >> 5;
    char* V_lds = lds; char* K_lds = lds + 2 * SHM_V;
    float* ws = (float*)(lds + 2 * SHM_V + 2 * SHM_K) + wid * 64; float* li_l = ws; float* al_l = ws + 32;
    float m_reg = -1e30f, l_reg = 0; f32x16 o[4] = {}; bf16x8 qr[12];
    const u16* Qw = Qb + (long)(wid * QBLK + r32) * QKD + hi * 8;
#pragma unroll
    for (int d0 = 0; d0 < 12; ++d0) qr[d0] = *reinterpret_cast<const bf16x8*>(Qw + d0 * 16);
    const int sr = tid >> 4, sc = (tid & 15) * 8, vst0 = v_st(sr, sc), vst1 = v_st(32 + sr, sc);
    const int kr0 = tid / 24, kc0 = tid % 24, kr1 = (tid + 512) / 24, kc1 = (tid + 512) % 24, kr2 = (tid + 1024) / 24, kc2 = (tid + 1024) % 24;
    const int kst0 = KSWZ(kr0, kc0 * 16), kst1 = KSWZ(kr1, kc1 * 16), kst2 = KSWZ(kr2, kc2 * 16);
    const int vb0 = (int)(uintptr_t)V_lds + v_rd_base(lane);
    bf16x8 vs0, vs1, ks0, ks1, ks2;
#define SLOAD(k0) do { vs0 = *reinterpret_cast<const bf16x8*>(&Vh[(long)((k0) + sr) * 128 + sc]); vs1 = *reinterpret_cast<const bf16x8*>(&Vh[(long)((k0) + 32 + sr) * 128 + sc]); \
    ks0 = *reinterpret_cast<const bf16x8*>(&Kh[(long)((k0) + kr0) * QKD + kc0 * 8]); ks1 = *reinterpret_cast<const bf16x8*>(&Kh[(long)((k0) + kr1) * QKD + kc1 * 8]); \
    ks2 = *reinterpret_cast<const bf16x8*>(&Kh[(long)((k0) + kr2) * QKD + kc2 * 8]); } while (0)
#define SWRITE(b) do { *(bf16x8*)(V_lds + (b) * SHM_V + vst0) = vs0; *(bf16x8*)(V_lds + (b) * SHM_V + vst1) = vs1; \
    *(bf16x8*)(K_lds + (b) * SHM_K + kst0) = ks0; *(bf16x8*)(K_lds + (b) * SHM_K + kst1) = ks1; *(bf16x8*)(K_lds + (b) * SHM_K + kst2) = ks2; } while (0)
#define SWAIT() asm volatile("s_waitcnt vmcnt(0)" ::: "memory")
#define RESC(a) do { if (__any((a) < 1.f)) { if (hi == 0) al_l[r32] = (a); asm volatile("s_waitcnt lgkmcnt(0)" ::: "memory"); \
    _Pragma("unroll") for (int d = 0; d < 4; ++d) _Pragma("unroll") for (int r = 0; r < 16; ++r) o[d][r] *= al_l[crow(r, hi)]; } } while (0)
    f32x16 p0, p1; float mn, al; bf16x8 pa0, pa1, pa2, pa3; const int NT = seq / KVBLK;
    SLOAD(0); SWAIT(); SWRITE(0); __syncthreads();
    for (int j = 0; j < NT; ++j) {
        const int cb = j & 1;
        if (j + 1 < NT) SLOAD((j + 1) * KVBLK);
        SBAR(); qkt(p0, p1, K_lds + cb * SHM_K, qr, r32, hi);
        partialSM(p0, p1, m_reg, mn, al); RESC(al);
        finishSM(p0, p1, al, l_reg, pa0, pa1, pa2, pa3); SBAR();
        pv_d0(o, vb0 + cb * SHM_V, pa0, pa1, pa2, pa3);
        if (j + 1 < NT) { SWAIT(); SWRITE(cb ^ 1); }
        __syncthreads();
    }
    if (hi == 0) li_l[r32] = l_reg; asm volatile("s_waitcnt lgkmcnt(0)" ::: "memory");
    float rli[16];
#pragma unroll
    for (int r = 0; r < 16; ++r) rli[r] = __builtin_amdgcn_rcpf(li_l[crow(r, hi)]);
    u16* Ow = Ob + (long)(wid * QBLK) * ldo;
#pragma unroll
    for (int r = 0; r < 16; ++r) { const int orow = crow(r, hi);
#pragma unroll
        for (int d0 = 0; d0 < 4; ++d0) Ow[(long)orow * ldo + d0 * 32 + r32] = f2bf(o[d0][r] * rli[r]); }
    __syncthreads();
#undef SLOAD
#undef SWRITE
#undef SWAIT
#undef RESC
}
#undef KSWZ
#undef SBAR
}
struct NormDst { float* X; u16* HX; u16* UH; unsigned* cnt; int* list; unsigned char* seli; unsigned char* selw; const float* xin; const float* cin; };
__device__ __forceinline__ NormDst norm_dst_real(unsigned char* ws, int li) {
    NormDst d; d.X = (float*)(ws + WS_X); d.HX = (u16*)(ws + WS_HX); d.UH = (u16*)(ws + WS_R1 + R1_UH); d.cnt = (unsigned*)(ws + WS_CTL) + CW_CNT + li * 32 * CS; d.list = (int*)(ws + WS_LIST); d.seli = ws + WS_SELI; d.selw = ws + WS_SELW; d.xin = nullptr; d.cin = nullptr; return d; }
__device__ __forceinline__ NormDst norm_dst_dummy(unsigned char* ws) {
    NormDst d; unsigned char* t = ws + WS_NTMP; d.X = (float*)t; d.HX = (u16*)(t + (size_t)T * D * 4); d.UH = d.HX; d.cnt = (unsigned*)(ws + WS_CTL) + CW_CNT_DUMMY; d.list = (int*)(t + (size_t)T * D * 4 + (size_t)64 * 2304 * 512 * 2);
    d.seli = (unsigned char*)(d.list + (size_t)64 * T); d.selw = d.seli + (size_t)T * 16; d.xin = nullptr; d.cin = nullptr; return d; }
__device__ __forceinline__ float bperm(float v, int srclane) { return __int_as_float(__builtin_amdgcn_ds_bpermute(srclane << 2, __float_as_int(v))); }
template <int MODE>
__device__ __forceinline__ void norm2_rows(unsigned char* ws, float* outp, const NormDst d, int li, int which, int* s_base, char* lds, int wv) {
    const float* sm = (const float*)(ws + WS_SMALL);
    const int tidn = tid_opaque(wv); const int lane = tidn & 63, wave = wv;
    const float* X = (const float*)(ws + WS_X);
    const float* mod = (const float*)(ws + WS_MOD);
    float* WG = (float*)lds;
    u16* WE = (u16*)(lds + 16384);
    __syncthreads();
    if (MODE & 1) { if (tidn == 0) { const unsigned* cnt = (const unsigned*)(ws + WS_CTL) + CW_CNT + (li - 1) * 32 * CS; int a = 0; for (int e = 0; e < 32; ++e) { s_base[e] = a; a += (int)((cnt[e * CS] + 255u) / 256u); } s_base[32] = a; } }
    if (MODE & 8) {
        const float* wg = sm + SM_WGROUP + (size_t)li * 4096; const float* we = sm + SM_WEXP + (size_t)li * 32768;
        for (int i = tidn; i < 4096 / 4; i += 512) *(float4*)(WG + 4 * i) = *(const float4*)(wg + 4 * i);
        for (int i = tidn; i < 32768 / 2; i += 512) { const float2 v = *(const float2*)(we + 2 * i); *(unsigned*)(WE + 2 * i) = g8::cvt_pk_bf16(v.x, v.y); }
    }
    __syncthreads();
    const bool lastl = (li == 3);
    const int rstride = gridDim.x * 8; const u16* YB = (const u16*)(ws + WS_YB); const u16* DL = (const u16*)(ws + WS_HX);
    float4 vA[4], vB[4]; int4 siA = make_int4(0, 0, 0, 0), siB = siA; float2 swA = make_float2(0.f, 0.f), swB = swA; uint2 dlA[4], dlB[4], yaB[4], ybB[4];
#define NR_LOAD_A(rw) do { if ((rw) < T) { const float* xs_ = X + (size_t)(rw) * D; if (MODE & 64) { const int b_ = (rw) / LTOT, p_ = (rw) % LTOT; xs_ = p_ < CTXL ? d.cin + ((size_t)b_ * CTXL + p_) * D : d.xin + ((size_t)b_ * SEQ + (p_ - CTXL)) * D; } \
        _Pragma("unroll") for (int q = 0; q < 4; ++q) vA[q] = *(const float4*)(xs_ + q * 256 + lane * 4); \
        if (MODE & 1) { siA = *(const int4*)(ws + WS_SELI + (size_t)(rw) * 16); swA = *(const float2*)(ws + WS_SELW + (size_t)(rw) * 8); } \
        if (MODE & 32) { _Pragma("unroll") for (int q = 0; q < 4; ++q) dlA[q] = *(const uint2*)(DL + (size_t)(rw) * D + q * 256 + lane * 4); } } } while (0)
#define NR_A_TO_B(rw) do { _Pragma("unroll") for (int q = 0; q < 4; ++q) { vB[q] = vA[q]; dlB[q] = dlA[q]; } siB = siA; swB = swA; \
        if ((MODE & 1) && (rw) < T && !((li - 1 == 3) && ((rw) % LTOT) < CTXL)) { const size_t g1 = (size_t)s_base[siB.x] * 256 + siB.y, g2 = (size_t)s_base[siB.z] * 256 + siB.w; \
            _Pragma("unroll") for (int q = 0; q < 4; ++q) { yaB[q] = *(const uint2*)(YB + g1 * 1024 + q * 256 + lane * 4); ybB[q] = *(const uint2*)(YB + g2 * 1024 + q * 256 + lane * 4); } } } while (0)
    const int row0 = blockIdx.x * 8 + wave;
    NR_LOAD_A(row0); NR_A_TO_B(row0); NR_LOAD_A(row0 + rstride);
    int rec_e1 = 0, rec_e2 = 0, rec_row = -1; float rec_w1 = 0.f, rec_w2 = 0.f; int it = -1;
    for (int row = row0; row < T; row += rstride) {
        ++it;
        const int b = row / LTOT, pos = row % LTOT; const bool isctx = pos < CTXL; const int r = isctx ? 16 : b;
        float4 v[4]; uint2 ya[4], yb[4], dl[4]; const float2 sw = swB;
#pragma unroll
        for (int q = 0; q < 4; ++q) { v[q] = vB[q]; ya[q] = yaB[q]; yb[q] = ybB[q]; dl[q] = dlB[q]; }
        NR_A_TO_B(row + rstride); NR_LOAD_A(row + 2 * rstride);
        if ((MODE & 16) && isctx) continue;
        if ((MODE & 8) && lastl && isctx) continue;
        if (MODE & 1) {
            const bool skip = (li - 1 == 3) && isctx;
            if (!skip) {
                const float* gate = mod + (size_t)((li - 1) * 17 + r) * 6144 + 5 * 1024;
#pragma unroll
                for (int q = 0; q < 4; ++q) { const int c = q * 256 + lane * 4; const float4 gg = *(const float4*)(gate + c);
                    v[q].x += gg.x * (sw.x * bf2f((u16)(ya[q].x & 0xffff)) + sw.y * bf2f((u16)(yb[q].x & 0xffff)));
                    v[q].y += gg.y * (sw.x * bf2f((u16)(ya[q].x >> 16)) + sw.y * bf2f((u16)(yb[q].x >> 16)));
                    v[q].z += gg.z * (sw.x * bf2f((u16)(ya[q].y & 0xffff)) + sw.y * bf2f((u16)(yb[q].y & 0xffff)));
                    v[q].w += gg.w * (sw.x * bf2f((u16)(ya[q].y >> 16)) + sw.y * bf2f((u16)(yb[q].y >> 16)));
                    if (!(MODE & 16)) *(float4*)(d.X + (size_t)row * D + c) = v[q]; }
            }
        }
        if (MODE & 32) {
#pragma unroll
            for (int q = 0; q < 4; ++q) { const int c = q * 256 + lane * 4;
                v[q].x += bf2f((u16)(dl[q].x & 0xffff)); v[q].y += bf2f((u16)(dl[q].x >> 16)); v[q].z += bf2f((u16)(dl[q].y & 0xffff)); v[q].w += bf2f((u16)(dl[q].y >> 16));
                *(float4*)(d.X + (size_t)row * D + c) = v[q]; }
        }
        float ss = 0.f;
#pragma unroll
        for (int q = 0; q < 4; ++q) ss += v[q].x * v[q].x + v[q].y * v[q].y + v[q].z * v[q].z + v[q].w * v[q].w;
        ss = wave_sum_l(ss, lane);
        const float rstd = rsqrtf(ss * (1.f / 1024.f) + EPS);
        if (MODE & 16) {
            float* out = outp + ((size_t)b * SEQ + (pos - CTXL)) * D;
#pragma unroll
            for (int q = 0; q < 4; ++q) { const int c = q * 256 + lane * 4; const float4 g = *(const float4*)(sm + SM_FINALG + c);
                *(float4*)(out + c) = make_float4(v[q].x * rstd * g.x, v[q].y * rstd * g.y, v[q].z * rstd * g.z, v[q].w * rstd * g.w); }
            continue;
        }
        const float* gv = sm + (which ? SM_GFFN : SM_GMIX) + li * 1024;
        const float* sh = mod + (size_t)(li * 17 + r) * 6144 + (which ? 3 : 0) * 1024; const float* scl = sh + 1024;
        float h[16];
#pragma unroll
        for (int q = 0; q < 4; ++q) { const int c = q * 256 + lane * 4; const float4 g = *(const float4*)(gv + c), s4 = *(const float4*)(sh + c), c4 = *(const float4*)(scl + c);
            h[q * 4 + 0] = v[q].x * rstd * g.x * (1.f + c4.x) + s4.x; h[q * 4 + 1] = v[q].y * rstd * g.y * (1.f + c4.y) + s4.y;
            h[q * 4 + 2] = v[q].z * rstd * g.z * (1.f + c4.z) + s4.z; h[q * 4 + 3] = v[q].w * rstd * g.w * (1.f + c4.w) + s4.w; }
        if (MODE & 2) {
#pragma unroll
            for (int q = 0; q < 4; ++q) { uint2 w; w.x = g8::cvt_pk_bf16(h[q * 4], h[q * 4 + 1]); w.y = g8::cvt_pk_bf16(h[q * 4 + 2], h[q * 4 + 3]);
                *(uint2*)(d.HX + (size_t)row * D + q * 256 + lane * 4) = w; }
        }
        if (MODE & 4) {
#pragma unroll
            for (int q = 0; q < 4; ++q) { const int c = q * 256 + lane * 4; const int g = c >> 4, ch = c & 15;
                uint2 w; w.x = g8::cvt_pk_bf16(h[q * 4], h[q * 4 + 1]); w.y = g8::cvt_pk_bf16(h[q * 4 + 2], h[q * 4 + 3]);
                *(uint2*)(d.UH + ((size_t)g * 2304 + b * 144 + (pos >> 4)) * 512 + (pos & 15) * 16 + ch) = w; }
        }
        if (MODE & 8) {
            float lg[4] = {0.f, 0.f, 0.f, 0.f};
#pragma unroll
            for (int q = 0; q < 4; ++q)
#pragma unroll
                for (int j = 0; j < 4; ++j) { const float4 w = *(const float4*)(WG + (q * 256 + lane * 4 + j) * 4); const float hv = h[q * 4 + j];
                    lg[0] += hv * w.x; lg[1] += hv * w.y; lg[2] += hv * w.z; lg[3] += hv * w.w; }
            { const bool hi5 = (lane & 32) != 0; float k0 = hi5 ? lg[2] : lg[0], k1 = hi5 ? lg[3] : lg[1]; const float s0 = hi5 ? lg[0] : lg[2], s1 = hi5 ? lg[1] : lg[3];
              k0 += bperm(s0, lane ^ 32); k1 += bperm(s1, lane ^ 32);
              const bool hi4 = (lane & 16) != 0; float kk = hi4 ? k1 : k0; const float sd = hi4 ? k0 : k1; kk += bperm(sd, lane ^ 16);
              kk += bperm(kk, lane ^ 8); kk += bperm(kk, lane ^ 4); kk += bperm(kk, lane ^ 2); kk += bperm(kk, lane ^ 1);
              lg[0] = __int_as_float(__builtin_amdgcn_readlane(__float_as_int(kk), 0)); lg[1] = __int_as_float(__builtin_amdgcn_readlane(__float_as_int(kk), 16));
              lg[2] = __int_as_float(__builtin_amdgcn_readlane(__float_as_int(kk), 32)); lg[3] = __int_as_float(__builtin_amdgcn_readlane(__float_as_int(kk), 48)); }
#pragma unroll
            for (int g = 0; g < 4; ++g) lg[g] += sm[SM_BGROUP + li * 4 + g];
            int gi = 0; float best = lg[0];
#pragma unroll
            for (int g = 1; g < 4; ++g) if (lg[g] > best) { best = lg[g]; gi = g; }
            float den = 0.f;
#pragma unroll
            for (int g = 0; g < 4; ++g) den += __expf(lg[g] - best);
            const float pg = 1.f / den;
            const u16* wes = WE + (size_t)gi * 8192;
            float le[8];
#pragma unroll
            for (int e = 0; e < 8; ++e) le[e] = 0.f;
#pragma unroll
            for (int q = 0; q < 4; ++q)
#pragma unroll
                for (int j = 0; j < 4; ++j) { const u32x4 w = *(const u32x4*)(wes + (q * 256 + lane * 4 + j) * 8); const float hv = h[q * 4 + j];
                    le[0] += hv * __uint_as_float(w.x << 16); le[1] += hv * __uint_as_float(w.x & 0xffff0000u); le[2] += hv * __uint_as_float(w.y << 16); le[3] += hv * __uint_as_float(w.y & 0xffff0000u);
                    le[4] += hv * __uint_as_float(w.z << 16); le[5] += hv * __uint_as_float(w.z & 0xffff0000u); le[6] += hv * __uint_as_float(w.w << 16); le[7] += hv * __uint_as_float(w.w & 0xffff0000u); }
            { const bool hi5 = (lane & 32) != 0; float k[4]; float s[4];
#pragma unroll
              for (int i = 0; i < 4; ++i) { k[i] = hi5 ? le[4 + i] : le[i]; s[i] = hi5 ? le[i] : le[4 + i]; }
#pragma unroll
              for (int i = 0; i < 4; ++i) k[i] += bperm(s[i], lane ^ 32);
              const bool hi4 = (lane & 16) != 0; float k2[2], s2[2];
#pragma unroll
              for (int i = 0; i < 2; ++i) { k2[i] = hi4 ? k[2 + i] : k[i]; s2[i] = hi4 ? k[i] : k[2 + i]; }
#pragma unroll
              for (int i = 0; i < 2; ++i) k2[i] += bperm(s2[i], lane ^ 16);
              const bool hi3 = (lane & 8) != 0; float kk = hi3 ? k2[1] : k2[0]; const float sd = hi3 ? k2[0] : k2[1]; kk += bperm(sd, lane ^ 8);
              kk += bperm(kk, lane ^ 4); kk += bperm(kk, lane ^ 2); kk += bperm(kk, lane ^ 1);
#pragma unroll
              for (int e = 0; e < 8; ++e) le[e] = __int_as_float(__builtin_amdgcn_readlane(__float_as_int(kk), e * 8)); }
#pragma unroll
            for (int e = 0; e < 8; ++e) le[e] += sm[SM_BEXP + (li * 4 + gi) * 8 + e];
            int i1 = 0; float b1 = le[0];
#pragma unroll
            for (int e = 1; e < 8; ++e) if (le[e] > b1) { b1 = le[e]; i1 = e; }
            int i2 = -1; float b2 = -3.0e38f;
#pragma unroll
            for (int e = 0; e < 8; ++e) if (e != i1 && le[e] > b2) { b2 = le[e]; i2 = e; }
            { const float ex = __expf(b2 - b1); const float w1 = 1.f / (1.f + ex), w2 = ex / (1.f + ex);
              if (lane == it) { rec_e1 = gi * 8 + i1; rec_e2 = gi * 8 + i2; rec_w1 = pg * w1; rec_w2 = pg * w2; rec_row = row; } }
        }
    }
    if (MODE & 8) {
        if (rec_row >= 0) {
            const int s1 = (int)atomicAdd(&d.cnt[rec_e1 * CS], 1u), s2 = (int)atomicAdd(&d.cnt[rec_e2 * CS], 1u);
            d.list[(size_t)rec_e1 * T + s1] = rec_row; d.list[(size_t)rec_e2 * T + s2] = rec_row;
            *(int4*)(d.seli + (size_t)rec_row * 16) = make_int4(rec_e1, s1, rec_e2, s2);
            *(float2*)(d.selw + (size_t)rec_row * 8) = make_float2(rec_w1, rec_w2);
        }
    }
#undef NR_LOAD_A
#undef NR_A_TO_B
}
#define XB_TMO      128
#define XB_XCNT(j)  (256  + 64 * (j))
#define XB_XSUB(j)  (1280 + 64 * (j))
#define XB_XGEN(j)  (2304 + 64 * (j))
#define XB_TOP      3328
#define XB_TOPGEN   3392
#define XCD_BAR_WORDS 3456
#define XB_SPIN_CAP (1u << 18)
__device__ __forceinline__ unsigned xb_ld(unsigned* p)              { return __hip_atomic_load(p, __ATOMIC_RELAXED, __HIP_MEMORY_SCOPE_AGENT); }
__device__ __forceinline__ unsigned xb_add(unsigned* p, unsigned v) { return __hip_atomic_fetch_add(p, v, __ATOMIC_RELAXED, __HIP_MEMORY_SCOPE_AGENT); }
__device__ __forceinline__ unsigned xb_xcc_id() { return (unsigned)__builtin_amdgcn_s_getreg((3 << 11) | 20) & 0xFu; }
#define XB_SPIN(cond, bar) do { unsigned _sp = 0; while (cond) { __builtin_amdgcn_s_sleep(1); \
    if ((++_sp & 255u) == 0u) { if (xb_ld(&(bar)[XB_TMO])) break; if (_sp > XB_SPIN_CAP) { atomicAdd(&(bar)[XB_TMO], 1u); break; } } } } while (0)
struct XcdBarrier { unsigned* bar; unsigned x; volatile LAS unsigned* st; };
__device__ __forceinline__ XcdBarrier xcd_barrier_post(unsigned* bar, volatile LAS unsigned* st) {
    XcdBarrier b; b.bar = bar; b.x = xb_xcc_id(); b.st = st;
    if (threadIdx.x == 0) (void)xb_add(&bar[XB_XCNT(b.x)], 1u);
    return b;
}
__device__ __forceinline__ void xcd_barrier_complete(unsigned* bar, unsigned x, unsigned& nloc, unsigned& nx) {
    const unsigned G = gridDim.x * gridDim.y * gridDim.z;
    unsigned sum, cnt, mine, sp = 0u;
    for (;;) {
        sum = 0u; cnt = 0u; mine = 0u;
#pragma unroll
        for (unsigned j = 0; j < 16; ++j) { const unsigned c = xb_ld(&bar[XB_XCNT(j)]); sum += c; cnt += (c > 0u) ? 1u : 0u; mine = (j == x) ? c : mine; }
        if (sum == G) break;
        __builtin_amdgcn_s_sleep(1);
        if ((++sp & 255u) == 0u) { if (xb_ld(&bar[XB_TMO])) break; if (sp > XB_SPIN_CAP) { atomicAdd(&bar[XB_TMO], 1u); break; } }
    }
    nloc = mine > 0u ? mine : 1u; nx = cnt > 0u ? cnt : 1u;
}
__device__ __forceinline__ void xcd_barrier(const XcdBarrier& b, const int tid) {
    asm volatile("s_waitcnt vmcnt(0)" ::: "memory");
    __syncthreads();
    if (tid == 0) {
        unsigned* bar = b.bar;
        __builtin_amdgcn_s_waitcnt(0);
        unsigned nloc = b.st[0], nx = b.st[1];
        if (nloc == 0u) { xcd_barrier_complete(bar, b.x, nloc, nx); b.st[0] = nloc; b.st[1] = nx; }
        const unsigned old = xb_add(&bar[XB_XSUB(b.x)], 1u);
        const unsigned gen = old / nloc;
        if (old + 1u == (gen + 1u) * nloc) {
            __builtin_amdgcn_fence(__ATOMIC_RELEASE, "agent");
            asm volatile("s_waitcnt vmcnt(0)" ::: "memory");
            const unsigned og = xb_add(&bar[XB_TOP], 1u);
            const unsigned tg = og / nx;
            if (og + 1u == (tg + 1u) * nx) xb_add(&bar[XB_TOPGEN], 1u);
            else XB_SPIN(xb_ld(&bar[XB_TOPGEN]) == tg, bar);
            __builtin_amdgcn_fence(__ATOMIC_ACQUIRE, "agent");
            xb_add(&bar[XB_XGEN(b.x)], 1u);
            asm volatile("s_waitcnt vmcnt(0)" ::: "memory");
        } else {
            XB_SPIN(xb_ld(&bar[XB_XGEN(b.x)]) == gen, bar);
            __builtin_amdgcn_fence(__ATOMIC_ACQUIRE, "agent");
            asm volatile("s_waitcnt vmcnt(0)" ::: "memory");
        }
    }
    __syncthreads();
}

struct CvtSeg { int in_idx, nmat, K, N, NP, map; size_t dst_off; };
__device__ __forceinline__ void cvt_tile(const float* __restrict__ src, u16* __restrict__ dst, int K, int N, int NP, int map, int t, LAS unsigned* slab, int lane) {
    const int kt_n = K / 64, nt_n = N / 64, per = kt_n * nt_n;
    const int mat = t / per, rem = t % per, nt = rem / kt_n, kt = rem % kt_n;
    const float* s = src + ((size_t)mat * K + (size_t)kt * 64) * N + nt * 64 + lane;
    float v[64];
#pragma unroll
    for (int k = 0; k < 64; ++k) v[k] = s[(size_t)k * N];
#pragma unroll
    for (int q = 0; q < 8; ++q) { u32x4 w; w.x = g8::cvt_pk_bf16(v[q * 8], v[q * 8 + 1]); w.y = g8::cvt_pk_bf16(v[q * 8 + 2], v[q * 8 + 3]); w.z = g8::cvt_pk_bf16(v[q * 8 + 4], v[q * 8 + 5]); w.w = g8::cvt_pk_bf16(v[q * 8 + 6], v[q * 8 + 7]);
        *(LAS u32x4*)(slab + lane * 36 + q * 4) = w; }
#pragma unroll
    for (int i = 0; i < 8; ++i) { const int rl = i * 8 + (lane >> 3); const u32x4 w = *(const LAS u32x4*)(slab + rl * 36 + (lane & 7) * 4);
        const int n = nt * 64 + rl; int np = n;
        if (map) { const int half = N / 2; const int which = n >= half ? 1 : 0; const int j = n - which * half; np = (j / 128) * 256 + which * 128 + (j % 128); }
        *(u32x4*)(dst + ((size_t)mat * NP + np) * K + kt * 64 + (lane & 7) * 8) = w; }
}
__device__ __forceinline__ void mod_task(const Ptrs& P, char* lds, int task) {
    float* sc = (float*)lds;
    float* mod = (float*)(P.ws + WS_MOD);
    const int tid = threadIdx.x, cq = tid & 63, kg = tid >> 6;
    __syncthreads();
    for (int idx = tid; idx < 17 * 1024; idx += 512) { const int r = idx >> 10, kk = idx & 1023; const float v = r < 16 ? P.in[1][r * 1024 + kk] : P.in[3][kk]; sc[idx] = silu_f(v); }
    __syncthreads();
    const int i = task / 24, cc = task % 24; const int col = cc * 256 + cq * 4;
    const float* W = P.in[4] + ((size_t)i * 1024 + kg * 128) * 6144 + col;
    f32x4 acc[17];
#pragma unroll
    for (int r = 0; r < 17; ++r) acc[r] = (f32x4){0.f, 0.f, 0.f, 0.f};
#pragma unroll 8
    for (int kk = 0; kk < 128; ++kk) { const f32x4 w = *(const f32x4*)(W + (size_t)kk * 6144);
#pragma unroll
        for (int r = 0; r < 17; ++r) acc[r] += w * sc[r * 1024 + kg * 128 + kk]; }
    float* red2 = sc;
    __syncthreads();
#pragma unroll
    for (int pass = 0; pass < 2; ++pass) {
#pragma unroll
        for (int r = 0; r < 9; ++r) if (pass * 9 + r < 17) *(f32x4*)(red2 + ((kg * 9 + r) * 256 + cq * 4)) = acc[pass * 9 + r < 17 ? pass * 9 + r : 0];
        __syncthreads();
        for (int idx = tid; idx < 9 * 256; idx += 512) { const int rr = idx >> 8, c = idx & 255, r = pass * 9 + rr;
            if (r < 17) { float s = P.in[5][i * 6144 + cc * 256 + c];
#pragma unroll
                for (int g = 0; g < 8; ++g) s += red2[(g * 9 + rr) * 256 + c];
                mod[(size_t)(i * 17 + r) * 6144 + cc * 256 + c] = s; } }
        __syncthreads();
    }
}
__device__ __forceinline__ void s5_prep(const Ptrs& P, int j, int g, char* lds) {
    float2* Apow = (float2*)lds;
    float2* Bb = Apow + 2 * 64 * 17;
    float2* Cc = Bb + 2 * 64 * 16;
    float* Kt = (float*)(Cc + 2 * 16 * 64);
    const int tid = threadIdx.x;
    __syncthreads();
    if (tid < 128) { const int dir = tid >> 6, p = tid & 63; const size_t gd = ((size_t)j * 2 + dir) * SG + g;
        const float dt = __expf(P.in[10][gd]); const float ar = P.in[8][gd * SP + p], ai = P.in[9][gd * SP + p]; const float ldr = ar * dt, ldi = ai * dt;
        for (int tau = 0; tau <= 16; ++tau) { const float mag = __expf(ldr * (float)tau), ang = ldi * (float)tau; Apow[(dir * 64 + p) * 17 + tau] = make_float2(mag * __cosf(ang), mag * __sinf(ang)); }
        const float2 ab = Apow[(dir * 64 + p) * 17 + 1]; const float nr = ab.x - 1.f, ni = ab.y, den = ar * ar + ai * ai; const float qr = (nr * ar + ni * ai) / den, qi = (ni * ar - nr * ai) / den;
        for (int c = 0; c < 16; ++c) { const float br = P.in[11][(gd * SP + p) * SC + c], bi = P.in[12][(gd * SP + p) * SC + c]; Bb[(dir * 64 + p) * 16 + c] = make_float2(qr * br - qi * bi, qr * bi + qi * br); }
        ((float2*)(P.ws + WS_WB + WB_AT))[gd * SP + p] = Apow[(dir * 64 + p) * 17 + 16];
    }
    for (int i = tid; i < 2 * 16 * 64; i += 512) { const int d2 = i >> 10, c = (i >> 6) & 15, pp = i & 63; const size_t o = ((((size_t)j * 2 + d2) * SG + g) * SC + c) * SP + pp; Cc[i] = make_float2(P.in[13][o], P.in[14][o]); }
    __syncthreads();
    for (int idx = tid; idx < 8192; idx += 512) { const int dir = idx >> 12, tau = (idx >> 8) & 15, c = (idx >> 4) & 15, c2 = idx & 15; float s = 0.f;
        for (int p = 0; p < 64; ++p) { const float2 cc = Cc[(dir * 16 + c) * 64 + p], aa = Apow[(dir * 64 + p) * 17 + tau], bb = Bb[(dir * 64 + p) * 16 + c2];
            const float xr = aa.x * bb.x - aa.y * bb.y, xi = aa.x * bb.y + aa.y * bb.x; s += cc.x * xr - cc.y * xi; }
        Kt[idx] = s; }
    __syncthreads();
    u16* W1 = (u16*)(P.ws + WS_WB + WB_W1) + ((size_t)j * 64 + g) * 256 * 256; u16* W2 = (u16*)(P.ws + WS_WB + WB_W2) + ((size_t)j * 64 + g) * 256 * 512;
    for (int idx = tid; idx < 256 * 32; idx += 512) { const int row = idx >> 5, s8 = idx & 31; const int t = row >> 4, c = row & 15, s = s8 >> 1, cb = (s8 & 1) * 8;
        float v[8];
#pragma unroll
        for (int q = 0; q < 8; ++q) { const int c2 = cb + q;
            v[q] = s < t ? Kt[((0 * 16 + (t - s)) * 16 + c) * 16 + c2] : s > t ? Kt[((1 * 16 + (s - t)) * 16 + c) * 16 + c2] : Kt[((0 * 16 + 0) * 16 + c) * 16 + c2] + Kt[((1 * 16 + 0) * 16 + c) * 16 + c2]; }
        u32x4 w; w.x = g8::cvt_pk_bf16(v[0], v[1]); w.y = g8::cvt_pk_bf16(v[2], v[3]); w.z = g8::cvt_pk_bf16(v[4], v[5]); w.w = g8::cvt_pk_bf16(v[6], v[7]);
        *(u32x4*)(W2 + (size_t)row * 512 + s8 * 8) = w; }
    for (int idx = tid; idx < 256 * 128; idx += 512) { const int row = idx >> 7, dp = idx & 127; const int dir = dp >> 6, p = dp & 63, t = row >> 4, c = row & 15;
        const float2 cc = Cc[(dir * 16 + c) * 64 + p], aa = Apow[(dir * 64 + p) * 17 + (dir ? 16 - t : t + 1)];
        const float gr = cc.x * aa.x - cc.y * aa.y, gi = cc.x * aa.y + cc.y * aa.x;
        *(unsigned*)(W2 + (size_t)row * 512 + 256 + dir * 128 + 2 * p) = g8::cvt_pk_bf16(gr, -gi); }
    for (int idx = tid; idx < 256 * 32; idx += 512) { const int n = idx >> 5, s8 = idx & 31; const int dir = n >> 7, p = (n >> 1) & 63, ri = n & 1, s = s8 >> 1, cb = (s8 & 1) * 8;
        const float2 aa = Apow[(dir * 64 + p) * 17 + (dir ? s : 15 - s)];
        float v[8];
#pragma unroll
        for (int q = 0; q < 8; ++q) { const float2 bb = Bb[(dir * 64 + p) * 16 + cb + q]; v[q] = ri ? aa.x * bb.y + aa.y * bb.x : aa.x * bb.x - aa.y * bb.y; }
        u32x4 w; w.x = g8::cvt_pk_bf16(v[0], v[1]); w.y = g8::cvt_pk_bf16(v[2], v[3]); w.z = g8::cvt_pk_bf16(v[4], v[5]); w.w = g8::cvt_pk_bf16(v[6], v[7]);
        *(u32x4*)(W1 + (size_t)n * 256 + s8 * 8) = w; }
    __syncthreads();
}
__device__ __forceinline__ void prologue_phase(const Ptrs& P, char* lds, const int parts) {
    if (parts & 1) {
        copy_small(P, blockIdx.x * 512 + threadIdx.x, gridDim.x * 512);
        float2* rope = (float2*)(P.ws + WS_ROPE);
        for (int i = blockIdx.x * 512 + threadIdx.x; i < 2048 * 32; i += gridDim.x * 512) { const int s = i >> 5, k = i & 31, f = k & 15; const float invf = exp2f(-(float)f * (13.287712379549449f / 16.f));
            const float ang = (float)(k < 16 ? (s >> 6) : (s & 63)) * invf; rope[i] = make_float2(__cosf(ang), __sinf(ang)); }
        unsigned char* wb = P.ws + WS_WB;
        for (int i = blockIdx.x * 512 + threadIdx.x; i < 2 * 64 * 1024 / 8; i += gridDim.x * 512) { const int mat = i / 8192, r = i % 8192; *(u32x4*)((u16*)(wb + WB_WIN) + ((size_t)mat * 768 + 704) * 1024 + (size_t)r * 8) = (u32x4){0u, 0u, 0u, 0u}; }
    }
    if (parts & 2) for (int task = blockIdx.x; task < 96; task += gridDim.x) mod_task(P, lds, task);
    if (parts & 4) for (int idx = (int)blockIdx.x - 96; idx >= 0 && idx < 128; idx += gridDim.x) s5_prep(P, idx >> 6, idx & 63, lds);
    if (parts & 24) {
        const CvtSeg seg[7] = { {16, 2, 1024, 2048, 2048, 1, WB_GLU}, {17, 2, 1024, 704, 768, 0, WB_WIN}, {20, 2, 384, 1536, 1536, 0, WB_UQ}, {21, 2, 256, 2048, 2048, 0, WB_UKV}, {22, 2, 1024, 1024, 1024, 0, WB_WO},
                                {27, 128, 1024, 1024, 1024, 1, WB_GU}, {28, 128, 512, 1024, 1024, 0, WB_DN} };
        __syncthreads();
        const int lane = threadIdx.x & 63, wv = threadIdx.x >> 6;
        LAS unsigned* slab = (LAS unsigned*)((LAS unsigned char*)lds) + wv * (64 * 36);
        unsigned* qhead = (unsigned*)(P.ws + WS_CTL) + CW_QUEUE + ((parts >> 5) & 7) * 64;
        int tstart[8]; tstart[0] = 0;
#pragma unroll
        for (int s = 0; s < 7; ++s) tstart[s + 1] = tstart[s] + seg[s].nmat * (seg[s].K / 64) * (seg[s].N / 64);
        const int ntot = tstart[7], nchunk = (ntot + 7) / 8;
        for (;;) {
            unsigned c = 0; if (lane == 0) c = atomicAdd(qhead, 1u);
            c = (unsigned)__builtin_amdgcn_readfirstlane((int)c);
            if ((int)c >= nchunk) break;
            for (int t = (int)c * 8; t < (int)c * 8 + 8 && t < ntot; ++t) {
                int s = 0;
#pragma unroll
                for (int k = 1; k < 7; ++k) s = (t >= tstart[k]) ? k : s;
                int in_idx = 0, K = 0, N = 0, NP = 0, map = 0, t0 = 0; size_t doff = 0;
#pragma unroll
                for (int k = 0; k < 7; ++k) if (s == k) { in_idx = seg[k].in_idx; K = seg[k].K; N = seg[k].N; NP = seg[k].NP; map = seg[k].map; doff = seg[k].dst_off; t0 = tstart[k]; }
                cvt_tile(P.in[in_idx], (u16*)(P.ws + WS_WB + doff), K, N, NP, map, t - t0, slab, lane);
            }
        }
        __syncthreads();
    }
}
__device__ __forceinline__ void s5_scan_phase(unsigned char* wsp, int j, int wv) {
    struct { unsigned char* ws; } P{wsp};
    const int tids = tid_opaque(wv); const int lane = tids & 63;
    const float* S = (const float*)(P.ws + WS_R1 + R1_S); u16* UH = (u16*)(P.ws + WS_R1 + R1_UH); const float2* AT = (const float2*)(P.ws + WS_WB + WB_AT);
    for (int task = blockIdx.x * 8 + (tids >> 6); task < 2048; task += gridDim.x * 8) {
        const int g = task >> 5, b = (task >> 1) & 15, dir = task & 1;
        const float2 a = AT[(((size_t)j * 2 + dir) * SG + g) * SP + lane];
        const float* sp = S + ((size_t)g * 2304 + b * 144) * 256 + dir * 128 + 2 * lane; u16* hp = UH + ((size_t)g * 2304 + b * 144) * 512 + 256 + dir * 128 + 2 * lane;
        float hr = 0.f, hi = 0.f;
        for (int s0 = 0; s0 < 144; s0 += 16) {
            float2 sv[16];
#pragma unroll
            for (int k = 0; k < 16; ++k) { const int st = s0 + k; const int n = dir ? (st < 16 ? 15 - st : 159 - st) : st; sv[k] = *(const float2*)(sp + (size_t)n * 256); }
#pragma unroll
            for (int k = 0; k < 16; ++k) { const int st = s0 + k; const int n = dir ? (st < 16 ? 15 - st : 159 - st) : st;
                *(unsigned*)(hp + (size_t)n * 512) = g8::cvt_pk_bf16(hr, hi);
                const float nr = a.x * hr - a.y * hi + sv[k].x, ni = a.x * hi + a.y * hr + sv[k].y; hr = nr; hi = ni; }
        }
    }
}
__device__ __forceinline__ void mla_post_rows(unsigned char* wsp, int j, const float* Pm, int stride, int nwaves_blk, int wv) {
    struct { unsigned char* ws; } P{wsp}; const float* sm = (const float*)(wsp + WS_SMALL);
    const int tidp = tid_opaque(wv); const int lane = tidp & 63, wave = tidp >> 6;
    u16* CQ = (u16*)(P.ws + WS_CQ); u16* CKV = (u16*)(P.ws + WS_CKV); u16* KT = (u16*)(P.ws + WS_R1 + R1_KT); const float2* rope = (const float2*)(P.ws + WS_ROPE);
    for (int row = blockIdx.x * nwaves_blk + wave; row < T; row += gridDim.x * nwaves_blk) {
        const float* t = Pm + (size_t)row * stride; const int b = row / LTOT, pos = row % LTOT;
        float q[6]; float ss = 0.f;
#pragma unroll
        for (int i = 0; i < 6; ++i) { q[i] = t[i * 64 + lane]; ss += q[i] * q[i]; }
        ss = wave_sum_l(ss, lane); float rstd = rsqrtf(ss * (1.f / 384.f) + EPS);
#pragma unroll
        for (int i = 0; i < 6; ++i) CQ[(size_t)row * QR + i * 64 + lane] = f2bf(q[i] * rstd * sm[SM_GQ + j * QR + i * 64 + lane]);
        float k[4]; ss = 0.f;
#pragma unroll
        for (int i = 0; i < 4; ++i) { k[i] = t[384 + i * 64 + lane]; ss += k[i] * k[i]; }
        ss = wave_sum_l(ss, lane); rstd = rsqrtf(ss * (1.f / 256.f) + EPS);
#pragma unroll
        for (int i = 0; i < 4; ++i) CKV[(size_t)row * KVR + i * 64 + lane] = f2bf(k[i] * rstd * sm[SM_GKV + j * KVR + i * 64 + lane]);
        float v = t[640 + lane];
        if (pos >= CTXL) { const float pv = t[640 + (lane ^ 16)]; const float2 cs = rope[(size_t)(pos - CTXL) * 32 + (lane >> 5) * 16 + (lane & 15)];
            v = (lane & 16) ? v * cs.x + pv * cs.y : v * cs.x - pv * cs.y; }
        const u16 kb = f2bf(v);
#pragma unroll
        for (int h = 0; h < NH; ++h) KT[(((size_t)b * NH + h) * LTOT + pos) * QKD + 128 + lane] = kb;
    }
}
__device__ __forceinline__ void attn_phase(unsigned char* wsp, bool ctx_out, char* lds, int wv) {
    struct { unsigned char* ws; } P{wsp};
    const u16* QT = (const u16*)(P.ws + WS_R1 + R1_QT); const u16* KT = (const u16*)(P.ws + WS_R1 + R1_KT); const u16* VT = (const u16*)(P.ws + WS_R1 + R1_VT); u16* O = (u16*)(P.ws + WS_ZO);
    const int nunits = ctx_out ? 1152 : 1024;
    for (int u = blockIdx.x; u < nunits; u += gridDim.x) {
        int bh, qt, seq;
        if (u < 1024) { const int xcd = u & 7, k = u >> 3; bh = xcd * 16 + (k >> 3); qt = 1 + (k & 7); seq = LTOT; } else { bh = u - 1024; qt = 0; seq = CTXL; }
        const int b = bh >> 3, h = bh & 7;
        at::attn_body(QT + ((size_t)bh * LTOT + qt * 256) * QKD, KT + (size_t)bh * LTOT * QKD, VT + (size_t)bh * LTOT * 128, O + ((size_t)b * LTOT + qt * 256) * D + h * 128, D, seq, lds, wv);
    }
}
constexpr int LDS_MISC = g8::STAGE_BYTES;
constexpr int LDS_BYTES = g8::STAGE_BYTES + 1024;
constexpr int NPHASE = 42;
struct MkArgs { Ptrs P; int lo, hi, bar_region, pad; };
__device__ __forceinline__ int lo_opq(int v) { asm volatile("" : "+s"(v)); return v; }
__global__ void __launch_bounds__(512, 2) mk(MkArgs a) {
    extern __shared__ __attribute__((aligned(16))) unsigned char lds[];
    LAS unsigned char* ldsl = (LAS unsigned char*)lds;
    volatile LAS unsigned* misc = (volatile LAS unsigned*)(ldsl + LDS_MISC);
    int* sbase = (int*)(lds + LDS_MISC + 64);
    const int wv = __builtin_amdgcn_readfirstlane(threadIdx.x >> 6);
    if (threadIdx.x < 4) misc[threadIdx.x] = 0u;
    __syncthreads();
#if defined(MK_FULL)
    const bool use_bar = true;
#else
    const bool use_bar = (a.hi - a.lo) > 1;
#endif
    unsigned char* ws = a.P.ws; float* outp = a.P.out;
    XcdBarrier bar; bar.bar = (unsigned*)(ws + WS_CTL) + a.bar_region * XCD_BAR_WORDS; bar.x = 0; bar.st = misc;
    if (use_bar) bar = xcd_barrier_post((unsigned*)(ws + WS_CTL) + a.bar_region * XCD_BAR_WORDS, misc);
    const int lo = a.lo, hi = a.hi;
#if defined(MK_FULL)
#define IN(k) (true)
#else
#define IN(k) (lo_opq(lo) <= (k) && (k) < lo_opq(hi))
#endif
#ifndef REP_GROUP
#define REP_GROUP (-1)
#define REP_N 1
#endif
#define NDST(li, g) (((g) == REP_GROUP && rep_ + 1 < REP_N) ? norm_dst_dummy(ws) : norm_dst_real(ws, li))
#define REP(g) for (int rep_ = 0; rep_ < ((g) == REP_GROUP ? REP_N : 1); ++rep_)
#if defined(PROBE_A)
#define STAMP(s) do { if (blockIdx.x == 0 && tid_opaque(wv) == 0) ((unsigned long long*)(ws0 + WS_CTL))[CW_STAMP64 + (s)] = __builtin_amdgcn_s_memrealtime(); } while (0)
#else
#define STAMP(s) do { } while (0)
#endif
#define SEAM(k) do { if (IN((k) + 1)) xcd_barrier(bar, tid_opaque(wv)); STAMP((k) + 1); } while (0)
    unsigned char* const ws0 = ws;
    STAMP(0);
#ifndef PRO_PART
#define PRO_PART 31
#endif
    if (IN(0)) REP(0) { prologue_phase(a.P, (char*)lds, (rep_ + 1 < ((0) == REP_GROUP ? REP_N : 1)) ? (PRO_PART | ((rep_ + 1) << 5)) : 31); SEAM(0); }

    {
        constexpr int li = 0; constexpr int base = 1 + li * 10, j = li >> 1;
#define PH_BEGIN size_t zoff_ = 0; asm volatile("" : "+s"(zoff_)); unsigned char* ws = ws0 + zoff_; unsigned char* wb = ws + WS_WB; const float* sm = (const float*)(ws + WS_SMALL); float* X = (float*)(ws + WS_X); const float* mod = (const float*)(ws + WS_MOD); (void)wb; (void)sm; (void)X; (void)mod;
        if ((li & 1) == 0) {
            if (IN(base + 0)) REP(1) { PH_BEGIN NormDst nd = NDST(li, 1); if (li == 0) { nd.xin = a.P.in[0]; nd.cin = a.P.in[2]; norm2_rows<4 | 64>(ws, outp, nd, li, 0, sbase, (char*)lds, wv); } else norm2_rows<5>(ws, outp, nd, li, 0, sbase, (char*)lds, wv); SEAM(base + 0); }
            if (IN(base + 1)) REP(3) { PH_BEGIN SchedS5 S; S.init(ws + WS_R1 + R1_UH, wb + WB_W1 + (size_t)j * 64 * 256 * 256 * 2, 256); EpiS5a E{(float*)(ws + WS_R1 + R1_S)};
                g8::gemm_phase<EpiS5a, SchedS5>(ldsl, 256, S, E, wv); SEAM(base + 1); }
            if (IN(base + 2)) REP(3) { PH_BEGIN s5_scan_phase(ws, j, wv); SEAM(base + 2); }
            if (IN(base + 3)) REP(3) { PH_BEGIN SchedS5 S; S.init(ws + WS_R1 + R1_UH, wb + WB_W2 + (size_t)j * 64 * 256 * 512 * 2, 512); EpiS5b E{(u16*)(ws + WS_ZO), (const u16*)(ws + WS_R1 + R1_UH), sm + SM_S5D + j * 1024};
                g8::gemm_phase<EpiS5b, SchedS5>(ldsl, 512, S, E, wv); SEAM(base + 3); }
            if (IN(base + 4)) REP(4) { PH_BEGIN SchedDense S; S.init(ws + WS_ZO, 1024, wb + WB_GLU + (size_t)j * 2048 * 1024 * 2, T, 2048, 1024); EpiGlu E{(u16*)(ws + WS_HX), mod, li};
                g8::gemm_phase<EpiGlu, SchedDense>(ldsl, 1024, S, E, wv); SEAM(base + 4); }
        } else {
            if (IN(base + 0)) REP(1) { PH_BEGIN const NormDst nd = NDST(li, 1); norm2_rows<3>(ws, outp, nd, li, 0, sbase, (char*)lds, wv); SEAM(base + 0); }
            if (IN(base + 1)) REP(5) { PH_BEGIN SchedDense S; S.init(ws + WS_HX, 1024, wb + WB_WIN + (size_t)j * 768 * 1024 * 2, T, 768, 1024); EpiF32 E{(float*)(ws + WS_YB), 768};
                g8::gemm_phase<EpiF32, SchedDense>(ldsl, 1024, S, E, wv); SEAM(base + 1); }
            if (IN(base + 2)) REP(5) { PH_BEGIN mla_post_rows(ws, j, (const float*)(ws + WS_YB), 768, 8, wv); SEAM(base + 2); }
            if (IN(base + 3)) REP(5) { PH_BEGIN
                { SchedDense S; S.init(ws + WS_CQ, QR, wb + WB_UQ + (size_t)j * 1536 * 384 * 2, T, 1536, 384); EpiQ E{(u16*)(ws + WS_R1 + R1_QT), (const float2*)(ws + WS_ROPE)};
                  g8::gemm_phase<EpiQ, SchedDense>(ldsl, 384, S, E, wv); }
                { SchedDense S; S.init(ws + WS_CKV, KVR, wb + WB_UKV + (size_t)j * 2048 * 256 * 2, T, 2048, 256); EpiKV E{(u16*)(ws + WS_R1 + R1_KT), (u16*)(ws + WS_R1 + R1_VT)};
                  int kk_ = 256; asm volatile("" : "+s"(kk_)); g8::gemm_phase<EpiKV, SchedDense>(ldsl, kk_, S, E, wv); }
                SEAM(base + 3); }
            if (IN(base + 4)) REP(6) { PH_BEGIN attn_phase(ws, li != 3, (char*)lds, wv); SEAM(base + 4); }
            if (IN(base + 5)) REP(10) { PH_BEGIN SchedDense S; S.init(ws + WS_ZO, 1024, wb + WB_WO + (size_t)j * 1024 * 1024 * 2, T, 1024, 1024); EpiWo E{(u16*)(ws + WS_HX), mod, li};
                g8::gemm_phase<EpiWo, SchedDense>(ldsl, 1024, S, E, wv); SEAM(base + 5); }
        }
        if (IN(base + 6)) REP(2) { PH_BEGIN NormDst nd = NDST(li, 2); if (li == 0) { nd.xin = a.P.in[0]; nd.cin = a.P.in[2]; norm2_rows<42 | 64>(ws, outp, nd, li, 1, sbase, (char*)lds, wv); } else norm2_rows<42>(ws, outp, nd, li, 1, sbase, (char*)lds, wv); SEAM(base + 6); }
        if (IN(base + 7) || IN(base + 8)) {
            const unsigned* cnt = (const unsigned*)(ws0 + WS_CTL) + CW_CNT + li * 32 * CS;
            __syncthreads();
            if (tid_opaque(wv) == 0) { int acc = 0; for (int e = 0; e < 32; ++e) { sbase[e] = acc; acc += (int)((cnt[e * CS] + 255u) / 256u); } sbase[32] = acc; }
            __syncthreads();
            if (IN(base + 7)) REP(7) { PH_BEGIN SchedMoe<true> S; S.init(ws + WS_HX, wb + WB_GU + (size_t)li * 32 * 1024 * 1024 * 2, 1024, sbase, cnt, (const int*)(ws + WS_LIST)); EpiMoe1 E{(u16*)(ws + WS_R1 + R1_ACT)};
                g8::gemm_phase<EpiMoe1, SchedMoe<true>>(ldsl, 1024, S, E, wv); SEAM(base + 7); }
            if (IN(base + 8)) REP(8) { PH_BEGIN SchedMoe<false> S; S.init(ws + WS_R1 + R1_ACT, wb + WB_DN + (size_t)li * 32 * 1024 * 512 * 2, 512, sbase, cnt, (const int*)(ws + WS_LIST)); EpiMoe2 E{(u16*)(ws + WS_YB)};
                g8::gemm_phase<EpiMoe2, SchedMoe<false>>(ldsl, 512, S, E, wv); SEAM(base + 8); }
        }
    }

    {
        constexpr int li = 1; constexpr int base = 1 + li * 10, j = li >> 1;
#define PH_BEGIN size_t zoff_ = 0; asm volatile("" : "+s"(zoff_)); unsigned char* ws = ws0 + zoff_; unsigned char* wb = ws + WS_WB; const float* sm = (const float*)(ws + WS_SMALL); float* X = (float*)(ws + WS_X); const float* mod = (const float*)(ws + WS_MOD); (void)wb; (void)sm; (void)X; (void)mod;
        if ((li & 1) == 0) {
            if (IN(base + 0)) REP(1) { PH_BEGIN NormDst nd = NDST(li, 1); if (li == 0) { nd.xin = a.P.in[0]; nd.cin = a.P.in[2]; norm2_rows<4 | 64>(ws, outp, nd, li, 0, sbase, (char*)lds, wv); } else norm2_rows<5>(ws, outp, nd, li, 0, sbase, (char*)lds, wv); SEAM(base + 0); }
            if (IN(base + 1)) REP(3) { PH_BEGIN SchedS5 S; S.init(ws + WS_R1 + R1_UH, wb + WB_W1 + (size_t)j * 64 * 256 * 256 * 2, 256); EpiS5a E{(float*)(ws + WS_R1 + R1_S)};
                g8::gemm_phase<EpiS5a, SchedS5>(ldsl, 256, S, E, wv); SEAM(base + 1); }
            if (IN(base + 2)) REP(3) { PH_BEGIN s5_scan_phase(ws, j, wv); SEAM(base + 2); }
            if (IN(base + 3)) REP(3) { PH_BEGIN SchedS5 S; S.init(ws + WS_R1 + R1_UH, wb + WB_W2 + (size_t)j * 64 * 256 * 512 * 2, 512); EpiS5b E{(u16*)(ws + WS_ZO), (const u16*)(ws + WS_R1 + R1_UH), sm + SM_S5D + j * 1024};
                g8::gemm_phase<EpiS5b, SchedS5>(ldsl, 512, S, E, wv); SEAM(base + 3); }
            if (IN(base + 4)) REP(4) { PH_BEGIN SchedDense S; S.init(ws + WS_ZO, 1024, wb + WB_GLU + (size_t)j * 2048 * 1024 * 2, T, 2048, 1024); EpiGlu E{(u16*)(ws + WS_HX), mod, li};
                g8::gemm_phase<EpiGlu, SchedDense>(ldsl, 1024, S, E, wv); SEAM(base + 4); }
        } else {
            if (IN(base + 0)) REP(1) { PH_BEGIN const NormDst nd = NDST(li, 1); norm2_rows<3>(ws, outp, nd, li, 0, sbase, (char*)lds, wv); SEAM(base + 0); }
            if (IN(base + 1)) REP(5) { PH_BEGIN SchedDense S; S.init(ws + WS_HX, 1024, wb + WB_WIN + (size_t)j * 768 * 1024 * 2, T, 768, 1024); EpiF32 E{(float*)(ws + WS_YB), 768};
                g8::gemm_phase<EpiF32, SchedDense>(ldsl, 1024, S, E, wv); SEAM(base + 1); }
            if (IN(base + 2)) REP(5) { PH_BEGIN mla_post_rows(ws, j, (const float*)(ws + WS_YB), 768, 8, wv); SEAM(base + 2); }
            if (IN(base + 3)) REP(5) { PH_BEGIN
                { SchedDense S; S.init(ws + WS_CQ, QR, wb + WB_UQ + (size_t)j * 1536 * 384 * 2, T, 1536, 384); EpiQ E{(u16*)(ws + WS_R1 + R1_QT), (const float2*)(ws + WS_ROPE)};
                  g8::gemm_phase<EpiQ, SchedDense>(ldsl, 384, S, E, wv); }
                { SchedDense S; S.init(ws + WS_CKV, KVR, wb + WB_UKV + (size_t)j * 2048 * 256 * 2, T, 2048, 256); EpiKV E{(u16*)(ws + WS_R1 + R1_KT), (u16*)(ws + WS_R1 + R1_VT)};
                  int kk_ = 256; asm volatile("" : "+s"(kk_)); g8::gemm_phase<EpiKV, SchedDense>(ldsl, kk_, S, E, wv); }
                SEAM(base + 3); }
            if (IN(base + 4)) REP(6) { PH_BEGIN attn_phase(ws, li != 3, (char*)lds, wv); SEAM(base + 4); }
            if (IN(base + 5)) REP(10) { PH_BEGIN SchedDense S; S.init(ws + WS_ZO, 1024, wb + WB_WO + (size_t)j * 1024 * 1024 * 2, T, 1024, 1024); EpiWo E{(u16*)(ws + WS_HX), mod, li};
                g8::gemm_phase<EpiWo, SchedDense>(ldsl, 1024, S, E, wv); SEAM(base + 5); }
        }
        if (IN(base + 6)) REP(2) { PH_BEGIN NormDst nd = NDST(li, 2); if (li == 0) { nd.xin = a.P.in[0]; nd.cin = a.P.in[2]; norm2_rows<42 | 64>(ws, outp, nd, li, 1, sbase, (char*)lds, wv); } else norm2_rows<42>(ws, outp, nd, li, 1, sbase, (char*)lds, wv); SEAM(base + 6); }
        if (IN(base + 7) || IN(base + 8)) {
            const unsigned* cnt = (const unsigned*)(ws0 + WS_CTL) + CW_CNT + li * 32 * CS;
            __syncthreads();
            if (tid_opaque(wv) == 0) { int acc = 0; for (int e = 0; e < 32; ++e) { sbase[e] = acc; acc += (int)((cnt[e * CS] + 255u) / 256u); } sbase[32] = acc; }
            __syncthreads();
            if (IN(base + 7)) REP(7) { PH_BEGIN SchedMoe<true> S; S.init(ws + WS_HX, wb + WB_GU + (size_t)li * 32 * 1024 * 1024 * 2, 1024, sbase, cnt, (const int*)(ws + WS_LIST)); EpiMoe1 E{(u16*)(ws + WS_R1 + R1_ACT)};
                g8::gemm_phase<EpiMoe1, SchedMoe<true>>(ldsl, 1024, S, E, wv); SEAM(base + 7); }
            if (IN(base + 8)) REP(8) { PH_BEGIN SchedMoe<false> S; S.init(ws + WS_R1 + R1_ACT, wb + WB_DN + (size_t)li * 32 * 1024 * 512 * 2, 512, sbase, cnt, (const int*)(ws + WS_LIST)); EpiMoe2 E{(u16*)(ws + WS_YB)};
                g8::gemm_phase<EpiMoe2, SchedMoe<false>>(ldsl, 512, S, E, wv); SEAM(base + 8); }
        }
    }

    {
        constexpr int li = 2; constexpr int base = 1 + li * 10, j = li >> 1;
#define PH_BEGIN size_t zoff_ = 0; asm volatile("" : "+s"(zoff_)); unsigned char* ws = ws0 + zoff_; unsigned char* wb = ws + WS_WB; const float* sm = (const float*)(ws + WS_SMALL); float* X = (float*)(ws + WS_X); const float* mod = (const float*)(ws + WS_MOD); (void)wb; (void)sm; (void)X; (void)mod;
        if ((li & 1) == 0) {
            if (IN(base + 0)) REP(1) { PH_BEGIN NormDst nd = NDST(li, 1); if (li == 0) { nd.xin = a.P.in[0]; nd.cin = a.P.in[2]; norm2_rows<4 | 64>(ws, outp, nd, li, 0, sbase, (char*)lds, wv); } else norm2_rows<5>(ws, outp, nd, li, 0, sbase, (char*)lds, wv); SEAM(base + 0); }
            if (IN(base + 1)) REP(3) { PH_BEGIN SchedS5 S; S.init(ws + WS_R1 + R1_UH, wb + WB_W1 + (size_t)j * 64 * 256 * 256 * 2, 256); EpiS5a E{(float*)(ws + WS_R1 + R1_S)};
                g8::gemm_phase<EpiS5a, SchedS5>(ldsl, 256, S, E, wv); SEAM(base + 1); }
            if (IN(base + 2)) REP(3) { PH_BEGIN s5_scan_phase(ws, j, wv); SEAM(base + 2); }
            if (IN(base + 3)) REP(3) { PH_BEGIN SchedS5 S; S.init(ws + WS_R1 + R1_UH, wb + WB_W2 + (size_t)j * 64 * 256 * 512 * 2, 512); EpiS5b E{(u16*)(ws + WS_ZO), (const u16*)(ws + WS_R1 + R1_UH), sm + SM_S5D + j * 1024};
                g8::gemm_phase<EpiS5b, SchedS5>(ldsl, 512, S, E, wv); SEAM(base + 3); }
            if (IN(base + 4)) REP(4) { PH_BEGIN SchedDense S; S.init(ws + WS_ZO, 1024, wb + WB_GLU + (size_t)j * 2048 * 1024 * 2, T, 2048, 1024); EpiGlu E{(u16*)(ws + WS_HX), mod, li};
                g8::gemm_phase<EpiGlu, SchedDense>(ldsl, 1024, S, E, wv); SEAM(base + 4); }
        } else {
            if (IN(base + 0)) REP(1) { PH_BEGIN const NormDst nd = NDST(li, 1); norm2_rows<3>(ws, outp, nd, li, 0, sbase, (char*)lds, wv); SEAM(base + 0); }
            if (IN(base + 1)) REP(5) { PH_BEGIN SchedDense S; S.init(ws + WS_HX, 1024, wb + WB_WIN + (size_t)j * 768 * 1024 * 2, T, 768, 1024); EpiF32 E{(float*)(ws + WS_YB), 768};
                g8::gemm_phase<EpiF32, SchedDense>(ldsl, 1024, S, E, wv); SEAM(base + 1); }
            if (IN(base + 2)) REP(5) { PH_BEGIN mla_post_rows(ws, j, (const float*)(ws + WS_YB), 768, 8, wv); SEAM(base + 2); }
            if (IN(base + 3)) REP(5) { PH_BEGIN
                { SchedDense S; S.init(ws + WS_CQ, QR, wb + WB_UQ + (size_t)j * 1536 * 384 * 2, T, 1536, 384); EpiQ E{(u16*)(ws + WS_R1 + R1_QT), (const float2*)(ws + WS_ROPE)};
                  g8::gemm_phase<EpiQ, SchedDense>(ldsl, 384, S, E, wv); }
                { SchedDense S; S.init(ws + WS_CKV, KVR, wb + WB_UKV + (size_t)j * 2048 * 256 * 2, T, 2048, 256); EpiKV E{(u16*)(ws + WS_R1 + R1_KT), (u16*)(ws + WS_R1 + R1_VT)};
                  int kk_ = 256; asm volatile("" : "+s"(kk_)); g8::gemm_phase<EpiKV, SchedDense>(ldsl, kk_, S, E, wv); }
                SEAM(base + 3); }
            if (IN(base + 4)) REP(6) { PH_BEGIN attn_phase(ws, li != 3, (char*)lds, wv); SEAM(base + 4); }
            if (IN(base + 5)) REP(10) { PH_BEGIN SchedDense S; S.init(ws + WS_ZO, 1024, wb + WB_WO + (size_t)j * 1024 * 1024 * 2, T, 1024, 1024); EpiWo E{(u16*)(ws + WS_HX), mod, li};
                g8::gemm_phase<EpiWo, SchedDense>(ldsl, 1024, S, E, wv); SEAM(base + 5); }
        }
        if (IN(base + 6)) REP(2) { PH_BEGIN NormDst nd = NDST(li, 2); if (li == 0) { nd.xin = a.P.in[0]; nd.cin = a.P.in[2]; norm2_rows<42 | 64>(ws, outp, nd, li, 1, sbase, (char*)lds, wv); } else norm2_rows<42>(ws, outp, nd, li, 1, sbase, (char*)lds, wv); SEAM(base + 6); }
        if (IN(base + 7) || IN(base + 8)) {
            const unsigned* cnt = (const unsigned*)(ws0 + WS_CTL) + CW_CNT + li * 32 * CS;
            __syncthreads();
            if (tid_opaque(wv) == 0) { int acc = 0; for (int e = 0; e < 32; ++e) { sbase[e] = acc; acc += (int)((cnt[e * CS] + 255u) / 256u); } sbase[32] = acc; }
            __syncthreads();
            if (IN(base + 7)) REP(7) { PH_BEGIN SchedMoe<true> S; S.init(ws + WS_HX, wb + WB_GU + (size_t)li * 32 * 1024 * 1024 * 2, 1024, sbase, cnt, (const int*)(ws + WS_LIST)); EpiMoe1 E{(u16*)(ws + WS_R1 + R1_ACT)};
                g8::gemm_phase<EpiMoe1, SchedMoe<true>>(ldsl, 1024, S, E, wv); SEAM(base + 7); }
            if (IN(base + 8)) REP(8) { PH_BEGIN SchedMoe<false> S; S.init(ws + WS_R1 + R1_ACT, wb + WB_DN + (size_t)li * 32 * 1024 * 512 * 2, 512, sbase, cnt, (const int*)(ws + WS_LIST)); EpiMoe2 E{(u16*)(ws + WS_YB)};
                g8::gemm_phase<EpiMoe2, SchedMoe<false>>(ldsl, 512, S, E, wv); SEAM(base + 8); }
        }
    }

    {
        constexpr int li = 3; constexpr int base = 1 + li * 10, j = li >> 1;
#define PH_BEGIN size_t zoff_ = 0; asm volatile("" : "+s"(zoff_)); unsigned char* ws = ws0 + zoff_; unsigned char* wb = ws + WS_WB; const float* sm = (const float*)(ws + WS_SMALL); float* X = (float*)(ws + WS_X); const float* mod = (const float*)(ws + WS_MOD); (void)wb; (void)sm; (void)X; (void)mod;
        if ((li & 1) == 0) {
            if (IN(base + 0)) REP(1) { PH_BEGIN NormDst nd = NDST(li, 1); if (li == 0) { nd.xin = a.P.in[0]; nd.cin = a.P.in[2]; norm2_rows<4 | 64>(ws, outp, nd, li, 0, sbase, (char*)lds, wv); } else norm2_rows<5>(ws, outp, nd, li, 0, sbase, (char*)lds, wv); SEAM(base + 0); }
            if (IN(base + 1)) REP(3) { PH_BEGIN SchedS5 S; S.init(ws + WS_R1 + R1_UH, wb + WB_W1 + (size_t)j * 64 * 256 * 256 * 2, 256); EpiS5a E{(float*)(ws + WS_R1 + R1_S)};
                g8::gemm_phase<EpiS5a, SchedS5>(ldsl, 256, S, E, wv); SEAM(base + 1); }
            if (IN(base + 2)) REP(3) { PH_BEGIN s5_scan_phase(ws, j, wv); SEAM(base + 2); }
            if (IN(base + 3)) REP(3) { PH_BEGIN SchedS5 S; S.init(ws + WS_R1 + R1_UH, wb + WB_W2 + (size_t)j * 64 * 256 * 512 * 2, 512); EpiS5b E{(u16*)(ws + WS_ZO), (const u16*)(ws + WS_R1 + R1_UH), sm + SM_S5D + j * 1024};
                g8::gemm_phase<EpiS5b, SchedS5>(ldsl, 512, S, E, wv); SEAM(base + 3); }
            if (IN(base + 4)) REP(4) { PH_BEGIN SchedDense S; S.init(ws + WS_ZO, 1024, wb + WB_GLU + (size_t)j * 2048 * 1024 * 2, T, 2048, 1024); EpiGlu E{(u16*)(ws + WS_HX), mod, li};
                g8::gemm_phase<EpiGlu, SchedDense>(ldsl, 1024, S, E, wv); SEAM(base + 4); }
        } else {
            if (IN(base + 0)) REP(1) { PH_BEGIN const NormDst nd = NDST(li, 1); norm2_rows<3>(ws, outp, nd, li, 0, sbase, (char*)lds, wv); SEAM(base + 0); }
            if (IN(base + 1)) REP(5) { PH_BEGIN SchedDense S; S.init(ws + WS_HX, 1024, wb + WB_WIN + (size_t)j * 768 * 1024 * 2, T, 768, 1024); EpiF32 E{(float*)(ws + WS_YB), 768};
                g8::gemm_phase<EpiF32, SchedDense>(ldsl, 1024, S, E, wv); SEAM(base + 1); }
            if (IN(base + 2)) REP(5) { PH_BEGIN mla_post_rows(ws, j, (const float*)(ws + WS_YB), 768, 8, wv); SEAM(base + 2); }
            if (IN(base + 3)) REP(5) { PH_BEGIN
                { SchedDense S; S.init(ws + WS_CQ, QR, wb + WB_UQ + (size_t)j * 1536 * 384 * 2, T, 1536, 384); EpiQ E{(u16*)(ws + WS_R1 + R1_QT), (const float2*)(ws + WS_ROPE)};
                  g8::gemm_phase<EpiQ, SchedDense>(ldsl, 384, S, E, wv); }
                { SchedDense S; S.init(ws + WS_CKV, KVR, wb + WB_UKV + (size_t)j * 2048 * 256 * 2, T, 2048, 256); EpiKV E{(u16*)(ws + WS_R1 + R1_KT), (u16*)(ws + WS_R1 + R1_VT)};
                  int kk_ = 256; asm volatile("" : "+s"(kk_)); g8::gemm_phase<EpiKV, SchedDense>(ldsl, kk_, S, E, wv); }
                SEAM(base + 3); }
            if (IN(base + 4)) REP(6) { PH_BEGIN attn_phase(ws, li != 3, (char*)lds, wv); SEAM(base + 4); }
            if (IN(base + 5)) REP(10) { PH_BEGIN SchedDense S; S.init(ws + WS_ZO, 1024, wb + WB_WO + (size_t)j * 1024 * 1024 * 2, T, 1024, 1024); EpiWo E{(u16*)(ws + WS_HX), mod, li};
                g8::gemm_phase<EpiWo, SchedDense>(ldsl, 1024, S, E, wv); SEAM(base + 5); }
        }
        if (IN(base + 6)) REP(2) { PH_BEGIN NormDst nd = NDST(li, 2); if (li == 0) { nd.xin = a.P.in[0]; nd.cin = a.P.in[2]; norm2_rows<42 | 64>(ws, outp, nd, li, 1, sbase, (char*)lds, wv); } else norm2_rows<42>(ws, outp, nd, li, 1, sbase, (char*)lds, wv); SEAM(base + 6); }
        if (IN(base + 7) || IN(base + 8)) {
            const unsigned* cnt = (const unsigned*)(ws0 + WS_CTL) + CW_CNT + li * 32 * CS;
            __syncthreads();
            if (tid_opaque(wv) == 0) { int acc = 0; for (int e = 0; e < 32; ++e) { sbase[e] = acc; acc += (int)((cnt[e * CS] + 255u) / 256u); } sbase[32] = acc; }
            __syncthreads();
            if (IN(base + 7)) REP(7) { PH_BEGIN SchedMoe<true> S; S.init(ws + WS_HX, wb + WB_GU + (size_t)li * 32 * 1024 * 1024 * 2, 1024, sbase, cnt, (const int*)(ws + WS_LIST)); EpiMoe1 E{(u16*)(ws + WS_R1 + R1_ACT)};
                g8::gemm_phase<EpiMoe1, SchedMoe<true>>(ldsl, 1024, S, E, wv); SEAM(base + 7); }
            if (IN(base + 8)) REP(8) { PH_BEGIN SchedMoe<false> S; S.init(ws + WS_R1 + R1_ACT, wb + WB_DN + (size_t)li * 32 * 1024 * 512 * 2, 512, sbase, cnt, (const int*)(ws + WS_LIST)); EpiMoe2 E{(u16*)(ws + WS_YB)};
                g8::gemm_phase<EpiMoe2, SchedMoe<false>>(ldsl, 512, S, E, wv); SEAM(base + 8); }
        }
    }

#if defined(PROBE_A)
    if (IN(41)) { xcd_barrier(bar, tid_opaque(wv));
        if (tid_opaque(wv) == 0) { const unsigned long long* ts = (const unsigned long long*)(ws0 + WS_CTL) + CW_STAMP64; unsigned long long last = ts[0], sa = 0, sb = 0;
            for (int p = 0; p <= 40; ++p) { const unsigned long long e = ts[p + 1]; if (e == 0) continue; const unsigned long long d = e - last; last = e;
                int grp; if (p == 0) grp = 0; else { const int k = (p - 1) % 10, l = (p - 1) / 10; const bool s5 = (l & 1) == 0;
                    grp = k == 0 ? 1 : k == 6 ? 2 : k == 7 ? 7 : k == 8 ? 8 : s5 ? (k == 4 ? 4 : 3) : (k == 4 ? 6 : 5); }
                if (grp == PROBE_A) sa += d; if (grp == PROBE_B) sb += d; }
            ((float*)sbase)[40] = (float)sa * 1e-5f; ((float*)sbase)[41] = 2.f + (float)sb * (1.f / 2000.f); }
        __syncthreads(); }
#endif
    if (IN(41)) { const NormDst nd = norm_dst_real(ws0, 0); norm2_rows<17>(ws0, outp, nd, 4, 0, sbase, (char*)lds, wv); }
#undef PH_BEGIN
#undef IN
#undef SEAM
}
__global__ __launch_bounds__(256) void n_post_win(Ptrs P, int j) { mla_post_rows(P.ws, j, (const float*)(P.ws + WS_YB), 768, 4, __builtin_amdgcn_readfirstlane(threadIdx.x >> 6)); }
static void gemm_naive(hipStream_t st, const void* A, int lda, const int* rowidx, const float* B, int ldb, long bstride, const int* tileexp, const int* mdyn, float* C, int ldc, int M, int N, int K) {
    NG g{}; g.A = A; g.lda = lda; g.rowidx = rowidx; g.B = B; g.ldb = ldb; g.bstride = bstride; g.tileexp = tileexp; g.mdyn = mdyn; g.C = C; g.ldc = ldc; g.M = M; g.N = N; g.K = K; g.pad = 0;
    hipLaunchKernelGGL(n_gemm<1>, dim3(N / 64, (M + 63) / 64), dim3(256), 0, st, g);
}
#ifndef REALMASK_STR
#define REALMASK_STR "111111111111111111111111111111111111111111"
#endif
extern "C" void kernel_launch(void* const* d_in, const int* in_sizes, int n_in, void* d_out, int out_size, void* d_ws, size_t ws_size, hipStream_t stream) {
    static int grid = 0;
    static const char* realmask = REALMASK_STR;
    if (grid == 0) {
        if (n_in != 30 || out_size != NB * SEQ * D || ws_size < WS_NEND) { fprintf(stderr, "kernel_launch: unexpected shapes n_in %d out %d ws %zu (need %zu)\n", n_in, out_size, ws_size, (size_t)WS_NEND); grid = -1; return; }
        int dev = 0, cus = 0, per_cu = 0;
        if (hipGetDevice(&dev) != hipSuccess || hipDeviceGetAttribute(&cus, hipDeviceAttributeMultiprocessorCount, dev) != hipSuccess) { grid = -1; return; }
        if (hipFuncSetAttribute((const void*)mk, hipFuncAttributeMaxDynamicSharedMemorySize, LDS_BYTES) != hipSuccess) { fprintf(stderr, "kernel_launch: hipFuncSetAttribute failed\n"); grid = -1; return; }
        if (hipOccupancyMaxActiveBlocksPerMultiprocessor(&per_cu, (const void*)mk, 512, LDS_BYTES) != hipSuccess || per_cu < 1) { fprintf(stderr, "kernel_launch: occupancy query says %d\n", per_cu); }
        (void)hipGetLastError();
        grid = cus;
    }
    if (grid < 0) return;
    Ptrs P{}; for (int i = 0; i < 30; ++i) P.in[i] = (const float*)d_in[i]; P.out = (float*)d_out; P.ws = (unsigned char*)d_ws;
    unsigned char* ws = P.ws;
    (void)hipMemsetAsync(ws + WS_CTL, 0, ZERO_BYTES, stream);
    int nreg = 0;
    auto real = [&](int p) { return realmask[p] == '1'; };
    auto run_mk = [&](int lo, int hi) { MkArgs a{}; a.P = P; a.lo = lo; a.hi = hi; a.bar_region = (hi - lo > 1) ? nreg++ : 0; a.pad = 0; hipLaunchKernelGGL(mk, dim3(grid), dim3(512), LDS_BYTES, stream, a); };
    const int NG_ = 4096; float* NTMP = (float*)(ws + WS_NTMP);
    int p = 0;
    while (p < NPHASE) {
        if (real(p)) { int q = p; while (q < NPHASE && real(q)) ++q; run_mk(p, q); p = q; continue; }
        if (p == 0) { hipLaunchKernelGGL(k_mod, dim3(24, 4), dim3(256), 0, stream, P); hipLaunchKernelGGL(k_init, dim3(2048), dim3(256), 0, stream, P); }
        else if (p == 41) hipLaunchKernelGGL(k_norm<17>, dim3(2048), dim3(256), 0, stream, P, 4, 0);
        else {
            const int li = (p - 1) / 10, k = (p - 1) % 10, j = li >> 1; const bool s5 = (li & 1) == 0;
            if (k == 0) { if (li == 0) hipLaunchKernelGGL(k_norm<2>, dim3(2048), dim3(256), 0, stream, P, li, 0); else hipLaunchKernelGGL(k_norm<3>, dim3(2048), dim3(256), 0, stream, P, li, 0); }
            else if (s5 && k == 1) { hipLaunchKernelGGL(n_s5, dim3(NB * SG), dim3(128), 0, stream, P, j); }
            else if (s5 && k == 3) { hipLaunchKernelGGL(n_post_s5, dim3(NG_), dim3(256), 0, stream, P, j); }
            else if (s5 && k == 4) { gemm_naive(stream, ws + WS_ZO, D, nullptr, P.in[16] + (size_t)j * 1024 * 2048, 2048, 0, nullptr, nullptr, NTMP, 2048, T, 2048, 1024); hipLaunchKernelGGL(n_post_glu, dim3(NG_), dim3(256), 0, stream, P, li); }
            else if (!s5 && k == 1) { gemm_naive(stream, ws + WS_HX, D, nullptr, P.in[17] + (size_t)j * 1024 * 704, 704, 0, nullptr, nullptr, (float*)(ws + WS_YB), 768, T, 704, 1024); }
            else if (!s5 && k == 2) { hipLaunchKernelGGL(n_post_win, dim3(2048), dim3(256), 0, stream, P, j); }
            else if (!s5 && k == 3) {
                gemm_naive(stream, ws + WS_CQ, QR, nullptr, P.in[20] + (size_t)j * 384 * 1536, 1536, 0, nullptr, nullptr, NTMP, 1536, T, 1536, 384); hipLaunchKernelGGL(n_post_q, dim3(NG_), dim3(256), 0, stream, P);
                gemm_naive(stream, ws + WS_CKV, KVR, nullptr, P.in[21] + (size_t)j * 256 * 2048, 2048, 0, nullptr, nullptr, NTMP, 2048, T, 2048, 256); hipLaunchKernelGGL(n_post_kv, dim3(NG_), dim3(256), 0, stream, P); }
            else if (!s5 && k == 4) { hipLaunchKernelGGL(n_attn, dim3(LTOT / 64, NH, NB), dim3(256), 0, stream, P); }
            else if (!s5 && k == 5) { gemm_naive(stream, ws + WS_ZO, D, nullptr, P.in[22] + (size_t)j * 1024 * 1024, 1024, 0, nullptr, nullptr, NTMP, 1024, T, 1024, 1024); hipLaunchKernelGGL(n_post_wo, dim3(NG_), dim3(256), 0, stream, P, li); }
            else if (k == 6) { hipLaunchKernelGGL(k_norm<10>, dim3(2048), dim3(256), 0, stream, P, li, 1); }
            else if (k == 7 || k == 8) {
                const int* tileexp = (const int*)(ws + WS_TILEEXP);
                hipLaunchKernelGGL(n_build, dim3(1), dim3(256), 0, stream, P, li);
                if (k == 7) { gemm_naive(stream, ws + WS_HX, D, (const int*)(ws + WS_SLOTROW), P.in[27] + (size_t)li * 32 * 1024 * 1024, 1024, 1024L * 1024, tileexp, tileexp + 512, NTMP, 1024, MAXSLOT, 1024, 1024);
                    hipLaunchKernelGGL(n_post_act2, dim3(NG_), dim3(256), 0, stream, P, (u16*)(ws + WS_R1 + R1_ACT)); }
                else { gemm_naive(stream, ws + WS_R1 + R1_ACT, 512, nullptr, P.in[28] + (size_t)li * 32 * 512 * 1024, 1024, 512L * 1024, tileexp, tileexp + 512, NTMP, 1024, MAXSLOT, 1024, 512);
                    hipLaunchKernelGGL(n_post_y, dim3(NG_), dim3(256), 0, stream, P); }
            }
        }
        ++p;
    }
}
```

```cpp
#define MK_FULL 1
#include <hip/hip_runtime.h>
#include <cstdio>
#include <cstdint>

typedef unsigned short u16;
typedef unsigned short bf16_t;

constexpr int D = 1024, NB = 16, SEQ = 2048, CTXL = 256, LTOT = 2304, T = NB * LTOT;
constexpr int SG = 64, SP = 64, SC = 16;
constexpr int QR = 384, KVR = 256, NH = 8, QKD = 192;
constexpr int NE = 32;
constexpr int MAXSLOT = 81920;
constexpr float EPS = 1e-6f;

constexpr size_t al256(size_t x) { return (x + 255) / 256 * 256; }
constexpr size_t WS_CTL = 0;
constexpr size_t CTL_BYTES = 131072;
constexpr size_t WS_MOD = WS_CTL + CTL_BYTES;
constexpr size_t MOD_BYTES = al256((size_t)4 * 17 * 6144 * 4);
constexpr size_t ZERO_BYTES = CTL_BYTES;
constexpr size_t WS_ROPE = WS_MOD + MOD_BYTES;
constexpr size_t WS_SMALL = WS_ROPE + al256((size_t)2048 * 32 * 8);
constexpr int SM_GMIX = 0, SM_GFFN = 4096, SM_S5D = 8192, SM_GQ = 10240, SM_GKV = 11008, SM_FINALG = 11520, SM_BGROUP = 12544, SM_BEXP = 12560, SM_WGROUP = 12800, SM_WEXP = 29184, SM_END = 160256;
constexpr size_t WS_X = WS_SMALL + al256((size_t)SM_END * 4);
constexpr size_t WS_HX = WS_X + (size_t)T * D * 4;
constexpr size_t WS_ZO = WS_HX + (size_t)T * D * 2;
constexpr size_t WS_CQ = WS_ZO + (size_t)T * D * 2;
constexpr size_t WS_CKV = WS_CQ + (size_t)T * QR * 2;
constexpr size_t WS_SELI = WS_CKV + (size_t)T * KVR * 2;
constexpr size_t WS_SELW = WS_SELI + (size_t)T * 16;
constexpr size_t WS_LIST = WS_SELW + (size_t)T * 8;
constexpr size_t WS_SLOTROW = WS_LIST + (size_t)NE * T * 4;
constexpr size_t WS_TILEEXP = WS_SLOTROW + (size_t)MAXSLOT * 4;
constexpr size_t WS_R1 = WS_TILEEXP + 4096;
constexpr size_t R1_BYTES = (size_t)MAXSLOT * 1024 * 4;
constexpr size_t WS_YB = WS_R1 + R1_BYTES;
constexpr size_t WS_WB = WS_YB + (size_t)MAXSLOT * 1024 * 2;
constexpr size_t R1_QT = 0;
constexpr size_t R1_KT = R1_QT + (size_t)NB * NH * LTOT * QKD * 2;
constexpr size_t R1_VT = R1_KT + (size_t)NB * NH * LTOT * QKD * 2;
constexpr size_t R1_ACT = 0;
constexpr size_t R1_S = 0;
constexpr size_t R1_UH = (size_t)64 * 2304 * 256 * 4;
constexpr size_t WB_GLU = 0;
constexpr size_t WB_WIN = WB_GLU + (size_t)2 * 2048 * 1024 * 2;
constexpr size_t WB_UQ = WB_WIN + (size_t)2 * 768 * 1024 * 2;
constexpr size_t WB_UKV = WB_UQ + (size_t)2 * 1536 * 384 * 2;
constexpr size_t WB_WO = WB_UKV + (size_t)2 * 2048 * 256 * 2;
constexpr size_t WB_GU = WB_WO + (size_t)2 * 1024 * 1024 * 2;
constexpr size_t WB_DN = WB_GU + (size_t)128 * 1024 * 1024 * 2;
constexpr size_t WB_W1 = WB_DN + (size_t)128 * 1024 * 512 * 2;
constexpr size_t WB_W2 = WB_W1 + (size_t)128 * 256 * 256 * 2;
constexpr size_t WB_AT = WB_W2 + (size_t)128 * 256 * 512 * 2;
constexpr size_t WB_END = WB_AT + (size_t)2 * 2 * 64 * 64 * 8;
constexpr size_t WS_END = WS_WB + WB_END;
constexpr size_t WS_NTMP = al256(WS_END);
constexpr size_t WS_NEND = WS_NTMP + (size_t)MAXSLOT * 1024 * 4;
static_assert(R1_UH + (size_t)64 * 2304 * 512 * 2 <= R1_BYTES, "R1");
static_assert(R1_VT + (size_t)NB * NH * LTOT * 128 * 2 <= R1_BYTES, "R1");
constexpr int CS = 64;
constexpr int CW_CNT = 8192;
constexpr int CW_QUEUE = 7168;
constexpr int CW_CNT_DUMMY = 16384;
constexpr int CW_STAMP64 = 12288;

__device__ __forceinline__ float bf2f(u16 v) { return __uint_as_float(((unsigned)v) << 16); }
__device__ __forceinline__ u16 f2bf(float f) { unsigned u = __float_as_uint(f); u += 0x7FFFu + ((u >> 16) & 1u); return (u16)(u >> 16); }
__device__ __forceinline__ float silu_f(float x) { return x / (1.f + __expf(-x)); }
__device__ __forceinline__ float sigmoid_f(float x) { return 1.f / (1.f + __expf(-x)); }
__device__ __forceinline__ float gelu_tanh(float x) { const float u = 0.7978845608028654f * (x + 0.044715f * x * x * x); const float e = __expf(2.f * u); const float t = 1.f - 2.f / (e + 1.f); return 0.5f * x * (1.f + t); }
__device__ __forceinline__ float wave_sum(float v) {
#pragma unroll
    for (int o = 32; o > 0; o >>= 1) v += __shfl_xor(v, o);
    return v;
}

struct Ptrs { const float* in[30]; float* out; unsigned char* ws; };
__device__ __forceinline__ int tid_opaque(int wv) { int l; asm volatile("v_mbcnt_lo_u32_b32 %0, -1, 0\n\tv_mbcnt_hi_u32_b32 %0, -1, %0" : "=v"(l)); return (wv << 6) | l; }
__device__ __forceinline__ float wave_sum_l(float v, int lane) {
#pragma unroll
    for (int o = 32; o > 0; o >>= 1) v += __int_as_float(__builtin_amdgcn_ds_bpermute((lane ^ o) << 2, __float_as_int(v)));
    return v;
}

__global__ __launch_bounds__(256) void k_mod(Ptrs P) {
    __shared__ float sc[17][64];
    const int i = blockIdx.y, col = blockIdx.x * 256 + threadIdx.x, tid = threadIdx.x;
    const float* W = P.in[4] + (size_t)i * 1024 * 6144;
    float acc[17];
#pragma unroll
    for (int r = 0; r < 17; ++r) acc[r] = 0.f;
    for (int k0 = 0; k0 < 1024; k0 += 64) {
        __syncthreads();
        for (int idx = tid; idx < 17 * 64; idx += 256) { const int r = idx >> 6, kk = idx & 63; const float v = r < 16 ? P.in[1][r * 1024 + k0 + kk] : P.in[3][k0 + kk]; sc[r][kk] = silu_f(v); }
        __syncthreads();
#pragma unroll 8
        for (int kk = 0; kk < 64; ++kk) { const float w = W[(size_t)(k0 + kk) * 6144 + col];
#pragma unroll
            for (int r = 0; r < 17; ++r) acc[r] += sc[r][kk] * w; }
    }
    float* mod = (float*)(P.ws + WS_MOD);
    const float bb = P.in[5][i * 6144 + col];
#pragma unroll
    for (int r = 0; r < 17; ++r) mod[(size_t)(i * 17 + r) * 6144 + col] = acc[r] + bb;
}
__device__ __forceinline__ void copy_small(const Ptrs& P, int t0, int nt) {
    float* sm = (float*)(P.ws + WS_SMALL);
    for (int i = t0; i < 4096; i += nt) { sm[SM_GMIX + i] = P.in[6][i]; sm[SM_GFFN + i] = P.in[7][i]; }
    for (int i = t0; i < 2048; i += nt) sm[SM_S5D + i] = P.in[15][i];
    for (int i = t0; i < 768; i += nt) sm[SM_GQ + i] = P.in[18][i];
    for (int i = t0; i < 512; i += nt) sm[SM_GKV + i] = P.in[19][i];
    for (int i = t0; i < 1024; i += nt) sm[SM_FINALG + i] = P.in[29][i];
    for (int i = t0; i < 16; i += nt) sm[SM_BGROUP + i] = P.in[24][i];
    for (int i = t0; i < 128; i += nt) sm[SM_BEXP + i] = P.in[26][i];
    for (int i = t0; i < 16384; i += nt) sm[SM_WGROUP + i] = P.in[23][i];
    for (int i = t0; i < 131072; i += nt) sm[SM_WEXP + i] = P.in[25][i];
}
__global__ __launch_bounds__(256) void k_init(Ptrs P) {
    copy_small(P, blockIdx.x * 256 + threadIdx.x, gridDim.x * 256);
    float4* X = (float4*)(P.ws + WS_X);
    const size_t n4 = (size_t)T * D / 4;
    for (size_t i = (size_t)blockIdx.x * 256 + threadIdx.x; i < n4; i += (size_t)gridDim.x * 256) {
        const size_t row = i / 256, c4 = i % 256; const int b = (int)(row / LTOT), pos = (int)(row % LTOT);
        X[i] = pos < CTXL ? ((const float4*)P.in[2])[((size_t)b * CTXL + pos) * 256 + c4] : ((const float4*)P.in[0])[((size_t)b * SEQ + (pos - CTXL)) * 256 + c4];
    }
    float2* rope = (float2*)(P.ws + WS_ROPE);
    for (int i = blockIdx.x * 256 + threadIdx.x; i < 2048 * 32; i += gridDim.x * 256) {
        const int s = i >> 5, k = i & 31, f = k & 15; const float invf = exp2f(-(float)f * (13.287712379549449f / 16.f));
        const float ang = (float)(k < 16 ? (s >> 6) : (s & 63)) * invf;
        rope[i] = make_float2(__cosf(ang), __sinf(ang));
    }
}

template <int MODE>
__device__ __forceinline__ void norm_rows(unsigned char* wsp, float* outp, int li, int which, int nwaves_blk, int* s_base, int wv) {
    struct { unsigned char* ws; float* out; } P{wsp, outp}; const float* sm = (const float*)(wsp + WS_SMALL);
    const int tidn = tid_opaque(wv); const int lane = tidn & 63, wave = tidn >> 6;
    float* X = (float*)(P.ws + WS_X);
    const float* mod = (const float*)(P.ws + WS_MOD);
    if (MODE & 1) {
        if (tidn == 0) { const unsigned* cnt = (const unsigned*)(P.ws + WS_CTL) + CW_CNT + (li - 1) * 32 * CS; int a = 0; for (int e = 0; e < 32; ++e) { s_base[e] = a; a += (int)((cnt[e * CS] + 255u) / 256u); } s_base[32] = a; }
        __syncthreads();
    }
    const bool lastl = (li == 3);
    for (int row = blockIdx.x * nwaves_blk + wave; row < T; row += gridDim.x * nwaves_blk) {
        const int b = row / LTOT, pos = row % LTOT; const bool isctx = pos < CTXL; const int r = isctx ? 16 : b;
        if ((MODE & 16) && isctx) continue;
        if ((MODE & 8) && lastl && isctx) continue;
        float4 v[4];
#pragma unroll
        for (int q = 0; q < 4; ++q) v[q] = *(const float4*)(X + (size_t)row * D + q * 256 + lane * 4);
        if (MODE & 1) {
            const bool skip = (li - 1 == 3) && isctx;
            if (!skip) {
                const int4 si = *(const int4*)(P.ws + WS_SELI + (size_t)row * 16); const float2 sw = *(const float2*)(P.ws + WS_SELW + (size_t)row * 8);
                const size_t g1 = (size_t)s_base[si.x] * 256 + si.y, g2 = (size_t)s_base[si.z] * 256 + si.w;
                const u16* YB = (const u16*)(P.ws + WS_YB);
                const float* gate = mod + (size_t)((li - 1) * 17 + r) * 6144 + 5 * 1024;
#pragma unroll
                for (int q = 0; q < 4; ++q) { const int c = q * 256 + lane * 4;
                    const uint2 ya = *(const uint2*)(YB + g1 * 1024 + c), yb = *(const uint2*)(YB + g2 * 1024 + c); const float4 gg = *(const float4*)(gate + c);
                    v[q].x += gg.x * (sw.x * bf2f((u16)(ya.x & 0xffff)) + sw.y * bf2f((u16)(yb.x & 0xffff)));
                    v[q].y += gg.y * (sw.x * bf2f((u16)(ya.x >> 16)) + sw.y * bf2f((u16)(yb.x >> 16)));
                    v[q].z += gg.z * (sw.x * bf2f((u16)(ya.y & 0xffff)) + sw.y * bf2f((u16)(yb.y & 0xffff)));
                    v[q].w += gg.w * (sw.x * bf2f((u16)(ya.y >> 16)) + sw.y * bf2f((u16)(yb.y >> 16)));
                    if (!(MODE & 16)) *(float4*)(X + (size_t)row * D + c) = v[q]; }
            }
        }
        float ss = 0.f;
#pragma unroll
        for (int q = 0; q < 4; ++q) ss += v[q].x * v[q].x + v[q].y * v[q].y + v[q].z * v[q].z + v[q].w * v[q].w;
        ss = wave_sum_l(ss, lane);
        const float rstd = rsqrtf(ss * (1.f / 1024.f) + EPS);
        if (MODE & 16) {
            float* out = P.out + ((size_t)b * SEQ + (pos - CTXL)) * D;
#pragma unroll
            for (int q = 0; q < 4; ++q) { const int c = q * 256 + lane * 4; const float4 g = *(const float4*)(sm + SM_FINALG + c);
                float4 ov = make_float4(v[q].x * rstd * g.x, v[q].y * rstd * g.y, v[q].z * rstd * g.z, v[q].w * rstd * g.w);
#if defined(PROBE_A)
                { const float da = 1.f + ((const float*)s_base)[40]; ov.x *= da; ov.y *= da; ov.z *= da; ov.w *= da; if (row == CTXL && c == 0) ov.x += ((const float*)s_base)[41]; }
#endif
                *(float4*)(out + c) = ov; }
            continue;
        }
        const float* gv = sm + (which ? SM_GFFN : SM_GMIX) + li * 1024;
        const float* sh = mod + (size_t)(li * 17 + r) * 6144 + (which ? 3 : 0) * 1024; const float* scl = sh + 1024;
        float h[16];
#pragma unroll
        for (int q = 0; q < 4; ++q) { const int c = q * 256 + lane * 4; const float4 g = *(const float4*)(gv + c), s4 = *(const float4*)(sh + c), c4 = *(const float4*)(scl + c);
            h[q * 4 + 0] = v[q].x * rstd * g.x * (1.f + c4.x) + s4.x; h[q * 4 + 1] = v[q].y * rstd * g.y * (1.f + c4.y) + s4.y;
            h[q * 4 + 2] = v[q].z * rstd * g.z * (1.f + c4.z) + s4.z; h[q * 4 + 3] = v[q].w * rstd * g.w * (1.f + c4.w) + s4.w; }
        if (MODE & 2) {
            u16* HX = (u16*)(P.ws + WS_HX);
#pragma unroll
            for (int q = 0; q < 4; ++q) { uint2 w; w.x = (unsigned)f2bf(h[q * 4]) | ((unsigned)f2bf(h[q * 4 + 1]) << 16); w.y = (unsigned)f2bf(h[q * 4 + 2]) | ((unsigned)f2bf(h[q * 4 + 3]) << 16);
                *(uint2*)(HX + (size_t)row * D + q * 256 + lane * 4) = w; }
        }
        if (MODE & 4) {
            u16* UH = (u16*)(P.ws + WS_R1 + R1_UH);
#pragma unroll
            for (int q = 0; q < 4; ++q) { const int c = q * 256 + lane * 4; const int g = c >> 4, ch = c & 15;
                uint2 w; w.x = (unsigned)f2bf(h[q * 4]) | ((unsigned)f2bf(h[q * 4 + 1]) << 16); w.y = (unsigned)f2bf(h[q * 4 + 2]) | ((unsigned)f2bf(h[q * 4 + 3]) << 16);
                *(uint2*)(UH + ((size_t)g * 2304 + b * 144 + (pos >> 4)) * 512 + (pos & 15) * 16 + ch) = w; }
        }
        if (MODE & 8) {
            const float* wg = sm + SM_WGROUP + (size_t)li * 1024 * 4;
            float lg[4] = {0.f, 0.f, 0.f, 0.f};
#pragma unroll
            for (int q = 0; q < 4; ++q)
#pragma unroll
                for (int j = 0; j < 4; ++j) { const int k = q * 256 + lane * 4 + j; const float4 w = *(const float4*)(wg + k * 4); const float hv = h[q * 4 + j];
                    lg[0] += hv * w.x; lg[1] += hv * w.y; lg[2] += hv * w.z; lg[3] += hv * w.w; }
#pragma unroll
            for (int g = 0; g < 4; ++g) lg[g] = wave_sum_l(lg[g], lane) + sm[SM_BGROUP + li * 4 + g];
            int gi = 0; float best = lg[0];
#pragma unroll
            for (int g = 1; g < 4; ++g) if (lg[g] > best) { best = lg[g]; gi = g; }
            float den = 0.f;
#pragma unroll
            for (int g = 0; g < 4; ++g) den += __expf(lg[g] - best);
            const float pg = 1.f / den;
            const float* we = sm + SM_WEXP + ((size_t)li * 4 + gi) * 1024 * 8;
            float le[8];
#pragma unroll
            for (int e = 0; e < 8; ++e) le[e] = 0.f;
#pragma unroll
            for (int q = 0; q < 4; ++q)
#pragma unroll
                for (int j = 0; j < 4; ++j) { const int k = q * 256 + lane * 4 + j; const float4 w0 = *(const float4*)(we + k * 8), w1 = *(const float4*)(we + k * 8 + 4); const float hv = h[q * 4 + j];
                    le[0] += hv * w0.x; le[1] += hv * w0.y; le[2] += hv * w0.z; le[3] += hv * w0.w; le[4] += hv * w1.x; le[5] += hv * w1.y; le[6] += hv * w1.z; le[7] += hv * w1.w; }
#pragma unroll
            for (int e = 0; e < 8; ++e) le[e] = wave_sum_l(le[e], lane) + sm[SM_BEXP + (li * 4 + gi) * 8 + e];
            int i1 = 0; float b1 = le[0];
#pragma unroll
            for (int e = 1; e < 8; ++e) if (le[e] > b1) { b1 = le[e]; i1 = e; }
            int i2 = -1; float b2 = -3.0e38f;
#pragma unroll
            for (int e = 0; e < 8; ++e) if (e != i1 && le[e] > b2) { b2 = le[e]; i2 = e; }
            if (lane == 0) {
                const float ex = __expf(b2 - b1); const float w1 = 1.f / (1.f + ex), w2 = ex / (1.f + ex);
                unsigned* cnt = (unsigned*)(P.ws + WS_CTL) + CW_CNT + li * 32 * CS; int* list = (int*)(P.ws + WS_LIST);
                const int e1 = gi * 8 + i1, e2 = gi * 8 + i2;
                const int s1 = (int)atomicAdd(&cnt[e1 * CS], 1u), s2 = (int)atomicAdd(&cnt[e2 * CS], 1u);
                list[(size_t)e1 * T + s1] = row; list[(size_t)e2 * T + s2] = row;
                *(int4*)(P.ws + WS_SELI + (size_t)row * 16) = make_int4(e1, s1, e2, s2);
                *(float2*)(P.ws + WS_SELW + (size_t)row * 8) = make_float2(pg * w1, pg * w2);
            }
        }
    }
}
template <int MODE> __global__ __launch_bounds__(256) void k_norm(Ptrs P, int li, int which) { __shared__ int sb[36]; norm_rows<MODE>(P.ws, P.out, li, which, 4, sb, __builtin_amdgcn_readfirstlane(threadIdx.x >> 6)); }

struct NG { const void* A; int lda; const int* rowidx; const float* B; int ldb; long bstride; const int* tileexp; const int* mdyn; float* C; int ldc; int M, N, K, pad; };
template <int ABF> __global__ __launch_bounds__(256) void n_gemm(NG g) {
    __shared__ float As[16][68], Bs[16][68];
    const int tm = blockIdx.y, tn = blockIdx.x, tid = threadIdx.x, tx = tid & 15, ty = tid >> 4;
    const int M = g.mdyn ? (*g.mdyn) * 256 : g.M;
    if (tm * 64 >= M) return;
    const float* B = g.B; if (g.tileexp) B += (long)g.tileexp[(tm * 64) / 256] * g.bstride;
    float acc[4][4];
#pragma unroll
    for (int i = 0; i < 4; ++i)
#pragma unroll
        for (int j = 0; j < 4; ++j) acc[i][j] = 0.f;
    const int arow = tm * 64 + (tid >> 2), ak = (tid & 3) * 4; long asrc = -1;
    if (arow < M) { const int r = g.rowidx ? g.rowidx[arow] : arow; if (r >= 0) asrc = (long)r * g.lda; }
    for (int k0 = 0; k0 < g.K; k0 += 16) {
        float a[4] = {0.f, 0.f, 0.f, 0.f};
        if (asrc >= 0) {
            if (ABF) { const uint2 w = *(const uint2*)((const u16*)g.A + asrc + k0 + ak); a[0] = bf2f((u16)(w.x & 0xffff)); a[1] = bf2f((u16)(w.x >> 16)); a[2] = bf2f((u16)(w.y & 0xffff)); a[3] = bf2f((u16)(w.y >> 16)); }
            else { const float4 w = *(const float4*)((const float*)g.A + asrc + k0 + ak); a[0] = w.x; a[1] = w.y; a[2] = w.z; a[3] = w.w; }
        }
        const float4 bv = *(const float4*)(B + (size_t)(k0 + (tid >> 4)) * g.ldb + tn * 64 + (tid & 15) * 4);
        __syncthreads();
#pragma unroll
        for (int i = 0; i < 4; ++i) As[ak + i][tid >> 2] = a[i];
        *(float4*)&Bs[tid >> 4][(tid & 15) * 4] = bv;
        __syncthreads();
#pragma unroll
        for (int kk = 0; kk < 16; ++kk) { const float4 a4 = *(const float4*)&As[kk][ty * 4], b4 = *(const float4*)&Bs[kk][tx * 4];
            const float av[4] = {a4.x, a4.y, a4.z, a4.w}, bw[4] = {b4.x, b4.y, b4.z, b4.w};
#pragma unroll
            for (int i = 0; i < 4; ++i)
#pragma unroll
                for (int j = 0; j < 4; ++j) acc[i][j] += av[i] * bw[j]; }
    }
#pragma unroll
    for (int i = 0; i < 4; ++i) { const int row = tm * 64 + ty * 4 + i; if (row < M) *(float4*)(g.C + (size_t)row * g.ldc + tn * 64 + tx * 4) = make_float4(acc[i][0], acc[i][1], acc[i][2], acc[i][3]); }
}
__device__ __forceinline__ int row_r(int row) { return (row % LTOT) < CTXL ? 16 : row / LTOT; }
__global__ __launch_bounds__(256) void n_post_glu(Ptrs P, int li) {
    float* X = (float*)(P.ws + WS_X); const float* TMP = (const float*)(P.ws + WS_NTMP); const float* mod = (const float*)(P.ws + WS_MOD);
    for (size_t i = (size_t)blockIdx.x * 256 + threadIdx.x; i < (size_t)T * D; i += (size_t)gridDim.x * 256) { const int row = (int)(i >> 10), c = (int)(i & 1023); const int r = row_r(row);
        const float val = TMP[(size_t)row * 2048 + c], gt = TMP[(size_t)row * 2048 + 1024 + c]; X[i] += mod[(size_t)(li * 17 + r) * 6144 + 2048 + c] * val * sigmoid_f(gt); }
}
__global__ __launch_bounds__(256) void n_post_wo(Ptrs P, int li) {
    float* X = (float*)(P.ws + WS_X); const float* TMP = (const float*)(P.ws + WS_NTMP); const float* mod = (const float*)(P.ws + WS_MOD);
    for (size_t i = (size_t)blockIdx.x * 256 + threadIdx.x; i < (size_t)T * D; i += (size_t)gridDim.x * 256) { const int row = (int)(i >> 10), c = (int)(i & 1023); const int r = row_r(row);
        X[i] += mod[(size_t)(li * 17 + r) * 6144 + 2048 + c] * TMP[i]; }
}
__global__ __launch_bounds__(256) void n_post_q(Ptrs P) {
    const float* TMP = (const float*)(P.ws + WS_NTMP); u16* QT = (u16*)(P.ws + WS_R1 + R1_QT); const float2* rope = (const float2*)(P.ws + WS_ROPE);
    const float scale = 0.07216878364870322f;
    for (size_t i = (size_t)blockIdx.x * 256 + threadIdx.x; i < (size_t)T * 1536; i += (size_t)gridDim.x * 256) { const int row = (int)(i / 1536), c = (int)(i % 1536); const int h = c / 192, dd = c % 192;
        const int b = row / LTOT, pos = row % LTOT; float v = TMP[i];
        if (dd >= 128 && pos >= CTXL) { const int l = dd - 128; const float pv = TMP[(size_t)row * 1536 + h * 192 + 128 + (l ^ 16)]; const float2 cs = rope[(size_t)(pos - CTXL) * 32 + (l >> 5) * 16 + (l & 15)];
            v = (l & 16) ? v * cs.x + pv * cs.y : v * cs.x - pv * cs.y; }
        QT[(((size_t)b * NH + h) * LTOT + pos) * QKD + dd] = f2bf(v * scale); }
}
__global__ __launch_bounds__(256) void n_post_kv(Ptrs P) {
    const float* TMP = (const float*)(P.ws + WS_NTMP); u16* KT = (u16*)(P.ws + WS_R1 + R1_KT); u16* VT = (u16*)(P.ws + WS_R1 + R1_VT);
    for (size_t i = (size_t)blockIdx.x * 256 + threadIdx.x; i < (size_t)T * 2048; i += (size_t)gridDim.x * 256) { const int row = (int)(i >> 11), c = (int)(i & 2047); const int h = c >> 8, dd = c & 255;
        const int b = row / LTOT, pos = row % LTOT; const u16 v = f2bf(TMP[i]);
        if (dd < 128) KT[(((size_t)b * NH + h) * LTOT + pos) * QKD + dd] = v; else VT[(((size_t)b * NH + h) * LTOT + pos) * 128 + dd - 128] = v; }
}
__global__ __launch_bounds__(256) void n_attn(Ptrs P) {
    __shared__ float Ks[32][192], Vs[32][128];
    const int qt = blockIdx.x, h = blockIdx.y, b = blockIdx.z, tid = threadIdx.x, ql = tid >> 2, part = tid & 3;
    const u16* QT = (const u16*)(P.ws + WS_R1 + R1_QT) + ((size_t)b * NH + h) * LTOT * QKD; const u16* KT = (const u16*)(P.ws + WS_R1 + R1_KT) + ((size_t)b * NH + h) * LTOT * QKD;
    const u16* VT = (const u16*)(P.ws + WS_R1 + R1_VT) + ((size_t)b * NH + h) * LTOT * 128; u16* O = (u16*)(P.ws + WS_ZO);
    const int pos = qt * 64 + ql; const int nk = (qt * 64 < CTXL) ? CTXL : LTOT;
    float q[48], o[32];
#pragma unroll
    for (int i = 0; i < 48; ++i) q[i] = bf2f(QT[(size_t)pos * QKD + part * 48 + i]);
#pragma unroll
    for (int i = 0; i < 32; ++i) o[i] = 0.f;
    float m = -1e30f, l = 0.f;
    for (int k0 = 0; k0 < nk; k0 += 32) {
        __syncthreads();
        for (int i = tid; i < 32 * 192; i += 256) Ks[i / 192][i % 192] = bf2f(KT[(size_t)k0 * QKD + i]);
        for (int i = tid; i < 32 * 128; i += 256) Vs[i / 128][i % 128] = bf2f(VT[(size_t)k0 * 128 + i]);
        __syncthreads();
        for (int kk = 0; kk < 32; ++kk) {
            float s = 0.f;
#pragma unroll
            for (int i = 0; i < 48; ++i) s += q[i] * Ks[kk][part * 48 + i];
            s += __shfl_xor(s, 1); s += __shfl_xor(s, 2);
            const float mn = fmaxf(m, s), al = __expf(m - mn), p = __expf(s - mn);
            l = l * al + p; m = mn;
#pragma unroll
            for (int i = 0; i < 32; ++i) o[i] = o[i] * al + p * Vs[kk][part * 32 + i];
        }
    }
    const float rl = 1.f / l;
#pragma unroll
    for (int i = 0; i < 32; ++i) O[((size_t)b * LTOT + pos) * D + h * 128 + part * 32 + i] = f2bf(o[i] * rl);
}
__global__ __launch_bounds__(128) void n_s5(Ptrs P, int j) {
    __shared__ float us[2][16], hre[2][64], him[2][64], Cre[2][16][64], Cim[2][16][64];
    const int b = blockIdx.x >> 6, g = blockIdx.x & 63, tid = threadIdx.x, dir = tid >> 6, p = tid & 63;
    const size_t gd = ((size_t)j * 2 + dir) * SG + g;
    const float dt = __expf(P.in[10][gd]); const float ar = P.in[8][gd * SP + p], ai = P.in[9][gd * SP + p];
    const float ldr = ar * dt, ldi = ai * dt, mag = __expf(ldr); const float abr = mag * __cosf(ldi), abi = mag * __sinf(ldi);
    const float nr = abr - 1.f, ni = abi, den = ar * ar + ai * ai; const float qr = (nr * ar + ni * ai) / den, qi = (ni * ar - nr * ai) / den;
    float bbr[16], bbi[16];
#pragma unroll
    for (int c = 0; c < 16; ++c) { const float br = P.in[11][(gd * SP + p) * SC + c], bi = P.in[12][(gd * SP + p) * SC + c]; bbr[c] = qr * br - qi * bi; bbi[c] = qr * bi + qi * br; }
    for (int i = tid; i < 2 * 16 * 64; i += 128) { const int d2 = i >> 10, c = (i >> 6) & 15, pp = i & 63; const size_t o = ((((size_t)j * 2 + d2) * SG + g) * SC + c) * SP + pp; Cre[d2][c][pp] = P.in[13][o]; Cim[d2][c][pp] = P.in[14][o]; }
    const u16* HX = (const u16*)(P.ws + WS_HX); float* Yf = (float*)(P.ws + WS_NTMP); float* Yr = Yf + (size_t)T * D;
    float hr = 0.f, hi = 0.f;
    for (int t = 0; t < LTOT; ++t) {
        __syncthreads();
        if (tid < 32) { const int d2 = tid >> 4, c = tid & 15; const int ps = d2 ? (t < CTXL ? CTXL - 1 - t : LTOT - 1 - (t - CTXL)) : t; us[d2][c] = bf2f(HX[((size_t)b * LTOT + ps) * D + g * 16 + c]); }
        __syncthreads();
        float bur = 0.f, bui = 0.f;
#pragma unroll
        for (int c = 0; c < 16; ++c) { bur += bbr[c] * us[dir][c]; bui += bbi[c] * us[dir][c]; }
        const float nhr = abr * hr - abi * hi + bur, nhi = abr * hi + abi * hr + bui; hr = nhr; hi = nhi;
        hre[dir][p] = hr; him[dir][p] = hi;
        __syncthreads();
        if (tid < 32) { const int d2 = tid >> 4, c = tid & 15; const int ps = d2 ? (t < CTXL ? CTXL - 1 - t : LTOT - 1 - (t - CTXL)) : t; float y = 0.f;
            for (int pp = 0; pp < 64; ++pp) y += Cre[d2][c][pp] * hre[d2][pp] - Cim[d2][c][pp] * him[d2][pp];
            (d2 ? Yr : Yf)[((size_t)b * LTOT + ps) * D + g * 16 + c] = y; }
    }
}
__global__ __launch_bounds__(256) void n_post_s5(Ptrs P, int j) {
    const float* Yf = (const float*)(P.ws + WS_NTMP); const float* Yr = Yf + (size_t)T * D; const u16* HX = (const u16*)(P.ws + WS_HX); u16* Z = (u16*)(P.ws + WS_ZO);
    for (size_t i = (size_t)blockIdx.x * 256 + threadIdx.x; i < (size_t)T * D; i += (size_t)gridDim.x * 256) { const int c = (int)(i & 1023);
        Z[i] = f2bf(gelu_tanh(Yf[i] + Yr[i] + P.in[15][j * 1024 + c] * bf2f(HX[i]))); }
}
__global__ __launch_bounds__(256) void n_build(Ptrs P, int li) {
    __shared__ int base[33];
    const unsigned* cnt = (const unsigned*)(P.ws + WS_CTL) + CW_CNT + li * 32 * CS; int* tileexp = (int*)(P.ws + WS_TILEEXP); int* slotrow = (int*)(P.ws + WS_SLOTROW); const int* list = (const int*)(P.ws + WS_LIST);
    if (threadIdx.x == 0) { int a = 0; for (int e = 0; e < 32; ++e) { base[e] = a; a += (int)((cnt[e * CS] + 255u) / 256u); } base[32] = a; tileexp[512] = a; }
    __syncthreads();
    for (int e = 0; e < 32; ++e) { const int nt = base[e + 1] - base[e];
        for (int t = threadIdx.x; t < nt; t += 256) tileexp[base[e] + t] = e;
        for (int s = threadIdx.x; s < nt * 256; s += 256) slotrow[base[e] * 256 + s] = s < (int)cnt[e * CS] ? list[(size_t)e * T + s] : -1; }
}
__global__ __launch_bounds__(256) void n_post_act2(Ptrs P, u16* ACT) {
    const float* TMP = (const float*)(P.ws + WS_NTMP); const int ntot = ((const int*)(P.ws + WS_TILEEXP))[512];
    for (size_t i = (size_t)blockIdx.x * 256 + threadIdx.x; i < (size_t)ntot * 256 * 512; i += (size_t)gridDim.x * 256) { const size_t gs = i >> 9; const int c = (int)(i & 511);
        ACT[i] = f2bf(silu_f(TMP[gs * 1024 + c]) * TMP[gs * 1024 + 512 + c]); }
}
__global__ __launch_bounds__(256) void n_post_y(Ptrs P) {
    const float* TMP = (const float*)(P.ws + WS_NTMP); u16* YB = (u16*)(P.ws + WS_YB); const int ntot = ((const int*)(P.ws + WS_TILEEXP))[512];
    for (size_t i = (size_t)blockIdx.x * 256 + threadIdx.x; i < (size_t)ntot * 256 * 1024; i += (size_t)gridDim.x * 256) YB[i] = f2bf(TMP[i]);
}

#define LAS __attribute__((address_space(3)))
typedef short bf16x8 __attribute__((ext_vector_type(8)));
typedef float f32x4 __attribute__((ext_vector_type(4)));
typedef unsigned u32x4 __attribute__((ext_vector_type(4)));
typedef unsigned u32x2 __attribute__((ext_vector_type(2)));
namespace g8 {
constexpr int BM = 256, BK = 64, HALF = 128, HTB = HALF * BK * 2, STAGE_BYTES = 8 * HTB, NXCD = 8, WGM = 8;
__host__ __device__ __forceinline__ int lds_byte(int r, int c) { const int st = (r >> 4) * 2 + (c >> 5), rr = r & 15, cc = c & 31, ob = rr * 64 + cc * 2; return st * 1024 + (ob ^ (((ob >> 9) & 1) << 5)); }
__host__ __device__ __forceinline__ void stage_rc(int b, int& R, int& C) { const int st = b / 1024, sb = b % 1024, swz = sb ^ (((sb >> 9) & 1) << 5); R = (st >> 1) * 16 + swz / 64; C = (st & 1) * 32 + (swz % 64) / 2; }
__host__ __device__ __forceinline__ int perm32(int rho) { const int n = rho >> 4, i = rho & 15; return 8 * (i >> 2) + 4 * n + (i & 3); }
struct Unit { int pm, pn, aux; };
struct Order {
    int nM, nN, nwg, G, c;
    __device__ __forceinline__ void init(int nM_, int nN_, int G_, int c_) { nM = nM_; nN = nN_; nwg = nM * nN; G = G_; c = c_; }
    __device__ __forceinline__ bool next(int i, int& pm, int& pn) const {
        const long L = (long)i * G + c; if (L >= nwg) return false;
        int wgid = (int)L; { const int q = nwg / NXCD, r = nwg % NXCD, xcd = wgid % NXCD, off = wgid / NXCD; wgid = (xcd < r ? xcd * (q + 1) : r * (q + 1) + (xcd - r) * q) + off; }
        const int nig = WGM * nN, gid = wgid / nig, fm = gid * WGM, gsz = (nM - fm) < WGM ? (nM - fm) : WGM;
        pm = fm + ((wgid % nig) % gsz); pn = (wgid % nig) / gsz; return true;
    }
};
__device__ __forceinline__ unsigned cvt_pk_bf16(float lo, float hi) { unsigned r; asm volatile("v_cvt_pk_bf16_f32 %0, %1, %2" : "=v"(r) : "v"(lo), "v"(hi)); return r; }

template <class Epi, class Sched>
__device__ __forceinline__ void gemm_phase(LAS unsigned char* lds, const int K, const Sched& S, const Epi& E, const int wv) {
    const int tid = tid_opaque(wv), wid = wv, lane = tid & 63, wr = wid >> 2, wc = wid & 3, fr = lane & 15, fq = lane >> 4;
    const int nt = K / BK;
    int R0, C0; stage_rc(tid * 16, R0, C0);
    unsigned voffB[2];
    { const int Rb0 = Epi::PERM ? ((R0 & ~31) + perm32(R0 & 31)) : R0;
      voffB[0] = (unsigned)(Rb0 * K + C0) * 2u; voffB[1] = voffB[0] + (unsigned)(64 * K) * 2u; }
    const size_t kstepB = (size_t)(BK * 2), hstepB = (size_t)HALF * K * 2;
    const size_t kstepA = S.a_kstep();
    const unsigned ldsw = (unsigned)wid * 1024u;
    const int aoff = lds_byte(wr * 64 + fr, fq * 8), boff = lds_byte(wc * 32 + fr, fq * 8);
#define G8_SA(b, h) (((b) * 2 + (h)) * HTB)
#define G8_SB(b, h) ((4 + (b) * 2 + (h)) * HTB)
#define G8_STAGE_B(bufoff, gbase) do { _Pragma("unroll") for (int _i = 0; _i < 2; ++_i) \
        __builtin_amdgcn_global_load_lds((const unsigned*)((const char*)(gbase) + voffB[_i]), (LAS unsigned*)(lds + (bufoff) + ldsw + _i * 8192), 16, 0, 0); } while (0)
#define G8_VI(h, i) ((Sched::NV == 1) ? 0 : ((h) * 2 + (i)))
#define G8_STAGE_A(bufoff, U, V, h, kb) do { \
        __builtin_amdgcn_global_load_lds((const unsigned*)(S.a_uptr(U, h, 0) + (size_t)(kb) + (V)[G8_VI(h, 0)]), (LAS unsigned*)(lds + (bufoff) + ldsw), 16, 0, 0); \
        __builtin_amdgcn_global_load_lds((const unsigned*)(S.a_uptr(U, h, 1) + (size_t)(kb) + (V)[G8_VI(h, 1)]), (LAS unsigned*)(lds + (bufoff) + ldsw + 8192), 16, 0, 0); } while (0)
#define G8_LDA(dst, b, h) do { _Pragma("unroll") for (int m = 0; m < 4; ++m) _Pragma("unroll") for (int k = 0; k < 2; ++k) dst[m][k] = *(const LAS bf16x8*)(lds + G8_SA(b, h) + aoff + m * 2048 + k * 1024); } while (0)
#define G8_LDB(dst, b, h) do { _Pragma("unroll") for (int n = 0; n < 2; ++n) _Pragma("unroll") for (int k = 0; k < 2; ++k) dst[n][k] = *(const LAS bf16x8*)(lds + G8_SB(b, h) + boff + n * 2048 + k * 1024); } while (0)
#define G8_MMA(ai, bj, At, Bt) do { __builtin_amdgcn_s_setprio(1); _Pragma("unroll") for (int m = 0; m < 4; ++m) _Pragma("unroll") for (int n = 0; n < 2; ++n) _Pragma("unroll") for (int k = 0; k < 2; ++k) \
        acc[ai][bj][m][n] = __builtin_amdgcn_mfma_f32_16x16x32_bf16(Bt[n][k], At[m][k], acc[ai][bj][m][n], 0, 0, 0); __builtin_amdgcn_s_setprio(0); } while (0)
#define G8_WAIT_V(n) asm volatile("s_waitcnt vmcnt(" #n ")" ::: "memory")
#define G8_WAIT_L(n) asm volatile("s_waitcnt lgkmcnt(" #n ")" ::: "memory")
#define G8_BAR __builtin_amdgcn_s_barrier()
#define G8_SCHED __builtin_amdgcn_sched_barrier(0)
    Unit cur, nxt; int ui = 0;
    if (!S.next(0, cur)) return;
    f32x4 acc[2][2][4][2];
#pragma unroll
    for (int a = 0; a < 2; ++a)
#pragma unroll
        for (int b = 0; b < 2; ++b)
#pragma unroll
            for (int m = 0; m < 4; ++m)
#pragma unroll
                for (int n = 0; n < 2; ++n) acc[a][b][m][n] = (f32x4){0.f, 0.f, 0.f, 0.f};
    bf16x8 At[4][2], B0[2][2], B1[2][2];
    unsigned cO[4], nO[4];
    S.a_voff(cur, R0, C0, cO);
    const char* cB = S.b_ptr(cur);
    G8_STAGE_B(G8_SB(0, 0), cB); G8_STAGE_A(G8_SA(0, 0), cur, cO, 0, 0); G8_STAGE_B(G8_SB(0, 1), cB + hstepB); G8_STAGE_A(G8_SA(0, 1), cur, cO, 1, 0);
    if (wr == 1) G8_BAR;
    G8_WAIT_V(4); G8_BAR;
    G8_STAGE_B(G8_SB(1, 0), cB + kstepB); G8_STAGE_A(G8_SA(1, 0), cur, cO, 0, kstepA); G8_STAGE_B(G8_SB(1, 1), cB + hstepB + kstepB);
    G8_WAIT_V(6); G8_BAR;
    for (;;) {
        const bool has_next = S.next(ui + 1, nxt);
        const char* nB = cB;
        if (has_next) { S.a_voff(nxt, R0, C0, nO); nB = S.b_ptr(nxt); }
        else { nxt = cur;
#pragma unroll
            for (int q = 0; q < 4; ++q) nO[q] = cO[q]; }
        for (int t = 0; t < nt; t += 2) {
            const bool last = (t == nt - 2);
            const size_t k1 = (size_t)(t + 1) * kstepA;
            const size_t k2 = last ? 0 : (size_t)(t + 2) * kstepA, k3 = k2 + kstepA;
            unsigned pV[4]; g8::Unit pU;
            if (last) { pU = nxt; pV[0] = nO[0]; pV[1] = nO[1]; pV[2] = nO[2]; pV[3] = nO[3]; } else { pU = cur; pV[0] = cO[0]; pV[1] = cO[1]; pV[2] = cO[2]; pV[3] = cO[3]; }
            const char* b2 = last ? nB : cB + (size_t)(t + 2) * kstepB; const char* b3 = b2 + kstepB;
            G8_LDB(B0, 0, 0); G8_SCHED; G8_LDA(At, 0, 0); G8_STAGE_A(G8_SA(1, 1), cur, cO, 1, k1);
            G8_WAIT_L(8); G8_BAR; G8_WAIT_L(0); G8_MMA(0, 0, At, B0); G8_BAR; G8_SCHED;
            G8_LDB(B1, 0, 1); G8_STAGE_B(G8_SB(0, 0), b2);
            G8_BAR; G8_WAIT_L(0); G8_MMA(0, 1, At, B1); G8_BAR;
            G8_LDA(At, 0, 1); G8_STAGE_A(G8_SA(0, 0), pU, pV, 0, k2);
            G8_BAR; G8_WAIT_L(0); G8_MMA(1, 0, At, B0); G8_BAR; G8_SCHED;
            G8_STAGE_B(G8_SB(0, 1), b2 + hstepB);
            G8_WAIT_V(6); G8_BAR; G8_MMA(1, 1, At, B1); G8_BAR;
            G8_LDB(B0, 1, 0); G8_SCHED; G8_LDA(At, 1, 0); G8_STAGE_A(G8_SA(0, 1), pU, pV, 1, k2);
            G8_WAIT_L(8); G8_BAR; G8_WAIT_L(0); G8_MMA(0, 0, At, B0); G8_BAR; G8_SCHED;
            G8_LDB(B1, 1, 1); G8_STAGE_B(G8_SB(1, 0), b3);
            G8_BAR; G8_WAIT_L(0); G8_MMA(0, 1, At, B1); G8_BAR;
            G8_LDA(At, 1, 1); G8_STAGE_A(G8_SA(1, 0), pU, pV, 0, k3);
            G8_BAR; G8_WAIT_L(0); G8_MMA(1, 0, At, B0); G8_BAR; G8_SCHED;
            G8_STAGE_B(G8_SB(1, 1), b3 + hstepB);
            G8_WAIT_V(6); G8_BAR; G8_MMA(1, 1, At, B1); G8_BAR;
        }
        E(acc, cur, wr, wc, fr, fq);
        if (!has_next) break;
#pragma unroll
        for (int a = 0; a < 2; ++a)
#pragma unroll
            for (int b = 0; b < 2; ++b)
#pragma unroll
                for (int m = 0; m < 4; ++m)
#pragma unroll
                    for (int n = 0; n < 2; ++n) acc[a][b][m][n] = (f32x4){0.f, 0.f, 0.f, 0.f};
        cur = nxt; cB = nB; ++ui;
#pragma unroll
        for (int q = 0; q < 4; ++q) cO[q] = nO[q];
    }
    G8_WAIT_V(0);
    if (wr == 0) G8_BAR;
    G8_BAR;
#undef G8_SA
#undef G8_SB
#undef G8_STAGE_A
#undef G8_VI
#undef G8_STAGE_B
#undef G8_LDA
#undef G8_LDB
#undef G8_MMA
#undef G8_WAIT_V
#undef G8_WAIT_L
#undef G8_BAR
#undef G8_SCHED
}
}
struct SchedDense {
    g8::Order ord; const char* A; unsigned lda2; const char* Bt; int K;
    __device__ __forceinline__ void init(const void* A_, int lda, const void* Bt_, int M, int N, int K_) { A = (const char*)A_; lda2 = (unsigned)lda * 2u; Bt = (const char*)Bt_; K = K_; ord.init(M / 256, N / 256, (int)gridDim.x, (int)blockIdx.x); }
    __device__ __forceinline__ bool next(int i, g8::Unit& u) const { u.aux = 0; return ord.next(i, u.pm, u.pn); }
    static constexpr int NV = 1;
    __device__ __forceinline__ size_t a_kstep() const { return 128; }
    __device__ __forceinline__ const char* a_uptr(const g8::Unit& u, int h, int i) const { return A + (size_t)(u.pm * 256 + h * 128 + i * 64) * lda2; }
    __device__ __forceinline__ void a_voff(const g8::Unit& u, int R0, int C0, unsigned (&o)[4]) const { o[0] = (unsigned)R0 * lda2 + C0 * 2; }
    __device__ __forceinline__ const char* b_ptr(const g8::Unit& u) const { return Bt + (size_t)u.pn * 256 * K * 2; }
};
struct SchedS5 {
    g8::Order ord; const char* A; const char* W; int K;
    __device__ __forceinline__ void init(const void* A_, const void* W_, int K_) { A = (const char*)A_; W = (const char*)W_; K = K_; ord.init(576, 1, (int)gridDim.x, (int)blockIdx.x); }
    __device__ __forceinline__ bool next(int i, g8::Unit& u) const { int pmx, pn; if (!ord.next(i, pmx, pn)) return false; u.aux = pmx / 9; u.pm = pmx % 9; u.pn = 0; return true; }
    static constexpr int NV = 1;
    __device__ __forceinline__ size_t a_kstep() const { return 128; }
    __device__ __forceinline__ const char* a_uptr(const g8::Unit& u, int h, int i) const { return A + (size_t)(u.aux * 2304 + u.pm * 256 + h * 128 + i * 64) * 1024; }
    __device__ __forceinline__ void a_voff(const g8::Unit& u, int R0, int C0, unsigned (&o)[4]) const { o[0] = (unsigned)R0 * 1024u + C0 * 2; }
    __device__ __forceinline__ const char* b_ptr(const g8::Unit& u) const { return W + (size_t)u.aux * 256 * K * 2; }
};
template <bool GATHER> struct SchedMoe {
    g8::Order ord; const char* A; const char* W; int K; const int* sbase; const unsigned* cnt; const int* list; size_t wstride;
    __device__ __forceinline__ void init(const void* A_, const void* W_, int K_, const int* sbase_, const unsigned* cnt_, const int* list_) {
        A = (const char*)A_; W = (const char*)W_; K = K_; sbase = sbase_; cnt = cnt_; list = list_; wstride = (size_t)1024 * K * 2; ord.init(sbase_[32], 4, (int)gridDim.x, (int)blockIdx.x); }
    __device__ __forceinline__ bool next(int i, g8::Unit& u) const { if (!ord.next(i, u.pm, u.pn)) return false; int e = 0;
        for (int k = 1; k < 32; ++k) e = (u.pm >= sbase[k]) ? k : e;
        u.aux = e; return true; }
    static constexpr int NV = GATHER ? 4 : 1;
    __device__ __forceinline__ size_t a_kstep() const { return 128; }
    __device__ __forceinline__ const char* a_uptr(const g8::Unit& u, int h, int i) const { return GATHER ? A : A + (size_t)(u.pm * 256 + h * 128 + i * 64) * 1024; }
    __device__ __forceinline__ void a_voff(const g8::Unit& u, int R0, int C0, unsigned (&o)[4]) const {
        if (GATHER) {
            const int e = u.aux; const int s0 = (u.pm - sbase[e]) * 256 + R0; const int n = (int)cnt[e * CS]; const int* l = list + (size_t)e * T;
#pragma unroll
            for (int q = 0; q < 4; ++q) { const int a = s0 + q * 64; o[q] = (unsigned)l[a < n ? a : 0] * 2048u + C0 * 2; }
        } else o[0] = (unsigned)R0 * 1024u + C0 * 2; }
    __device__ __forceinline__ const char* b_ptr(const g8::Unit& u) const { return W + (size_t)u.aux * wstride + (size_t)u.pn * 256 * K * 2; }
};

#define EPI_LOOP_AM for (int ai = 0; ai < 2; ++ai) _Pragma("unroll") for (int m = 0; m < 4; ++m)
struct EpiS5a {
    static constexpr bool PERM = false; float* S;
    __device__ __forceinline__ void operator()(const f32x4 (&acc)[2][2][4][2], const g8::Unit& u, int wr, int wc, int fr, int fq) const {
        float* base = S + ((size_t)u.aux * 2304 + (size_t)u.pm * 256 + wr * 64 + fr) * 256 + wc * 32 + 4 * fq;
#pragma unroll
        EPI_LOOP_AM { float* rowp = base + (size_t)(ai * 128 + m * 16) * 256;
#pragma unroll
            for (int bj = 0; bj < 2; ++bj)
#pragma unroll
                for (int n = 0; n < 2; ++n) *(f32x4*)(rowp + bj * 128 + n * 16) = acc[ai][bj][m][n]; }
    }
};
struct EpiS5b {
    static constexpr bool PERM = true; u16* Z; const u16* UH; const float* dvec;
    __device__ __forceinline__ void operator()(const f32x4 (&acc)[2][2][4][2], const g8::Unit& u, int wr, int wc, int fr, int fq) const {
        const int g = u.aux; const int ch0 = (fq & 1) * 8;
        const f32x4 d0 = *(const f32x4*)(dvec + g * 16 + ch0), d1 = *(const f32x4*)(dvec + g * 16 + ch0 + 4);
#pragma unroll
        EPI_LOOP_AM { const int rowin = u.pm * 256 + ai * 128 + wr * 64 + m * 16 + fr;
#pragma unroll
            for (int bj = 0; bj < 2; ++bj) { const int c0 = bj * 128 + wc * 32 + fq * 8; const int t = c0 >> 4;
                const u32x4 uu = *(const u32x4*)(UH + ((size_t)g * 2304 + rowin) * 512 + c0);
                const f32x4 a0 = acc[ai][bj][m][0], a1 = acc[ai][bj][m][1];
                float z[8];
                z[0] = a0[0] + d0[0] * __uint_as_float(uu.x << 16); z[1] = a0[1] + d0[1] * __uint_as_float(uu.x & 0xffff0000u);
                z[2] = a0[2] + d0[2] * __uint_as_float(uu.y << 16); z[3] = a0[3] + d0[3] * __uint_as_float(uu.y & 0xffff0000u);
                z[4] = a1[0] + d1[0] * __uint_as_float(uu.z << 16); z[5] = a1[1] + d1[1] * __uint_as_float(uu.z & 0xffff0000u);
                z[6] = a1[2] + d1[2] * __uint_as_float(uu.w << 16); z[7] = a1[3] + d1[3] * __uint_as_float(uu.w & 0xffff0000u);
#pragma unroll
                for (int q = 0; q < 8; ++q) z[q] = gelu_tanh(z[q]);
                u32x4 w; w.x = g8::cvt_pk_bf16(z[0], z[1]); w.y = g8::cvt_pk_bf16(z[2], z[3]); w.z = g8::cvt_pk_bf16(z[4], z[5]); w.w = g8::cvt_pk_bf16(z[6], z[7]);
                *(u32x4*)(Z + ((size_t)rowin * 16 + t) * 1024 + g * 16 + ch0) = w; } }
    }
};
struct EpiGlu {
    static constexpr bool PERM = true; u16* DL; const float* mod; int li;
    __device__ __forceinline__ void operator()(const f32x4 (&acc)[2][2][4][2], const g8::Unit& u, int wr, int wc, int fr, int fq) const {
        const int r = (u.pm % 9 == 0) ? 16 : u.pm / 9; const float* gate = mod + (size_t)(li * 17 + r) * 6144 + 2048;
        const int j0 = u.pn * 128 + wc * 32 + fq * 8;
        const f32x4 g0 = *(const f32x4*)(gate + j0), g1 = *(const f32x4*)(gate + j0 + 4);
#pragma unroll
        EPI_LOOP_AM { const size_t row = (size_t)u.pm * 256 + ai * 128 + wr * 64 + m * 16 + fr;
            const f32x4 v0 = acc[ai][0][m][0], v1 = acc[ai][0][m][1], t0 = acc[ai][1][m][0], t1 = acc[ai][1][m][1];
            u32x4 w; w.x = g8::cvt_pk_bf16(g0[0] * v0[0] * sigmoid_f(t0[0]), g0[1] * v0[1] * sigmoid_f(t0[1])); w.y = g8::cvt_pk_bf16(g0[2] * v0[2] * sigmoid_f(t0[2]), g0[3] * v0[3] * sigmoid_f(t0[3]));
            w.z = g8::cvt_pk_bf16(g1[0] * v1[0] * sigmoid_f(t1[0]), g1[1] * v1[1] * sigmoid_f(t1[1])); w.w = g8::cvt_pk_bf16(g1[2] * v1[2] * sigmoid_f(t1[2]), g1[3] * v1[3] * sigmoid_f(t1[3]));
            *(u32x4*)(DL + row * 1024 + j0) = w; }
    }
};
struct EpiF32 {
    static constexpr bool PERM = false; float* C; int ldc;
    __device__ __forceinline__ void operator()(const f32x4 (&acc)[2][2][4][2], const g8::Unit& u, int wr, int wc, int fr, int fq) const {
        float* base = C + ((size_t)u.pm * 256 + wr * 64 + fr) * ldc + u.pn * 256 + wc * 32 + 4 * fq;
#pragma unroll
        EPI_LOOP_AM { float* rowp = base + (size_t)(ai * 128 + m * 16) * ldc;
#pragma unroll
            for (int bj = 0; bj < 2; ++bj)
#pragma unroll
                for (int n = 0; n < 2; ++n) *(f32x4*)(rowp + bj * 128 + n * 16) = acc[ai][bj][m][n]; }
    }
};
struct EpiQ {
    static constexpr bool PERM = false; u16* QT; const float2* rope;
    __device__ __forceinline__ void operator()(const f32x4 (&acc)[2][2][4][2], const g8::Unit& u, int wr, int wc, int fr, int fq) const {
        const float scale = 0.07216878364870322f; const int b = u.pm / 9, pt = u.pm % 9;
#pragma unroll
        EPI_LOOP_AM { const int pos = pt * 256 + ai * 128 + wr * 64 + m * 16 + fr;
#pragma unroll
            for (int bj = 0; bj < 2; ++bj) { const int g32 = u.pn * 8 + bj * 4 + wc; const int h = g32 / 6, part = g32 % 6;
                f32x4 a = acc[ai][bj][m][0], bq = acc[ai][bj][m][1];
                if (part >= 4 && pos >= CTXL) { const float2* rp = rope + (size_t)(pos - CTXL) * 32 + (part - 4) * 16 + fq * 4;
#pragma unroll
                    for (int q = 0; q < 4; ++q) { const float2 cs = rp[q]; const float x0 = a[q], x1 = bq[q]; a[q] = x0 * cs.x - x1 * cs.y; bq[q] = x1 * cs.x + x0 * cs.y; } }
                u16* dst = QT + (((size_t)b * NH + h) * LTOT + pos) * QKD + part * 32 + fq * 4;
                u32x2 w0, w1; w0.x = g8::cvt_pk_bf16(a[0] * scale, a[1] * scale); w0.y = g8::cvt_pk_bf16(a[2] * scale, a[3] * scale);
                w1.x = g8::cvt_pk_bf16(bq[0] * scale, bq[1] * scale); w1.y = g8::cvt_pk_bf16(bq[2] * scale, bq[3] * scale);
                *(u32x2*)dst = w0; *(u32x2*)(dst + 16) = w1; } }
    }
};
struct EpiKV {
    static constexpr bool PERM = true; u16* KT; u16* VT;
    __device__ __forceinline__ void operator()(const f32x4 (&acc)[2][2][4][2], const g8::Unit& u, int wr, int wc, int fr, int fq) const {
        const int b = u.pm / 9, pt = u.pm % 9, h = u.pn;
#pragma unroll
        EPI_LOOP_AM { const int pos = pt * 256 + ai * 128 + wr * 64 + m * 16 + fr; const size_t rr = ((size_t)b * NH + h) * LTOT + pos;
#pragma unroll
            for (int bj = 0; bj < 2; ++bj) { const f32x4 a0 = acc[ai][bj][m][0], a1 = acc[ai][bj][m][1];
                u32x4 w; w.x = g8::cvt_pk_bf16(a0[0], a0[1]); w.y = g8::cvt_pk_bf16(a0[2], a0[3]); w.z = g8::cvt_pk_bf16(a1[0], a1[1]); w.w = g8::cvt_pk_bf16(a1[2], a1[3]);
                u16* dst = bj == 0 ? KT + rr * QKD + wc * 32 + fq * 8 : VT + rr * 128 + wc * 32 + fq * 8;
                *(u32x4*)dst = w; } }
    }
};
struct EpiWo {
    static constexpr bool PERM = true; u16* DL; const float* mod; int li;
    __device__ __forceinline__ void operator()(const f32x4 (&acc)[2][2][4][2], const g8::Unit& u, int wr, int wc, int fr, int fq) const {
        const int r = (u.pm % 9 == 0) ? 16 : u.pm / 9; const float* gate = mod + (size_t)(li * 17 + r) * 6144 + 2048;
        f32x4 gg[2][2];
#pragma unroll
        for (int bj = 0; bj < 2; ++bj)
#pragma unroll
            for (int n = 0; n < 2; ++n) gg[bj][n] = *(const f32x4*)(gate + u.pn * 256 + bj * 128 + wc * 32 + fq * 8 + n * 4);
#pragma unroll
        EPI_LOOP_AM { const size_t row = (size_t)u.pm * 256 + ai * 128 + wr * 64 + m * 16 + fr;
#pragma unroll
            for (int bj = 0; bj < 2; ++bj) { const f32x4 a0 = acc[ai][bj][m][0] * gg[bj][0], a1 = acc[ai][bj][m][1] * gg[bj][1];
                u32x4 w; w.x = g8::cvt_pk_bf16(a0[0], a0[1]); w.y = g8::cvt_pk_bf16(a0[2], a0[3]); w.z = g8::cvt_pk_bf16(a1[0], a1[1]); w.w = g8::cvt_pk_bf16(a1[2], a1[3]);
                *(u32x4*)(DL + row * 1024 + u.pn * 256 + bj * 128 + wc * 32 + fq * 8) = w; } }
    }
};
struct EpiMoe1 {
    static constexpr bool PERM = true; u16* ACT;
    __device__ __forceinline__ void operator()(const f32x4 (&acc)[2][2][4][2], const g8::Unit& u, int wr, int wc, int fr, int fq) const {
        const int j0 = u.pn * 128 + wc * 32 + fq * 8;
#pragma unroll
        EPI_LOOP_AM { const size_t gs = (size_t)u.pm * 256 + ai * 128 + wr * 64 + m * 16 + fr;
            const f32x4 g0 = acc[ai][0][m][0], g1 = acc[ai][0][m][1], u0 = acc[ai][1][m][0], u1 = acc[ai][1][m][1];
            u32x4 w; w.x = g8::cvt_pk_bf16(silu_f(g0[0]) * u0[0], silu_f(g0[1]) * u0[1]); w.y = g8::cvt_pk_bf16(silu_f(g0[2]) * u0[2], silu_f(g0[3]) * u0[3]);
            w.z = g8::cvt_pk_bf16(silu_f(g1[0]) * u1[0], silu_f(g1[1]) * u1[1]); w.w = g8::cvt_pk_bf16(silu_f(g1[2]) * u1[2], silu_f(g1[3]) * u1[3]);
            *(u32x4*)(ACT + gs * 512 + j0) = w; }
    }
};
struct EpiMoe2 {
    static constexpr bool PERM = true; u16* YB;
    __device__ __forceinline__ void operator()(const f32x4 (&acc)[2][2][4][2], const g8::Unit& u, int wr, int wc, int fr, int fq) const {
#pragma unroll
        EPI_LOOP_AM { const size_t gs = (size_t)u.pm * 256 + ai * 128 + wr * 64 + m * 16 + fr;
#pragma unroll
            for (int bj = 0; bj < 2; ++bj) { const f32x4 a0 = acc[ai][bj][m][0], a1 = acc[ai][bj][m][1];
                u32x4 w; w.x = g8::cvt_pk_bf16(a0[0], a0[1]); w.y = g8::cvt_pk_bf16(a0[2], a0[3]); w.z = g8::cvt_pk_bf16(a1[0], a1[1]); w.w = g8::cvt_pk_bf16(a1[2], a1[3]);
                *(u32x4*)(YB + gs * 1024 + u.pn * 256 + bj * 128 + wc * 32 + fq * 8) = w; } }
    }
};
namespace at {
typedef short s16x4 __attribute__((ext_vector_type(4)));
typedef float f32x16 __attribute__((ext_vector_type(16)));
constexpr int KVBLK = 64, QBLK = 32, NW = 8;
constexpr int SHM_V = KVBLK * 128 * 2, SHM_K = KVBLK * QKD * 2, NBUF = 3, SHM_ATTN = NBUF * SHM_V + NBUF * SHM_K + NW * 64 * 4;
constexpr float SCALE = 1.0f;
constexpr float THR = 8.f;
#define KSWZ(row, colB) ((row) * 384 + ((colB) ^ (((row) & 7) << 4)))
#define SBAR() __builtin_amdgcn_sched_barrier(0)
__device__ __forceinline__ int crow(int r, int hi) { return (r & 3) + 8 * (r >> 2) + 4 * hi; }
__device__ __forceinline__ unsigned cvtpk(float lo, float hi) { unsigned r; asm volatile("v_cvt_pk_bf16_f32 %0, %1, %2" : "=v"(r) : "v"(lo), "v"(hi)); return r; }
__device__ __forceinline__ void partialSM(f32x16& p0, f32x16& p1, float& m_reg, float& mn, float& alpha) {
    constexpr float C = SCALE * 1.4426950408889634f;
    float pmax = p0[0];
#pragma unroll
    for (int r = 1; r < 16; ++r) pmax = fmaxf(pmax, p0[r]);
#pragma unroll
    for (int r = 0; r < 16; ++r) pmax = fmaxf(pmax, p1[r]);
    { auto rr = __builtin_amdgcn_permlane32_swap(__float_as_uint(pmax), __float_as_uint(pmax), false, false); pmax = fmaxf(__uint_as_float(rr[0]), __uint_as_float(rr[1])); }
    if (__builtin_expect(__all(pmax - m_reg <= THR / SCALE), 1)) { mn = m_reg; alpha = 1.f; }
    else { mn = fmaxf(m_reg, pmax); alpha = __builtin_amdgcn_exp2f((m_reg - mn) * C); m_reg = mn; }
    const float mnC = -mn * C;
#pragma unroll
    for (int r = 0; r < 16; ++r) p0[r] = fmaf(p0[r], C, mnC);
#pragma unroll
    for (int r = 0; r < 16; ++r) p1[r] = fmaf(p1[r], C, mnC);
#pragma unroll
    for (int r = 0; r < 16; ++r) p0[r] = __builtin_amdgcn_exp2f(p0[r]);
}
__device__ __forceinline__ void finishSM(f32x16& p0, f32x16& p1, float alpha, float& l_reg, bf16x8& pa0, bf16x8& pa1, bf16x8& pa2, bf16x8& pa3) {
#pragma unroll
    for (int r = 0; r < 16; ++r) p1[r] = __builtin_amdgcn_exp2f(p1[r]);
    float ps = 0;
#pragma unroll
    for (int r = 0; r < 16; ++r) ps += p0[r];
#pragma unroll
    for (int r = 0; r < 16; ++r) ps += p1[r];
    { auto rr = __builtin_amdgcn_permlane32_swap(__float_as_uint(ps), __float_as_uint(ps), false, false); ps = __uint_as_float(rr[0]) + __uint_as_float(rr[1]); }
    l_reg = l_reg * alpha + ps;
#define PK4(P, BASE, OUT) do { unsigned a0 = cvtpk(P[BASE + 0], P[BASE + 1]), a1 = cvtpk(P[BASE + 2], P[BASE + 3]);   \
    unsigned b0 = cvtpk(P[BASE + 4], P[BASE + 5]), b1 = cvtpk(P[BASE + 6], P[BASE + 7]);                              \
    auto r0 = __builtin_amdgcn_permlane32_swap(a0, b0, false, false); auto r1 = __builtin_amdgcn_permlane32_swap(a1, b1, false, false); \
    u32x4 w = {r0[0], r1[0], r0[1], r1[1]}; OUT = *reinterpret_cast<bf16x8*>(&w); } while (0)
    PK4(p0, 0, pa0); PK4(p0, 8, pa1); PK4(p1, 0, pa2); PK4(p1, 8, pa3);
#undef PK4
}
#define KRD(x0, x1, kb, a) do { asm volatile("ds_read_b128 %0, %1 offset:%2" : "=v"(x0) : "v"(kb), "i"((a) * 128) : "memory"); \
                                asm volatile("ds_read_b128 %0, %1 offset:%2" : "=v"(x1) : "v"(kb), "i"((a) * 128 + 32 * 384) : "memory"); } while (0)
#define KWT(n, x0, x1) asm volatile("s_waitcnt lgkmcnt(" #n ")" : "+v"(x0), "+v"(x1) :: "memory")
#define KMM(x0, x1, q) do { p0 = __builtin_amdgcn_mfma_f32_32x32x16_bf16(x0, q, p0, 0, 0, 0); p1 = __builtin_amdgcn_mfma_f32_32x32x16_bf16(x1, q, p1, 0, 0, 0); } while (0)
__device__ __forceinline__ void qkt(f32x16& p0, f32x16& p1, int kb0, int kb1, int kb2, int kb3, const bf16x8* qr) {
    p0 = f32x16{}; p1 = f32x16{};
    bf16x8 a0, a1, b0, b1, c0, c1;
    KRD(a0, a1, kb0, 0); KRD(b0, b1, kb1, 0); KRD(c0, c1, kb2, 0);
    KWT(4, a0, a1); KMM(a0, a1, qr[0]);
    KWT(2, b0, b1); KMM(b0, b1, qr[1]);  KRD(a0, a1, kb3, 0);
    KWT(2, c0, c1); KMM(c0, c1, qr[2]);  KRD(b0, b1, kb0, 1);
    KWT(2, a0, a1); KMM(a0, a1, qr[3]);  KRD(c0, c1, kb1, 1);
    KWT(2, b0, b1); KMM(b0, b1, qr[4]);  KRD(a0, a1, kb2, 1);
    KWT(2, c0, c1); KMM(c0, c1, qr[5]);  KRD(b0, b1, kb3, 1);
    KWT(2, a0, a1); KMM(a0, a1, qr[6]);  KRD(c0, c1, kb0, 2);
    KWT(2, b0, b1); KMM(b0, b1, qr[7]);  KRD(a0, a1, kb1, 2);
    KWT(2, c0, c1); KMM(c0, c1, qr[8]);  KRD(b0, b1, kb2, 2);
    KWT(2, a0, a1); KMM(a0, a1, qr[9]);  KRD(c0, c1, kb3, 2);
    KWT(2, b0, b1); KMM(b0, b1, qr[10]);
    KWT(0, c0, c1); KMM(c0, c1, qr[11]);
}
#undef KRD
#undef KWT
#undef KMM
__device__ __forceinline__ int v_st(int k, int c) { const int kk = (k & ~0xC) | ((k & 4) << 1) | ((k & 8) >> 1); return ((kk >> 3) * 4 + (c >> 5)) * 512 + ((kk & 7) * 32 + (c & 31)) * 2; }
__device__ __forceinline__ int v_rd_base(int lane) { return ((lane & 3) << 3) | (((lane >> 2) & 3) << 6) | (((lane >> 4) & 1) << 5) | (((lane >> 5) & 1) << 8); }
constexpr int v_rd_off(int d0, int ks, int half) { return d0 * 512 + ks * 4096 + half * 2048; }
template <int OFF> __device__ __forceinline__ s16x4 tr_read(int vb) { s16x4 r; asm volatile("ds_read_b64_tr_b16 %0, %1 offset:%2" : "=&v"(r) : "v"(vb), "i"(OFF) : "memory"); return r; }
struct VFr { s16x4 l0, h0, l1, h1, l2, h2, l3, h3; };
template <int D0> __device__ __forceinline__ void pv_rd(VFr& f, int vb) {
    f.l0 = tr_read<v_rd_off(D0, 0, 0)>(vb); f.h0 = tr_read<v_rd_off(D0, 0, 1)>(vb); f.l1 = tr_read<v_rd_off(D0, 1, 0)>(vb); f.h1 = tr_read<v_rd_off(D0, 1, 1)>(vb);
    f.l2 = tr_read<v_rd_off(D0, 2, 0)>(vb); f.h2 = tr_read<v_rd_off(D0, 2, 1)>(vb); f.l3 = tr_read<v_rd_off(D0, 3, 0)>(vb); f.h3 = tr_read<v_rd_off(D0, 3, 1)>(vb);
}
#define VWT(n, f) asm volatile("s_waitcnt lgkmcnt(" #n ")" : "+v"(f.l0), "+v"(f.h0), "+v"(f.l1), "+v"(f.h1), "+v"(f.l2), "+v"(f.h2), "+v"(f.l3), "+v"(f.h3) :: "memory")
__device__ __forceinline__ void pv_mm(f32x16& od, const VFr& f, bf16x8 pa0, bf16x8 pa1, bf16x8 pa2, bf16x8 pa3) {
#define PK(L, H) (bf16x8){L[0], L[1], L[2], L[3], H[0], H[1], H[2], H[3]}
    od = __builtin_amdgcn_mfma_f32_32x32x16_bf16(pa0, PK(f.l0, f.h0), od, 0, 0, 0);
    od = __builtin_amdgcn_mfma_f32_32x32x16_bf16(pa1, PK(f.l1, f.h1), od, 0, 0, 0);
    od = __builtin_amdgcn_mfma_f32_32x32x16_bf16(pa2, PK(f.l2, f.h2), od, 0, 0, 0);
    od = __builtin_amdgcn_mfma_f32_32x32x16_bf16(pa3, PK(f.l3, f.h3), od, 0, 0, 0);
#undef PK
}
__device__ __forceinline__ void pv_d0(f32x16* o, int vb, bf16x8 pa0, bf16x8 pa1, bf16x8 pa2, bf16x8 pa3) {
    VFr fa, fb;
    pv_rd<0>(fa, vb);
    pv_rd<1>(fb, vb); VWT(8, fa); pv_mm(o[0], fa, pa0, pa1, pa2, pa3);
    pv_rd<2>(fa, vb); VWT(8, fb); pv_mm(o[1], fb, pa0, pa1, pa2, pa3);
    pv_rd<3>(fb, vb); VWT(8, fa); pv_mm(o[2], fa, pa0, pa1, pa2, pa3);
                      VWT(0, fb); pv_mm(o[3], fb, pa0, pa1, pa2, pa3);
}
#undef VWT
__device__ __forceinline__ void attn_body(const u16* __restrict__ Qb, const u16* __restrict__ Kh, const u16* __restrict__ Vh, u16* __restrict__ Ob, int ldo, int seq, char* lds, LAS unsigned char* ldsl, int wv) {
    const int tid = tid_opaque(wv), wid = wv, lane = tid & 63, r32 = lane & 31, hi = lane >> 5;
    char* V_lds = lds; char* K_lds = lds + NBUF * SHM_V;
    float* ws = (float*)(lds + NBUF * SHM_V + NBUF * SHM_K) + wid * 64; float* li_l = ws; float* al_l = ws + 32;
    float m_reg = -1e30f, l_reg = 0; f32x16 o[4] = {}; bf16x8 qr[12];
    const u16* Qw = Qb + (long)(wid * QBLK + r32) * QKD + hi * 8;
#pragma unroll
    for (int d0 = 0; d0 < 12; ++d0) qr[d0] = *reinterpret_cast<const bf16x8*>(Qw + d0 * 16);
    unsigned kof[3], vof[2];
#pragma unroll
    for (int i = 0; i < 3; ++i) { const int p = (wid + 8 * i) * 64 + lane, row = p / 24, slot = p % 24; kof[i] = (unsigned)(row * 384 + ((slot * 16) ^ ((row & 7) << 4))); }
#pragma unroll
    for (int i = 0; i < 2; ++i) { const int ob = (wid + 8 * i) * 1024 + lane * 16, sub = ob >> 9, within = (ob & 511) >> 1; const int kk = (sub >> 2) * 8 + (within >> 5);
        const int k = (kk & ~0xC) | ((kk & 4) << 1) | ((kk & 8) >> 1), col = (sub & 3) * 32 + (within & 31); vof[i] = (unsigned)(k * 256 + col * 2); }
    const char* Kg = (const char*)Kh; const char* Vg = (const char*)Vh;
#define DMA(t, bK, bV) do { _Pragma("unroll") for (int i_ = 0; i_ < 3; ++i_) __builtin_amdgcn_global_load_lds((const unsigned*)(Kg + (size_t)(t) * (KVBLK * 384) + kof[i_]), (LAS unsigned*)(ldsl + NBUF * SHM_V + (bK) + (wid + 8 * i_) * 1024), 16, 0, 0); \
    _Pragma("unroll") for (int i_ = 0; i_ < 2; ++i_) __builtin_amdgcn_global_load_lds((const unsigned*)(Vg + (size_t)(t) * (KVBLK * 256) + vof[i_]), (LAS unsigned*)(ldsl + (bV) + (wid + 8 * i_) * 1024), 16, 0, 0); } while (0)
    const int vb0 = (int)(uintptr_t)V_lds + v_rd_base(lane);
    const int kx = (r32 & 7) << 4, kl = (int)(uintptr_t)K_lds + r32 * 384;
    const int kbs0 = kl + ((0 * 32 + hi * 16) ^ kx), kbs1 = kl + ((1 * 32 + hi * 16) ^ kx), kbs2 = kl + ((2 * 32 + hi * 16) ^ kx), kbs3 = kl + ((3 * 32 + hi * 16) ^ kx);
#define RESC(a) do { if (__any((a) < 1.f)) { if (hi == 0) al_l[r32] = (a); asm volatile("s_waitcnt lgkmcnt(0)" ::: "memory"); \
    _Pragma("unroll") for (int d = 0; d < 4; ++d) _Pragma("unroll") for (int r = 0; r < 16; ++r) o[d][r] *= al_l[crow(r, hi)]; } } while (0)
    f32x16 p0, p1; float mn, al; bf16x8 pa0, pa1, pa2, pa3; const int NT = seq / KVBLK;
    int b0 = 0, b1 = 1, b2 = 2;
    DMA(0, 0, 0); DMA(1, SHM_K, SHM_V);
    asm volatile("s_waitcnt vmcnt(5)" ::: "memory"); __builtin_amdgcn_s_barrier(); asm volatile("" ::: "memory");
    for (int j = 0; j < NT; ++j) {
        if (j + 2 < NT) DMA(j + 2, b2 * SHM_K, b2 * SHM_V);
        SBAR(); qkt(p0, p1, kbs0 + b0 * SHM_K, kbs1 + b0 * SHM_K, kbs2 + b0 * SHM_K, kbs3 + b0 * SHM_K, qr);
        partialSM(p0, p1, m_reg, mn, al); RESC(al);
        finishSM(p0, p1, al, l_reg, pa0, pa1, pa2, pa3); SBAR();
        pv_d0(o, vb0 + b0 * SHM_V, pa0, pa1, pa2, pa3);
        if (j + 2 < NT) asm volatile("s_waitcnt vmcnt(5)" ::: "memory"); else asm volatile("s_waitcnt vmcnt(0)" ::: "memory");
        asm volatile("s_waitcnt lgkmcnt(0)" ::: "memory"); __builtin_amdgcn_s_barrier(); asm volatile("" ::: "memory");
        { const int t_ = b0; b0 = b1; b1 = b2; b2 = t_; }
    }
    if (hi == 0) li_l[r32] = l_reg; asm volatile("s_waitcnt lgkmcnt(0)" ::: "memory");
    float rli[16];
#pragma unroll
    for (int r = 0; r < 16; ++r) rli[r] = __builtin_amdgcn_rcpf(li_l[crow(r, hi)]);
    u16* Ow = Ob + (long)(wid * QBLK) * ldo;
#pragma unroll
    for (int r = 0; r < 16; ++r) { const int orow = crow(r, hi);
#pragma unroll
        for (int d0 = 0; d0 < 4; ++d0) Ow[(long)orow * ldo + d0 * 32 + r32] = f2bf(o[d0][r] * rli[r]); }
#undef DMA
#undef RESC
}
#undef KSWZ
#undef SBAR
}
struct NormDst { float* X; u16* HX; u16* UH; unsigned* cnt; int* list; unsigned char* seli; unsigned char* selw; const float* xin; const float* cin; };
__device__ __forceinline__ NormDst norm_dst_real(unsigned char* ws, int li) {
    NormDst d; d.X = (float*)(ws + WS_X); d.HX = (u16*)(ws + WS_HX); d.UH = (u16*)(ws + WS_R1 + R1_UH); d.cnt = (unsigned*)(ws + WS_CTL) + CW_CNT + li * 32 * CS; d.list = (int*)(ws + WS_LIST); d.seli = ws + WS_SELI; d.selw = ws + WS_SELW; d.xin = nullptr; d.cin = nullptr; return d; }
__device__ __forceinline__ NormDst norm_dst_dummy(unsigned char* ws) {
    NormDst d; unsigned char* t = ws + WS_NTMP; d.X = (float*)t; d.HX = (u16*)(t + (size_t)T * D * 4); d.UH = d.HX; d.cnt = (unsigned*)(ws + WS_CTL) + CW_CNT_DUMMY; d.list = (int*)(t + (size_t)T * D * 4 + (size_t)64 * 2304 * 512 * 2);
    d.seli = (unsigned char*)(d.list + (size_t)64 * T); d.selw = d.seli + (size_t)T * 16; d.xin = nullptr; d.cin = nullptr; return d; }
__device__ __forceinline__ float bperm(float v, int srclane) { return __int_as_float(__builtin_amdgcn_ds_bpermute(srclane << 2, __float_as_int(v))); }
template <int MODE>
__device__ __forceinline__ void norm2_rows(unsigned char* ws, float* outp, const NormDst d, int li, int which, int* s_base, char* lds, int wv) {
    const float* sm = (const float*)(ws + WS_SMALL);
    const int tidn = tid_opaque(wv); const int lane = tidn & 63, wave = wv;
    const float* X = (const float*)(ws + WS_X);
    const float* mod = (const float*)(ws + WS_MOD);
    float* WG = (float*)lds;
    u16* WE = (u16*)(lds + 16384);
    __syncthreads();
    if (MODE & 1) { if (tidn == 0) { const unsigned* cnt = (const unsigned*)(ws + WS_CTL) + CW_CNT + (li - 1) * 32 * CS; int a = 0; for (int e = 0; e < 32; ++e) { s_base[e] = a; a += (int)((cnt[e * CS] + 255u) / 256u); } s_base[32] = a; } }
    if (MODE & 8) {
        const float* wg = sm + SM_WGROUP + (size_t)li * 4096; const float* we = sm + SM_WEXP + (size_t)li * 32768;
        for (int i = tidn; i < 4096 / 4; i += 512) *(float4*)(WG + 4 * i) = *(const float4*)(wg + 4 * i);
        for (int i = tidn; i < 32768 / 2; i += 512) { const float2 v = *(const float2*)(we + 2 * i); *(unsigned*)(WE + 2 * i) = g8::cvt_pk_bf16(v.x, v.y); }
    }
    __syncthreads();
    const bool lastl = (li == 3);
    const int rstride = gridDim.x * 8; const u16* YB = (const u16*)(ws + WS_YB); const u16* DL = (const u16*)(ws + WS_HX);
    float4 vA[4], vB[4]; int4 siA = make_int4(0, 0, 0, 0), siB = siA; float2 swA = make_float2(0.f, 0.f), swB = swA; uint2 dlA[4], dlB[4], yaB[4], ybB[4];
#define NR_LOAD_A(rw) do { if ((rw) < T) { const float* xs_ = X + (size_t)(rw) * D; if (MODE & 64) { const int b_ = (rw) / LTOT, p_ = (rw) % LTOT; xs_ = p_ < CTXL ? d.cin + ((size_t)b_ * CTXL + p_) * D : d.xin + ((size_t)b_ * SEQ + (p_ - CTXL)) * D; } \
        _Pragma("unroll") for (int q = 0; q < 4; ++q) vA[q] = *(const float4*)(xs_ + q * 256 + lane * 4); \
        if (MODE & 1) { siA = *(const int4*)(ws + WS_SELI + (size_t)(rw) * 16); swA = *(const float2*)(ws + WS_SELW + (size_t)(rw) * 8); } \
        if (MODE & 32) { _Pragma("unroll") for (int q = 0; q < 4; ++q) dlA[q] = *(const uint2*)(DL + (size_t)(rw) * D + q * 256 + lane * 4); } } } while (0)
#define NR_A_TO_B(rw) do { _Pragma("unroll") for (int q = 0; q < 4; ++q) { vB[q] = vA[q]; dlB[q] = dlA[q]; } siB = siA; swB = swA; \
        if ((MODE & 1) && (rw) < T && !((li - 1 == 3) && ((rw) % LTOT) < CTXL)) { const size_t g1 = (size_t)s_base[siB.x] * 256 + siB.y, g2 = (size_t)s_base[siB.z] * 256 + siB.w; \
            _Pragma("unroll") for (int q = 0; q < 4; ++q) { yaB[q] = *(const uint2*)(YB + g1 * 1024 + q * 256 + lane * 4); ybB[q] = *(const uint2*)(YB + g2 * 1024 + q * 256 + lane * 4); } } } while (0)
    const int row0 = blockIdx.x * 8 + wave;
    NR_LOAD_A(row0); NR_A_TO_B(row0); NR_LOAD_A(row0 + rstride);
    int rec_e1 = 0, rec_e2 = 0, rec_row = -1; float rec_w1 = 0.f, rec_w2 = 0.f; int it = -1;
    for (int row = row0; row < T; row += rstride) {
        ++it;
        const int b = row / LTOT, pos = row % LTOT; const bool isctx = pos < CTXL; const int r = isctx ? 16 : b;
        float4 v[4]; uint2 ya[4], yb[4], dl[4]; const float2 sw = swB;
#pragma unroll
        for (int q = 0; q < 4; ++q) { v[q] = vB[q]; ya[q] = yaB[q]; yb[q] = ybB[q]; dl[q] = dlB[q]; }
        NR_A_TO_B(row + rstride); NR_LOAD_A(row + 2 * rstride);
        if ((MODE & 16) && isctx) continue;
        if ((MODE & 8) && lastl && isctx) continue;
        if (MODE & 1) {
            const bool skip = (li - 1 == 3) && isctx;
            if (!skip) {
                const float* gate = mod + (size_t)((li - 1) * 17 + r) * 6144 + 5 * 1024;
#pragma unroll
                for (int q = 0; q < 4; ++q) { const int c = q * 256 + lane * 4; const float4 gg = *(const float4*)(gate + c);
                    v[q].x += gg.x * (sw.x * bf2f((u16)(ya[q].x & 0xffff)) + sw.y * bf2f((u16)(yb[q].x & 0xffff)));
                    v[q].y += gg.y * (sw.x * bf2f((u16)(ya[q].x >> 16)) + sw.y * bf2f((u16)(yb[q].x >> 16)));
                    v[q].z += gg.z * (sw.x * bf2f((u16)(ya[q].y & 0xffff)) + sw.y * bf2f((u16)(yb[q].y & 0xffff)));
                    v[q].w += gg.w * (sw.x * bf2f((u16)(ya[q].y >> 16)) + sw.y * bf2f((u16)(yb[q].y >> 16)));
                    if (!(MODE & 16)) *(float4*)(d.X + (size_t)row * D + c) = v[q]; }
            }
        }
        if (MODE & 32) {
#pragma unroll
            for (int q = 0; q < 4; ++q) { const int c = q * 256 + lane * 4;
                v[q].x += bf2f((u16)(dl[q].x & 0xffff)); v[q].y += bf2f((u16)(dl[q].x >> 16)); v[q].z += bf2f((u16)(dl[q].y & 0xffff)); v[q].w += bf2f((u16)(dl[q].y >> 16));
                *(float4*)(d.X + (size_t)row * D + c) = v[q]; }
        }
        float ss = 0.f;
#pragma unroll
        for (int q = 0; q < 4; ++q) ss += v[q].x * v[q].x + v[q].y * v[q].y + v[q].z * v[q].z + v[q].w * v[q].w;
        ss = wave_sum_l(ss, lane);
        const float rstd = rsqrtf(ss * (1.f / 1024.f) + EPS);
        if (MODE & 16) {
            float* out = outp + ((size_t)b * SEQ + (pos - CTXL)) * D;
#pragma unroll
            for (int q = 0; q < 4; ++q) { const int c = q * 256 + lane * 4; const float4 g = *(const float4*)(sm + SM_FINALG + c);
                *(float4*)(out + c) = make_float4(v[q].x * rstd * g.x, v[q].y * rstd * g.y, v[q].z * rstd * g.z, v[q].w * rstd * g.w); }
            continue;
        }
        const float* gv = sm + (which ? SM_GFFN : SM_GMIX) + li * 1024;
        const float* sh = mod + (size_t)(li * 17 + r) * 6144 + (which ? 3 : 0) * 1024; const float* scl = sh + 1024;
        float h[16];
#pragma unroll
        for (int q = 0; q < 4; ++q) { const int c = q * 256 + lane * 4; const float4 g = *(const float4*)(gv + c), s4 = *(const float4*)(sh + c), c4 = *(const float4*)(scl + c);
            h[q * 4 + 0] = v[q].x * rstd * g.x * (1.f + c4.x) + s4.x; h[q * 4 + 1] = v[q].y * rstd * g.y * (1.f + c4.y) + s4.y;
            h[q * 4 + 2] = v[q].z * rstd * g.z * (1.f + c4.z) + s4.z; h[q * 4 + 3] = v[q].w * rstd * g.w * (1.f + c4.w) + s4.w; }
        if (MODE & 2) {
#pragma unroll
            for (int q = 0; q < 4; ++q) { uint2 w; w.x = g8::cvt_pk_bf16(h[q * 4], h[q * 4 + 1]); w.y = g8::cvt_pk_bf16(h[q * 4 + 2], h[q * 4 + 3]);
                *(uint2*)(d.HX + (size_t)row * D + q * 256 + lane * 4) = w; }
        }
        if (MODE & 4) {
#pragma unroll
            for (int q = 0; q < 4; ++q) { const int c = q * 256 + lane * 4; const int g = c >> 4, ch = c & 15;
                uint2 w; w.x = g8::cvt_pk_bf16(h[q * 4], h[q * 4 + 1]); w.y = g8::cvt_pk_bf16(h[q * 4 + 2], h[q * 4 + 3]);
                *(uint2*)(d.UH + ((size_t)g * 2304 + b * 144 + (pos >> 4)) * 512 + (pos & 15) * 16 + ch) = w; }
        }
        if (MODE & 8) {
            float lg[4] = {0.f, 0.f, 0.f, 0.f};
#pragma unroll
            for (int q = 0; q < 4; ++q)
#pragma unroll
                for (int j = 0; j < 4; ++j) { const float4 w = *(const float4*)(WG + (q * 256 + lane * 4 + j) * 4); const float hv = h[q * 4 + j];
                    lg[0] += hv * w.x; lg[1] += hv * w.y; lg[2] += hv * w.z; lg[3] += hv * w.w; }
            { const bool hi5 = (lane & 32) != 0; float k0 = hi5 ? lg[2] : lg[0], k1 = hi5 ? lg[3] : lg[1]; const float s0 = hi5 ? lg[0] : lg[2], s1 = hi5 ? lg[1] : lg[3];
              k0 += bperm(s0, lane ^ 32); k1 += bperm(s1, lane ^ 32);
              const bool hi4 = (lane & 16) != 0; float kk = hi4 ? k1 : k0; const float sd = hi4 ? k0 : k1; kk += bperm(sd, lane ^ 16);
              kk += bperm(kk, lane ^ 8); kk += bperm(kk, lane ^ 4); kk += bperm(kk, lane ^ 2); kk += bperm(kk, lane ^ 1);
              lg[0] = __int_as_float(__builtin_amdgcn_readlane(__float_as_int(kk), 0)); lg[1] = __int_as_float(__builtin_amdgcn_readlane(__float_as_int(kk), 16));
              lg[2] = __int_as_float(__builtin_amdgcn_readlane(__float_as_int(kk), 32)); lg[3] = __int_as_float(__builtin_amdgcn_readlane(__float_as_int(kk), 48)); }
#pragma unroll
            for (int g = 0; g < 4; ++g) lg[g] += sm[SM_BGROUP + li * 4 + g];
            int gi = 0; float best = lg[0];
#pragma unroll
            for (int g = 1; g < 4; ++g) if (lg[g] > best) { best = lg[g]; gi = g; }
            float den = 0.f;
#pragma unroll
            for (int g = 0; g < 4; ++g) den += __expf(lg[g] - best);
            const float pg = 1.f / den;
            const u16* wes = WE + (size_t)gi * 8192;
            float le[8];
#pragma unroll
            for (int e = 0; e < 8; ++e) le[e] = 0.f;
#pragma unroll
            for (int q = 0; q < 4; ++q)
#pragma unroll
                for (int j = 0; j < 4; ++j) { const u32x4 w = *(const u32x4*)(wes + (q * 256 + lane * 4 + j) * 8); const float hv = h[q * 4 + j];
                    le[0] += hv * __uint_as_float(w.x << 16); le[1] += hv * __uint_as_float(w.x & 0xffff0000u); le[2] += hv * __uint_as_float(w.y << 16); le[3] += hv * __uint_as_float(w.y & 0xffff0000u);
                    le[4] += hv * __uint_as_float(w.z << 16); le[5] += hv * __uint_as_float(w.z & 0xffff0000u); le[6] += hv * __uint_as_float(w.w << 16); le[7] += hv * __uint_as_float(w.w & 0xffff0000u); }
            { const bool hi5 = (lane & 32) != 0; float k[4]; float s[4];
#pragma unroll
              for (int i = 0; i < 4; ++i) { k[i] = hi5 ? le[4 + i] : le[i]; s[i] = hi5 ? le[i] : le[4 + i]; }
#pragma unroll
              for (int i = 0; i < 4; ++i) k[i] += bperm(s[i], lane ^ 32);
              const bool hi4 = (lane & 16) != 0; float k2[2], s2[2];
#pragma unroll
              for (int i = 0; i < 2; ++i) { k2[i] = hi4 ? k[2 + i] : k[i]; s2[i] = hi4 ? k[i] : k[2 + i]; }
#pragma unroll
              for (int i = 0; i < 2; ++i) k2[i] += bperm(s2[i], lane ^ 16);
              const bool hi3 = (lane & 8) != 0; float kk = hi3 ? k2[1] : k2[0]; const float sd = hi3 ? k2[0] : k2[1]; kk += bperm(sd, lane ^ 8);
              kk += bperm(kk, lane ^ 4); kk += bperm(kk, lane ^ 2); kk += bperm(kk, lane ^ 1);
#pragma unroll
              for (int e = 0; e < 8; ++e) le[e] = __int_as_float(__builtin_amdgcn_readlane(__float_as_int(kk), e * 8)); }
#pragma unroll
            for (int e = 0; e < 8; ++e) le[e] += sm[SM_BEXP + (li * 4 + gi) * 8 + e];
            int i1 = 0; float b1 = le[0];
#pragma unroll
            for (int e = 1; e < 8; ++e) if (le[e] > b1) { b1 = le[e]; i1 = e; }
            int i2 = -1; float b2 = -3.0e38f;
#pragma unroll
            for (int e = 0; e < 8; ++e) if (e != i1 && le[e] > b2) { b2 = le[e]; i2 = e; }
            { const float ex = __expf(b2 - b1); const float w1 = 1.f / (1.f + ex), w2 = ex / (1.f + ex);
              if (lane == it) { rec_e1 = gi * 8 + i1; rec_e2 = gi * 8 + i2; rec_w1 = pg * w1; rec_w2 = pg * w2; rec_row = row; } }
        }
    }
    if (MODE & 8) {
        if (rec_row >= 0) {
            const int s1 = (int)atomicAdd(&d.cnt[rec_e1 * CS], 1u), s2 = (int)atomicAdd(&d.cnt[rec_e2 * CS], 1u);
            d.list[(size_t)rec_e1 * T + s1] = rec_row; d.list[(size_t)rec_e2 * T + s2] = rec_row;
            *(int4*)(d.seli + (size_t)rec_row * 16) = make_int4(rec_e1, s1, rec_e2, s2);
            *(float2*)(d.selw + (size_t)rec_row * 8) = make_float2(rec_w1, rec_w2);
        }
    }
#undef NR_LOAD_A
#undef NR_A_TO_B
}
#define XB_TMO      128
#define XB_XCNT(j)  (256  + 64 * (j))
#define XB_XSUB(j)  (1280 + 64 * (j))
#define XB_XGEN(j)  (2304 + 64 * (j))
#define XB_TOP      3328
#define XB_TOPGEN   3392
#define XCD_BAR_WORDS 3456
#define XB_SPIN_CAP (1u << 18)
__device__ __forceinline__ unsigned xb_ld(unsigned* p)              { return __hip_atomic_load(p, __ATOMIC_RELAXED, __HIP_MEMORY_SCOPE_AGENT); }
__device__ __forceinline__ unsigned xb_add(unsigned* p, unsigned v) { return __hip_atomic_fetch_add(p, v, __ATOMIC_RELAXED, __HIP_MEMORY_SCOPE_AGENT); }
__device__ __forceinline__ unsigned xb_xcc_id() { return (unsigned)__builtin_amdgcn_s_getreg((3 << 11) | 20) & 0xFu; }
#define XB_SPIN(cond, bar) do { unsigned _sp = 0; while (cond) { __builtin_amdgcn_s_sleep(1); \
    if ((++_sp & 255u) == 0u) { if (xb_ld(&(bar)[XB_TMO])) break; if (_sp > XB_SPIN_CAP) { atomicAdd(&(bar)[XB_TMO], 1u); break; } } } } while (0)
struct XcdBarrier { unsigned* bar; unsigned x; volatile LAS unsigned* st; };
__device__ __forceinline__ XcdBarrier xcd_barrier_post(unsigned* bar, volatile LAS unsigned* st) {
    XcdBarrier b; b.bar = bar; b.x = xb_xcc_id(); b.st = st;
    if (threadIdx.x == 0) (void)xb_add(&bar[XB_XCNT(b.x)], 1u);
    return b;
}
__device__ __forceinline__ void xcd_barrier_complete(unsigned* bar, unsigned x, unsigned& nloc, unsigned& nx) {
    const unsigned G = gridDim.x * gridDim.y * gridDim.z;
    unsigned sum, cnt, mine, sp = 0u;
    for (;;) {
        sum = 0u; cnt = 0u; mine = 0u;
#pragma unroll
        for (unsigned j = 0; j < 16; ++j) { const unsigned c = xb_ld(&bar[XB_XCNT(j)]); sum += c; cnt += (c > 0u) ? 1u : 0u; mine = (j == x) ? c : mine; }
        if (sum == G) break;
        __builtin_amdgcn_s_sleep(1);
        if ((++sp & 255u) == 0u) { if (xb_ld(&bar[XB_TMO])) break; if (sp > XB_SPIN_CAP) { atomicAdd(&bar[XB_TMO], 1u); break; } }
    }
    nloc = mine > 0u ? mine : 1u; nx = cnt > 0u ? cnt : 1u;
}
__device__ __forceinline__ void xcd_barrier(const XcdBarrier& b, const int tid) {
    asm volatile("s_waitcnt vmcnt(0)" ::: "memory");
    __syncthreads();
    if (tid == 0) {
        unsigned* bar = b.bar;
        __builtin_amdgcn_s_waitcnt(0);
        unsigned nloc = b.st[0], nx = b.st[1];
        if (nloc == 0u) { xcd_barrier_complete(bar, b.x, nloc, nx); b.st[0] = nloc; b.st[1] = nx; }
        const unsigned old = xb_add(&bar[XB_XSUB(b.x)], 1u);
        const unsigned gen = old / nloc;
        if (old + 1u == (gen + 1u) * nloc) {
            __builtin_amdgcn_fence(__ATOMIC_RELEASE, "agent");
            asm volatile("s_waitcnt vmcnt(0)" ::: "memory");
            const unsigned og = xb_add(&bar[XB_TOP], 1u);
            const unsigned tg = og / nx;
            if (og + 1u == (tg + 1u) * nx) xb_add(&bar[XB_TOPGEN], 1u);
            else XB_SPIN(xb_ld(&bar[XB_TOPGEN]) == tg, bar);
            __builtin_amdgcn_fence(__ATOMIC_ACQUIRE, "agent");
            xb_add(&bar[XB_XGEN(b.x)], 1u);
            asm volatile("s_waitcnt vmcnt(0)" ::: "memory");
        } else {
            XB_SPIN(xb_ld(&bar[XB_XGEN(b.x)]) == gen, bar);
            __builtin_amdgcn_fence(__ATOMIC_ACQUIRE, "agent");
            asm volatile("s_waitcnt vmcnt(0)" ::: "memory");
        }
    }
    __syncthreads();
}

struct CvtSeg { int in_idx, nmat, K, N, NP, map; size_t dst_off; };
__device__ __forceinline__ void cvt_tile(const float* __restrict__ src, u16* __restrict__ dst, int K, int N, int NP, int map, int t, LAS unsigned* slab, int lane) {
    const int kt_n = K / 64, nt_n = N / 64, per = kt_n * nt_n;
    const int mat = t / per, rem = t % per, nt = rem / kt_n, kt = rem % kt_n;
    const float* s = src + ((size_t)mat * K + (size_t)kt * 64) * N + nt * 64 + lane;
    float v[64];
#pragma unroll
    for (int k = 0; k < 64; ++k) v[k] = s[(size_t)k * N];
#pragma unroll
    for (int q = 0; q < 8; ++q) { u32x4 w; w.x = g8::cvt_pk_bf16(v[q * 8], v[q * 8 + 1]); w.y = g8::cvt_pk_bf16(v[q * 8 + 2], v[q * 8 + 3]); w.z = g8::cvt_pk_bf16(v[q * 8 + 4], v[q * 8 + 5]); w.w = g8::cvt_pk_bf16(v[q * 8 + 6], v[q * 8 + 7]);
        *(LAS u32x4*)(slab + lane * 36 + q * 4) = w; }
#pragma unroll
    for (int i = 0; i < 8; ++i) { const int rl = i * 8 + (lane >> 3); const u32x4 w = *(const LAS u32x4*)(slab + rl * 36 + (lane & 7) * 4);
        const int n = nt * 64 + rl; int np = n;
        if (map) { const int half = N / 2; const int which = n >= half ? 1 : 0; const int j = n - which * half; np = (j / 128) * 256 + which * 128 + (j % 128); }
        *(u32x4*)(dst + ((size_t)mat * NP + np) * K + kt * 64 + (lane & 7) * 8) = w; }
}
__device__ __forceinline__ void mod_task(const Ptrs& P, char* lds, int task) {
    float* sc = (float*)lds;
    float* mod = (float*)(P.ws + WS_MOD);
    const int tid = threadIdx.x, cq = tid & 63, kg = tid >> 6;
    __syncthreads();
    for (int idx = tid; idx < 17 * 1024; idx += 512) { const int r = idx >> 10, kk = idx & 1023; const float v = r < 16 ? P.in[1][r * 1024 + kk] : P.in[3][kk]; sc[idx] = silu_f(v); }
    __syncthreads();
    const int i = task / 24, cc = task % 24; const int col = cc * 256 + cq * 4;
    const float* W = P.in[4] + ((size_t)i * 1024 + kg * 128) * 6144 + col;
    f32x4 acc[17];
#pragma unroll
    for (int r = 0; r < 17; ++r) acc[r] = (f32x4){0.f, 0.f, 0.f, 0.f};
#pragma unroll 8
    for (int kk = 0; kk < 128; ++kk) { const f32x4 w = *(const f32x4*)(W + (size_t)kk * 6144);
#pragma unroll
        for (int r = 0; r < 17; ++r) acc[r] += w * sc[r * 1024 + kg * 128 + kk]; }
    float* red2 = sc;
    __syncthreads();
#pragma unroll
    for (int pass = 0; pass < 2; ++pass) {
#pragma unroll
        for (int r = 0; r < 9; ++r) if (pass * 9 + r < 17) *(f32x4*)(red2 + ((kg * 9 + r) * 256 + cq * 4)) = acc[pass * 9 + r < 17 ? pass * 9 + r : 0];
        __syncthreads();
        for (int idx = tid; idx < 9 * 256; idx += 512) { const int rr = idx >> 8, c = idx & 255, r = pass * 9 + rr;
            if (r < 17) { float s = P.in[5][i * 6144 + cc * 256 + c];
#pragma unroll
                for (int g = 0; g < 8; ++g) s += red2[(g * 9 + rr) * 256 + c];
                mod[(size_t)(i * 17 + r) * 6144 + cc * 256 + c] = s; } }
        __syncthreads();
    }
}
__device__ __forceinline__ void s5_prep(const Ptrs& P, int j, int g, char* lds) {
    float2* Apow = (float2*)lds;
    float2* Bb = Apow + 2 * 64 * 17;
    float2* Cc = Bb + 2 * 64 * 16;
    float* Kt = (float*)(Cc + 2 * 16 * 64);
    const int tid = threadIdx.x;
    __syncthreads();
    if (tid < 128) { const int dir = tid >> 6, p = tid & 63; const size_t gd = ((size_t)j * 2 + dir) * SG + g;
        const float dt = __expf(P.in[10][gd]); const float ar = P.in[8][gd * SP + p], ai = P.in[9][gd * SP + p]; const float ldr = ar * dt, ldi = ai * dt;
        for (int tau = 0; tau <= 16; ++tau) { const float mag = __expf(ldr * (float)tau), ang = ldi * (float)tau; Apow[(dir * 64 + p) * 17 + tau] = make_float2(mag * __cosf(ang), mag * __sinf(ang)); }
        const float2 ab = Apow[(dir * 64 + p) * 17 + 1]; const float nr = ab.x - 1.f, ni = ab.y, den = ar * ar + ai * ai; const float qr = (nr * ar + ni * ai) / den, qi = (ni * ar - nr * ai) / den;
        for (int c = 0; c < 16; ++c) { const float br = P.in[11][(gd * SP + p) * SC + c], bi = P.in[12][(gd * SP + p) * SC + c]; Bb[(dir * 64 + p) * 16 + c] = make_float2(qr * br - qi * bi, qr * bi + qi * br); }
        ((float2*)(P.ws + WS_WB + WB_AT))[gd * SP + p] = Apow[(dir * 64 + p) * 17 + 16];
    }
    for (int i = tid; i < 2 * 16 * 64; i += 512) { const int d2 = i >> 10, c = (i >> 6) & 15, pp = i & 63; const size_t o = ((((size_t)j * 2 + d2) * SG + g) * SC + c) * SP + pp; Cc[i] = make_float2(P.in[13][o], P.in[14][o]); }
    __syncthreads();
    for (int idx = tid; idx < 8192; idx += 512) { const int dir = idx >> 12, tau = (idx >> 8) & 15, c = (idx >> 4) & 15, c2 = idx & 15; float s = 0.f;
        for (int p = 0; p < 64; ++p) { const float2 cc = Cc[(dir * 16 + c) * 64 + p], aa = Apow[(dir * 64 + p) * 17 + tau], bb = Bb[(dir * 64 + p) * 16 + c2];
            const float xr = aa.x * bb.x - aa.y * bb.y, xi = aa.x * bb.y + aa.y * bb.x; s += cc.x * xr - cc.y * xi; }
        Kt[idx] = s; }
    __syncthreads();
    u16* W1 = (u16*)(P.ws + WS_WB + WB_W1) + ((size_t)j * 64 + g) * 256 * 256; u16* W2 = (u16*)(P.ws + WS_WB + WB_W2) + ((size_t)j * 64 + g) * 256 * 512;
    for (int idx = tid; idx < 256 * 32; idx += 512) { const int row = idx >> 5, s8 = idx & 31; const int t = row >> 4, c = row & 15, s = s8 >> 1, cb = (s8 & 1) * 8;
        float v[8];
#pragma unroll
        for (int q = 0; q < 8; ++q) { const int c2 = cb + q;
            v[q] = s < t ? Kt[((0 * 16 + (t - s)) * 16 + c) * 16 + c2] : s > t ? Kt[((1 * 16 + (s - t)) * 16 + c) * 16 + c2] : Kt[((0 * 16 + 0) * 16 + c) * 16 + c2] + Kt[((1 * 16 + 0) * 16 + c) * 16 + c2]; }
        u32x4 w; w.x = g8::cvt_pk_bf16(v[0], v[1]); w.y = g8::cvt_pk_bf16(v[2], v[3]); w.z = g8::cvt_pk_bf16(v[4], v[5]); w.w = g8::cvt_pk_bf16(v[6], v[7]);
        *(u32x4*)(W2 + (size_t)row * 512 + s8 * 8) = w; }
    for (int idx = tid; idx < 256 * 128; idx += 512) { const int row = idx >> 7, dp = idx & 127; const int dir = dp >> 6, p = dp & 63, t = row >> 4, c = row & 15;
        const float2 cc = Cc[(dir * 16 + c) * 64 + p], aa = Apow[(dir * 64 + p) * 17 + (dir ? 16 - t : t + 1)];
        const float gr = cc.x * aa.x - cc.y * aa.y, gi = cc.x * aa.y + cc.y * aa.x;
        *(unsigned*)(W2 + (size_t)row * 512 + 256 + dir * 128 + 2 * p) = g8::cvt_pk_bf16(gr, -gi); }
    for (int idx = tid; idx < 256 * 32; idx += 512) { const int n = idx >> 5, s8 = idx & 31; const int dir = n >> 7, p = (n >> 1) & 63, ri = n & 1, s = s8 >> 1, cb = (s8 & 1) * 8;
        const float2 aa = Apow[(dir * 64 + p) * 17 + (dir ? s : 15 - s)];
        float v[8];
#pragma unroll
        for (int q = 0; q < 8; ++q) { const float2 bb = Bb[(dir * 64 + p) * 16 + cb + q]; v[q] = ri ? aa.x * bb.y + aa.y * bb.x : aa.x * bb.x - aa.y * bb.y; }
        u32x4 w; w.x = g8::cvt_pk_bf16(v[0], v[1]); w.y = g8::cvt_pk_bf16(v[2], v[3]); w.z = g8::cvt_pk_bf16(v[4], v[5]); w.w = g8::cvt_pk_bf16(v[6], v[7]);
        *(u32x4*)(W1 + (size_t)n * 256 + s8 * 8) = w; }
    __syncthreads();
}
__device__ __forceinline__ void prologue_phase(const Ptrs& P, char* lds, const int parts) {
    if (parts & 1) {
        copy_small(P, blockIdx.x * 512 + threadIdx.x, gridDim.x * 512);
        float2* rope = (float2*)(P.ws + WS_ROPE);
        for (int i = blockIdx.x * 512 + threadIdx.x; i < 2048 * 32; i += gridDim.x * 512) { const int s = i >> 5, k = i & 31, f = k & 15; const float invf = exp2f(-(float)f * (13.287712379549449f / 16.f));
            const float ang = (float)(k < 16 ? (s >> 6) : (s & 63)) * invf; rope[i] = make_float2(__cosf(ang), __sinf(ang)); }
        unsigned char* wb = P.ws + WS_WB;
        for (int i = blockIdx.x * 512 + threadIdx.x; i < 2 * 64 * 1024 / 8; i += gridDim.x * 512) { const int mat = i / 8192, r = i % 8192; *(u32x4*)((u16*)(wb + WB_WIN) + ((size_t)mat * 768 + 704) * 1024 + (size_t)r * 8) = (u32x4){0u, 0u, 0u, 0u}; }
    }
    if (parts & 2) for (int task = blockIdx.x; task < 96; task += gridDim.x) mod_task(P, lds, task);
    if (parts & 4) for (int idx = (int)blockIdx.x - 96; idx >= 0 && idx < 128; idx += gridDim.x) s5_prep(P, idx >> 6, idx & 63, lds);
    if (parts & 24) {
        const CvtSeg seg[7] = { {16, 2, 1024, 2048, 2048, 1, WB_GLU}, {17, 2, 1024, 704, 768, 0, WB_WIN}, {20, 2, 384, 1536, 1536, 0, WB_UQ}, {21, 2, 256, 2048, 2048, 0, WB_UKV}, {22, 2, 1024, 1024, 1024, 0, WB_WO},
                                {27, 128, 1024, 1024, 1024, 1, WB_GU}, {28, 128, 512, 1024, 1024, 0, WB_DN} };
        __syncthreads();
        const int lane = threadIdx.x & 63, wv = threadIdx.x >> 6;
        LAS unsigned* slab = (LAS unsigned*)((LAS unsigned char*)lds) + wv * (64 * 36);
        unsigned* qhead = (unsigned*)(P.ws + WS_CTL) + CW_QUEUE + ((parts >> 5) & 7) * 64;
        int tstart[8]; tstart[0] = 0;
#pragma unroll
        for (int s = 0; s < 7; ++s) tstart[s + 1] = tstart[s] + seg[s].nmat * (seg[s].K / 64) * (seg[s].N / 64);
        const int ntot = tstart[7], nchunk = (ntot + 7) / 8;
        for (;;) {
            unsigned c = 0; if (lane == 0) c = atomicAdd(qhead, 1u);
            c = (unsigned)__builtin_amdgcn_readfirstlane((int)c);
            if ((int)c >= nchunk) break;
            for (int t = (int)c * 8; t < (int)c * 8 + 8 && t < ntot; ++t) {
                int s = 0;
#pragma unroll
                for (int k = 1; k < 7; ++k) s = (t >= tstart[k]) ? k : s;
                int in_idx = 0, K = 0, N = 0, NP = 0, map = 0, t0 = 0; size_t doff = 0;
#pragma unroll
                for (int k = 0; k < 7; ++k) if (s == k) { in_idx = seg[k].in_idx; K = seg[k].K; N = seg[k].N; NP = seg[k].NP; map = seg[k].map; doff = seg[k].dst_off; t0 = tstart[k]; }
                cvt_tile(P.in[in_idx], (u16*)(P.ws + WS_WB + doff), K, N, NP, map, t - t0, slab, lane);
            }
        }
        __syncthreads();
    }
}
__device__ __forceinline__ void s5_scan_phase(unsigned char* wsp, int j, int wv) {
    struct { unsigned char* ws; } P{wsp};
    const int tids = tid_opaque(wv); const int lane = tids & 63;
    const float* S = (const float*)(P.ws + WS_R1 + R1_S); u16* UH = (u16*)(P.ws + WS_R1 + R1_UH); const float2* AT = (const float2*)(P.ws + WS_WB + WB_AT);
    for (int task = blockIdx.x * 8 + (tids >> 6); task < 2048; task += gridDim.x * 8) {
        const int g = task >> 5, b = (task >> 1) & 15, dir = task & 1;
        const float2 a = AT[(((size_t)j * 2 + dir) * SG + g) * SP + lane];
        const float* sp = S + ((size_t)g * 2304 + b * 144) * 256 + dir * 128 + 2 * lane; u16* hp = UH + ((size_t)g * 2304 + b * 144) * 512 + 256 + dir * 128 + 2 * lane;
        float hr = 0.f, hi = 0.f;
        for (int s0 = 0; s0 < 144; s0 += 16) {
            float2 sv[16];
#pragma unroll
            for (int k = 0; k < 16; ++k) { const int st = s0 + k; const int n = dir ? (st < 16 ? 15 - st : 159 - st) : st; sv[k] = *(const float2*)(sp + (size_t)n * 256); }
#pragma unroll
            for (int k = 0; k < 16; ++k) { const int st = s0 + k; const int n = dir ? (st < 16 ? 15 - st : 159 - st) : st;
                *(unsigned*)(hp + (size_t)n * 512) = g8::cvt_pk_bf16(hr, hi);
                const float nr = a.x * hr - a.y * hi + sv[k].x, ni = a.x * hi + a.y * hr + sv[k].y; hr = nr; hi = ni; }
        }
    }
}
__device__ __forceinline__ void mla_post_rows(unsigned char* wsp, int j, const float* Pm, int stride, int nwaves_blk, int wv) {
    struct { unsigned char* ws; } P{wsp}; const float* sm = (const float*)(wsp + WS_SMALL);
    const int tidp = tid_opaque(wv); const int lane = tidp & 63, wave = tidp >> 6;
    u16* CQ = (u16*)(P.ws + WS_CQ); u16* CKV = (u16*)(P.ws + WS_CKV); u16* KT = (u16*)(P.ws + WS_R1 + R1_KT); const float2* rope = (const float2*)(P.ws + WS_ROPE);
    for (int row = blockIdx.x * nwaves_blk + wave; row < T; row += gridDim.x * nwaves_blk) {
        const float* t = Pm + (size_t)row * stride; const int b = row / LTOT, pos = row % LTOT;
        float q[6]; float ss = 0.f;
#pragma unroll
        for (int i = 0; i < 6; ++i) { q[i] = t[i * 64 + lane]; ss += q[i] * q[i]; }
        ss = wave_sum_l(ss, lane); float rstd = rsqrtf(ss * (1.f / 384.f) + EPS);
#pragma unroll
        for (int i = 0; i < 6; ++i) CQ[(size_t)row * QR + i * 64 + lane] = f2bf(q[i] * rstd * sm[SM_GQ + j * QR + i * 64 + lane]);
        float k[4]; ss = 0.f;
#pragma unroll
        for (int i = 0; i < 4; ++i) { k[i] = t[384 + i * 64 + lane]; ss += k[i] * k[i]; }
        ss = wave_sum_l(ss, lane); rstd = rsqrtf(ss * (1.f / 256.f) + EPS);
#pragma unroll
        for (int i = 0; i < 4; ++i) CKV[(size_t)row * KVR + i * 64 + lane] = f2bf(k[i] * rstd * sm[SM_GKV + j * KVR + i * 64 + lane]);
        float v = t[640 + lane];
        if (pos >= CTXL) { const float pv = t[640 + (lane ^ 16)]; const float2 cs = rope[(size_t)(pos - CTXL) * 32 + (lane >> 5) * 16 + (lane & 15)];
            v = (lane & 16) ? v * cs.x + pv * cs.y : v * cs.x - pv * cs.y; }
        const u16 kb = f2bf(v);
#pragma unroll
        for (int h = 0; h < NH; ++h) KT[(((size_t)b * NH + h) * LTOT + pos) * QKD + 128 + lane] = kb;
    }
}
__device__ __forceinline__ void attn_phase(unsigned char* wsp, bool ctx_out, char* lds, LAS unsigned char* ldsl, int wv) {
    struct { unsigned char* ws; } P{wsp};
    const u16* QT = (const u16*)(P.ws + WS_R1 + R1_QT); const u16* KT = (const u16*)(P.ws + WS_R1 + R1_KT); const u16* VT = (const u16*)(P.ws + WS_R1 + R1_VT); u16* O = (u16*)(P.ws + WS_ZO);
    const int nunits = ctx_out ? 1152 : 1024;
    for (int u = blockIdx.x; u < nunits; u += gridDim.x) {
        int bh, qt, seq;
        if (u < 1024) { const int xcd = u & 7, k = u >> 3; bh = xcd * 16 + (k >> 3); qt = 1 + (k & 7); seq = LTOT; } else { bh = u - 1024; qt = 0; seq = CTXL; }
        const int b = bh >> 3, h = bh & 7;
        at::attn_body(QT + ((size_t)bh * LTOT + qt * 256) * QKD, KT + (size_t)bh * LTOT * QKD, VT + (size_t)bh * LTOT * 128, O + ((size_t)b * LTOT + qt * 256) * D + h * 128, D, seq, lds, ldsl, wv);
    }
}
constexpr int LDS_MISC = g8::STAGE_BYTES;
constexpr int LDS_BYTES = g8::STAGE_BYTES + 1024;
constexpr int NPHASE = 42;
struct MkArgs { Ptrs P; int lo, hi, bar_region, pad; };
__device__ __forceinline__ int lo_opq(int v) { asm volatile("" : "+s"(v)); return v; }
__global__ void __launch_bounds__(512, 2) mk(MkArgs a) {
    extern __shared__ __attribute__((aligned(16))) unsigned char lds[];
    LAS unsigned char* ldsl = (LAS unsigned char*)lds;
    volatile LAS unsigned* misc = (volatile LAS unsigned*)(ldsl + LDS_MISC);
    int* sbase = (int*)(lds + LDS_MISC + 64);
    const int wv = __builtin_amdgcn_readfirstlane(threadIdx.x >> 6);
    if (threadIdx.x < 4) misc[threadIdx.x] = 0u;
    __syncthreads();
#if defined(MK_FULL)
    const bool use_bar = true;
#else
    const bool use_bar = (a.hi - a.lo) > 1;
#endif
    unsigned char* ws = a.P.ws; float* outp = a.P.out;
    XcdBarrier bar; bar.bar = (unsigned*)(ws + WS_CTL) + a.bar_region * XCD_BAR_WORDS; bar.x = 0; bar.st = misc;
    if (use_bar) bar = xcd_barrier_post((unsigned*)(ws + WS_CTL) + a.bar_region * XCD_BAR_WORDS, misc);
    const int lo = a.lo, hi = a.hi;
#if defined(MK_FULL)
#define IN(k) (true)
#else
#define IN(k) (lo_opq(lo) <= (k) && (k) < lo_opq(hi))
#endif
#ifndef REP_GROUP
#define REP_GROUP (-1)
#define REP_N 1
#endif
#define NDST(li, g) (((g) == REP_GROUP && rep_ + 1 < REP_N) ? norm_dst_dummy(ws) : norm_dst_real(ws, li))
#define REP(g) for (int rep_ = 0; rep_ < ((g) == REP_GROUP ? REP_N : 1); ++rep_)
#if defined(PROBE_A)
#define STAMP(s) do { if (blockIdx.x == 0 && tid_opaque(wv) == 0) ((unsigned long long*)(ws0 + WS_CTL))[CW_STAMP64 + (s)] = __builtin_amdgcn_s_memrealtime(); } while (0)
#else
#define STAMP(s) do { } while (0)
#endif
#define SEAM(k) do { if (IN((k) + 1)) xcd_barrier(bar, tid_opaque(wv)); STAMP((k) + 1); } while (0)
    unsigned char* const ws0 = ws;
    STAMP(0);
#ifndef PRO_PART
#define PRO_PART 31
#endif
    if (IN(0)) REP(0) { prologue_phase(a.P, (char*)lds, (rep_ + 1 < ((0) == REP_GROUP ? REP_N : 1)) ? (PRO_PART | ((rep_ + 1) << 5)) : 31); SEAM(0); }

    {
        constexpr int li = 0; constexpr int base = 1 + li * 10, j = li >> 1;
#define PH_BEGIN size_t zoff_ = 0; asm volatile("" : "+s"(zoff_)); unsigned char* ws = ws0 + zoff_; unsigned char* wb = ws + WS_WB; const float* sm = (const float*)(ws + WS_SMALL); float* X = (float*)(ws + WS_X); const float* mod = (const float*)(ws + WS_MOD); (void)wb; (void)sm; (void)X; (void)mod;
        if ((li & 1) == 0) {
            if (IN(base + 0)) REP(1) { PH_BEGIN NormDst nd = NDST(li, 1); if (li == 0) { nd.xin = a.P.in[0]; nd.cin = a.P.in[2]; norm2_rows<4 | 64>(ws, outp, nd, li, 0, sbase, (char*)lds, wv); } else norm2_rows<5>(ws, outp, nd, li, 0, sbase, (char*)lds, wv); SEAM(base + 0); }
            if (IN(base + 1)) REP(3) { PH_BEGIN SchedS5 S; S.init(ws + WS_R1 + R1_UH, wb + WB_W1 + (size_t)j * 64 * 256 * 256 * 2, 256); EpiS5a E{(float*)(ws + WS_R1 + R1_S)};
                g8::gemm_phase<EpiS5a, SchedS5>(ldsl, 256, S, E, wv); SEAM(base + 1); }
            if (IN(base + 2)) REP(3) { PH_BEGIN s5_scan_phase(ws, j, wv); SEAM(base + 2); }
            if (IN(base + 3)) REP(3) { PH_BEGIN SchedS5 S; S.init(ws + WS_R1 + R1_UH, wb + WB_W2 + (size_t)j * 64 * 256 * 512 * 2, 512); EpiS5b E{(u16*)(ws + WS_ZO), (const u16*)(ws + WS_R1 + R1_UH), sm + SM_S5D + j * 1024};
                g8::gemm_phase<EpiS5b, SchedS5>(ldsl, 512, S, E, wv); SEAM(base + 3); }
            if (IN(base + 4)) REP(4) { PH_BEGIN SchedDense S; S.init(ws + WS_ZO, 1024, wb + WB_GLU + (size_t)j * 2048 * 1024 * 2, T, 2048, 1024); EpiGlu E{(u16*)(ws + WS_HX), mod, li};
                g8::gemm_phase<EpiGlu, SchedDense>(ldsl, 1024, S, E, wv); SEAM(base + 4); }
        } else {
            if (IN(base + 0)) REP(1) { PH_BEGIN const NormDst nd = NDST(li, 1); norm2_rows<3>(ws, outp, nd, li, 0, sbase, (char*)lds, wv); SEAM(base + 0); }
            if (IN(base + 1)) REP(5) { PH_BEGIN SchedDense S; S.init(ws + WS_HX, 1024, wb + WB_WIN + (size_t)j * 768 * 1024 * 2, T, 768, 1024); EpiF32 E{(float*)(ws + WS_YB), 768};
                g8::gemm_phase<EpiF32, SchedDense>(ldsl, 1024, S, E, wv); SEAM(base + 1); }
            if (IN(base + 2)) REP(5) { PH_BEGIN mla_post_rows(ws, j, (const float*)(ws + WS_YB), 768, 8, wv); SEAM(base + 2); }
            if (IN(base + 3)) REP(5) { PH_BEGIN
                { SchedDense S; S.init(ws + WS_CQ, QR, wb + WB_UQ + (size_t)j * 1536 * 384 * 2, T, 1536, 384); EpiQ E{(u16*)(ws + WS_R1 + R1_QT), (const float2*)(ws + WS_ROPE)};
                  g8::gemm_phase<EpiQ, SchedDense>(ldsl, 384, S, E, wv); }
                { SchedDense S; S.init(ws + WS_CKV, KVR, wb + WB_UKV + (size_t)j * 2048 * 256 * 2, T, 2048, 256); EpiKV E{(u16*)(ws + WS_R1 + R1_KT), (u16*)(ws + WS_R1 + R1_VT)};
                  int kk_ = 256; asm volatile("" : "+s"(kk_)); g8::gemm_phase<EpiKV, SchedDense>(ldsl, kk_, S, E, wv); }
                SEAM(base + 3); }
            if (IN(base + 4)) REP(6) { PH_BEGIN attn_phase(ws, li != 3, (char*)lds, ldsl, wv); SEAM(base + 4); }
            if (IN(base + 5)) REP(10) { PH_BEGIN SchedDense S; S.init(ws + WS_ZO, 1024, wb + WB_WO + (size_t)j * 1024 * 1024 * 2, T, 1024, 1024); EpiWo E{(u16*)(ws + WS_HX), mod, li};
                g8::gemm_phase<EpiWo, SchedDense>(ldsl, 1024, S, E, wv); SEAM(base + 5); }
        }
        if (IN(base + 6)) REP(2) { PH_BEGIN NormDst nd = NDST(li, 2); if (li == 0) { nd.xin = a.P.in[0]; nd.cin = a.P.in[2]; norm2_rows<42 | 64>(ws, outp, nd, li, 1, sbase, (char*)lds, wv); } else norm2_rows<42>(ws, outp, nd, li, 1, sbase, (char*)lds, wv); SEAM(base + 6); }
        if (IN(base + 7) || IN(base + 8)) {
            const unsigned* cnt = (const unsigned*)(ws0 + WS_CTL) + CW_CNT + li * 32 * CS;
            __syncthreads();
            if (tid_opaque(wv) == 0) { int acc = 0; for (int e = 0; e < 32; ++e) { sbase[e] = acc; acc += (int)((cnt[e * CS] + 255u) / 256u); } sbase[32] = acc; }
            __syncthreads();
            if (IN(base + 7)) REP(7) { PH_BEGIN SchedMoe<true> S; S.init(ws + WS_HX, wb + WB_GU + (size_t)li * 32 * 1024 * 1024 * 2, 1024, sbase, cnt, (const int*)(ws + WS_LIST)); EpiMoe1 E{(u16*)(ws + WS_R1 + R1_ACT)};
                g8::gemm_phase<EpiMoe1, SchedMoe<true>>(ldsl, 1024, S, E, wv); SEAM(base + 7); }
            if (IN(base + 8)) REP(8) { PH_BEGIN SchedMoe<false> S; S.init(ws + WS_R1 + R1_ACT, wb + WB_DN + (size_t)li * 32 * 1024 * 512 * 2, 512, sbase, cnt, (const int*)(ws + WS_LIST)); EpiMoe2 E{(u16*)(ws + WS_YB)};
                g8::gemm_phase<EpiMoe2, SchedMoe<false>>(ldsl, 512, S, E, wv); SEAM(base + 8); }
        }
    }

    {
        constexpr int li = 1; constexpr int base = 1 + li * 10, j = li >> 1;
#define PH_BEGIN size_t zoff_ = 0; asm volatile("" : "+s"(zoff_)); unsigned char* ws = ws0 + zoff_; unsigned char* wb = ws + WS_WB; const float* sm = (const float*)(ws + WS_SMALL); float* X = (float*)(ws + WS_X); const float* mod = (const float*)(ws + WS_MOD); (void)wb; (void)sm; (void)X; (void)mod;
        if ((li & 1) == 0) {
            if (IN(base + 0)) REP(1) { PH_BEGIN NormDst nd = NDST(li, 1); if (li == 0) { nd.xin = a.P.in[0]; nd.cin = a.P.in[2]; norm2_rows<4 | 64>(ws, outp, nd, li, 0, sbase, (char*)lds, wv); } else norm2_rows<5>(ws, outp, nd, li, 0, sbase, (char*)lds, wv); SEAM(base + 0); }
            if (IN(base + 1)) REP(3) { PH_BEGIN SchedS5 S; S.init(ws + WS_R1 + R1_UH, wb + WB_W1 + (size_t)j * 64 * 256 * 256 * 2, 256); EpiS5a E{(float*)(ws + WS_R1 + R1_S)};
                g8::gemm_phase<EpiS5a, SchedS5>(ldsl, 256, S, E, wv); SEAM(base + 1); }
            if (IN(base + 2)) REP(3) { PH_BEGIN s5_scan_phase(ws, j, wv); SEAM(base + 2); }
            if (IN(base + 3)) REP(3) { PH_BEGIN SchedS5 S; S.init(ws + WS_R1 + R1_UH, wb + WB_W2 + (size_t)j * 64 * 256 * 512 * 2, 512); EpiS5b E{(u16*)(ws + WS_ZO), (const u16*)(ws + WS_R1 + R1_UH), sm + SM_S5D + j * 1024};
                g8::gemm_phase<EpiS5b, SchedS5>(ldsl, 512, S, E, wv); SEAM(base + 3); }
            if (IN(base + 4)) REP(4) { PH_BEGIN SchedDense S; S.init(ws + WS_ZO, 1024, wb + WB_GLU + (size_t)j * 2048 * 1024 * 2, T, 2048, 1024); EpiGlu E{(u16*)(ws + WS_HX), mod, li};
                g8::gemm_phase<EpiGlu, SchedDense>(ldsl, 1024, S, E, wv); SEAM(base + 4); }
        } else {
            if (IN(base + 0)) REP(1) { PH_BEGIN const NormDst nd = NDST(li, 1); norm2_rows<3>(ws, outp, nd, li, 0, sbase, (char*)lds, wv); SEAM(base + 0); }
            if (IN(base + 1)) REP(5) { PH_BEGIN SchedDense S; S.init(ws + WS_HX, 1024, wb + WB_WIN + (size_t)j * 768 * 1024 * 2, T, 768, 1024); EpiF32 E{(float*)(ws + WS_YB), 768};
                g8::gemm_phase<EpiF32, SchedDense>(ldsl, 1024, S, E, wv); SEAM(base + 1); }
            if (IN(base + 2)) REP(5) { PH_BEGIN mla_post_rows(ws, j, (const float*)(ws + WS_YB), 768, 8, wv); SEAM(base + 2); }
            if (IN(base + 3)) REP(5) { PH_BEGIN
                { SchedDense S; S.init(ws + WS_CQ, QR, wb + WB_UQ + (size_t)j * 1536 * 384 * 2, T, 1536, 384); EpiQ E{(u16*)(ws + WS_R1 + R1_QT), (const float2*)(ws + WS_ROPE)};
                  g8::gemm_phase<EpiQ, SchedDense>(ldsl, 384, S, E, wv); }
                { SchedDense S; S.init(ws + WS_CKV, KVR, wb + WB_UKV + (size_t)j * 2048 * 256 * 2, T, 2048, 256); EpiKV E{(u16*)(ws + WS_R1 + R1_KT), (u16*)(ws + WS_R1 + R1_VT)};
                  int kk_ = 256; asm volatile("" : "+s"(kk_)); g8::gemm_phase<EpiKV, SchedDense>(ldsl, kk_, S, E, wv); }
                SEAM(base + 3); }
            if (IN(base + 4)) REP(6) { PH_BEGIN attn_phase(ws, li != 3, (char*)lds, ldsl, wv); SEAM(base + 4); }
            if (IN(base + 5)) REP(10) { PH_BEGIN SchedDense S; S.init(ws + WS_ZO, 1024, wb + WB_WO + (size_t)j * 1024 * 1024 * 2, T, 1024, 1024); EpiWo E{(u16*)(ws + WS_HX), mod, li};
                g8::gemm_phase<EpiWo, SchedDense>(ldsl, 1024, S, E, wv); SEAM(base + 5); }
        }
        if (IN(base + 6)) REP(2) { PH_BEGIN NormDst nd = NDST(li, 2); if (li == 0) { nd.xin = a.P.in[0]; nd.cin = a.P.in[2]; norm2_rows<42 | 64>(ws, outp, nd, li, 1, sbase, (char*)lds, wv); } else norm2_rows<42>(ws, outp, nd, li, 1, sbase, (char*)lds, wv); SEAM(base + 6); }
        if (IN(base + 7) || IN(base + 8)) {
            const unsigned* cnt = (const unsigned*)(ws0 + WS_CTL) + CW_CNT + li * 32 * CS;
            __syncthreads();
            if (tid_opaque(wv) == 0) { int acc = 0; for (int e = 0; e < 32; ++e) { sbase[e] = acc; acc += (int)((cnt[e * CS] + 255u) / 256u); } sbase[32] = acc; }
            __syncthreads();
            if (IN(base + 7)) REP(7) { PH_BEGIN SchedMoe<true> S; S.init(ws + WS_HX, wb + WB_GU + (size_t)li * 32 * 1024 * 1024 * 2, 1024, sbase, cnt, (const int*)(ws + WS_LIST)); EpiMoe1 E{(u16*)(ws + WS_R1 + R1_ACT)};
                g8::gemm_phase<EpiMoe1, SchedMoe<true>>(ldsl, 1024, S, E, wv); SEAM(base + 7); }
            if (IN(base + 8)) REP(8) { PH_BEGIN SchedMoe<false> S; S.init(ws + WS_R1 + R1_ACT, wb + WB_DN + (size_t)li * 32 * 1024 * 512 * 2, 512, sbase, cnt, (const int*)(ws + WS_LIST)); EpiMoe2 E{(u16*)(ws + WS_YB)};
                g8::gemm_phase<EpiMoe2, SchedMoe<false>>(ldsl, 512, S, E, wv); SEAM(base + 8); }
        }
    }

    {
        constexpr int li = 2; constexpr int base = 1 + li * 10, j = li >> 1;
#define PH_BEGIN size_t zoff_ = 0; asm volatile("" : "+s"(zoff_)); unsigned char* ws = ws0 + zoff_; unsigned char* wb = ws + WS_WB; const float* sm = (const float*)(ws + WS_SMALL); float* X = (float*)(ws + WS_X); const float* mod = (const float*)(ws + WS_MOD); (void)wb; (void)sm; (void)X; (void)mod;
        if ((li & 1) == 0) {
            if (IN(base + 0)) REP(1) { PH_BEGIN NormDst nd = NDST(li, 1); if (li == 0) { nd.xin = a.P.in[0]; nd.cin = a.P.in[2]; norm2_rows<4 | 64>(ws, outp, nd, li, 0, sbase, (char*)lds, wv); } else norm2_rows<5>(ws, outp, nd, li, 0, sbase, (char*)lds, wv); SEAM(base + 0); }
            if (IN(base + 1)) REP(3) { PH_BEGIN SchedS5 S; S.init(ws + WS_R1 + R1_UH, wb + WB_W1 + (size_t)j * 64 * 256 * 256 * 2, 256); EpiS5a E{(float*)(ws + WS_R1 + R1_S)};
                g8::gemm_phase<EpiS5a, SchedS5>(ldsl, 256, S, E, wv); SEAM(base + 1); }
            if (IN(base + 2)) REP(3) { PH_BEGIN s5_scan_phase(ws, j, wv); SEAM(base + 2); }
            if (IN(base + 3)) REP(3) { PH_BEGIN SchedS5 S; S.init(ws + WS_R1 + R1_UH, wb + WB_W2 + (size_t)j * 64 * 256 * 512 * 2, 512); EpiS5b E{(u16*)(ws + WS_ZO), (const u16*)(ws + WS_R1 + R1_UH), sm + SM_S5D + j * 1024};
                g8::gemm_phase<EpiS5b, SchedS5>(ldsl, 512, S, E, wv); SEAM(base + 3); }
            if (IN(base + 4)) REP(4) { PH_BEGIN SchedDense S; S.init(ws + WS_ZO, 1024, wb + WB_GLU + (size_t)j * 2048 * 1024 * 2, T, 2048, 1024); EpiGlu E{(u16*)(ws + WS_HX), mod, li};
                g8::gemm_phase<EpiGlu, SchedDense>(ldsl, 1024, S, E, wv); SEAM(base + 4); }
        } else {
            if (IN(base + 0)) REP(1) { PH_BEGIN const NormDst nd = NDST(li, 1); norm2_rows<3>(ws, outp, nd, li, 0, sbase, (char*)lds, wv); SEAM(base + 0); }
            if (IN(base + 1)) REP(5) { PH_BEGIN SchedDense S; S.init(ws + WS_HX, 1024, wb + WB_WIN + (size_t)j * 768 * 1024 * 2, T, 768, 1024); EpiF32 E{(float*)(ws + WS_YB), 768};
                g8::gemm_phase<EpiF32, SchedDense>(ldsl, 1024, S, E, wv); SEAM(base + 1); }
            if (IN(base + 2)) REP(5) { PH_BEGIN mla_post_rows(ws, j, (const float*)(ws + WS_YB), 768, 8, wv); SEAM(base + 2); }
            if (IN(base + 3)) REP(5) { PH_BEGIN
                { SchedDense S; S.init(ws + WS_CQ, QR, wb + WB_UQ + (size_t)j * 1536 * 384 * 2, T, 1536, 384); EpiQ E{(u16*)(ws + WS_R1 + R1_QT), (const float2*)(ws + WS_ROPE)};
                  g8::gemm_phase<EpiQ, SchedDense>(ldsl, 384, S, E, wv); }
                { SchedDense S; S.init(ws + WS_CKV, KVR, wb + WB_UKV + (size_t)j * 2048 * 256 * 2, T, 2048, 256); EpiKV E{(u16*)(ws + WS_R1 + R1_KT), (u16*)(ws + WS_R1 + R1_VT)};
                  int kk_ = 256; asm volatile("" : "+s"(kk_)); g8::gemm_phase<EpiKV, SchedDense>(ldsl, kk_, S, E, wv); }
                SEAM(base + 3); }
            if (IN(base + 4)) REP(6) { PH_BEGIN attn_phase(ws, li != 3, (char*)lds, ldsl, wv); SEAM(base + 4); }
            if (IN(base + 5)) REP(10) { PH_BEGIN SchedDense S; S.init(ws + WS_ZO, 1024, wb + WB_WO + (size_t)j * 1024 * 1024 * 2, T, 1024, 1024); EpiWo E{(u16*)(ws + WS_HX), mod, li};
                g8::gemm_phase<EpiWo, SchedDense>(ldsl, 1024, S, E, wv); SEAM(base + 5); }
        }
        if (IN(base + 6)) REP(2) { PH_BEGIN NormDst nd = NDST(li, 2); if (li == 0) { nd.xin = a.P.in[0]; nd.cin = a.P.in[2]; norm2_rows<42 | 64>(ws, outp, nd, li, 1, sbase, (char*)lds, wv); } else norm2_rows<42>(ws, outp, nd, li, 1, sbase, (char*)lds, wv); SEAM(base + 6); }
        if (IN(base + 7) || IN(base + 8)) {
            const unsigned* cnt = (const unsigned*)(ws0 + WS_CTL) + CW_CNT + li * 32 * CS;
            __syncthreads();
            if (tid_opaque(wv) == 0) { int acc = 0; for (int e = 0; e < 32; ++e) { sbase[e] = acc; acc += (int)((cnt[e * CS] + 255u) / 256u); } sbase[32] = acc; }
            __syncthreads();
            if (IN(base + 7)) REP(7) { PH_BEGIN SchedMoe<true> S; S.init(ws + WS_HX, wb + WB_GU + (size_t)li * 32 * 1024 * 1024 * 2, 1024, sbase, cnt, (const int*)(ws + WS_LIST)); EpiMoe1 E{(u16*)(ws + WS_R1 + R1_ACT)};
                g8::gemm_phase<EpiMoe1, SchedMoe<true>>(ldsl, 1024, S, E, wv); SEAM(base + 7); }
            if (IN(base + 8)) REP(8) { PH_BEGIN SchedMoe<false> S; S.init(ws + WS_R1 + R1_ACT, wb + WB_DN + (size_t)li * 32 * 1024 * 512 * 2, 512, sbase, cnt, (const int*)(ws + WS_LIST)); EpiMoe2 E{(u16*)(ws + WS_YB)};
                g8::gemm_phase<EpiMoe2, SchedMoe<false>>(ldsl, 512, S, E, wv); SEAM(base + 8); }
        }
    }

    {
        constexpr int li = 3; constexpr int base = 1 + li * 10, j = li >> 1;
#define PH_BEGIN size_t zoff_ = 0; asm volatile("" : "+s"(zoff_)); unsigned char* ws = ws0 + zoff_; unsigned char* wb = ws + WS_WB; const float* sm = (const float*)(ws + WS_SMALL); float* X = (float*)(ws + WS_X); const float* mod = (const float*)(ws + WS_MOD); (void)wb; (void)sm; (void)X; (void)mod;
        if ((li & 1) == 0) {
            if (IN(base + 0)) REP(1) { PH_BEGIN NormDst nd = NDST(li, 1); if (li == 0) { nd.xin = a.P.in[0]; nd.cin = a.P.in[2]; norm2_rows<4 | 64>(ws, outp, nd, li, 0, sbase, (char*)lds, wv); } else norm2_rows<5>(ws, outp, nd, li, 0, sbase, (char*)lds, wv); SEAM(base + 0); }
            if (IN(base + 1)) REP(3) { PH_BEGIN SchedS5 S; S.init(ws + WS_R1 + R1_UH, wb + WB_W1 + (size_t)j * 64 * 256 * 256 * 2, 256); EpiS5a E{(float*)(ws + WS_R1 + R1_S)};
                g8::gemm_phase<EpiS5a, SchedS5>(ldsl, 256, S, E, wv); SEAM(base + 1); }
            if (IN(base + 2)) REP(3) { PH_BEGIN s5_scan_phase(ws, j, wv); SEAM(base + 2); }
            if (IN(base + 3)) REP(3) { PH_BEGIN SchedS5 S; S.init(ws + WS_R1 + R1_UH, wb + WB_W2 + (size_t)j * 64 * 256 * 512 * 2, 512); EpiS5b E{(u16*)(ws + WS_ZO), (const u16*)(ws + WS_R1 + R1_UH), sm + SM_S5D + j * 1024};
                g8::gemm_phase<EpiS5b, SchedS5>(ldsl, 512, S, E, wv); SEAM(base + 3); }
            if (IN(base + 4)) REP(4) { PH_BEGIN SchedDense S; S.init(ws + WS_ZO, 1024, wb + WB_GLU + (size_t)j * 2048 * 1024 * 2, T, 2048, 1024); EpiGlu E{(u16*)(ws + WS_HX), mod, li};
                g8::gemm_phase<EpiGlu, SchedDense>(ldsl, 1024, S, E, wv); SEAM(base + 4); }
        } else {
            if (IN(base + 0)) REP(1) { PH_BEGIN const NormDst nd = NDST(li, 1); norm2_rows<3>(ws, outp, nd, li, 0, sbase, (char*)lds, wv); SEAM(base + 0); }
            if (IN(base + 1)) REP(5) { PH_BEGIN SchedDense S; S.init(ws + WS_HX, 1024, wb + WB_WIN + (size_t)j * 768 * 1024 * 2, T, 768, 1024); EpiF32 E{(float*)(ws + WS_YB), 768};
                g8::gemm_phase<EpiF32, SchedDense>(ldsl, 1024, S, E, wv); SEAM(base + 1); }
            if (IN(base + 2)) REP(5) { PH_BEGIN mla_post_rows(ws, j, (const float*)(ws + WS_YB), 768, 8, wv); SEAM(base + 2); }
            if (IN(base + 3)) REP(5) { PH_BEGIN
                { SchedDense S; S.init(ws + WS_CQ, QR, wb + WB_UQ + (size_t)j * 1536 * 384 * 2, T, 1536, 384); EpiQ E{(u16*)(ws + WS_R1 + R1_QT), (const float2*)(ws + WS_ROPE)};
                  g8::gemm_phase<EpiQ, SchedDense>(ldsl, 384, S, E, wv); }
                { SchedDense S; S.init(ws + WS_CKV, KVR, wb + WB_UKV + (size_t)j * 2048 * 256 * 2, T, 2048, 256); EpiKV E{(u16*)(ws + WS_R1 + R1_KT), (u16*)(ws + WS_R1 + R1_VT)};
                  int kk_ = 256; asm volatile("" : "+s"(kk_)); g8::gemm_phase<EpiKV, SchedDense>(ldsl, kk_, S, E, wv); }
                SEAM(base + 3); }
            if (IN(base + 4)) REP(6) { PH_BEGIN attn_phase(ws, li != 3, (char*)lds, ldsl, wv); SEAM(base + 4); }
            if (IN(base + 5)) REP(10) { PH_BEGIN SchedDense S; S.init(ws + WS_ZO, 1024, wb + WB_WO + (size_t)j * 1024 * 1024 * 2, T, 1024, 1024); EpiWo E{(u16*)(ws + WS_HX), mod, li};
                g8::gemm_phase<EpiWo, SchedDense>(ldsl, 1024, S, E, wv); SEAM(base + 5); }
        }
        if (IN(base + 6)) REP(2) { PH_BEGIN NormDst nd = NDST(li, 2); if (li == 0) { nd.xin = a.P.in[0]; nd.cin = a.P.in[2]; norm2_rows<42 | 64>(ws, outp, nd, li, 1, sbase, (char*)lds, wv); } else norm2_rows<42>(ws, outp, nd, li, 1, sbase, (char*)lds, wv); SEAM(base + 6); }
        if (IN(base + 7) || IN(base + 8)) {
            const unsigned* cnt = (const unsigned*)(ws0 + WS_CTL) + CW_CNT + li * 32 * CS;
            __syncthreads();
            if (tid_opaque(wv) == 0) { int acc = 0; for (int e = 0; e < 32; ++e) { sbase[e] = acc; acc += (int)((cnt[e * CS] + 255u) / 256u); } sbase[32] = acc; }
            __syncthreads();
            if (IN(base + 7)) REP(7) { PH_BEGIN SchedMoe<true> S; S.init(ws + WS_HX, wb + WB_GU + (size_t)li * 32 * 1024 * 1024 * 2, 1024, sbase, cnt, (const int*)(ws + WS_LIST)); EpiMoe1 E{(u16*)(ws + WS_R1 + R1_ACT)};
                g8::gemm_phase<EpiMoe1, SchedMoe<true>>(ldsl, 1024, S, E, wv); SEAM(base + 7); }
            if (IN(base + 8)) REP(8) { PH_BEGIN SchedMoe<false> S; S.init(ws + WS_R1 + R1_ACT, wb + WB_DN + (size_t)li * 32 * 1024 * 512 * 2, 512, sbase, cnt, (const int*)(ws + WS_LIST)); EpiMoe2 E{(u16*)(ws + WS_YB)};
                g8::gemm_phase<EpiMoe2, SchedMoe<false>>(ldsl, 512, S, E, wv); SEAM(base + 8); }
        }
    }

#if defined(PROBE_A)
    if (IN(41)) { xcd_barrier(bar, tid_opaque(wv));
        if (tid_opaque(wv) == 0) { const unsigned long long* ts = (const unsigned long long*)(ws0 + WS_CTL) + CW_STAMP64; unsigned long long last = ts[0], sa = 0, sb = 0;
            for (int p = 0; p <= 40; ++p) { const unsigned long long e = ts[p + 1]; if (e == 0) continue; const unsigned long long d = e - last; last = e;
                int grp; if (p == 0) grp = 0; else { const int k = (p - 1) % 10, l = (p - 1) / 10; const bool s5 = (l & 1) == 0;
                    grp = k == 0 ? 1 : k == 6 ? 2 : k == 7 ? 7 : k == 8 ? 8 : s5 ? (k == 4 ? 4 : 3) : (k == 4 ? 6 : 5); }
                if (grp == PROBE_A) sa += d; if (grp == PROBE_B) sb += d; }
            ((float*)sbase)[40] = (float)sa * 1e-5f; ((float*)sbase)[41] = 2.f + (float)sb * (1.f / 2000.f); }
        __syncthreads(); }
#endif
    if (IN(41)) { const NormDst nd = norm_dst_real(ws0, 0); norm2_rows<17>(ws0, outp, nd, 4, 0, sbase, (char*)lds, wv); }
#undef PH_BEGIN
#undef IN
#undef SEAM
}
__global__ __launch_bounds__(256) void n_post_win(Ptrs P, int j) { mla_post_rows(P.ws, j, (const float*)(P.ws + WS_YB), 768, 4, __builtin_amdgcn_readfirstlane(threadIdx.x >> 6)); }
static void gemm_naive(hipStream_t st, const void* A, int lda, const int* rowidx, const float* B, int ldb, long bstride, const int* tileexp, const int* mdyn, float* C, int ldc, int M, int N, int K) {
    NG g{}; g.A = A; g.lda = lda; g.rowidx = rowidx; g.B = B; g.ldb = ldb; g.bstride = bstride; g.tileexp = tileexp; g.mdyn = mdyn; g.C = C; g.ldc = ldc; g.M = M; g.N = N; g.K = K; g.pad = 0;
    hipLaunchKernelGGL(n_gemm<1>, dim3(N / 64, (M + 63) / 64), dim3(256), 0, st, g);
}
#ifndef REALMASK_STR
#define REALMASK_STR "111111111111111111111111111111111111111111"
#endif
extern "C" void kernel_launch(void* const* d_in, const int* in_sizes, int n_in, void* d_out, int out_size, void* d_ws, size_t ws_size, hipStream_t stream) {
    static int grid = 0;
    static const char* realmask = REALMASK_STR;
    if (grid == 0) {
        if (n_in != 30 || out_size != NB * SEQ * D || ws_size < WS_NEND) { fprintf(stderr, "kernel_launch: unexpected shapes n_in %d out %d ws %zu (need %zu)\n", n_in, out_size, ws_size, (size_t)WS_NEND); grid = -1; return; }
        int dev = 0, cus = 0, per_cu = 0;
        if (hipGetDevice(&dev) != hipSuccess || hipDeviceGetAttribute(&cus, hipDeviceAttributeMultiprocessorCount, dev) != hipSuccess) { grid = -1; return; }
        if (hipFuncSetAttribute((const void*)mk, hipFuncAttributeMaxDynamicSharedMemorySize, LDS_BYTES) != hipSuccess) { fprintf(stderr, "kernel_launch: hipFuncSetAttribute failed\n"); grid = -1; return; }
        if (hipOccupancyMaxActiveBlocksPerMultiprocessor(&per_cu, (const void*)mk, 512, LDS_BYTES) != hipSuccess || per_cu < 1) { fprintf(stderr, "kernel_launch: occupancy query says %d\n", per_cu); }
        (void)hipGetLastError();
        grid = cus;
    }
    if (grid < 0) return;
    Ptrs P{}; for (int i = 0; i < 30; ++i) P.in[i] = (const float*)d_in[i]; P.out = (float*)d_out; P.ws = (unsigned char*)d_ws;
    unsigned char* ws = P.ws;
    (void)hipMemsetAsync(ws + WS_CTL, 0, ZERO_BYTES, stream);
    int nreg = 0;
    auto real = [&](int p) { return realmask[p] == '1'; };
    auto run_mk = [&](int lo, int hi) { MkArgs a{}; a.P = P; a.lo = lo; a.hi = hi; a.bar_region = (hi - lo > 1) ? nreg++ : 0; a.pad = 0; hipLaunchKernelGGL(mk, dim3(grid), dim3(512), LDS_BYTES, stream, a); };
    const int NG_ = 4096; float* NTMP = (float*)(ws + WS_NTMP);
    int p = 0;
    while (p < NPHASE) {
        if (real(p)) { int q = p; while (q < NPHASE && real(q)) ++q; run_mk(p, q); p = q; continue; }
        if (p == 0) { hipLaunchKernelGGL(k_mod, dim3(24, 4), dim3(256), 0, stream, P); hipLaunchKernelGGL(k_init, dim3(2048), dim3(256), 0, stream, P); }
        else if (p == 41) hipLaunchKernelGGL(k_norm<17>, dim3(2048), dim3(256), 0, stream, P, 4, 0);
        else {
            const int li = (p - 1) / 10, k = (p - 1) % 10, j = li >> 1; const bool s5 = (li & 1) == 0;
            if (k == 0) { if (li == 0) hipLaunchKernelGGL(k_norm<2>, dim3(2048), dim3(256), 0, stream, P, li, 0); else hipLaunchKernelGGL(k_norm<3>, dim3(2048), dim3(256), 0, stream, P, li, 0); }
            else if (s5 && k == 1) { hipLaunchKernelGGL(n_s5, dim3(NB * SG), dim3(128), 0, stream, P, j); }
            else if (s5 && k == 3) { hipLaunchKernelGGL(n_post_s5, dim3(NG_), dim3(256), 0, stream, P, j); }
            else if (s5 && k == 4) { gemm_naive(stream, ws + WS_ZO, D, nullptr, P.in[16] + (size_t)j * 1024 * 2048, 2048, 0, nullptr, nullptr, NTMP, 2048, T, 2048, 1024); hipLaunchKernelGGL(n_post_glu, dim3(NG_), dim3(256), 0, stream, P, li); }
            else if (!s5 && k == 1) { gemm_naive(stream, ws + WS_HX, D, nullptr, P.in[17] + (size_t)j * 1024 * 704, 704, 0, nullptr, nullptr, (float*)(ws + WS_YB), 768, T, 704, 1024); }
            else if (!s5 && k == 2) { hipLaunchKernelGGL(n_post_win, dim3(2048), dim3(256), 0, stream, P, j); }
            else if (!s5 && k == 3) {
                gemm_naive(stream, ws + WS_CQ, QR, nullptr, P.in[20] + (size_t)j * 384 * 1536, 1536, 0, nullptr, nullptr, NTMP, 1536, T, 1536, 384); hipLaunchKernelGGL(n_post_q, dim3(NG_), dim3(256), 0, stream, P);
                gemm_naive(stream, ws + WS_CKV, KVR, nullptr, P.in[21] + (size_t)j * 256 * 2048, 2048, 0, nullptr, nullptr, NTMP, 2048, T, 2048, 256); hipLaunchKernelGGL(n_post_kv, dim3(NG_), dim3(256), 0, stream, P); }
            else if (!s5 && k == 4) { hipLaunchKernelGGL(n_attn, dim3(LTOT / 64, NH, NB), dim3(256), 0, stream, P); }
            else if (!s5 && k == 5) { gemm_naive(stream, ws + WS_ZO, D, nullptr, P.in[22] + (size_t)j * 1024 * 1024, 1024, 0, nullptr, nullptr, NTMP, 1024, T, 1024, 1024); hipLaunchKernelGGL(n_post_wo, dim3(NG_), dim3(256), 0, stream, P, li); }
            else if (k == 6) { hipLaunchKernelGGL(k_norm<10>, dim3(2048), dim3(256), 0, stream, P, li, 1); }
            else if (k == 7 || k == 8) {
                const int* tileexp = (const int*)(ws + WS_TILEEXP);
                hipLaunchKernelGGL(n_build, dim3(1), dim3(256), 0, stream, P, li);
                if (k == 7) { gemm_naive(stream, ws + WS_HX, D, (const int*)(ws + WS_SLOTROW), P.in[27] + (size_t)li * 32 * 1024 * 1024, 1024, 1024L * 1024, tileexp, tileexp + 512, NTMP, 1024, MAXSLOT, 1024, 1024);
                    hipLaunchKernelGGL(n_post_act2, dim3(NG_), dim3(256), 0, stream, P, (u16*)(ws + WS_R1 + R1_ACT)); }
                else { gemm_naive(stream, ws + WS_R1 + R1_ACT, 512, nullptr, P.in[28] + (size_t)li * 32 * 512 * 1024, 1024, 512L * 1024, tileexp, tileexp + 512, NTMP, 1024, MAXSLOT, 1024, 512);
                    hipLaunchKernelGGL(n_post_y, dim3(NG_), dim3(256), 0, stream, P); }
            }
        }
        ++p;
    }
}
```

```cpp
#define MK_FULL 1
#include <hip/hip_runtime.h>
#include <cstdio>
#include <cstdint>

typedef unsigned short u16;
typedef unsigned short bf16_t;

constexpr int D = 1024, NB = 16, SEQ = 2048, CTXL = 256, LTOT = 2304, T = NB * LTOT;
constexpr int SG = 64, SP = 64, SC = 16;
constexpr int QR = 384, KVR = 256, NH = 8, QKD = 192;
constexpr int NE = 32;
constexpr int MAXSLOT = 81920;
constexpr float EPS = 1e-6f;

constexpr size_t al256(size_t x) { return (x + 255) / 256 * 256; }
constexpr size_t WS_CTL = 0;
constexpr size_t CTL_BYTES = 131072;
constexpr size_t WS_MOD = WS_CTL + CTL_BYTES;
constexpr size_t MOD_BYTES = al256((size_t)4 * 17 * 6144 * 4);
constexpr size_t ZERO_BYTES = CTL_BYTES;
constexpr size_t WS_ROPE = WS_MOD + MOD_BYTES;
constexpr size_t WS_SMALL = WS_ROPE + al256((size_t)2048 * 32 * 8);
constexpr int SM_GMIX = 0, SM_GFFN = 4096, SM_S5D = 8192, SM_GQ = 10240, SM_GKV = 11008, SM_FINALG = 11520, SM_BGROUP = 12544, SM_BEXP = 12560, SM_WGROUP = 12800, SM_WEXP = 29184, SM_END = 160256;
constexpr size_t WS_X = WS_SMALL + al256((size_t)SM_END * 4);
constexpr size_t WS_HX = WS_X + (size_t)T * D * 4;
constexpr size_t WS_ZO = WS_HX + (size_t)T * D * 2;
constexpr size_t WS_CQ = WS_ZO + (size_t)T * D * 2;
constexpr size_t WS_CKV = WS_CQ + (size_t)T * QR * 2;
constexpr size_t WS_PS = WS_CKV + (size_t)T * KVR * 2;
constexpr size_t WS_SELI = WS_PS + (size_t)T * 24 * 4;
constexpr size_t WS_SELW = WS_SELI + (size_t)T * 16;
constexpr size_t WS_LIST = WS_SELW + (size_t)T * 8;
constexpr size_t WS_SLOTROW = WS_LIST + (size_t)NE * T * 4;
constexpr size_t WS_TILEEXP = WS_SLOTROW + (size_t)MAXSLOT * 4;
constexpr size_t WS_R1 = WS_TILEEXP + 4096;
constexpr size_t R1_BYTES = (size_t)MAXSLOT * 1024 * 4;
constexpr size_t WS_YB = WS_R1 + R1_BYTES;
constexpr size_t WS_WB = WS_YB + (size_t)MAXSLOT * 1024 * 2;
constexpr size_t R1_QT = 0;
constexpr size_t R1_KT = R1_QT + (size_t)NB * NH * LTOT * QKD * 2;
constexpr size_t R1_VT = R1_KT + (size_t)NB * NH * LTOT * QKD * 2;
constexpr size_t R1_ACT = 0;
constexpr size_t R1_S = 0;
constexpr size_t R1_UH = (size_t)64 * 2304 * 256 * 4;
constexpr size_t WB_GLU = 0;
constexpr size_t WB_WIN = WB_GLU + (size_t)2 * 2048 * 1024 * 2;
constexpr size_t WB_UQ = WB_WIN + (size_t)2 * 768 * 1024 * 2;
constexpr size_t WB_UKV = WB_UQ + (size_t)2 * 1536 * 384 * 2;
constexpr size_t WB_WO = WB_UKV + (size_t)2 * 2048 * 256 * 2;
constexpr size_t WB_GU = WB_WO + (size_t)2 * 1024 * 1024 * 2;
constexpr size_t WB_DN = WB_GU + (size_t)128 * 1024 * 1024 * 2;
constexpr size_t WB_W1 = WB_DN + (size_t)128 * 1024 * 512 * 2;
constexpr size_t WB_W2 = WB_W1 + (size_t)128 * 256 * 256 * 2;
constexpr size_t WB_AT = WB_W2 + (size_t)128 * 256 * 512 * 2;
constexpr size_t WB_END = WB_AT + (size_t)2 * 2 * 64 * 64 * 8;
constexpr size_t WS_END = WS_WB + WB_END;
constexpr size_t WS_NTMP = al256(WS_END);
constexpr size_t WS_NEND = WS_NTMP + (size_t)MAXSLOT * 1024 * 4;
static_assert(R1_UH + (size_t)64 * 2304 * 512 * 2 <= R1_BYTES, "R1");
static_assert(R1_VT + (size_t)NB * NH * LTOT * 128 * 2 <= R1_BYTES, "R1");
constexpr int CS = 64;
constexpr int CW_CNT = 8192;
constexpr int CW_QUEUE = 7168;
constexpr int CW_CNT_DUMMY = 16384;
constexpr int CW_STAMP64 = 12288;

__device__ __forceinline__ float bf2f(u16 v) { return __uint_as_float(((unsigned)v) << 16); }
__device__ __forceinline__ u16 f2bf(float f) { unsigned u = __float_as_uint(f); u += 0x7FFFu + ((u >> 16) & 1u); return (u16)(u >> 16); }
__device__ __forceinline__ float silu_f(float x) { return x / (1.f + __expf(-x)); }
__device__ __forceinline__ float sigmoid_f(float x) { return 1.f / (1.f + __expf(-x)); }
__device__ __forceinline__ float gelu_tanh(float x) { const float u = 0.7978845608028654f * (x + 0.044715f * x * x * x); const float e = __expf(2.f * u); const float t = 1.f - 2.f / (e + 1.f); return 0.5f * x * (1.f + t); }
__device__ __forceinline__ float wave_sum(float v) {
#pragma unroll
    for (int o = 32; o > 0; o >>= 1) v += __shfl_xor(v, o);
    return v;
}

struct Ptrs { const float* in[30]; float* out; unsigned char* ws; };
__device__ __forceinline__ int tid_opaque(int wv) { int l; asm volatile("v_mbcnt_lo_u32_b32 %0, -1, 0\n\tv_mbcnt_hi_u32_b32 %0, -1, %0" : "=v"(l)); return (wv << 6) | l; }
__device__ __forceinline__ float wave_sum_l(float v, int lane) {
#pragma unroll
    for (int o = 32; o > 0; o >>= 1) v += __int_as_float(__builtin_amdgcn_ds_bpermute((lane ^ o) << 2, __float_as_int(v)));
    return v;
}

__global__ __launch_bounds__(256) void k_mod(Ptrs P) {
    __shared__ float sc[17][64];
    const int i = blockIdx.y, col = blockIdx.x * 256 + threadIdx.x, tid = threadIdx.x;
    const float* W = P.in[4] + (size_t)i * 1024 * 6144;
    float acc[17];
#pragma unroll
    for (int r = 0; r < 17; ++r) acc[r] = 0.f;
    for (int k0 = 0; k0 < 1024; k0 += 64) {
        __syncthreads();
        for (int idx = tid; idx < 17 * 64; idx += 256) { const int r = idx >> 6, kk = idx & 63; const float v = r < 16 ? P.in[1][r * 1024 + k0 + kk] : P.in[3][k0 + kk]; sc[r][kk] = silu_f(v); }
        __syncthreads();
#pragma unroll 8
        for (int kk = 0; kk < 64; ++kk) { const float w = W[(size_t)(k0 + kk) * 6144 + col];
#pragma unroll
            for (int r = 0; r < 17; ++r) acc[r] += sc[r][kk] * w; }
    }
    float* mod = (float*)(P.ws + WS_MOD);
    const float bb = P.in[5][i * 6144 + col];
#pragma unroll
    for (int r = 0; r < 17; ++r) mod[(size_t)(i * 17 + r) * 6144 + col] = acc[r] + bb;
}
__device__ __forceinline__ void copy_small(const Ptrs& P, int t0, int nt) {
    float* sm = (float*)(P.ws + WS_SMALL);
    for (int i = t0; i < 4096; i += nt) { sm[SM_GMIX + i] = P.in[6][i]; sm[SM_GFFN + i] = P.in[7][i]; }
    for (int i = t0; i < 2048; i += nt) sm[SM_S5D + i] = P.in[15][i];
    for (int i = t0; i < 768; i += nt) sm[SM_GQ + i] = P.in[18][i];
    for (int i = t0; i < 512; i += nt) sm[SM_GKV + i] = P.in[19][i];
    for (int i = t0; i < 1024; i += nt) sm[SM_FINALG + i] = P.in[29][i];
    for (int i = t0; i < 16; i += nt) sm[SM_BGROUP + i] = P.in[24][i];
    for (int i = t0; i < 128; i += nt) sm[SM_BEXP + i] = P.in[26][i];
    for (int i = t0; i < 16384; i += nt) sm[SM_WGROUP + i] = P.in[23][i];
    for (int i = t0; i < 131072; i += nt) sm[SM_WEXP + i] = P.in[25][i];
}
__global__ __launch_bounds__(256) void k_init(Ptrs P) {
    copy_small(P, blockIdx.x * 256 + threadIdx.x, gridDim.x * 256);
    float4* X = (float4*)(P.ws + WS_X);
    const size_t n4 = (size_t)T * D / 4;
    for (size_t i = (size_t)blockIdx.x * 256 + threadIdx.x; i < n4; i += (size_t)gridDim.x * 256) {
        const size_t row = i / 256, c4 = i % 256; const int b = (int)(row / LTOT), pos = (int)(row % LTOT);
        X[i] = pos < CTXL ? ((const float4*)P.in[2])[((size_t)b * CTXL + pos) * 256 + c4] : ((const float4*)P.in[0])[((size_t)b * SEQ + (pos - CTXL)) * 256 + c4];
    }
    float2* rope = (float2*)(P.ws + WS_ROPE);
    for (int i = blockIdx.x * 256 + threadIdx.x; i < 2048 * 32; i += gridDim.x * 256) {
        const int s = i >> 5, k = i & 31, f = k & 15; const float invf = exp2f(-(float)f * (13.287712379549449f / 16.f));
        const float ang = (float)(k < 16 ? (s >> 6) : (s & 63)) * invf;
        rope[i] = make_float2(__cosf(ang), __sinf(ang));
    }
}

template <int MODE>
__device__ __forceinline__ void norm_rows(unsigned char* wsp, float* outp, int li, int which, int nwaves_blk, int* s_base, int wv) {
    struct { unsigned char* ws; float* out; } P{wsp, outp}; const float* sm = (const float*)(wsp + WS_SMALL);
    const int tidn = tid_opaque(wv); const int lane = tidn & 63, wave = tidn >> 6;
    float* X = (float*)(P.ws + WS_X);
    const float* mod = (const float*)(P.ws + WS_MOD);
    if (MODE & 1) {
        if (tidn == 0) { const unsigned* cnt = (const unsigned*)(P.ws + WS_CTL) + CW_CNT + (li - 1) * 32 * CS; int a = 0; for (int e = 0; e < 32; ++e) { s_base[e] = a; a += (int)((cnt[e * CS] + 255u) / 256u); } s_base[32] = a; }
        __syncthreads();
    }
    const bool lastl = (li == 3);
    for (int row = blockIdx.x * nwaves_blk + wave; row < T; row += gridDim.x * nwaves_blk) {
        const int b = row / LTOT, pos = row % LTOT; const bool isctx = pos < CTXL; const int r = isctx ? 16 : b;
        if ((MODE & 16) && isctx) continue;
        if ((MODE & 8) && lastl && isctx) continue;
        float4 v[4];
#pragma unroll
        for (int q = 0; q < 4; ++q) v[q] = *(const float4*)(X + (size_t)row * D + q * 256 + lane * 4);
        if (MODE & 1) {
            const bool skip = (li - 1 == 3) && isctx;
            if (!skip) {
                const int4 si = *(const int4*)(P.ws + WS_SELI + (size_t)row * 16); const float2 sw = *(const float2*)(P.ws + WS_SELW + (size_t)row * 8);
                const size_t g1 = (size_t)s_base[si.x] * 256 + si.y, g2 = (size_t)s_base[si.z] * 256 + si.w;
                const u16* YB = (const u16*)(P.ws + WS_YB);
                const float* gate = mod + (size_t)((li - 1) * 17 + r) * 6144 + 5 * 1024;
#pragma unroll
                for (int q = 0; q < 4; ++q) { const int c = q * 256 + lane * 4;
                    const uint2 ya = *(const uint2*)(YB + g1 * 1024 + c), yb = *(const uint2*)(YB + g2 * 1024 + c); const float4 gg = *(const float4*)(gate + c);
                    v[q].x += gg.x * (sw.x * bf2f((u16)(ya.x & 0xffff)) + sw.y * bf2f((u16)(yb.x & 0xffff)));
                    v[q].y += gg.y * (sw.x * bf2f((u16)(ya.x >> 16)) + sw.y * bf2f((u16)(yb.x >> 16)));
                    v[q].z += gg.z * (sw.x * bf2f((u16)(ya.y & 0xffff)) + sw.y * bf2f((u16)(yb.y & 0xffff)));
                    v[q].w += gg.w * (sw.x * bf2f((u16)(ya.y >> 16)) + sw.y * bf2f((u16)(yb.y >> 16)));
                    if (!(MODE & 16)) *(float4*)(X + (size_t)row * D + c) = v[q]; }
            }
        }
        float ss = 0.f;
#pragma unroll
        for (int q = 0; q < 4; ++q) ss += v[q].x * v[q].x + v[q].y * v[q].y + v[q].z * v[q].z + v[q].w * v[q].w;
        ss = wave_sum_l(ss, lane);
        const float rstd = rsqrtf(ss * (1.f / 1024.f) + EPS);
        if (MODE & 16) {
            float* out = P.out + ((size_t)b * SEQ + (pos - CTXL)) * D;
#pragma unroll
            for (int q = 0; q < 4; ++q) { const int c = q * 256 + lane * 4; const float4 g = *(const float4*)(sm + SM_FINALG + c);
                float4 ov = make_float4(v[q].x * rstd * g.x, v[q].y * rstd * g.y, v[q].z * rstd * g.z, v[q].w * rstd * g.w);
#if defined(PROBE_A)
                { const float da = 1.f + ((const float*)s_base)[40]; ov.x *= da; ov.y *= da; ov.z *= da; ov.w *= da; if (row == CTXL && c == 0) ov.x += ((const float*)s_base)[41]; }
#endif
                *(float4*)(out + c) = ov; }
            continue;
        }
        const float* gv = sm + (which ? SM_GFFN : SM_GMIX) + li * 1024;
        const float* sh = mod + (size_t)(li * 17 + r) * 6144 + (which ? 3 : 0) * 1024; const float* scl = sh + 1024;
        float h[16];
#pragma unroll
        for (int q = 0; q < 4; ++q) { const int c = q * 256 + lane * 4; const float4 g = *(const float4*)(gv + c), s4 = *(const float4*)(sh + c), c4 = *(const float4*)(scl + c);
            h[q * 4 + 0] = v[q].x * rstd * g.x * (1.f + c4.x) + s4.x; h[q * 4 + 1] = v[q].y * rstd * g.y * (1.f + c4.y) + s4.y;
            h[q * 4 + 2] = v[q].z * rstd * g.z * (1.f + c4.z) + s4.z; h[q * 4 + 3] = v[q].w * rstd * g.w * (1.f + c4.w) + s4.w; }
        if (MODE & 2) {
            u16* HX = (u16*)(P.ws + WS_HX);
#pragma unroll
            for (int q = 0; q < 4; ++q) { uint2 w; w.x = (unsigned)f2bf(h[q * 4]) | ((unsigned)f2bf(h[q * 4 + 1]) << 16); w.y = (unsigned)f2bf(h[q * 4 + 2]) | ((unsigned)f2bf(h[q * 4 + 3]) << 16);
                *(uint2*)(HX + (size_t)row * D + q * 256 + lane * 4) = w; }
        }
        if (MODE & 4) {
            u16* UH = (u16*)(P.ws + WS_R1 + R1_UH);
#pragma unroll
            for (int q = 0; q < 4; ++q) { const int c = q * 256 + lane * 4; const int g = c >> 4, ch = c & 15;
                uint2 w; w.x = (unsigned)f2bf(h[q * 4]) | ((unsigned)f2bf(h[q * 4 + 1]) << 16); w.y = (unsigned)f2bf(h[q * 4 + 2]) | ((unsigned)f2bf(h[q * 4 + 3]) << 16);
                *(uint2*)(UH + ((size_t)g * 2304 + b * 144 + (pos >> 4)) * 512 + (pos & 15) * 16 + ch) = w; }
        }
        if (MODE & 8) {
            const float* wg = sm + SM_WGROUP + (size_t)li * 1024 * 4;
            float lg[4] = {0.f, 0.f, 0.f, 0.f};
#pragma unroll
            for (int q = 0; q < 4; ++q)
#pragma unroll
                for (int j = 0; j < 4; ++j) { const int k = q * 256 + lane * 4 + j; const float4 w = *(const float4*)(wg + k * 4); const float hv = h[q * 4 + j];
                    lg[0] += hv * w.x; lg[1] += hv * w.y; lg[2] += hv * w.z; lg[3] += hv * w.w; }
#pragma unroll
            for (int g = 0; g < 4; ++g) lg[g] = wave_sum_l(lg[g], lane) + sm[SM_BGROUP + li * 4 + g];
            int gi = 0; float best = lg[0];
#pragma unroll
            for (int g = 1; g < 4; ++g) if (lg[g] > best) { best = lg[g]; gi = g; }
            float den = 0.f;
#pragma unroll
            for (int g = 0; g < 4; ++g) den += __expf(lg[g] - best);
            const float pg = 1.f / den;
            const float* we = sm + SM_WEXP + ((size_t)li * 4 + gi) * 1024 * 8;
            float le[8];
#pragma unroll
            for (int e = 0; e < 8; ++e) le[e] = 0.f;
#pragma unroll
            for (int q = 0; q < 4; ++q)
#pragma unroll
                for (int j = 0; j < 4; ++j) { const int k = q * 256 + lane * 4 + j; const float4 w0 = *(const float4*)(we + k * 8), w1 = *(const float4*)(we + k * 8 + 4); const float hv = h[q * 4 + j];
                    le[0] += hv * w0.x; le[1] += hv * w0.y; le[2] += hv * w0.z; le[3] += hv * w0.w; le[4] += hv * w1.x; le[5] += hv * w1.y; le[6] += hv * w1.z; le[7] += hv * w1.w; }
#pragma unroll
            for (int e = 0; e < 8; ++e) le[e] = wave_sum_l(le[e], lane) + sm[SM_BEXP + (li * 4 + gi) * 8 + e];
            int i1 = 0; float b1 = le[0];
#pragma unroll
            for (int e = 1; e < 8; ++e) if (le[e] > b1) { b1 = le[e]; i1 = e; }
            int i2 = -1; float b2 = -3.0e38f;
#pragma unroll
            for (int e = 0; e < 8; ++e) if (e != i1 && le[e] > b2) { b2 = le[e]; i2 = e; }
            if (lane == 0) {
                const float ex = __expf(b2 - b1); const float w1 = 1.f / (1.f + ex), w2 = ex / (1.f + ex);
                unsigned* cnt = (unsigned*)(P.ws + WS_CTL) + CW_CNT + li * 32 * CS; int* list = (int*)(P.ws + WS_LIST);
                const int e1 = gi * 8 + i1, e2 = gi * 8 + i2;
                const int s1 = (int)atomicAdd(&cnt[e1 * CS], 1u), s2 = (int)atomicAdd(&cnt[e2 * CS], 1u);
                list[(size_t)e1 * T + s1] = row; list[(size_t)e2 * T + s2] = row;
                *(int4*)(P.ws + WS_SELI + (size_t)row * 16) = make_int4(e1, s1, e2, s2);
                *(float2*)(P.ws + WS_SELW + (size_t)row * 8) = make_float2(pg * w1, pg * w2);
            }
        }
    }
}
template <int MODE> __global__ __launch_bounds__(256) void k_norm(Ptrs P, int li, int which) { __shared__ int sb[36]; norm_rows<MODE>(P.ws, P.out, li, which, 4, sb, __builtin_amdgcn_readfirstlane(threadIdx.x >> 6)); }

struct NG { const void* A; int lda; const int* rowidx; const float* B; int ldb; long bstride; const int* tileexp; const int* mdyn; float* C; int ldc; int M, N, K, pad; };
template <int ABF> __global__ __launch_bounds__(256) void n_gemm(NG g) {
    __shared__ float As[16][68], Bs[16][68];
    const int tm = blockIdx.y, tn = blockIdx.x, tid = threadIdx.x, tx = tid & 15, ty = tid >> 4;
    const int M = g.mdyn ? (*g.mdyn) * 256 : g.M;
    if (tm * 64 >= M) return;
    const float* B = g.B; if (g.tileexp) B += (long)g.tileexp[(tm * 64) / 256] * g.bstride;
    float acc[4][4];
#pragma unroll
    for (int i = 0; i < 4; ++i)
#pragma unroll
        for (int j = 0; j < 4; ++j) acc[i][j] = 0.f;
    const int arow = tm * 64 + (tid >> 2), ak = (tid & 3) * 4; long asrc = -1;
    if (arow < M) { const int r = g.rowidx ? g.rowidx[arow] : arow; if (r >= 0) asrc = (long)r * g.lda; }
    for (int k0 = 0; k0 < g.K; k0 += 16) {
        float a[4] = {0.f, 0.f, 0.f, 0.f};
        if (asrc >= 0) {
            if (ABF) { const uint2 w = *(const uint2*)((const u16*)g.A + asrc + k0 + ak); a[0] = bf2f((u16)(w.x & 0xffff)); a[1] = bf2f((u16)(w.x >> 16)); a[2] = bf2f((u16)(w.y & 0xffff)); a[3] = bf2f((u16)(w.y >> 16)); }
            else { const float4 w = *(const float4*)((const float*)g.A + asrc + k0 + ak); a[0] = w.x; a[1] = w.y; a[2] = w.z; a[3] = w.w; }
        }
        const float4 bv = *(const float4*)(B + (size_t)(k0 + (tid >> 4)) * g.ldb + tn * 64 + (tid & 15) * 4);
        __syncthreads();
#pragma unroll
        for (int i = 0; i < 4; ++i) As[ak + i][tid >> 2] = a[i];
        *(float4*)&Bs[tid >> 4][(tid & 15) * 4] = bv;
        __syncthreads();
#pragma unroll
        for (int kk = 0; kk < 16; ++kk) { const float4 a4 = *(const float4*)&As[kk][ty * 4], b4 = *(const float4*)&Bs[kk][tx * 4];
            const float av[4] = {a4.x, a4.y, a4.z, a4.w}, bw[4] = {b4.x, b4.y, b4.z, b4.w};
#pragma unroll
            for (int i = 0; i < 4; ++i)
#pragma unroll
                for (int j = 0; j < 4; ++j) acc[i][j] += av[i] * bw[j]; }
    }
#pragma unroll
    for (int i = 0; i < 4; ++i) { const int row = tm * 64 + ty * 4 + i; if (row < M) *(float4*)(g.C + (size_t)row * g.ldc + tn * 64 + tx * 4) = make_float4(acc[i][0], acc[i][1], acc[i][2], acc[i][3]); }
}
__device__ __forceinline__ int row_r(int row) { return (row % LTOT) < CTXL ? 16 : row / LTOT; }
__global__ __launch_bounds__(256) void n_post_glu(Ptrs P, int li) {
    float* X = (float*)(P.ws + WS_X); const float* TMP = (const float*)(P.ws + WS_NTMP); const float* mod = (const float*)(P.ws + WS_MOD);
    for (size_t i = (size_t)blockIdx.x * 256 + threadIdx.x; i < (size_t)T * D; i += (size_t)gridDim.x * 256) { const int row = (int)(i >> 10), c = (int)(i & 1023); const int r = row_r(row);
        const float val = TMP[(size_t)row * 2048 + c], gt = TMP[(size_t)row * 2048 + 1024 + c]; X[i] += mod[(size_t)(li * 17 + r) * 6144 + 2048 + c] * val * sigmoid_f(gt); }
}
__global__ __launch_bounds__(256) void n_post_wo(Ptrs P, int li) {
    float* X = (float*)(P.ws + WS_X); const float* TMP = (const float*)(P.ws + WS_NTMP); const float* mod = (const float*)(P.ws + WS_MOD);
    for (size_t i = (size_t)blockIdx.x * 256 + threadIdx.x; i < (size_t)T * D; i += (size_t)gridDim.x * 256) { const int row = (int)(i >> 10), c = (int)(i & 1023); const int r = row_r(row);
        X[i] += mod[(size_t)(li * 17 + r) * 6144 + 2048 + c] * TMP[i]; }
}
__global__ __launch_bounds__(256) void n_post_q(Ptrs P) {
    const float* TMP = (const float*)(P.ws + WS_NTMP); u16* QT = (u16*)(P.ws + WS_R1 + R1_QT); const float2* rope = (const float2*)(P.ws + WS_ROPE);
    const float scale = 0.07216878364870322f;
    for (size_t i = (size_t)blockIdx.x * 256 + threadIdx.x; i < (size_t)T * 1536; i += (size_t)gridDim.x * 256) { const int row = (int)(i / 1536), c = (int)(i % 1536); const int h = c / 192, dd = c % 192;
        const int b = row / LTOT, pos = row % LTOT; float v = TMP[i];
        if (dd >= 128 && pos >= CTXL) { const int l = dd - 128; const float pv = TMP[(size_t)row * 1536 + h * 192 + 128 + (l ^ 16)]; const float2 cs = rope[(size_t)(pos - CTXL) * 32 + (l >> 5) * 16 + (l & 15)];
            v = (l & 16) ? v * cs.x + pv * cs.y : v * cs.x - pv * cs.y; }
        QT[(((size_t)b * NH + h) * LTOT + pos) * QKD + dd] = f2bf(v * scale); }
}
__global__ __launch_bounds__(256) void n_post_kv(Ptrs P) {
    const float* TMP = (const float*)(P.ws + WS_NTMP); u16* KT = (u16*)(P.ws + WS_R1 + R1_KT); u16* VT = (u16*)(P.ws + WS_R1 + R1_VT);
    for (size_t i = (size_t)blockIdx.x * 256 + threadIdx.x; i < (size_t)T * 2048; i += (size_t)gridDim.x * 256) { const int row = (int)(i >> 11), c = (int)(i & 2047); const int h = c >> 8, dd = c & 255;
        const int b = row / LTOT, pos = row % LTOT; const u16 v = f2bf(TMP[i]);
        if (dd < 128) KT[(((size_t)b * NH + h) * LTOT + pos) * QKD + dd] = v; else VT[(((size_t)b * NH + h) * LTOT + pos) * 128 + dd - 128] = v; }
}
__global__ __launch_bounds__(256) void n_attn(Ptrs P) {
    __shared__ float Ks[32][192], Vs[32][128];
    const int qt = blockIdx.x, h = blockIdx.y, b = blockIdx.z, tid = threadIdx.x, ql = tid >> 2, part = tid & 3;
    const u16* QT = (const u16*)(P.ws + WS_R1 + R1_QT) + ((size_t)b * NH + h) * LTOT * QKD; const u16* KT = (const u16*)(P.ws + WS_R1 + R1_KT) + ((size_t)b * NH + h) * LTOT * QKD;
    const u16* VT = (const u16*)(P.ws + WS_R1 + R1_VT) + ((size_t)b * NH + h) * LTOT * 128; u16* O = (u16*)(P.ws + WS_ZO);
    const int pos = qt * 64 + ql; const int nk = (qt * 64 < CTXL) ? CTXL : LTOT;
    float q[48], o[32];
#pragma unroll
    for (int i = 0; i < 48; ++i) q[i] = bf2f(QT[(size_t)pos * QKD + part * 48 + i]);
#pragma unroll
    for (int i = 0; i < 32; ++i) o[i] = 0.f;
    float m = -1e30f, l = 0.f;
    for (int k0 = 0; k0 < nk; k0 += 32) {
        __syncthreads();
        for (int i = tid; i < 32 * 192; i += 256) Ks[i / 192][i % 192] = bf2f(KT[(size_t)k0 * QKD + i]);
        for (int i = tid; i < 32 * 128; i += 256) Vs[i / 128][i % 128] = bf2f(VT[(size_t)k0 * 128 + i]);
        __syncthreads();
        for (int kk = 0; kk < 32; ++kk) {
            float s = 0.f;
#pragma unroll
            for (int i = 0; i < 48; ++i) s += q[i] * Ks[kk][part * 48 + i];
            s += __shfl_xor(s, 1); s += __shfl_xor(s, 2);
            const float mn = fmaxf(m, s), al = __expf(m - mn), p = __expf(s - mn);
            l = l * al + p; m = mn;
#pragma unroll
            for (int i = 0; i < 32; ++i) o[i] = o[i] * al + p * Vs[kk][part * 32 + i];
        }
    }
    const float rl = 1.f / l;
#pragma unroll
    for (int i = 0; i < 32; ++i) O[((size_t)b * LTOT + pos) * D + h * 128 + part * 32 + i] = f2bf(o[i] * rl);
}
__global__ __launch_bounds__(128) void n_s5(Ptrs P, int j) {
    __shared__ float us[2][16], hre[2][64], him[2][64], Cre[2][16][64], Cim[2][16][64];
    const int b = blockIdx.x >> 6, g = blockIdx.x & 63, tid = threadIdx.x, dir = tid >> 6, p = tid & 63;
    const size_t gd = ((size_t)j * 2 + dir) * SG + g;
    const float dt = __expf(P.in[10][gd]); const float ar = P.in[8][gd * SP + p], ai = P.in[9][gd * SP + p];
    const float ldr = ar * dt, ldi = ai * dt, mag = __expf(ldr); const float abr = mag * __cosf(ldi), abi = mag * __sinf(ldi);
    const float nr = abr - 1.f, ni = abi, den = ar * ar + ai * ai; const float qr = (nr * ar + ni * ai) / den, qi = (ni * ar - nr * ai) / den;
    float bbr[16], bbi[16];
#pragma unroll
    for (int c = 0; c < 16; ++c) { const float br = P.in[11][(gd * SP + p) * SC + c], bi = P.in[12][(gd * SP + p) * SC + c]; bbr[c] = qr * br - qi * bi; bbi[c] = qr * bi + qi * br; }
    for (int i = tid; i < 2 * 16 * 64; i += 128) { const int d2 = i >> 10, c = (i >> 6) & 15, pp = i & 63; const size_t o = ((((size_t)j * 2 + d2) * SG + g) * SC + c) * SP + pp; Cre[d2][c][pp] = P.in[13][o]; Cim[d2][c][pp] = P.in[14][o]; }
    const u16* HX = (const u16*)(P.ws + WS_HX); float* Yf = (float*)(P.ws + WS_NTMP); float* Yr = Yf + (size_t)T * D;
    float hr = 0.f, hi = 0.f;
    for (int t = 0; t < LTOT; ++t) {
        __syncthreads();
        if (tid < 32) { const int d2 = tid >> 4, c = tid & 15; const int ps = d2 ? (t < CTXL ? CTXL - 1 - t : LTOT - 1 - (t - CTXL)) : t; us[d2][c] = bf2f(HX[((size_t)b * LTOT + ps) * D + g * 16 + c]); }
        __syncthreads();
        float bur = 0.f, bui = 0.f;
#pragma unroll
        for (int c = 0; c < 16; ++c) { bur += bbr[c] * us[dir][c]; bui += bbi[c] * us[dir][c]; }
        const float nhr = abr * hr - abi * hi + bur, nhi = abr * hi + abi * hr + bui; hr = nhr; hi = nhi;
        hre[dir][p] = hr; him[dir][p] = hi;
        __syncthreads();
        if (tid < 32) { const int d2 = tid >> 4, c = tid & 15; const int ps = d2 ? (t < CTXL ? CTXL - 1 - t : LTOT - 1 - (t - CTXL)) : t; float y = 0.f;
            for (int pp = 0; pp < 64; ++pp) y += Cre[d2][c][pp] * hre[d2][pp] - Cim[d2][c][pp] * him[d2][pp];
            (d2 ? Yr : Yf)[((size_t)b * LTOT + ps) * D + g * 16 + c] = y; }
    }
}
__global__ __launch_bounds__(256) void n_post_s5(Ptrs P, int j) {
    const float* Yf = (const float*)(P.ws + WS_NTMP); const float* Yr = Yf + (size_t)T * D; const u16* HX = (const u16*)(P.ws + WS_HX); u16* Z = (u16*)(P.ws + WS_ZO);
    for (size_t i = (size_t)blockIdx.x * 256 + threadIdx.x; i < (size_t)T * D; i += (size_t)gridDim.x * 256) { const int c = (int)(i & 1023);
        Z[i] = f2bf(gelu_tanh(Yf[i] + Yr[i] + P.in[15][j * 1024 + c] * bf2f(HX[i]))); }
}
__global__ __launch_bounds__(256) void n_build(Ptrs P, int li) {
    __shared__ int base[33];
    const unsigned* cnt = (const unsigned*)(P.ws + WS_CTL) + CW_CNT + li * 32 * CS; int* tileexp = (int*)(P.ws + WS_TILEEXP); int* slotrow = (int*)(P.ws + WS_SLOTROW); const int* list = (const int*)(P.ws + WS_LIST);
    if (threadIdx.x == 0) { int a = 0; for (int e = 0; e < 32; ++e) { base[e] = a; a += (int)((cnt[e * CS] + 255u) / 256u); } base[32] = a; tileexp[512] = a; }
    __syncthreads();
    for (int e = 0; e < 32; ++e) { const int nt = base[e + 1] - base[e];
        for (int t = threadIdx.x; t < nt; t += 256) tileexp[base[e] + t] = e;
        for (int s = threadIdx.x; s < nt * 256; s += 256) slotrow[base[e] * 256 + s] = s < (int)cnt[e * CS] ? list[(size_t)e * T + s] : -1; }
}
__global__ __launch_bounds__(256) void n_post_act2(Ptrs P, u16* ACT) {
    const float* TMP = (const float*)(P.ws + WS_NTMP); const int ntot = ((const int*)(P.ws + WS_TILEEXP))[512];
    for (size_t i = (size_t)blockIdx.x * 256 + threadIdx.x; i < (size_t)ntot * 256 * 512; i += (size_t)gridDim.x * 256) { const size_t gs = i >> 9; const int c = (int)(i & 511);
        ACT[i] = f2bf(silu_f(TMP[gs * 1024 + c]) * TMP[gs * 1024 + 512 + c]); }
}
__global__ __launch_bounds__(256) void n_post_y(Ptrs P) {
    const float* TMP = (const float*)(P.ws + WS_NTMP); u16* YB = (u16*)(P.ws + WS_YB); const int ntot = ((const int*)(P.ws + WS_TILEEXP))[512];
    for (size_t i = (size_t)blockIdx.x * 256 + threadIdx.x; i < (size_t)ntot * 256 * 1024; i += (size_t)gridDim.x * 256) YB[i] = f2bf(TMP[i]);
}

#define LAS __attribute__((address_space(3)))
typedef short bf16x8 __attribute__((ext_vector_type(8)));
typedef float f32x4 __attribute__((ext_vector_type(4)));
typedef unsigned u32x4 __attribute__((ext_vector_type(4)));
typedef unsigned u32x2 __attribute__((ext_vector_type(2)));
namespace g8 {
constexpr int BM = 256, BK = 64, HALF = 128, HTB = HALF * BK * 2, STAGE_BYTES = 8 * HTB, NXCD = 8, WGM = 8;
__host__ __device__ __forceinline__ int lds_byte(int r, int c) { const int st = (r >> 4) * 2 + (c >> 5), rr = r & 15, cc = c & 31, ob = rr * 64 + cc * 2; return st * 1024 + (ob ^ (((ob >> 9) & 1) << 5)); }
__host__ __device__ __forceinline__ void stage_rc(int b, int& R, int& C) { const int st = b / 1024, sb = b % 1024, swz = sb ^ (((sb >> 9) & 1) << 5); R = (st >> 1) * 16 + swz / 64; C = (st & 1) * 32 + (swz % 64) / 2; }
__host__ __device__ __forceinline__ int perm32(int rho) { const int n = rho >> 4, i = rho & 15; return 8 * (i >> 2) + 4 * n + (i & 3); }
struct Unit { int pm, pn, aux; };
struct Order {
    int nM, nN, nwg, G, c;
    __device__ __forceinline__ void init(int nM_, int nN_, int G_, int c_) { nM = nM_; nN = nN_; nwg = nM * nN; G = G_; c = c_; }
    __device__ __forceinline__ bool next(int i, int& pm, int& pn) const {
        const long L = (long)i * G + c; if (L >= nwg) return false;
        int wgid = (int)L; { const int q = nwg / NXCD, r = nwg % NXCD, xcd = wgid % NXCD, off = wgid / NXCD; wgid = (xcd < r ? xcd * (q + 1) : r * (q + 1) + (xcd - r) * q) + off; }
        const int nig = WGM * nN, gid = wgid / nig, fm = gid * WGM, gsz = (nM - fm) < WGM ? (nM - fm) : WGM;
        pm = fm + ((wgid % nig) % gsz); pn = (wgid % nig) / gsz; return true;
    }
};
__device__ __forceinline__ unsigned cvt_pk_bf16(float lo, float hi) { unsigned r; asm volatile("v_cvt_pk_bf16_f32 %0, %1, %2" : "=v"(r) : "v"(lo), "v"(hi)); return r; }

template <class Epi, class Sched>
__device__ __forceinline__ void gemm_phase(LAS unsigned char* lds, const int K, const Sched& S, const Epi& E, const int wv) {
    const int tid = tid_opaque(wv), wid = wv, lane = tid & 63, wr = wid >> 2, wc = wid & 3, fr = lane & 15, fq = lane >> 4;
    const int nt = K / BK;
    int R0, C0; stage_rc(tid * 16, R0, C0);
    unsigned voffB[2];
    { const int Rb0 = Epi::PERM ? ((R0 & ~31) + perm32(R0 & 31)) : R0;
      voffB[0] = (unsigned)(Rb0 * K + C0) * 2u; voffB[1] = voffB[0] + (unsigned)(64 * K) * 2u; }
    const size_t kstepB = (size_t)(BK * 2), hstepB = (size_t)HALF * K * 2;
    const size_t kstepA = S.a_kstep();
    const unsigned ldsw = (unsigned)wid * 1024u;
    const int aoff = lds_byte(wr * 64 + fr, fq * 8), boff = lds_byte(wc * 32 + fr, fq * 8);
#define G8_SA(b, h) (((b) * 2 + (h)) * HTB)
#define G8_SB(b, h) ((4 + (b) * 2 + (h)) * HTB)
#define G8_STAGE_B(bufoff, gbase) do { _Pragma("unroll") for (int _i = 0; _i < 2; ++_i) \
        __builtin_amdgcn_global_load_lds((const unsigned*)((const char*)(gbase) + voffB[_i]), (LAS unsigned*)(lds + (bufoff) + ldsw + _i * 8192), 16, 0, 0); } while (0)
#define G8_VI(h, i) ((Sched::NV == 1) ? 0 : ((h) * 2 + (i)))
#define G8_STAGE_A(bufoff, U, V, h, kb) do { \
        __builtin_amdgcn_global_load_lds((const unsigned*)(S.a_uptr(U, h, 0) + (size_t)(kb) + (V)[G8_VI(h, 0)]), (LAS unsigned*)(lds + (bufoff) + ldsw), 16, 0, 0); \
        __builtin_amdgcn_global_load_lds((const unsigned*)(S.a_uptr(U, h, 1) + (size_t)(kb) + (V)[G8_VI(h, 1)]), (LAS unsigned*)(lds + (bufoff) + ldsw + 8192), 16, 0, 0); } while (0)
#define G8_LDA(dst, b, h) do { _Pragma("unroll") for (int m = 0; m < 4; ++m) _Pragma("unroll") for (int k = 0; k < 2; ++k) dst[m][k] = *(const LAS bf16x8*)(lds + G8_SA(b, h) + aoff + m * 2048 + k * 1024); } while (0)
#define G8_LDB(dst, b, h) do { _Pragma("unroll") for (int n = 0; n < 2; ++n) _Pragma("unroll") for (int k = 0; k < 2; ++k) dst[n][k] = *(const LAS bf16x8*)(lds + G8_SB(b, h) + boff + n * 2048 + k * 1024); } while (0)
#define G8_MMA(ai, bj, At, Bt) do { __builtin_amdgcn_s_setprio(1); _Pragma("unroll") for (int m = 0; m < 4; ++m) _Pragma("unroll") for (int n = 0; n < 2; ++n) _Pragma("unroll") for (int k = 0; k < 2; ++k) \
        acc[ai][bj][m][n] = __builtin_amdgcn_mfma_f32_16x16x32_bf16(Bt[n][k], At[m][k], acc[ai][bj][m][n], 0, 0, 0); __builtin_amdgcn_s_setprio(0); } while (0)
#define G8_WAIT_V(n) asm volatile("s_waitcnt vmcnt(" #n ")" ::: "memory")
#define G8_WAIT_L(n) asm volatile("s_waitcnt lgkmcnt(" #n ")" ::: "memory")
#define G8_BAR __builtin_amdgcn_s_barrier()
#define G8_SCHED __builtin_amdgcn_sched_barrier(0)
    Unit cur, nxt; int ui = 0;
    if (!S.next(0, cur)) return;
    f32x4 acc[2][2][4][2];
#pragma unroll
    for (int a = 0; a < 2; ++a)
#pragma unroll
        for (int b = 0; b < 2; ++b)
#pragma unroll
            for (int m = 0; m < 4; ++m)
#pragma unroll
                for (int n = 0; n < 2; ++n) acc[a][b][m][n] = (f32x4){0.f, 0.f, 0.f, 0.f};
    bf16x8 At[4][2], B0[2][2], B1[2][2];
    unsigned cO[4], nO[4];
    S.a_voff(cur, R0, C0, cO);
    const char* cB = S.b_ptr(cur);
    G8_STAGE_B(G8_SB(0, 0), cB); G8_STAGE_A(G8_SA(0, 0), cur, cO, 0, 0); G8_STAGE_B(G8_SB(0, 1), cB + hstepB); G8_STAGE_A(G8_SA(0, 1), cur, cO, 1, 0);
    if (wr == 1) G8_BAR;
    G8_WAIT_V(4); G8_BAR;
    G8_STAGE_B(G8_SB(1, 0), cB + kstepB); G8_STAGE_A(G8_SA(1, 0), cur, cO, 0, kstepA); G8_STAGE_B(G8_SB(1, 1), cB + hstepB + kstepB);
    G8_WAIT_V(6); G8_BAR;
    for (;;) {
        const bool has_next = S.next(ui + 1, nxt);
        const char* nB = cB;
        if (has_next) { S.a_voff(nxt, R0, C0, nO); nB = S.b_ptr(nxt); }
        else { nxt = cur;
#pragma unroll
            for (int q = 0; q < 4; ++q) nO[q] = cO[q]; }
        for (int t = 0; t < nt; t += 2) {
            const bool last = (t == nt - 2);
            const size_t k1 = (size_t)(t + 1) * kstepA;
            const size_t k2 = last ? 0 : (size_t)(t + 2) * kstepA, k3 = k2 + kstepA;
            unsigned pV[4]; g8::Unit pU;
            if (last) { pU = nxt; pV[0] = nO[0]; pV[1] = nO[1]; pV[2] = nO[2]; pV[3] = nO[3]; } else { pU = cur; pV[0] = cO[0]; pV[1] = cO[1]; pV[2] = cO[2]; pV[3] = cO[3]; }
            const char* b2 = last ? nB : cB + (size_t)(t + 2) * kstepB; const char* b3 = b2 + kstepB;
            G8_LDB(B0, 0, 0); G8_SCHED; G8_LDA(At, 0, 0); G8_STAGE_A(G8_SA(1, 1), cur, cO, 1, k1);
            G8_WAIT_L(8); G8_BAR; G8_WAIT_L(0); G8_MMA(0, 0, At, B0); G8_BAR; G8_SCHED;
            G8_LDB(B1, 0, 1); G8_STAGE_B(G8_SB(0, 0), b2);
            G8_BAR; G8_WAIT_L(0); G8_MMA(0, 1, At, B1); G8_BAR;
            G8_LDA(At, 0, 1); G8_STAGE_A(G8_SA(0, 0), pU, pV, 0, k2);
            G8_BAR; G8_WAIT_L(0); G8_MMA(1, 0, At, B0); G8_BAR; G8_SCHED;
            G8_STAGE_B(G8_SB(0, 1), b2 + hstepB);
            G8_WAIT_V(6); G8_BAR; G8_MMA(1, 1, At, B1); G8_BAR;
            G8_LDB(B0, 1, 0); G8_SCHED; G8_LDA(At, 1, 0); G8_STAGE_A(G8_SA(0, 1), pU, pV, 1, k2);
            G8_WAIT_L(8); G8_BAR; G8_WAIT_L(0); G8_MMA(0, 0, At, B0); G8_BAR; G8_SCHED;
            G8_LDB(B1, 1, 1); G8_STAGE_B(G8_SB(1, 0), b3);
            G8_BAR; G8_WAIT_L(0); G8_MMA(0, 1, At, B1); G8_BAR;
            G8_LDA(At, 1, 1); G8_STAGE_A(G8_SA(1, 0), pU, pV, 0, k3);
            G8_BAR; G8_WAIT_L(0); G8_MMA(1, 0, At, B0); G8_BAR; G8_SCHED;
            G8_STAGE_B(G8_SB(1, 1), b3 + hstepB);
            G8_WAIT_V(6); G8_BAR; G8_MMA(1, 1, At, B1); G8_BAR;
        }
        E(acc, cur, wr, wc, fr, fq);
        if (!has_next) break;
#pragma unroll
        for (int a = 0; a < 2; ++a)
#pragma unroll
            for (int b = 0; b < 2; ++b)
#pragma unroll
                for (int m = 0; m < 4; ++m)
#pragma unroll
                    for (int n = 0; n < 2; ++n) acc[a][b][m][n] = (f32x4){0.f, 0.f, 0.f, 0.f};
        cur = nxt; cB = nB; ++ui;
#pragma unroll
        for (int q = 0; q < 4; ++q) cO[q] = nO[q];
    }
    G8_WAIT_V(0);
    if (wr == 0) G8_BAR;
    G8_BAR;
#undef G8_SA
#undef G8_SB
#undef G8_STAGE_A
#undef G8_VI
#undef G8_STAGE_B
#undef G8_LDA
#undef G8_LDB
#undef G8_MMA
#undef G8_WAIT_V
#undef G8_WAIT_L
#undef G8_BAR
#undef G8_SCHED
}
}
struct SchedDense {
    g8::Order ord; const char* A; unsigned lda2; const char* Bt; int K;
    __device__ __forceinline__ void init(const void* A_, int lda, const void* Bt_, int M, int N, int K_) { A = (const char*)A_; lda2 = (unsigned)lda * 2u; Bt = (const char*)Bt_; K = K_; ord.init(M / 256, N / 256, (int)gridDim.x, (int)blockIdx.x); }
    __device__ __forceinline__ bool next(int i, g8::Unit& u) const { u.aux = 0; return ord.next(i, u.pm, u.pn); }
    static constexpr int NV = 1;
    __device__ __forceinline__ size_t a_kstep() const { return 128; }
    __device__ __forceinline__ const char* a_uptr(const g8::Unit& u, int h, int i) const { return A + (size_t)(u.pm * 256 + h * 128 + i * 64) * lda2; }
    __device__ __forceinline__ void a_voff(const g8::Unit& u, int R0, int C0, unsigned (&o)[4]) const { o[0] = (unsigned)R0 * lda2 + C0 * 2; }
    __device__ __forceinline__ const char* b_ptr(const g8::Unit& u) const { return Bt + (size_t)u.pn * 256 * K * 2; }
};
struct SchedS5 {
    g8::Order ord; const char* A; const char* W; int K;
    __device__ __forceinline__ void init(const void* A_, const void* W_, int K_) { A = (const char*)A_; W = (const char*)W_; K = K_; ord.init(576, 1, (int)gridDim.x, (int)blockIdx.x); }
    __device__ __forceinline__ bool next(int i, g8::Unit& u) const { int pmx, pn; if (!ord.next(i, pmx, pn)) return false; u.aux = pmx / 9; u.pm = pmx % 9; u.pn = 0; return true; }
    static constexpr int NV = 1;
    __device__ __forceinline__ size_t a_kstep() const { return 128; }
    __device__ __forceinline__ const char* a_uptr(const g8::Unit& u, int h, int i) const { return A + (size_t)(u.aux * 2304 + u.pm * 256 + h * 128 + i * 64) * 1024; }
    __device__ __forceinline__ void a_voff(const g8::Unit& u, int R0, int C0, unsigned (&o)[4]) const { o[0] = (unsigned)R0 * 1024u + C0 * 2; }
    __device__ __forceinline__ const char* b_ptr(const g8::Unit& u) const { return W + (size_t)u.aux * 256 * K * 2; }
};
template <bool GATHER> struct SchedMoe {
    g8::Order ord; const char* A; const char* W; int K; const int* sbase; const unsigned* cnt; const int* list; size_t wstride;
    __device__ __forceinline__ void init(const void* A_, const void* W_, int K_, const int* sbase_, const unsigned* cnt_, const int* list_) {
        A = (const char*)A_; W = (const char*)W_; K = K_; sbase = sbase_; cnt = cnt_; list = list_; wstride = (size_t)1024 * K * 2; ord.init(sbase_[32], 4, (int)gridDim.x, (int)blockIdx.x); }
    __device__ __forceinline__ bool next(int i, g8::Unit& u) const { if (!ord.next(i, u.pm, u.pn)) return false; int e = 0;
        for (int k = 1; k < 32; ++k) e = (u.pm >= sbase[k]) ? k : e;
        u.aux = e; return true; }
    static constexpr int NV = GATHER ? 4 : 1;
    __device__ __forceinline__ size_t a_kstep() const { return 128; }
    __device__ __forceinline__ const char* a_uptr(const g8::Unit& u, int h, int i) const { return GATHER ? A : A + (size_t)(u.pm * 256 + h * 128 + i * 64) * 1024; }
    __device__ __forceinline__ void a_voff(const g8::Unit& u, int R0, int C0, unsigned (&o)[4]) const {
        if (GATHER) {
            const int e = u.aux; const int s0 = (u.pm - sbase[e]) * 256 + R0; const int n = (int)cnt[e * CS]; const int* l = list + (size_t)e * T;
#pragma unroll
            for (int q = 0; q < 4; ++q) { const int a = s0 + q * 64; o[q] = (unsigned)l[a < n ? a : 0] * 2048u + C0 * 2; }
        } else o[0] = (unsigned)R0 * 1024u + C0 * 2; }
    __device__ __forceinline__ const char* b_ptr(const g8::Unit& u) const { return W + (size_t)u.aux * wstride + (size_t)u.pn * 256 * K * 2; }
};

#define EPI_LOOP_AM for (int ai = 0; ai < 2; ++ai) _Pragma("unroll") for (int m = 0; m < 4; ++m)
struct EpiS5a {
    static constexpr bool PERM = false; float* S;
    __device__ __forceinline__ void operator()(const f32x4 (&acc)[2][2][4][2], const g8::Unit& u, int wr, int wc, int fr, int fq) const {
        float* base = S + ((size_t)u.aux * 2304 + (size_t)u.pm * 256 + wr * 64 + fr) * 256 + wc * 32 + 4 * fq;
#pragma unroll
        EPI_LOOP_AM { float* rowp = base + (size_t)(ai * 128 + m * 16) * 256;
#pragma unroll
            for (int bj = 0; bj < 2; ++bj)
#pragma unroll
                for (int n = 0; n < 2; ++n) *(f32x4*)(rowp + bj * 128 + n * 16) = acc[ai][bj][m][n]; }
    }
};
struct EpiS5b {
    static constexpr bool PERM = true; u16* Z; const u16* UH; const float* dvec;
    __device__ __forceinline__ void operator()(const f32x4 (&acc)[2][2][4][2], const g8::Unit& u, int wr, int wc, int fr, int fq) const {
        const int g = u.aux; const int ch0 = (fq & 1) * 8;
        const f32x4 d0 = *(const f32x4*)(dvec + g * 16 + ch0), d1 = *(const f32x4*)(dvec + g * 16 + ch0 + 4);
#pragma unroll
        EPI_LOOP_AM { const int rowin = u.pm * 256 + ai * 128 + wr * 64 + m * 16 + fr;
#pragma unroll
            for (int bj = 0; bj < 2; ++bj) { const int c0 = bj * 128 + wc * 32 + fq * 8; const int t = c0 >> 4;
                const u32x4 uu = *(const u32x4*)(UH + ((size_t)g * 2304 + rowin) * 512 + c0);
                const f32x4 a0 = acc[ai][bj][m][0], a1 = acc[ai][bj][m][1];
                float z[8];
                z[0] = a0[0] + d0[0] * __uint_as_float(uu.x << 16); z[1] = a0[1] + d0[1] * __uint_as_float(uu.x & 0xffff0000u);
                z[2] = a0[2] + d0[2] * __uint_as_float(uu.y << 16); z[3] = a0[3] + d0[3] * __uint_as_float(uu.y & 0xffff0000u);
                z[4] = a1[0] + d1[0] * __uint_as_float(uu.z << 16); z[5] = a1[1] + d1[1] * __uint_as_float(uu.z & 0xffff0000u);
                z[6] = a1[2] + d1[2] * __uint_as_float(uu.w << 16); z[7] = a1[3] + d1[3] * __uint_as_float(uu.w & 0xffff0000u);
#pragma unroll
                for (int q = 0; q < 8; ++q) z[q] = gelu_tanh(z[q]);
                u32x4 w; w.x = g8::cvt_pk_bf16(z[0], z[1]); w.y = g8::cvt_pk_bf16(z[2], z[3]); w.z = g8::cvt_pk_bf16(z[4], z[5]); w.w = g8::cvt_pk_bf16(z[6], z[7]);
                *(u32x4*)(Z + ((size_t)rowin * 16 + t) * 1024 + g * 16 + ch0) = w; } }
    }
};
struct EpiGlu {
    static constexpr bool PERM = true; u16* DL; const float* mod; int li;
    __device__ __forceinline__ void operator()(const f32x4 (&acc)[2][2][4][2], const g8::Unit& u, int wr, int wc, int fr, int fq) const {
        const int r = (u.pm % 9 == 0) ? 16 : u.pm / 9; const float* gate = mod + (size_t)(li * 17 + r) * 6144 + 2048;
        const int j0 = u.pn * 128 + wc * 32 + fq * 8;
        const f32x4 g0 = *(const f32x4*)(gate + j0), g1 = *(const f32x4*)(gate + j0 + 4);
#pragma unroll
        EPI_LOOP_AM { const size_t row = (size_t)u.pm * 256 + ai * 128 + wr * 64 + m * 16 + fr;
            const f32x4 v0 = acc[ai][0][m][0], v1 = acc[ai][0][m][1], t0 = acc[ai][1][m][0], t1 = acc[ai][1][m][1];
            u32x4 w; w.x = g8::cvt_pk_bf16(g0[0] * v0[0] * sigmoid_f(t0[0]), g0[1] * v0[1] * sigmoid_f(t0[1])); w.y = g8::cvt_pk_bf16(g0[2] * v0[2] * sigmoid_f(t0[2]), g0[3] * v0[3] * sigmoid_f(t0[3]));
            w.z = g8::cvt_pk_bf16(g1[0] * v1[0] * sigmoid_f(t1[0]), g1[1] * v1[1] * sigmoid_f(t1[1])); w.w = g8::cvt_pk_bf16(g1[2] * v1[2] * sigmoid_f(t1[2]), g1[3] * v1[3] * sigmoid_f(t1[3]));
            *(u32x4*)(DL + row * 1024 + j0) = w; }
    }
};
struct EpiF32 {
    static constexpr bool PERM = false; float* C; int ldc;
    __device__ __forceinline__ void operator()(const f32x4 (&acc)[2][2][4][2], const g8::Unit& u, int wr, int wc, int fr, int fq) const {
        float* base = C + ((size_t)u.pm * 256 + wr * 64 + fr) * ldc + u.pn * 256 + wc * 32 + 4 * fq;
#pragma unroll
        EPI_LOOP_AM { float* rowp = base + (size_t)(ai * 128 + m * 16) * ldc;
#pragma unroll
            for (int bj = 0; bj < 2; ++bj)
#pragma unroll
                for (int n = 0; n < 2; ++n) *(f32x4*)(rowp + bj * 128 + n * 16) = acc[ai][bj][m][n]; }
    }
};
__device__ __forceinline__ float rstd_from_ps(const float* PS, size_t row, int first4, int n4, float inv_n) {
    float s = 0.f;
#pragma unroll
    for (int q = 0; q < 3; ++q) if (q < n4) { const f32x4 v = *(const f32x4*)(PS + row * 24 + (first4 + q) * 4); s += (v[0] + v[1]) + (v[2] + v[3]); }
    return rsqrtf(s * inv_n + EPS);
}
struct EpiWin {
    static constexpr bool PERM = false; u16* CQ; u16* CKV; u16* KT; float* PS; const float2* rope;
    __device__ __forceinline__ void operator()(const f32x4 (&acc)[2][2][4][2], const g8::Unit& u, int wr, int wc, int fr, int fq) const {
        const int b = u.pm / 9, pt = u.pm % 9; const int lane = fr + 16 * fq;
#pragma unroll
        EPI_LOOP_AM { const int pos = pt * 256 + ai * 128 + wr * 64 + m * 16 + fr; const size_t row = (size_t)u.pm * 256 + ai * 128 + wr * 64 + m * 16 + fr;
#pragma unroll
            for (int bj = 0; bj < 2; ++bj) { const f32x4 a0 = acc[ai][bj][m][0], a1 = acc[ai][bj][m][1]; const int cg = u.pn * 256 + bj * 128;
                if (cg < 640) {
                    float s = (a0[0] * a0[0] + a0[1] * a0[1]) + (a0[2] * a0[2] + a0[3] * a0[3]) + (a1[0] * a1[0] + a1[1] * a1[1]) + (a1[2] * a1[2] + a1[3] * a1[3]);
                    s += __int_as_float(__builtin_amdgcn_ds_bpermute((lane ^ 16) << 2, __float_as_int(s))); s += __int_as_float(__builtin_amdgcn_ds_bpermute((lane ^ 32) << 2, __float_as_int(s)));
                    if (fq == 0) PS[row * 24 + (u.pn * 2 + bj) * 4 + wc] = s;
                    u16* dst = cg < 384 ? CQ + row * QR + cg + wc * 32 + fq * 4 : CKV + row * KVR + (cg - 384) + wc * 32 + fq * 4;
                    u32x2 w0, w1; w0.x = g8::cvt_pk_bf16(a0[0], a0[1]); w0.y = g8::cvt_pk_bf16(a0[2], a0[3]); w1.x = g8::cvt_pk_bf16(a1[0], a1[1]); w1.y = g8::cvt_pk_bf16(a1[2], a1[3]);
                    *(u32x2*)dst = w0; *(u32x2*)(dst + 16) = w1;
                } else if (wc < 2) {
                    f32x4 x0 = a0, x1 = a1;
                    if (pos >= CTXL) { const float2* rp = rope + (size_t)(pos - CTXL) * 32 + wc * 16 + fq * 4;
#pragma unroll
                        for (int q = 0; q < 4; ++q) { const float2 cs = rp[q]; x0[q] = a0[q] * cs.x - a1[q] * cs.y; x1[q] = a1[q] * cs.x + a0[q] * cs.y; } }
                    u32x2 w0, w1; w0.x = g8::cvt_pk_bf16(x0[0], x0[1]); w0.y = g8::cvt_pk_bf16(x0[2], x0[3]); w1.x = g8::cvt_pk_bf16(x1[0], x1[1]); w1.y = g8::cvt_pk_bf16(x1[2], x1[3]);
#pragma unroll
                    for (int h = 0; h < NH; ++h) { u16* dst = KT + (((size_t)b * NH + h) * LTOT + pos) * QKD + 128 + wc * 32 + fq * 4; *(u32x2*)dst = w0; *(u32x2*)(dst + 16) = w1; }
                } } }
    }
};
struct EpiQ {
    static constexpr bool PERM = false; u16* QT; const float2* rope; const float* PS;
    __device__ __forceinline__ void operator()(const f32x4 (&acc)[2][2][4][2], const g8::Unit& u, int wr, int wc, int fr, int fq) const {
        const int b = u.pm / 9, pt = u.pm % 9;
#pragma unroll
        EPI_LOOP_AM { const int pos = pt * 256 + ai * 128 + wr * 64 + m * 16 + fr; const float scale = 0.07216878364870322f * rstd_from_ps(PS, (size_t)u.pm * 256 + ai * 128 + wr * 64 + m * 16 + fr, 0, 3, 1.f / 384.f);
#pragma unroll
            for (int bj = 0; bj < 2; ++bj) { const int g32 = u.pn * 8 + bj * 4 + wc; const int h = g32 / 6, part = g32 % 6;
                f32x4 a = acc[ai][bj][m][0], bq = acc[ai][bj][m][1];
                if (part >= 4 && pos >= CTXL) { const float2* rp = rope + (size_t)(pos - CTXL) * 32 + (part - 4) * 16 + fq * 4;
#pragma unroll
                    for (int q = 0; q < 4; ++q) { const float2 cs = rp[q]; const float x0 = a[q], x1 = bq[q]; a[q] = x0 * cs.x - x1 * cs.y; bq[q] = x1 * cs.x + x0 * cs.y; } }
                u16* dst = QT + (((size_t)b * NH + h) * LTOT + pos) * QKD + part * 32 + fq * 4;
                u32x2 w0, w1; w0.x = g8::cvt_pk_bf16(a[0] * scale, a[1] * scale); w0.y = g8::cvt_pk_bf16(a[2] * scale, a[3] * scale);
                w1.x = g8::cvt_pk_bf16(bq[0] * scale, bq[1] * scale); w1.y = g8::cvt_pk_bf16(bq[2] * scale, bq[3] * scale);
                *(u32x2*)dst = w0; *(u32x2*)(dst + 16) = w1; } }
    }
};
struct EpiKV {
    static constexpr bool PERM = true; u16* KT; u16* VT; const float* PS;
    __device__ __forceinline__ void operator()(const f32x4 (&acc)[2][2][4][2], const g8::Unit& u, int wr, int wc, int fr, int fq) const {
        const int b = u.pm / 9, pt = u.pm % 9, h = u.pn;
#pragma unroll
        EPI_LOOP_AM { const int pos = pt * 256 + ai * 128 + wr * 64 + m * 16 + fr; const size_t rr = ((size_t)b * NH + h) * LTOT + pos; const float rs = rstd_from_ps(PS, (size_t)u.pm * 256 + ai * 128 + wr * 64 + m * 16 + fr, 3, 2, 1.f / 256.f);
#pragma unroll
            for (int bj = 0; bj < 2; ++bj) { const f32x4 a0 = acc[ai][bj][m][0] * rs, a1 = acc[ai][bj][m][1] * rs;
                u32x4 w; w.x = g8::cvt_pk_bf16(a0[0], a0[1]); w.y = g8::cvt_pk_bf16(a0[2], a0[3]); w.z = g8::cvt_pk_bf16(a1[0], a1[1]); w.w = g8::cvt_pk_bf16(a1[2], a1[3]);
                u16* dst = bj == 0 ? KT + rr * QKD + wc * 32 + fq * 8 : VT + rr * 128 + wc * 32 + fq * 8;
                *(u32x4*)dst = w; } }
    }
};
struct EpiWo {
    static constexpr bool PERM = true; u16* DL; const float* mod; int li;
    __device__ __forceinline__ void operator()(const f32x4 (&acc)[2][2][4][2], const g8::Unit& u, int wr, int wc, int fr, int fq) const {
        const int r = (u.pm % 9 == 0) ? 16 : u.pm / 9; const float* gate = mod + (size_t)(li * 17 + r) * 6144 + 2048;
        f32x4 gg[2][2];
#pragma unroll
        for (int bj = 0; bj < 2; ++bj)
#pragma unroll
            for (int n = 0; n < 2; ++n) gg[bj][n] = *(const f32x4*)(gate + u.pn * 256 + bj * 128 + wc * 32 + fq * 8 + n * 4);
#pragma unroll
        EPI_LOOP_AM { const size_t row = (size_t)u.pm * 256 + ai * 128 + wr * 64 + m * 16 + fr;
#pragma unroll
            for (int bj = 0; bj < 2; ++bj) { const f32x4 a0 = acc[ai][bj][m][0] * gg[bj][0], a1 = acc[ai][bj][m][1] * gg[bj][1];
                u32x4 w; w.x = g8::cvt_pk_bf16(a0[0], a0[1]); w.y = g8::cvt_pk_bf16(a0[2], a0[3]); w.z = g8::cvt_pk_bf16(a1[0], a1[1]); w.w = g8::cvt_pk_bf16(a1[2], a1[3]);
                *(u32x4*)(DL + row * 1024 + u.pn * 256 + bj * 128 + wc * 32 + fq * 8) = w; } }
    }
};
struct EpiMoe1 {
    static constexpr bool PERM = true; u16* ACT;
    __device__ __forceinline__ void operator()(const f32x4 (&acc)[2][2][4][2], const g8::Unit& u, int wr, int wc, int fr, int fq) const {
        const int j0 = u.pn * 128 + wc * 32 + fq * 8;
#pragma unroll
        EPI_LOOP_AM { const size_t gs = (size_t)u.pm * 256 + ai * 128 + wr * 64 + m * 16 + fr;
            const f32x4 g0 = acc[ai][0][m][0], g1 = acc[ai][0][m][1], u0 = acc[ai][1][m][0], u1 = acc[ai][1][m][1];
            u32x4 w; w.x = g8::cvt_pk_bf16(silu_f(g0[0]) * u0[0], silu_f(g0[1]) * u0[1]); w.y = g8::cvt_pk_bf16(silu_f(g0[2]) * u0[2], silu_f(g0[3]) * u0[3]);
            w.z = g8::cvt_pk_bf16(silu_f(g1[0]) * u1[0], silu_f(g1[1]) * u1[1]); w.w = g8::cvt_pk_bf16(silu_f(g1[2]) * u1[2], silu_f(g1[3]) * u1[3]);
            *(u32x4*)(ACT + gs * 512 + j0) = w; }
    }
};
struct EpiMoe2 {
    static constexpr bool PERM = true; u16* YB;
    __device__ __forceinline__ void operator()(const f32x4 (&acc)[2][2][4][2], const g8::Unit& u, int wr, int wc, int fr, int fq) const {
#pragma unroll
        EPI_LOOP_AM { const size_t gs = (size_t)u.pm * 256 + ai * 128 + wr * 64 + m * 16 + fr;
#pragma unroll
            for (int bj = 0; bj < 2; ++bj) { const f32x4 a0 = acc[ai][bj][m][0], a1 = acc[ai][bj][m][1];
                u32x4 w; w.x = g8::cvt_pk_bf16(a0[0], a0[1]); w.y = g8::cvt_pk_bf16(a0[2], a0[3]); w.z = g8::cvt_pk_bf16(a1[0], a1[1]); w.w = g8::cvt_pk_bf16(a1[2], a1[3]);
                *(u32x4*)(YB + gs * 1024 + u.pn * 256 + bj * 128 + wc * 32 + fq * 8) = w; } }
    }
};
namespace at {
typedef short s16x4 __attribute__((ext_vector_type(4)));
typedef float f32x16 __attribute__((ext_vector_type(16)));
constexpr int KVBLK = 64, QBLK = 32, NW = 8;
constexpr int SHM_V = KVBLK * 128 * 2, SHM_K = KVBLK * QKD * 2, NBUF = 3, SHM_ATTN = NBUF * SHM_V + NBUF * SHM_K + NW * 64 * 4;
constexpr float SCALE = 1.0f;
constexpr float THR = 8.f;
#define KSWZ(row, colB) ((row) * 384 + ((colB) ^ (((row) & 7) << 4)))
#define SBAR() __builtin_amdgcn_sched_barrier(0)
__device__ __forceinline__ int crow(int r, int hi) { return (r & 3) + 8 * (r >> 2) + 4 * hi; }
__device__ __forceinline__ unsigned cvtpk(float lo, float hi) { unsigned r; asm volatile("v_cvt_pk_bf16_f32 %0, %1, %2" : "=v"(r) : "v"(lo), "v"(hi)); return r; }
__device__ __forceinline__ void partialSM(f32x16& p0, f32x16& p1, float& m_reg, float& mn, float& alpha) {
    constexpr float C = SCALE * 1.4426950408889634f;
    float pmax = p0[0];
#pragma unroll
    for (int r = 1; r < 16; ++r) pmax = fmaxf(pmax, p0[r]);
#pragma unroll
    for (int r = 0; r < 16; ++r) pmax = fmaxf(pmax, p1[r]);
    { auto rr = __builtin_amdgcn_permlane32_swap(__float_as_uint(pmax), __float_as_uint(pmax), false, false); pmax = fmaxf(__uint_as_float(rr[0]), __uint_as_float(rr[1])); }
    if (__builtin_expect(__all(pmax - m_reg <= THR / SCALE), 1)) { mn = m_reg; alpha = 1.f; }
    else { mn = fmaxf(m_reg, pmax); alpha = __builtin_amdgcn_exp2f((m_reg - mn) * C); m_reg = mn; }
    const float mnC = -mn * C;
#pragma unroll
    for (int r = 0; r < 16; ++r) p0[r] = fmaf(p0[r], C, mnC);
#pragma unroll
    for (int r = 0; r < 16; ++r) p1[r] = fmaf(p1[r], C, mnC);
#pragma unroll
    for (int r = 0; r < 16; ++r) p0[r] = __builtin_amdgcn_exp2f(p0[r]);
}
__device__ __forceinline__ void finishSM(f32x16& p0, f32x16& p1, float alpha, float& l_reg, bf16x8& pa0, bf16x8& pa1, bf16x8& pa2, bf16x8& pa3) {
#pragma unroll
    for (int r = 0; r < 16; ++r) p1[r] = __builtin_amdgcn_exp2f(p1[r]);
    float ps = 0;
#pragma unroll
    for (int r = 0; r < 16; ++r) ps += p0[r];
#pragma unroll
    for (int r = 0; r < 16; ++r) ps += p1[r];
    { auto rr = __builtin_amdgcn_permlane32_swap(__float_as_uint(ps), __float_as_uint(ps), false, false); ps = __uint_as_float(rr[0]) + __uint_as_float(rr[1]); }
    l_reg = l_reg * alpha + ps;
#define PK4(P, BASE, OUT) do { unsigned a0 = cvtpk(P[BASE + 0], P[BASE + 1]), a1 = cvtpk(P[BASE + 2], P[BASE + 3]);   \
    unsigned b0 = cvtpk(P[BASE + 4], P[BASE + 5]), b1 = cvtpk(P[BASE + 6], P[BASE + 7]);                              \
    auto r0 = __builtin_amdgcn_permlane32_swap(a0, b0, false, false); auto r1 = __builtin_amdgcn_permlane32_swap(a1, b1, false, false); \
    u32x4 w = {r0[0], r1[0], r0[1], r1[1]}; OUT = *reinterpret_cast<bf16x8*>(&w); } while (0)
    PK4(p0, 0, pa0); PK4(p0, 8, pa1); PK4(p1, 0, pa2); PK4(p1, 8, pa3);
#undef PK4
}
#define KRD(x0, x1, kb, a) do { asm volatile("ds_read_b128 %0, %1 offset:%2" : "=v"(x0) : "v"(kb), "i"((a) * 128) : "memory"); \
                                asm volatile("ds_read_b128 %0, %1 offset:%2" : "=v"(x1) : "v"(kb), "i"((a) * 128 + 32 * 384) : "memory"); } while (0)
#define KWT(n, x0, x1) asm volatile("s_waitcnt lgkmcnt(" #n ")" : "+v"(x0), "+v"(x1) :: "memory")
#define KMM(x0, x1, q) do { p0 = __builtin_amdgcn_mfma_f32_32x32x16_bf16(x0, q, p0, 0, 0, 0); p1 = __builtin_amdgcn_mfma_f32_32x32x16_bf16(x1, q, p1, 0, 0, 0); } while (0)
__device__ __forceinline__ void qkt(f32x16& p0, f32x16& p1, int kb0, int kb1, int kb2, int kb3, const bf16x8* qr) {
    p0 = f32x16{}; p1 = f32x16{};
    bf16x8 a0, a1, b0, b1, c0, c1;
    KRD(a0, a1, kb0, 0); KRD(b0, b1, kb1, 0); KRD(c0, c1, kb2, 0);
    KWT(4, a0, a1); KMM(a0, a1, qr[0]);
    KWT(2, b0, b1); KMM(b0, b1, qr[1]);  KRD(a0, a1, kb3, 0);
    KWT(2, c0, c1); KMM(c0, c1, qr[2]);  KRD(b0, b1, kb0, 1);
    KWT(2, a0, a1); KMM(a0, a1, qr[3]);  KRD(c0, c1, kb1, 1);
    KWT(2, b0, b1); KMM(b0, b1, qr[4]);  KRD(a0, a1, kb2, 1);
    KWT(2, c0, c1); KMM(c0, c1, qr[5]);  KRD(b0, b1, kb3, 1);
    KWT(2, a0, a1); KMM(a0, a1, qr[6]);  KRD(c0, c1, kb0, 2);
    KWT(2, b0, b1); KMM(b0, b1, qr[7]);  KRD(a0, a1, kb1, 2);
    KWT(2, c0, c1); KMM(c0, c1, qr[8]);  KRD(b0, b1, kb2, 2);
    KWT(2, a0, a1); KMM(a0, a1, qr[9]);  KRD(c0, c1, kb3, 2);
    KWT(2, b0, b1); KMM(b0, b1, qr[10]);
    KWT(0, c0, c1); KMM(c0, c1, qr[11]);
}
#undef KRD
#undef KWT
#undef KMM
__device__ __forceinline__ int v_st(int k, int c) { const int kk = (k & ~0xC) | ((k & 4) << 1) | ((k & 8) >> 1); return ((kk >> 3) * 4 + (c >> 5)) * 512 + ((kk & 7) * 32 + (c & 31)) * 2; }
__device__ __forceinline__ int v_rd_base(int lane) { return ((lane & 3) << 3) | (((lane >> 2) & 3) << 6) | (((lane >> 4) & 1) << 5) | (((lane >> 5) & 1) << 8); }
constexpr int v_rd_off(int d0, int ks, int half) { return d0 * 512 + ks * 4096 + half * 2048; }
template <int OFF> __device__ __forceinline__ s16x4 tr_read(int vb) { s16x4 r; asm volatile("ds_read_b64_tr_b16 %0, %1 offset:%2" : "=&v"(r) : "v"(vb), "i"(OFF) : "memory"); return r; }
struct VFr { s16x4 l0, h0, l1, h1, l2, h2, l3, h3; };
template <int D0> __device__ __forceinline__ void pv_rd(VFr& f, int vb) {
    f.l0 = tr_read<v_rd_off(D0, 0, 0)>(vb); f.h0 = tr_read<v_rd_off(D0, 0, 1)>(vb); f.l1 = tr_read<v_rd_off(D0, 1, 0)>(vb); f.h1 = tr_read<v_rd_off(D0, 1, 1)>(vb);
    f.l2 = tr_read<v_rd_off(D0, 2, 0)>(vb); f.h2 = tr_read<v_rd_off(D0, 2, 1)>(vb); f.l3 = tr_read<v_rd_off(D0, 3, 0)>(vb); f.h3 = tr_read<v_rd_off(D0, 3, 1)>(vb);
}
#define VWT(n, f) asm volatile("s_waitcnt lgkmcnt(" #n ")" : "+v"(f.l0), "+v"(f.h0), "+v"(f.l1), "+v"(f.h1), "+v"(f.l2), "+v"(f.h2), "+v"(f.l3), "+v"(f.h3) :: "memory")
__device__ __forceinline__ void pv_mm(f32x16& od, const VFr& f, bf16x8 pa0, bf16x8 pa1, bf16x8 pa2, bf16x8 pa3) {
#define PK(L, H) (bf16x8){L[0], L[1], L[2], L[3], H[0], H[1], H[2], H[3]}
    od = __builtin_amdgcn_mfma_f32_32x32x16_bf16(pa0, PK(f.l0, f.h0), od, 0, 0, 0);
    od = __builtin_amdgcn_mfma_f32_32x32x16_bf16(pa1, PK(f.l1, f.h1), od, 0, 0, 0);
    od = __builtin_amdgcn_mfma_f32_32x32x16_bf16(pa2, PK(f.l2, f.h2), od, 0, 0, 0);
    od = __builtin_amdgcn_mfma_f32_32x32x16_bf16(pa3, PK(f.l3, f.h3), od, 0, 0, 0);
#undef PK
}
__device__ __forceinline__ void pv_d0(f32x16* o, int vb, bf16x8 pa0, bf16x8 pa1, bf16x8 pa2, bf16x8 pa3) {
    VFr fa, fb;
    pv_rd<0>(fa, vb);
    pv_rd<1>(fb, vb); VWT(8, fa); pv_mm(o[0], fa, pa0, pa1, pa2, pa3);
    pv_rd<2>(fa, vb); VWT(8, fb); pv_mm(o[1], fb, pa0, pa1, pa2, pa3);
    pv_rd<3>(fb, vb); VWT(8, fa); pv_mm(o[2], fa, pa0, pa1, pa2, pa3);
                      VWT(0, fb); pv_mm(o[3], fb, pa0, pa1, pa2, pa3);
}
#undef VWT
__device__ __forceinline__ void attn_body(const u16* __restrict__ Qb, const u16* __restrict__ Kh, const u16* __restrict__ Vh, u16* __restrict__ Ob, int ldo, int seq, char* lds, LAS unsigned char* ldsl, int wv) {
    const int tid = tid_opaque(wv), wid = wv, lane = tid & 63, r32 = lane & 31, hi = lane >> 5;
    char* V_lds = lds; char* K_lds = lds + NBUF * SHM_V;
    float* ws = (float*)(lds + NBUF * SHM_V + NBUF * SHM_K) + wid * 64; float* li_l = ws; float* al_l = ws + 32;
    float m_reg = -1e30f, l_reg = 0; f32x16 o[4] = {}; bf16x8 qr[12];
    const u16* Qw = Qb + (long)(wid * QBLK + r32) * QKD + hi * 8;
#pragma unroll
    for (int d0 = 0; d0 < 12; ++d0) qr[d0] = *reinterpret_cast<const bf16x8*>(Qw + d0 * 16);
    unsigned kof[3], vof[2];
#pragma unroll
    for (int i = 0; i < 3; ++i) { const int p = (wid + 8 * i) * 64 + lane, row = p / 24, slot = p % 24; kof[i] = (unsigned)(row * 384 + ((slot * 16) ^ ((row & 7) << 4))); }
#pragma unroll
    for (int i = 0; i < 2; ++i) { const int ob = (wid + 8 * i) * 1024 + lane * 16, sub = ob >> 9, within = (ob & 511) >> 1; const int kk = (sub >> 2) * 8 + (within >> 5);
        const int k = (kk & ~0xC) | ((kk & 4) << 1) | ((kk & 8) >> 1), col = (sub & 3) * 32 + (within & 31); vof[i] = (unsigned)(k * 256 + col * 2); }
    const char* Kg = (const char*)Kh; const char* Vg = (const char*)Vh;
#define DMA(t, bK, bV) do { _Pragma("unroll") for (int i_ = 0; i_ < 3; ++i_) __builtin_amdgcn_global_load_lds((const unsigned*)(Kg + (size_t)(t) * (KVBLK * 384) + kof[i_]), (LAS unsigned*)(ldsl + NBUF * SHM_V + (bK) + (wid + 8 * i_) * 1024), 16, 0, 0); \
    _Pragma("unroll") for (int i_ = 0; i_ < 2; ++i_) __builtin_amdgcn_global_load_lds((const unsigned*)(Vg + (size_t)(t) * (KVBLK * 256) + vof[i_]), (LAS unsigned*)(ldsl + (bV) + (wid + 8 * i_) * 1024), 16, 0, 0); } while (0)
    const int vb0 = (int)(uintptr_t)V_lds + v_rd_base(lane);
    const int kx = (r32 & 7) << 4, kl = (int)(uintptr_t)K_lds + r32 * 384;
    const int kbs0 = kl + ((0 * 32 + hi * 16) ^ kx), kbs1 = kl + ((1 * 32 + hi * 16) ^ kx), kbs2 = kl + ((2 * 32 + hi * 16) ^ kx), kbs3 = kl + ((3 * 32 + hi * 16) ^ kx);
#define RESC(a) do { if (__any((a) < 1.f)) { if (hi == 0) al_l[r32] = (a); asm volatile("s_waitcnt lgkmcnt(0)" ::: "memory"); \
    _Pragma("unroll") for (int d = 0; d < 4; ++d) _Pragma("unroll") for (int r = 0; r < 16; ++r) o[d][r] *= al_l[crow(r, hi)]; } } while (0)
    f32x16 p0, p1; float mn, al; bf16x8 pa0, pa1, pa2, pa3; const int NT = seq / KVBLK;
    int b0 = 0, b1 = 1, b2 = 2;
    DMA(0, 0, 0); DMA(1, SHM_K, SHM_V);
    asm volatile("s_waitcnt vmcnt(5)" ::: "memory"); __builtin_amdgcn_s_barrier(); asm volatile("" ::: "memory");
    for (int j = 0; j < NT; ++j) {
        if (j + 2 < NT) DMA(j + 2, b2 * SHM_K, b2 * SHM_V);
        SBAR(); qkt(p0, p1, kbs0 + b0 * SHM_K, kbs1 + b0 * SHM_K, kbs2 + b0 * SHM_K, kbs3 + b0 * SHM_K, qr);
        partialSM(p0, p1, m_reg, mn, al); RESC(al);
        finishSM(p0, p1, al, l_reg, pa0, pa1, pa2, pa3); SBAR();
        pv_d0(o, vb0 + b0 * SHM_V, pa0, pa1, pa2, pa3);
        if (j + 2 < NT) asm volatile("s_waitcnt vmcnt(5)" ::: "memory"); else asm volatile("s_waitcnt vmcnt(0)" ::: "memory");
        asm volatile("s_waitcnt lgkmcnt(0)" ::: "memory"); __builtin_amdgcn_s_barrier(); asm volatile("" ::: "memory");
        { const int t_ = b0; b0 = b1; b1 = b2; b2 = t_; }
    }
    if (hi == 0) li_l[r32] = l_reg; asm volatile("s_waitcnt lgkmcnt(0)" ::: "memory");
    float rli[16];
#pragma unroll
    for (int r = 0; r < 16; ++r) rli[r] = __builtin_amdgcn_rcpf(li_l[crow(r, hi)]);
    u16* Ow = Ob + (long)(wid * QBLK) * ldo;
#pragma unroll
    for (int r = 0; r < 16; ++r) { const int orow = crow(r, hi);
#pragma unroll
        for (int d0 = 0; d0 < 4; ++d0) Ow[(long)orow * ldo + d0 * 32 + r32] = f2bf(o[d0][r] * rli[r]); }
#undef DMA
#undef RESC
}
#undef KSWZ
#undef SBAR
}
struct NormDst { float* X; u16* HX; u16* UH; unsigned* cnt; int* list; unsigned char* seli; unsigned char* selw; const float* xin; const float* cin; };
__device__ __forceinline__ NormDst norm_dst_real(unsigned char* ws, int li) {
    NormDst d; d.X = (float*)(ws + WS_X); d.HX = (u16*)(ws + WS_HX); d.UH = (u16*)(ws + WS_R1 + R1_UH); d.cnt = (unsigned*)(ws + WS_CTL) + CW_CNT + li * 32 * CS; d.list = (int*)(ws + WS_LIST); d.seli = ws + WS_SELI; d.selw = ws + WS_SELW; d.xin = nullptr; d.cin = nullptr; return d; }
__device__ __forceinline__ NormDst norm_dst_dummy(unsigned char* ws) {
    NormDst d; unsigned char* t = ws + WS_NTMP; d.X = (float*)t; d.HX = (u16*)(t + (size_t)T * D * 4); d.UH = d.HX; d.cnt = (unsigned*)(ws + WS_CTL) + CW_CNT_DUMMY; d.list = (int*)(t + (size_t)T * D * 4 + (size_t)64 * 2304 * 512 * 2);
    d.seli = (unsigned char*)(d.list + (size_t)64 * T); d.selw = d.seli + (size_t)T * 16; d.xin = nullptr; d.cin = nullptr; return d; }
__device__ __forceinline__ float wave_sum_dpp(float v) {
    v += __int_as_float(__builtin_amdgcn_update_dpp(0, __float_as_int(v), 0x111, 0xF, 0xF, true));
    v += __int_as_float(__builtin_amdgcn_update_dpp(0, __float_as_int(v), 0x112, 0xF, 0xF, true));
    v += __int_as_float(__builtin_amdgcn_update_dpp(0, __float_as_int(v), 0x114, 0xF, 0xF, true));
    v += __int_as_float(__builtin_amdgcn_update_dpp(0, __float_as_int(v), 0x118, 0xF, 0xF, true));
    v += __int_as_float(__builtin_amdgcn_update_dpp(0, __float_as_int(v), 0x142, 0xA, 0xF, false));
    v += __int_as_float(__builtin_amdgcn_update_dpp(0, __float_as_int(v), 0x143, 0xC, 0xF, false));
    return __int_as_float(__builtin_amdgcn_readlane(__float_as_int(v), 63));
}
__device__ __forceinline__ float bperm(float v, int srclane) { return __int_as_float(__builtin_amdgcn_ds_bpermute(srclane << 2, __float_as_int(v))); }
template <int MODE>
__device__ __forceinline__ void norm2_rows(unsigned char* ws, float* outp, const NormDst d, int li, int which, int* s_base, char* lds, int wv) {
    const float* sm = (const float*)(ws + WS_SMALL);
    const int tidn = tid_opaque(wv); const int lane = tidn & 63, wave = wv;
    const float* X = (const float*)(ws + WS_X);
    const float* mod = (const float*)(ws + WS_MOD);
    float* WG = (float*)lds;
    u16* WE = (u16*)(lds + 16384);
    __syncthreads();
    if (MODE & 1) { if (tidn == 0) { const unsigned* cnt = (const unsigned*)(ws + WS_CTL) + CW_CNT + (li - 1) * 32 * CS; int a = 0; for (int e = 0; e < 32; ++e) { s_base[e] = a; a += (int)((cnt[e * CS] + 255u) / 256u); } s_base[32] = a; } }
    if (MODE & 8) {
        const float* wg = sm + SM_WGROUP + (size_t)li * 4096; const float* we = sm + SM_WEXP + (size_t)li * 32768;
#pragma unroll 2
        for (int k = tidn; k < 1024; k += 512) { const int pk = ((k >> 8) * 4 + (k & 3)) * 64 + ((k >> 2) & 63); *(float4*)(WG + 4 * pk) = *(const float4*)(wg + 4 * k); }
#pragma unroll 8
        for (int i = tidn; i < 4096; i += 512) { const int g = i >> 10, k = i & 1023; const int pk = ((k >> 8) * 4 + (k & 3)) * 64 + ((k >> 2) & 63);
            const float4 v0 = *(const float4*)(we + (size_t)i * 8), v1 = *(const float4*)(we + (size_t)i * 8 + 4);
            u32x4 w; w.x = g8::cvt_pk_bf16(v0.x, v0.y); w.y = g8::cvt_pk_bf16(v0.z, v0.w); w.z = g8::cvt_pk_bf16(v1.x, v1.y); w.w = g8::cvt_pk_bf16(v1.z, v1.w);
            *(u32x4*)(WE + ((size_t)g * 1024 + pk) * 8) = w; }
    }
    __syncthreads();
    const bool lastl = (li == 3);
    const int rstride = gridDim.x * 8; const u16* YB = (const u16*)(ws + WS_YB); const u16* DL = (const u16*)(ws + WS_HX);
    float4 vA[4], vB[4]; int4 siA = make_int4(0, 0, 0, 0), siB = siA; float2 swA = make_float2(0.f, 0.f), swB = swA; uint2 dlA[4], dlB[4], yaB[4], ybB[4];
#define NR_LOAD_A(rw) do { if ((rw) < T) { const float* xs_ = X + (size_t)(rw) * D; if (MODE & 64) { const int b_ = (rw) / LTOT, p_ = (rw) % LTOT; xs_ = p_ < CTXL ? d.cin + ((size_t)b_ * CTXL + p_) * D : d.xin + ((size_t)b_ * SEQ + (p_ - CTXL)) * D; } \
        _Pragma("unroll") for (int q = 0; q < 4; ++q) vA[q] = *(const float4*)(xs_ + q * 256 + lane * 4); \
        if (MODE & 1) { siA = *(const int4*)(ws + WS_SELI + (size_t)(rw) * 16); swA = *(const float2*)(ws + WS_SELW + (size_t)(rw) * 8); } \
        if (MODE & 32) { _Pragma("unroll") for (int q = 0; q < 4; ++q) dlA[q] = *(const uint2*)(DL + (size_t)(rw) * D + q * 256 + lane * 4); } } } while (0)
#define NR_A_TO_B(rw) do { _Pragma("unroll") for (int q = 0; q < 4; ++q) { vB[q] = vA[q]; dlB[q] = dlA[q]; } siB = siA; swB = swA; \
        if ((MODE & 1) && (rw) < T && !((li - 1 == 3) && ((rw) % LTOT) < CTXL)) { const size_t g1 = (size_t)s_base[siB.x] * 256 + siB.y, g2 = (size_t)s_base[siB.z] * 256 + siB.w; \
            _Pragma("unroll") for (int q = 0; q < 4; ++q) { yaB[q] = *(const uint2*)(YB + g1 * 1024 + q * 256 + lane * 4); ybB[q] = *(const uint2*)(YB + g2 * 1024 + q * 256 + lane * 4); } } } while (0)
    const int row0 = blockIdx.x * 8 + wave;
    NR_LOAD_A(row0); NR_A_TO_B(row0); NR_LOAD_A(row0 + rstride);
    int rec_e1 = 0, rec_e2 = 0, rec_row = -1; float rec_w1 = 0.f, rec_w2 = 0.f; int it = -1;
    for (int row = row0; row < T; row += rstride) {
        ++it;
        const int b = row / LTOT, pos = row % LTOT; const bool isctx = pos < CTXL; const int r = isctx ? 16 : b;
        float4 v[4]; uint2 ya[4], yb[4], dl[4]; const float2 sw = swB;
#pragma unroll
        for (int q = 0; q < 4; ++q) { v[q] = vB[q]; ya[q] = yaB[q]; yb[q] = ybB[q]; dl[q] = dlB[q]; }
        NR_A_TO_B(row + rstride); NR_LOAD_A(row + 2 * rstride);
        if ((MODE & 16) && isctx) continue;
        if ((MODE & 8) && lastl && isctx) continue;
        if (MODE & 1) {
            const bool skip = (li - 1 == 3) && isctx;
            if (!skip) {
                const float* gate = mod + (size_t)((li - 1) * 17 + r) * 6144 + 5 * 1024;
#pragma unroll
                for (int q = 0; q < 4; ++q) { const int c = q * 256 + lane * 4; const float4 gg = *(const float4*)(gate + c);
                    v[q].x += gg.x * (sw.x * bf2f((u16)(ya[q].x & 0xffff)) + sw.y * bf2f((u16)(yb[q].x & 0xffff)));
                    v[q].y += gg.y * (sw.x * bf2f((u16)(ya[q].x >> 16)) + sw.y * bf2f((u16)(yb[q].x >> 16)));
                    v[q].z += gg.z * (sw.x * bf2f((u16)(ya[q].y & 0xffff)) + sw.y * bf2f((u16)(yb[q].y & 0xffff)));
                    v[q].w += gg.w * (sw.x * bf2f((u16)(ya[q].y >> 16)) + sw.y * bf2f((u16)(yb[q].y >> 16)));
                    if (!(MODE & 16)) *(float4*)(d.X + (size_t)row * D + c) = v[q]; }
            }
        }
        if (MODE & 32) {
#pragma unroll
            for (int q = 0; q < 4; ++q) { const int c = q * 256 + lane * 4;
                v[q].x += bf2f((u16)(dl[q].x & 0xffff)); v[q].y += bf2f((u16)(dl[q].x >> 16)); v[q].z += bf2f((u16)(dl[q].y & 0xffff)); v[q].w += bf2f((u16)(dl[q].y >> 16));
                *(float4*)(d.X + (size_t)row * D + c) = v[q]; }
        }
        float ss = 0.f;
#pragma unroll
        for (int q = 0; q < 4; ++q) ss += v[q].x * v[q].x + v[q].y * v[q].y + v[q].z * v[q].z + v[q].w * v[q].w;
        ss = wave_sum_dpp(ss);
        const float rstd = rsqrtf(ss * (1.f / 1024.f) + EPS);
        if (MODE & 16) {
            float* out = outp + ((size_t)b * SEQ + (pos - CTXL)) * D;
#pragma unroll
            for (int q = 0; q < 4; ++q) { const int c = q * 256 + lane * 4; const float4 g = *(const float4*)(sm + SM_FINALG + c);
                *(float4*)(out + c) = make_float4(v[q].x * rstd * g.x, v[q].y * rstd * g.y, v[q].z * rstd * g.z, v[q].w * rstd * g.w); }
            continue;
        }
        const float* gv = sm + (which ? SM_GFFN : SM_GMIX) + li * 1024;
        const float* sh = mod + (size_t)(li * 17 + r) * 6144 + (which ? 3 : 0) * 1024; const float* scl = sh + 1024;
        float h[16];
#pragma unroll
        for (int q = 0; q < 4; ++q) { const int c = q * 256 + lane * 4; const float4 g = *(const float4*)(gv + c), s4 = *(const float4*)(sh + c), c4 = *(const float4*)(scl + c);
            h[q * 4 + 0] = v[q].x * rstd * g.x * (1.f + c4.x) + s4.x; h[q * 4 + 1] = v[q].y * rstd * g.y * (1.f + c4.y) + s4.y;
            h[q * 4 + 2] = v[q].z * rstd * g.z * (1.f + c4.z) + s4.z; h[q * 4 + 3] = v[q].w * rstd * g.w * (1.f + c4.w) + s4.w; }
        if (MODE & 2) {
#pragma unroll
            for (int q = 0; q < 4; ++q) { uint2 w; w.x = g8::cvt_pk_bf16(h[q * 4], h[q * 4 + 1]); w.y = g8::cvt_pk_bf16(h[q * 4 + 2], h[q * 4 + 3]);
                *(uint2*)(d.HX + (size_t)row * D + q * 256 + lane * 4) = w; }
        }
        if (MODE & 4) {
#pragma unroll
            for (int q = 0; q < 4; ++q) { const int c = q * 256 + lane * 4; const int g = c >> 4, ch = c & 15;
                uint2 w; w.x = g8::cvt_pk_bf16(h[q * 4], h[q * 4 + 1]); w.y = g8::cvt_pk_bf16(h[q * 4 + 2], h[q * 4 + 3]);
                *(uint2*)(d.UH + ((size_t)g * 2304 + b * 144 + (pos >> 4)) * 512 + (pos & 15) * 16 + ch) = w; }
        }
        if (MODE & 8) {
            float lg[4] = {0.f, 0.f, 0.f, 0.f};
#pragma unroll
            for (int q = 0; q < 4; ++q)
#pragma unroll
                for (int j = 0; j < 4; ++j) { const float4 w = *(const float4*)(WG + ((q * 4 + j) * 64 + lane) * 4); const float hv = h[q * 4 + j];
                    lg[0] += hv * w.x; lg[1] += hv * w.y; lg[2] += hv * w.z; lg[3] += hv * w.w; }
#pragma unroll
            for (int g = 0; g < 4; ++g) lg[g] = wave_sum_dpp(lg[g]);
#pragma unroll
            for (int g = 0; g < 4; ++g) lg[g] += sm[SM_BGROUP + li * 4 + g];
            int gi = 0; float best = lg[0];
#pragma unroll
            for (int g = 1; g < 4; ++g) if (lg[g] > best) { best = lg[g]; gi = g; }
            float den = 0.f;
#pragma unroll
            for (int g = 0; g < 4; ++g) den += __expf(lg[g] - best);
            const float pg = 1.f / den;
            const u16* wes = WE + (size_t)gi * 8192;
            float le[8];
#pragma unroll
            for (int e = 0; e < 8; ++e) le[e] = 0.f;
#pragma unroll
            for (int q = 0; q < 4; ++q)
#pragma unroll
                for (int j = 0; j < 4; ++j) { const u32x4 w = *(const u32x4*)(wes + ((q * 4 + j) * 64 + lane) * 8); const float hv = h[q * 4 + j];
                    le[0] += hv * __uint_as_float(w.x << 16); le[1] += hv * __uint_as_float(w.x & 0xffff0000u); le[2] += hv * __uint_as_float(w.y << 16); le[3] += hv * __uint_as_float(w.y & 0xffff0000u);
                    le[4] += hv * __uint_as_float(w.z << 16); le[5] += hv * __uint_as_float(w.z & 0xffff0000u); le[6] += hv * __uint_as_float(w.w << 16); le[7] += hv * __uint_as_float(w.w & 0xffff0000u); }
#pragma unroll
            for (int e = 0; e < 8; ++e) le[e] = wave_sum_dpp(le[e]);
#pragma unroll
            for (int e = 0; e < 8; ++e) le[e] += sm[SM_BEXP + (li * 4 + gi) * 8 + e];
            int i1 = 0; float b1 = le[0];
#pragma unroll
            for (int e = 1; e < 8; ++e) if (le[e] > b1) { b1 = le[e]; i1 = e; }
            int i2 = -1; float b2 = -3.0e38f;
#pragma unroll
            for (int e = 0; e < 8; ++e) if (e != i1 && le[e] > b2) { b2 = le[e]; i2 = e; }
            { const float ex = __expf(b2 - b1); const float w1 = 1.f / (1.f + ex), w2 = ex / (1.f + ex);
              if (lane == it) { rec_e1 = gi * 8 + i1; rec_e2 = gi * 8 + i2; rec_w1 = pg * w1; rec_w2 = pg * w2; rec_row = row; } }
        }
    }
    if (MODE & 8) {
        if (rec_row >= 0) {
            const int s1 = (int)atomicAdd(&d.cnt[rec_e1 * CS], 1u), s2 = (int)atomicAdd(&d.cnt[rec_e2 * CS], 1u);
            d.list[(size_t)rec_e1 * T + s1] = rec_row; d.list[(size_t)rec_e2 * T + s2] = rec_row;
            *(int4*)(d.seli + (size_t)rec_row * 16) = make_int4(rec_e1, s1, rec_e2, s2);
            *(float2*)(d.selw + (size_t)rec_row * 8) = make_float2(rec_w1, rec_w2);
        }
    }
#undef NR_LOAD_A
#undef NR_A_TO_B
}
#define XB_TMO      128
#define XB_XCNT(j)  (256  + 64 * (j))
#define XB_XSUB(j)  (1280 + 64 * (j))
#define XB_XGEN(j)  (2304 + 64 * (j))
#define XB_TOP      3328
#define XB_TOPGEN   3392
#define XCD_BAR_WORDS 3456
#define XB_SPIN_CAP (1u << 18)
__device__ __forceinline__ unsigned xb_ld(unsigned* p)              { return __hip_atomic_load(p, __ATOMIC_RELAXED, __HIP_MEMORY_SCOPE_AGENT); }
__device__ __forceinline__ unsigned xb_add(unsigned* p, unsigned v) { return __hip_atomic_fetch_add(p, v, __ATOMIC_RELAXED, __HIP_MEMORY_SCOPE_AGENT); }
__device__ __forceinline__ unsigned xb_xcc_id() { return (unsigned)__builtin_amdgcn_s_getreg((3 << 11) | 20) & 0xFu; }
#define XB_SPIN(cond, bar) do { unsigned _sp = 0; while (cond) { __builtin_amdgcn_s_sleep(1); \
    if ((++_sp & 255u) == 0u) { if (xb_ld(&(bar)[XB_TMO])) break; if (_sp > XB_SPIN_CAP) { atomicAdd(&(bar)[XB_TMO], 1u); break; } } } } while (0)
struct XcdBarrier { unsigned* bar; unsigned x; volatile LAS unsigned* st; };
__device__ __forceinline__ XcdBarrier xcd_barrier_post(unsigned* bar, volatile LAS unsigned* st) {
    XcdBarrier b; b.bar = bar; b.x = xb_xcc_id(); b.st = st;
    if (threadIdx.x == 0) (void)xb_add(&bar[XB_XCNT(b.x)], 1u);
    return b;
}
__device__ __forceinline__ void xcd_barrier_complete(unsigned* bar, unsigned x, unsigned& nloc, unsigned& nx) {
    const unsigned G = gridDim.x * gridDim.y * gridDim.z;
    unsigned sum, cnt, mine, sp = 0u;
    for (;;) {
        sum = 0u; cnt = 0u; mine = 0u;
#pragma unroll
        for (unsigned j = 0; j < 16; ++j) { const unsigned c = xb_ld(&bar[XB_XCNT(j)]); sum += c; cnt += (c > 0u) ? 1u : 0u; mine = (j == x) ? c : mine; }
        if (sum == G) break;
        __builtin_amdgcn_s_sleep(1);
        if ((++sp & 255u) == 0u) { if (xb_ld(&bar[XB_TMO])) break; if (sp > XB_SPIN_CAP) { atomicAdd(&bar[XB_TMO], 1u); break; } }
    }
    nloc = mine > 0u ? mine : 1u; nx = cnt > 0u ? cnt : 1u;
}
__device__ __forceinline__ void xcd_barrier(const XcdBarrier& b, const int tid) {
    asm volatile("s_waitcnt vmcnt(0)" ::: "memory");
    __syncthreads();
    if (tid == 0) {
        unsigned* bar = b.bar;
        __builtin_amdgcn_s_waitcnt(0);
        unsigned nloc = b.st[0], nx = b.st[1];
        if (nloc == 0u) { xcd_barrier_complete(bar, b.x, nloc, nx); b.st[0] = nloc; b.st[1] = nx; }
        const unsigned old = xb_add(&bar[XB_XSUB(b.x)], 1u);
        const unsigned gen = old / nloc;
        if (old + 1u == (gen + 1u) * nloc) {
            __builtin_amdgcn_fence(__ATOMIC_RELEASE, "agent");
            asm volatile("s_waitcnt vmcnt(0)" ::: "memory");
            const unsigned og = xb_add(&bar[XB_TOP], 1u);
            const unsigned tg = og / nx;
            if (og + 1u == (tg + 1u) * nx) xb_add(&bar[XB_TOPGEN], 1u);
            else XB_SPIN(xb_ld(&bar[XB_TOPGEN]) == tg, bar);
            __builtin_amdgcn_fence(__ATOMIC_ACQUIRE, "agent");
            xb_add(&bar[XB_XGEN(b.x)], 1u);
            asm volatile("s_waitcnt vmcnt(0)" ::: "memory");
        } else {
            XB_SPIN(xb_ld(&bar[XB_XGEN(b.x)]) == gen, bar);
            __builtin_amdgcn_fence(__ATOMIC_ACQUIRE, "agent");
            asm volatile("s_waitcnt vmcnt(0)" ::: "memory");
        }
    }
    __syncthreads();
}

struct CvtSeg { int in_idx, nmat, K, N, NP, map; size_t dst_off; int g_idx; };
__device__ __forceinline__ void cvt_tile(const float* __restrict__ src, u16* __restrict__ dst, int K, int N, int NP, int map, int t, LAS unsigned* slab, int lane, const float* __restrict__ gvec) {
    const int kt_n = K / 64, nt_n = N / 64, per = kt_n * nt_n;
    const int mat = t / per, rem = t % per, nt = rem / kt_n, kt = rem % kt_n;
    const float* s = src + ((size_t)mat * K + (size_t)kt * 64) * N + nt * 64 + lane;
    float v[64];
#pragma unroll
    for (int k = 0; k < 64; ++k) v[k] = s[(size_t)k * N];
    if (gvec) { const float* gk = gvec + (size_t)mat * K + kt * 64;
#pragma unroll
        for (int k = 0; k < 64; ++k) v[k] *= gk[k]; }
#pragma unroll
    for (int q = 0; q < 8; ++q) { u32x4 w; w.x = g8::cvt_pk_bf16(v[q * 8], v[q * 8 + 1]); w.y = g8::cvt_pk_bf16(v[q * 8 + 2], v[q * 8 + 3]); w.z = g8::cvt_pk_bf16(v[q * 8 + 4], v[q * 8 + 5]); w.w = g8::cvt_pk_bf16(v[q * 8 + 6], v[q * 8 + 7]);
        *(LAS u32x4*)(slab + lane * 36 + q * 4) = w; }
#pragma unroll
    for (int i = 0; i < 8; ++i) { const int rl = i * 8 + (lane >> 3); const u32x4 w = *(const LAS u32x4*)(slab + rl * 36 + (lane & 7) * 4);
        const int n = nt * 64 + rl; int np = n;
        if (map) { const int half = N / 2; const int which = n >= half ? 1 : 0; const int j = n - which * half; np = (j / 128) * 256 + which * 128 + (j % 128); }
        *(u32x4*)(dst + ((size_t)mat * NP + np) * K + kt * 64 + (lane & 7) * 8) = w; }
}
__device__ __forceinline__ void mod_task(const Ptrs& P, char* lds, int task) {
    float* sc = (float*)lds;
    float* mod = (float*)(P.ws + WS_MOD);
    const int tid = threadIdx.x, cq = tid & 63, kg = tid >> 6;
    __syncthreads();
    for (int idx = tid; idx < 17 * 1024; idx += 512) { const int r = idx >> 10, kk = idx & 1023; const float v = r < 16 ? P.in[1][r * 1024 + kk] : P.in[3][kk]; sc[idx] = silu_f(v); }
    __syncthreads();
    const int i = task / 24, cc = task % 24; const int col = cc * 256 + cq * 4;
    const float* W = P.in[4] + ((size_t)i * 1024 + kg * 128) * 6144 + col;
    f32x4 acc[17];
#pragma unroll
    for (int r = 0; r < 17; ++r) acc[r] = (f32x4){0.f, 0.f, 0.f, 0.f};
#pragma unroll 8
    for (int kk = 0; kk < 128; ++kk) { const f32x4 w = *(const f32x4*)(W + (size_t)kk * 6144);
#pragma unroll
        for (int r = 0; r < 17; ++r) acc[r] += w * sc[r * 1024 + kg * 128 + kk]; }
    float* red2 = sc;
    __syncthreads();
#pragma unroll
    for (int pass = 0; pass < 2; ++pass) {
#pragma unroll
        for (int r = 0; r < 9; ++r) if (pass * 9 + r < 17) *(f32x4*)(red2 + ((kg * 9 + r) * 256 + cq * 4)) = acc[pass * 9 + r < 17 ? pass * 9 + r : 0];
        __syncthreads();
        for (int idx = tid; idx < 9 * 256; idx += 512) { const int rr = idx >> 8, c = idx & 255, r = pass * 9 + rr;
            if (r < 17) { float s = P.in[5][i * 6144 + cc * 256 + c];
#pragma unroll
                for (int g = 0; g < 8; ++g) s += red2[(g * 9 + rr) * 256 + c];
                mod[(size_t)(i * 17 + r) * 6144 + cc * 256 + c] = s; } }
        __syncthreads();
    }
}
__device__ __forceinline__ void s5_prep(const Ptrs& P, int j, int g, char* lds) {
    float2* Apow = (float2*)lds;
    float2* Bb = Apow + 2 * 64 * 17;
    float2* Cc = Bb + 2 * 64 * 16;
    float* Kt = (float*)(Cc + 2 * 16 * 64);
    const int tid = threadIdx.x;
    __syncthreads();
    if (tid < 128) { const int dir = tid >> 6, p = tid & 63; const size_t gd = ((size_t)j * 2 + dir) * SG + g;
        const float dt = __expf(P.in[10][gd]); const float ar = P.in[8][gd * SP + p], ai = P.in[9][gd * SP + p]; const float ldr = ar * dt, ldi = ai * dt;
        for (int tau = 0; tau <= 16; ++tau) { const float mag = __expf(ldr * (float)tau), ang = ldi * (float)tau; Apow[(dir * 64 + p) * 17 + tau] = make_float2(mag * __cosf(ang), mag * __sinf(ang)); }
        const float2 ab = Apow[(dir * 64 + p) * 17 + 1]; const float nr = ab.x - 1.f, ni = ab.y, den = ar * ar + ai * ai; const float qr = (nr * ar + ni * ai) / den, qi = (ni * ar - nr * ai) / den;
        for (int c = 0; c < 16; ++c) { const float br = P.in[11][(gd * SP + p) * SC + c], bi = P.in[12][(gd * SP + p) * SC + c]; Bb[(dir * 64 + p) * 16 + c] = make_float2(qr * br - qi * bi, qr * bi + qi * br); }
        ((float2*)(P.ws + WS_WB + WB_AT))[gd * SP + p] = Apow[(dir * 64 + p) * 17 + 16];
    }
    for (int i = tid; i < 2 * 16 * 64; i += 512) { const int d2 = i >> 10, c = (i >> 6) & 15, pp = i & 63; const size_t o = ((((size_t)j * 2 + d2) * SG + g) * SC + c) * SP + pp; Cc[i] = make_float2(P.in[13][o], P.in[14][o]); }
    __syncthreads();
    for (int idx = tid; idx < 8192; idx += 512) { const int dir = idx >> 12, tau = (idx >> 8) & 15, c = (idx >> 4) & 15, c2 = idx & 15; float s = 0.f;
        for (int p = 0; p < 64; ++p) { const float2 cc = Cc[(dir * 16 + c) * 64 + p], aa = Apow[(dir * 64 + p) * 17 + tau], bb = Bb[(dir * 64 + p) * 16 + c2];
            const float xr = aa.x * bb.x - aa.y * bb.y, xi = aa.x * bb.y + aa.y * bb.x; s += cc.x * xr - cc.y * xi; }
        Kt[idx] = s; }
    __syncthreads();
    u16* W1 = (u16*)(P.ws + WS_WB + WB_W1) + ((size_t)j * 64 + g) * 256 * 256; u16* W2 = (u16*)(P.ws + WS_WB + WB_W2) + ((size_t)j * 64 + g) * 256 * 512;
    for (int idx = tid; idx < 256 * 32; idx += 512) { const int row = idx >> 5, s8 = idx & 31; const int t = row >> 4, c = row & 15, s = s8 >> 1, cb = (s8 & 1) * 8;
        float v[8];
#pragma unroll
        for (int q = 0; q < 8; ++q) { const int c2 = cb + q;
            v[q] = s < t ? Kt[((0 * 16 + (t - s)) * 16 + c) * 16 + c2] : s > t ? Kt[((1 * 16 + (s - t)) * 16 + c) * 16 + c2] : Kt[((0 * 16 + 0) * 16 + c) * 16 + c2] + Kt[((1 * 16 + 0) * 16 + c) * 16 + c2]; }
        u32x4 w; w.x = g8::cvt_pk_bf16(v[0], v[1]); w.y = g8::cvt_pk_bf16(v[2], v[3]); w.z = g8::cvt_pk_bf16(v[4], v[5]); w.w = g8::cvt_pk_bf16(v[6], v[7]);
        *(u32x4*)(W2 + (size_t)row * 512 + s8 * 8) = w; }
    for (int idx = tid; idx < 256 * 128; idx += 512) { const int row = idx >> 7, dp = idx & 127; const int dir = dp >> 6, p = dp & 63, t = row >> 4, c = row & 15;
        const float2 cc = Cc[(dir * 16 + c) * 64 + p], aa = Apow[(dir * 64 + p) * 17 + (dir ? 16 - t : t + 1)];
        const float gr = cc.x * aa.x - cc.y * aa.y, gi = cc.x * aa.y + cc.y * aa.x;
        *(unsigned*)(W2 + (size_t)row * 512 + 256 + dir * 128 + 2 * p) = g8::cvt_pk_bf16(gr, -gi); }
    for (int idx = tid; idx < 256 * 32; idx += 512) { const int n = idx >> 5, s8 = idx & 31; const int dir = n >> 7, p = (n >> 1) & 63, ri = n & 1, s = s8 >> 1, cb = (s8 & 1) * 8;
        const float2 aa = Apow[(dir * 64 + p) * 17 + (dir ? s : 15 - s)];
        float v[8];
#pragma unroll
        for (int q = 0; q < 8; ++q) { const float2 bb = Bb[(dir * 64 + p) * 16 + cb + q]; v[q] = ri ? aa.x * bb.y + aa.y * bb.x : aa.x * bb.x - aa.y * bb.y; }
        u32x4 w; w.x = g8::cvt_pk_bf16(v[0], v[1]); w.y = g8::cvt_pk_bf16(v[2], v[3]); w.z = g8::cvt_pk_bf16(v[4], v[5]); w.w = g8::cvt_pk_bf16(v[6], v[7]);
        *(u32x4*)(W1 + (size_t)n * 256 + s8 * 8) = w; }
    __syncthreads();
}
__device__ __forceinline__ void prologue_phase(const Ptrs& P, char* lds, const int parts) {
    if (parts & 1) {
        copy_small(P, blockIdx.x * 512 + threadIdx.x, gridDim.x * 512);
        float2* rope = (float2*)(P.ws + WS_ROPE);
        for (int i = blockIdx.x * 512 + threadIdx.x; i < 2048 * 32; i += gridDim.x * 512) { const int s = i >> 5, k = i & 31, f = k & 15; const float invf = exp2f(-(float)f * (13.287712379549449f / 16.f));
            const float ang = (float)(k < 16 ? (s >> 6) : (s & 63)) * invf; rope[i] = make_float2(__cosf(ang), __sinf(ang)); }
        unsigned char* wb = P.ws + WS_WB;
        for (int i = blockIdx.x * 512 + threadIdx.x; i < 2 * 64 * 1024 / 8; i += gridDim.x * 512) { const int mat = i / 8192, r = i % 8192; *(u32x4*)((u16*)(wb + WB_WIN) + ((size_t)mat * 768 + 704) * 1024 + (size_t)r * 8) = (u32x4){0u, 0u, 0u, 0u}; }
    }
    if (parts & 2) for (int task = blockIdx.x; task < 96; task += gridDim.x) mod_task(P, lds, task);
    if (parts & 4) for (int idx = (int)blockIdx.x - 96; idx >= 0 && idx < 128; idx += gridDim.x) s5_prep(P, idx >> 6, idx & 63, lds);
    if (parts & 24) {
        const CvtSeg seg[7] = { {16, 2, 1024, 2048, 2048, 1, WB_GLU, -1}, {17, 2, 1024, 704, 768, 0, WB_WIN, -1}, {20, 2, 384, 1536, 1536, 0, WB_UQ, 18}, {21, 2, 256, 2048, 2048, 0, WB_UKV, 19}, {22, 2, 1024, 1024, 1024, 0, WB_WO, -1},
                                {27, 128, 1024, 1024, 1024, 1, WB_GU, -1}, {28, 128, 512, 1024, 1024, 0, WB_DN, -1} };
        __syncthreads();
        const int lane = threadIdx.x & 63, wv = threadIdx.x >> 6;
        LAS unsigned* slab = (LAS unsigned*)((LAS unsigned char*)lds) + wv * (64 * 36);
        unsigned* qhead = (unsigned*)(P.ws + WS_CTL) + CW_QUEUE + ((parts >> 5) & 7) * 64;
        int tstart[8]; tstart[0] = 0;
#pragma unroll
        for (int s = 0; s < 7; ++s) tstart[s + 1] = tstart[s] + seg[s].nmat * (seg[s].K / 64) * (seg[s].N / 64);
        const int ntot = tstart[7], nchunk = (ntot + 7) / 8;
        for (;;) {
            unsigned c = 0; if (lane == 0) c = atomicAdd(qhead, 1u);
            c = (unsigned)__builtin_amdgcn_readfirstlane((int)c);
            if ((int)c >= nchunk) break;
            for (int t = (int)c * 8; t < (int)c * 8 + 8 && t < ntot; ++t) {
                int s = 0;
#pragma unroll
                for (int k = 1; k < 7; ++k) s = (t >= tstart[k]) ? k : s;
                int in_idx = 0, K = 0, N = 0, NP = 0, map = 0, t0 = 0, gi = -1; size_t doff = 0;
#pragma unroll
                for (int k = 0; k < 7; ++k) if (s == k) { in_idx = seg[k].in_idx; K = seg[k].K; N = seg[k].N; NP = seg[k].NP; map = seg[k].map; doff = seg[k].dst_off; t0 = tstart[k]; gi = seg[k].g_idx; }
                cvt_tile(P.in[in_idx], (u16*)(P.ws + WS_WB + doff), K, N, NP, map, t - t0, slab, lane, gi >= 0 ? P.in[gi] : nullptr);
            }
        }
        __syncthreads();
    }
}
__device__ __forceinline__ void s5_scan_phase(unsigned char* wsp, int j, int wv) {
    struct { unsigned char* ws; } P{wsp};
    const int tids = tid_opaque(wv); const int lane = tids & 63;
    const float* S = (const float*)(P.ws + WS_R1 + R1_S); u16* UH = (u16*)(P.ws + WS_R1 + R1_UH); const float2* AT = (const float2*)(P.ws + WS_WB + WB_AT);
    for (int task = blockIdx.x * 8 + (tids >> 6); task < 2048; task += gridDim.x * 8) {
        const int g = task >> 5, b = (task >> 1) & 15, dir = task & 1;
        const float2 a = AT[(((size_t)j * 2 + dir) * SG + g) * SP + lane];
        const float* sp = S + ((size_t)g * 2304 + b * 144) * 256 + dir * 128 + 2 * lane; u16* hp = UH + ((size_t)g * 2304 + b * 144) * 512 + 256 + dir * 128 + 2 * lane;
        float hr = 0.f, hi = 0.f;
        for (int s0 = 0; s0 < 144; s0 += 16) {
            float2 sv[16];
#pragma unroll
            for (int k = 0; k < 16; ++k) { const int st = s0 + k; const int n = dir ? (st < 16 ? 15 - st : 159 - st) : st; sv[k] = *(const float2*)(sp + (size_t)n * 256); }
#pragma unroll
            for (int k = 0; k < 16; ++k) { const int st = s0 + k; const int n = dir ? (st < 16 ? 15 - st : 159 - st) : st;
                *(unsigned*)(hp + (size_t)n * 512) = g8::cvt_pk_bf16(hr, hi);
                const float nr = a.x * hr - a.y * hi + sv[k].x, ni = a.x * hi + a.y * hr + sv[k].y; hr = nr; hi = ni; }
        }
    }
}
__device__ __forceinline__ void mla_post_rows(unsigned char* wsp, int j, const float* Pm, int stride, int nwaves_blk, int wv) {
    struct { unsigned char* ws; } P{wsp}; const float* sm = (const float*)(wsp + WS_SMALL);
    const int tidp = tid_opaque(wv); const int lane = tidp & 63, wave = tidp >> 6;
    u16* CQ = (u16*)(P.ws + WS_CQ); u16* CKV = (u16*)(P.ws + WS_CKV); u16* KT = (u16*)(P.ws + WS_R1 + R1_KT); const float2* rope = (const float2*)(P.ws + WS_ROPE);
    for (int row = blockIdx.x * nwaves_blk + wave; row < T; row += gridDim.x * nwaves_blk) {
        const float* t = Pm + (size_t)row * stride; const int b = row / LTOT, pos = row % LTOT;
        float q[6]; float ss = 0.f;
#pragma unroll
        for (int i = 0; i < 6; ++i) { q[i] = t[i * 64 + lane]; ss += q[i] * q[i]; }
        ss = wave_sum_l(ss, lane); float rstd = rsqrtf(ss * (1.f / 384.f) + EPS);
#pragma unroll
        for (int i = 0; i < 6; ++i) CQ[(size_t)row * QR + i * 64 + lane] = f2bf(q[i] * rstd * sm[SM_GQ + j * QR + i * 64 + lane]);
        float k[4]; ss = 0.f;
#pragma unroll
        for (int i = 0; i < 4; ++i) { k[i] = t[384 + i * 64 + lane]; ss += k[i] * k[i]; }
        ss = wave_sum_l(ss, lane); rstd = rsqrtf(ss * (1.f / 256.f) + EPS);
#pragma unroll
        for (int i = 0; i < 4; ++i) CKV[(size_t)row * KVR + i * 64 + lane] = f2bf(k[i] * rstd * sm[SM_GKV + j * KVR + i * 64 + lane]);
        float v = t[640 + lane];
        if (pos >= CTXL) { const float pv = t[640 + (lane ^ 16)]; const float2 cs = rope[(size_t)(pos - CTXL) * 32 + (lane >> 5) * 16 + (lane & 15)];
            v = (lane & 16) ? v * cs.x + pv * cs.y : v * cs.x - pv * cs.y; }
        const u16 kb = f2bf(v);
#pragma unroll
        for (int h = 0; h < NH; ++h) KT[(((size_t)b * NH + h) * LTOT + pos) * QKD + 128 + lane] = kb;
    }
}
__device__ __forceinline__ void attn_phase(unsigned char* wsp, bool ctx_out, char* lds, LAS unsigned char* ldsl, int wv) {
    struct { unsigned char* ws; } P{wsp};
    const u16* QT = (const u16*)(P.ws + WS_R1 + R1_QT); const u16* KT = (const u16*)(P.ws + WS_R1 + R1_KT); const u16* VT = (const u16*)(P.ws + WS_R1 + R1_VT); u16* O = (u16*)(P.ws + WS_ZO);
    const int nunits = ctx_out ? 1152 : 1024;
    for (int u = blockIdx.x; u < nunits; u += gridDim.x) {
        int bh, qt, seq;
        if (u < 1024) { const int xcd = u & 7, k = u >> 3; bh = xcd * 16 + (k >> 3); qt = 1 + (k & 7); seq = LTOT; } else { bh = u - 1024; qt = 0; seq = CTXL; }
        const int b = bh >> 3, h = bh & 7;
        at::attn_body(QT + ((size_t)bh * LTOT + qt * 256) * QKD, KT + (size_t)bh * LTOT * QKD, VT + (size_t)bh * LTOT * 128, O + ((size_t)b * LTOT + qt * 256) * D + h * 128, D, seq, lds, ldsl, wv);
    }
}
constexpr int LDS_MISC = g8::STAGE_BYTES;
constexpr int LDS_BYTES = g8::STAGE_BYTES + 1024;
constexpr int NPHASE = 42;
struct MkArgs { Ptrs P; int lo, hi, bar_region, pad; };
__device__ __forceinline__ int lo_opq(int v) { asm volatile("" : "+s"(v)); return v; }
__global__ void __launch_bounds__(512, 2) mk(MkArgs a) {
    extern __shared__ __attribute__((aligned(16))) unsigned char lds[];
    LAS unsigned char* ldsl = (LAS unsigned char*)lds;
    volatile LAS unsigned* misc = (volatile LAS unsigned*)(ldsl + LDS_MISC);
    int* sbase = (int*)(lds + LDS_MISC + 64);
    const int wv = __builtin_amdgcn_readfirstlane(threadIdx.x >> 6);
    if (threadIdx.x < 4) misc[threadIdx.x] = 0u;
    __syncthreads();
#if defined(MK_FULL)
    const bool use_bar = true;
#else
    const bool use_bar = (a.hi - a.lo) > 1;
#endif
    unsigned char* ws = a.P.ws; float* outp = a.P.out;
    XcdBarrier bar; bar.bar = (unsigned*)(ws + WS_CTL) + a.bar_region * XCD_BAR_WORDS; bar.x = 0; bar.st = misc;
    if (use_bar) bar = xcd_barrier_post((unsigned*)(ws + WS_CTL) + a.bar_region * XCD_BAR_WORDS, misc);
    const int lo = a.lo, hi = a.hi;
#if defined(MK_FULL)
#define IN(k) (true)
#else
#define IN(k) (lo_opq(lo) <= (k) && (k) < lo_opq(hi))
#endif
#ifndef REP_GROUP
#define REP_GROUP (-1)
#define REP_N 1
#endif
#define NDST(li, g) (((g) == REP_GROUP && rep_ + 1 < REP_N) ? norm_dst_dummy(ws) : norm_dst_real(ws, li))
#define REP(g) for (int rep_ = 0; rep_ < ((g) == REP_GROUP ? REP_N : 1); ++rep_)
#if defined(PROBE_A)
#define STAMP(s) do { if (blockIdx.x == 0 && tid_opaque(wv) == 0) ((unsigned long long*)(ws0 + WS_CTL))[CW_STAMP64 + (s)] = __builtin_amdgcn_s_memrealtime(); } while (0)
#else
#define STAMP(s) do { } while (0)
#endif
#define SEAM(k) do { if (IN((k) + 1)) xcd_barrier(bar, tid_opaque(wv)); STAMP((k) + 1); } while (0)
    unsigned char* const ws0 = ws;
    STAMP(0);
#ifndef PRO_PART
#define PRO_PART 31
#endif
    if (IN(0)) REP(0) { prologue_phase(a.P, (char*)lds, (rep_ + 1 < ((0) == REP_GROUP ? REP_N : 1)) ? (PRO_PART | ((rep_ + 1) << 5)) : 31); SEAM(0); }

    {
        constexpr int li = 0; constexpr int base = 1 + li * 10, j = li >> 1;
#define PH_BEGIN size_t zoff_ = 0; asm volatile("" : "+s"(zoff_)); unsigned char* ws = ws0 + zoff_; unsigned char* wb = ws + WS_WB; const float* sm = (const float*)(ws + WS_SMALL); float* X = (float*)(ws + WS_X); const float* mod = (const float*)(ws + WS_MOD); (void)wb; (void)sm; (void)X; (void)mod;
        if ((li & 1) == 0) {
            if (IN(base + 0)) REP(1) { PH_BEGIN NormDst nd = NDST(li, 1); if (li == 0) { nd.xin = a.P.in[0]; nd.cin = a.P.in[2]; norm2_rows<4 | 64>(ws, outp, nd, li, 0, sbase, (char*)lds, wv); } else norm2_rows<5>(ws, outp, nd, li, 0, sbase, (char*)lds, wv); SEAM(base + 0); }
            if (IN(base + 1)) REP(3) { PH_BEGIN SchedS5 S; S.init(ws + WS_R1 + R1_UH, wb + WB_W1 + (size_t)j * 64 * 256 * 256 * 2, 256); EpiS5a E{(float*)(ws + WS_R1 + R1_S)};
                g8::gemm_phase<EpiS5a, SchedS5>(ldsl, 256, S, E, wv); SEAM(base + 1); }
            if (IN(base + 2)) REP(3) { PH_BEGIN s5_scan_phase(ws, j, wv); SEAM(base + 2); }
            if (IN(base + 3)) REP(3) { PH_BEGIN SchedS5 S; S.init(ws + WS_R1 + R1_UH, wb + WB_W2 + (size_t)j * 64 * 256 * 512 * 2, 512); EpiS5b E{(u16*)(ws + WS_ZO), (const u16*)(ws + WS_R1 + R1_UH), sm + SM_S5D + j * 1024};
                g8::gemm_phase<EpiS5b, SchedS5>(ldsl, 512, S, E, wv); SEAM(base + 3); }
            if (IN(base + 4)) REP(4) { PH_BEGIN SchedDense S; S.init(ws + WS_ZO, 1024, wb + WB_GLU + (size_t)j * 2048 * 1024 * 2, T, 2048, 1024); EpiGlu E{(u16*)(ws + WS_HX), mod, li};
                g8::gemm_phase<EpiGlu, SchedDense>(ldsl, 1024, S, E, wv); SEAM(base + 4); }
        } else {
            if (IN(base + 0)) REP(1) { PH_BEGIN const NormDst nd = NDST(li, 1); norm2_rows<3>(ws, outp, nd, li, 0, sbase, (char*)lds, wv); SEAM(base + 0); }
            if (IN(base + 1)) REP(5) { PH_BEGIN SchedDense S; S.init(ws + WS_HX, 1024, wb + WB_WIN + (size_t)j * 768 * 1024 * 2, T, 768, 1024); EpiWin E{(u16*)(ws + WS_CQ), (u16*)(ws + WS_CKV), (u16*)(ws + WS_R1 + R1_KT), (float*)(ws + WS_PS), (const float2*)(ws + WS_ROPE)};
                g8::gemm_phase<EpiWin, SchedDense>(ldsl, 1024, S, E, wv); SEAM(base + 1); }
            if (IN(base + 3)) REP(5) { PH_BEGIN
                { SchedDense S; S.init(ws + WS_CQ, QR, wb + WB_UQ + (size_t)j * 1536 * 384 * 2, T, 1536, 384); EpiQ E{(u16*)(ws + WS_R1 + R1_QT), (const float2*)(ws + WS_ROPE), (const float*)(ws + WS_PS)};
                  g8::gemm_phase<EpiQ, SchedDense>(ldsl, 384, S, E, wv); }
                { SchedDense S; S.init(ws + WS_CKV, KVR, wb + WB_UKV + (size_t)j * 2048 * 256 * 2, T, 2048, 256); EpiKV E{(u16*)(ws + WS_R1 + R1_KT), (u16*)(ws + WS_R1 + R1_VT), (const float*)(ws + WS_PS)};
                  int kk_ = 256; asm volatile("" : "+s"(kk_)); g8::gemm_phase<EpiKV, SchedDense>(ldsl, kk_, S, E, wv); }
                SEAM(base + 3); }
            if (IN(base + 4)) REP(6) { PH_BEGIN attn_phase(ws, li != 3, (char*)lds, ldsl, wv); SEAM(base + 4); }
            if (IN(base + 5)) REP(10) { PH_BEGIN SchedDense S; S.init(ws + WS_ZO, 1024, wb + WB_WO + (size_t)j * 1024 * 1024 * 2, T, 1024, 1024); EpiWo E{(u16*)(ws + WS_HX), mod, li};
                g8::gemm_phase<EpiWo, SchedDense>(ldsl, 1024, S, E, wv); SEAM(base + 5); }
        }
        if (IN(base + 6)) REP(2) { PH_BEGIN NormDst nd = NDST(li, 2); if (li == 0) { nd.xin = a.P.in[0]; nd.cin = a.P.in[2]; norm2_rows<42 | 64>(ws, outp, nd, li, 1, sbase, (char*)lds, wv); } else norm2_rows<42>(ws, outp, nd, li, 1, sbase, (char*)lds, wv); SEAM(base + 6); }
        if (IN(base + 7) || IN(base + 8)) {
            const unsigned* cnt = (const unsigned*)(ws0 + WS_CTL) + CW_CNT + li * 32 * CS;
            __syncthreads();
            if (tid_opaque(wv) == 0) { int acc = 0; for (int e = 0; e < 32; ++e) { sbase[e] = acc; acc += (int)((cnt[e * CS] + 255u) / 256u); } sbase[32] = acc; }
            __syncthreads();
            if (IN(base + 7)) REP(7) { PH_BEGIN SchedMoe<true> S; S.init(ws + WS_HX, wb + WB_GU + (size_t)li * 32 * 1024 * 1024 * 2, 1024, sbase, cnt, (const int*)(ws + WS_LIST)); EpiMoe1 E{(u16*)(ws + WS_R1 + R1_ACT)};
                g8::gemm_phase<EpiMoe1, SchedMoe<true>>(ldsl, 1024, S, E, wv); SEAM(base + 7); }
            if (IN(base + 8)) REP(8) { PH_BEGIN SchedMoe<false> S; S.init(ws + WS_R1 + R1_ACT, wb + WB_DN + (size_t)li * 32 * 1024 * 512 * 2, 512, sbase, cnt, (const int*)(ws + WS_LIST)); EpiMoe2 E{(u16*)(ws + WS_YB)};
                g8::gemm_phase<EpiMoe2, SchedMoe<false>>(ldsl, 512, S, E, wv); SEAM(base + 8); }
        }
    }

    {
        constexpr int li = 1; constexpr int base = 1 + li * 10, j = li >> 1;
#define PH_BEGIN size_t zoff_ = 0; asm volatile("" : "+s"(zoff_)); unsigned char* ws = ws0 + zoff_; unsigned char* wb = ws + WS_WB; const float* sm = (const float*)(ws + WS_SMALL); float* X = (float*)(ws + WS_X); const float* mod = (const float*)(ws + WS_MOD); (void)wb; (void)sm; (void)X; (void)mod;
        if ((li & 1) == 0) {
            if (IN(base + 0)) REP(1) { PH_BEGIN NormDst nd = NDST(li, 1); if (li == 0) { nd.xin = a.P.in[0]; nd.cin = a.P.in[2]; norm2_rows<4 | 64>(ws, outp, nd, li, 0, sbase, (char*)lds, wv); } else norm2_rows<5>(ws, outp, nd, li, 0, sbase, (char*)lds, wv); SEAM(base + 0); }
            if (IN(base + 1)) REP(3) { PH_BEGIN SchedS5 S; S.init(ws + WS_R1 + R1_UH, wb + WB_W1 + (size_t)j * 64 * 256 * 256 * 2, 256); EpiS5a E{(float*)(ws + WS_R1 + R1_S)};
                g8::gemm_phase<EpiS5a, SchedS5>(ldsl, 256, S, E, wv); SEAM(base + 1); }
            if (IN(base + 2)) REP(3) { PH_BEGIN s5_scan_phase(ws, j, wv); SEAM(base + 2); }
            if (IN(base + 3)) REP(3) { PH_BEGIN SchedS5 S; S.init(ws + WS_R1 + R1_UH, wb + WB_W2 + (size_t)j * 64 * 256 * 512 * 2, 512); EpiS5b E{(u16*)(ws + WS_ZO), (const u16*)(ws + WS_R1 + R1_UH), sm + SM_S5D + j * 1024};
                g8::gemm_phase<EpiS5b, SchedS5>(ldsl, 512, S, E, wv); SEAM(base + 3); }
            if (IN(base + 4)) REP(4) { PH_BEGIN SchedDense S; S.init(ws + WS_ZO, 1024, wb + WB_GLU + (size_t)j * 2048 * 1024 * 2, T, 2048, 1024); EpiGlu E{(u16*)(ws + WS_HX), mod, li};
                g8::gemm_phase<EpiGlu, SchedDense>(ldsl, 1024, S, E, wv); SEAM(base + 4); }
        } else {
            if (IN(base + 0)) REP(1) { PH_BEGIN const NormDst nd = NDST(li, 1); norm2_rows<3>(ws, outp, nd, li, 0, sbase, (char*)lds, wv); SEAM(base + 0); }
            if (IN(base + 1)) REP(5) { PH_BEGIN SchedDense S; S.init(ws + WS_HX, 1024, wb + WB_WIN + (size_t)j * 768 * 1024 * 2, T, 768, 1024); EpiWin E{(u16*)(ws + WS_CQ), (u16*)(ws + WS_CKV), (u16*)(ws + WS_R1 + R1_KT), (float*)(ws + WS_PS), (const float2*)(ws + WS_ROPE)};
                g8::gemm_phase<EpiWin, SchedDense>(ldsl, 1024, S, E, wv); SEAM(base + 1); }
            if (IN(base + 3)) REP(5) { PH_BEGIN
                { SchedDense S; S.init(ws + WS_CQ, QR, wb + WB_UQ + (size_t)j * 1536 * 384 * 2, T, 1536, 384); EpiQ E{(u16*)(ws + WS_R1 + R1_QT), (const float2*)(ws + WS_ROPE), (const float*)(ws + WS_PS)};
                  g8::gemm_phase<EpiQ, SchedDense>(ldsl, 384, S, E, wv); }
                { SchedDense S; S.init(ws + WS_CKV, KVR, wb + WB_UKV + (size_t)j * 2048 * 256 * 2, T, 2048, 256); EpiKV E{(u16*)(ws + WS_R1 + R1_KT), (u16*)(ws + WS_R1 + R1_VT), (const float*)(ws + WS_PS)};
                  int kk_ = 256; asm volatile("" : "+s"(kk_)); g8::gemm_phase<EpiKV, SchedDense>(ldsl, kk_, S, E, wv); }
                SEAM(base + 3); }
            if (IN(base + 4)) REP(6) { PH_BEGIN attn_phase(ws, li != 3, (char*)lds, ldsl, wv); SEAM(base + 4); }
            if (IN(base + 5)) REP(10) { PH_BEGIN SchedDense S; S.init(ws + WS_ZO, 1024, wb + WB_WO + (size_t)j * 1024 * 1024 * 2, T, 1024, 1024); EpiWo E{(u16*)(ws + WS_HX), mod, li};
                g8::gemm_phase<EpiWo, SchedDense>(ldsl, 1024, S, E, wv); SEAM(base + 5); }
        }
        if (IN(base + 6)) REP(2) { PH_BEGIN NormDst nd = NDST(li, 2); if (li == 0) { nd.xin = a.P.in[0]; nd.cin = a.P.in[2]; norm2_rows<42 | 64>(ws, outp, nd, li, 1, sbase, (char*)lds, wv); } else norm2_rows<42>(ws, outp, nd, li, 1, sbase, (char*)lds, wv); SEAM(base + 6); }
        if (IN(base + 7) || IN(base + 8)) {
            const unsigned* cnt = (const unsigned*)(ws0 + WS_CTL) + CW_CNT + li * 32 * CS;
            __syncthreads();
            if (tid_opaque(wv) == 0) { int acc = 0; for (int e = 0; e < 32; ++e) { sbase[e] = acc; acc += (int)((cnt[e * CS] + 255u) / 256u); } sbase[32] = acc; }
            __syncthreads();
            if (IN(base + 7)) REP(7) { PH_BEGIN SchedMoe<true> S; S.init(ws + WS_HX, wb + WB_GU + (size_t)li * 32 * 1024 * 1024 * 2, 1024, sbase, cnt, (const int*)(ws + WS_LIST)); EpiMoe1 E{(u16*)(ws + WS_R1 + R1_ACT)};
                g8::gemm_phase<EpiMoe1, SchedMoe<true>>(ldsl, 1024, S, E, wv); SEAM(base + 7); }
            if (IN(base + 8)) REP(8) { PH_BEGIN SchedMoe<false> S; S.init(ws + WS_R1 + R1_ACT, wb + WB_DN + (size_t)li * 32 * 1024 * 512 * 2, 512, sbase, cnt, (const int*)(ws + WS_LIST)); EpiMoe2 E{(u16*)(ws + WS_YB)};
                g8::gemm_phase<EpiMoe2, SchedMoe<false>>(ldsl, 512, S, E, wv); SEAM(base + 8); }
        }
    }

    {
        constexpr int li = 2; constexpr int base = 1 + li * 10, j = li >> 1;
#define PH_BEGIN size_t zoff_ = 0; asm volatile("" : "+s"(zoff_)); unsigned char* ws = ws0 + zoff_; unsigned char* wb = ws + WS_WB; const float* sm = (const float*)(ws + WS_SMALL); float* X = (float*)(ws + WS_X); const float* mod = (const float*)(ws + WS_MOD); (void)wb; (void)sm; (void)X; (void)mod;
        if ((li & 1) == 0) {
            if (IN(base + 0)) REP(1) { PH_BEGIN NormDst nd = NDST(li, 1); if (li == 0) { nd.xin = a.P.in[0]; nd.cin = a.P.in[2]; norm2_rows<4 | 64>(ws, outp, nd, li, 0, sbase, (char*)lds, wv); } else norm2_rows<5>(ws, outp, nd, li, 0, sbase, (char*)lds, wv); SEAM(base + 0); }
            if (IN(base + 1)) REP(3) { PH_BEGIN SchedS5 S; S.init(ws + WS_R1 + R1_UH, wb + WB_W1 + (size_t)j * 64 * 256 * 256 * 2, 256); EpiS5a E{(float*)(ws + WS_R1 + R1_S)};
                g8::gemm_phase<EpiS5a, SchedS5>(ldsl, 256, S, E, wv); SEAM(base + 1); }
            if (IN(base + 2)) REP(3) { PH_BEGIN s5_scan_phase(ws, j, wv); SEAM(base + 2); }
            if (IN(base + 3)) REP(3) { PH_BEGIN SchedS5 S; S.init(ws + WS_R1 + R1_UH, wb + WB_W2 + (size_t)j * 64 * 256 * 512 * 2, 512); EpiS5b E{(u16*)(ws + WS_ZO), (const u16*)(ws + WS_R1 + R1_UH), sm + SM_S5D + j * 1024};
                g8::gemm_phase<EpiS5b, SchedS5>(ldsl, 512, S, E, wv); SEAM(base + 3); }
            if (IN(base + 4)) REP(4) { PH_BEGIN SchedDense S; S.init(ws + WS_ZO, 1024, wb + WB_GLU + (size_t)j * 2048 * 1024 * 2, T, 2048, 1024); EpiGlu E{(u16*)(ws + WS_HX), mod, li};
                g8::gemm_phase<EpiGlu, SchedDense>(ldsl, 1024, S, E, wv); SEAM(base + 4); }
        } else {
            if (IN(base + 0)) REP(1) { PH_BEGIN const NormDst nd = NDST(li, 1); norm2_rows<3>(ws, outp, nd, li, 0, sbase, (char*)lds, wv); SEAM(base + 0); }
            if (IN(base + 1)) REP(5) { PH_BEGIN SchedDense S; S.init(ws + WS_HX, 1024, wb + WB_WIN + (size_t)j * 768 * 1024 * 2, T, 768, 1024); EpiWin E{(u16*)(ws + WS_CQ), (u16*)(ws + WS_CKV), (u16*)(ws + WS_R1 + R1_KT), (float*)(ws + WS_PS), (const float2*)(ws + WS_ROPE)};
                g8::gemm_phase<EpiWin, SchedDense>(ldsl, 1024, S, E, wv); SEAM(base + 1); }
            if (IN(base + 3)) REP(5) { PH_BEGIN
                { SchedDense S; S.init(ws + WS_CQ, QR, wb + WB_UQ + (size_t)j * 1536 * 384 * 2, T, 1536, 384); EpiQ E{(u16*)(ws + WS_R1 + R1_QT), (const float2*)(ws + WS_ROPE), (const float*)(ws + WS_PS)};
                  g8::gemm_phase<EpiQ, SchedDense>(ldsl, 384, S, E, wv); }
                { SchedDense S; S.init(ws + WS_CKV, KVR, wb + WB_UKV + (size_t)j * 2048 * 256 * 2, T, 2048, 256); EpiKV E{(u16*)(ws + WS_R1 + R1_KT), (u16*)(ws + WS_R1 + R1_VT), (const float*)(ws + WS_PS)};
                  int kk_ = 256; asm volatile("" : "+s"(kk_)); g8::gemm_phase<EpiKV, SchedDense>(ldsl, kk_, S, E, wv); }
                SEAM(base + 3); }
            if (IN(base + 4)) REP(6) { PH_BEGIN attn_phase(ws, li != 3, (char*)lds, ldsl, wv); SEAM(base + 4); }
            if (IN(base + 5)) REP(10) { PH_BEGIN SchedDense S; S.init(ws + WS_ZO, 1024, wb + WB_WO + (size_t)j * 1024 * 1024 * 2, T, 1024, 1024); EpiWo E{(u16*)(ws + WS_HX), mod, li};
                g8::gemm_phase<EpiWo, SchedDense>(ldsl, 1024, S, E, wv); SEAM(base + 5); }
        }
        if (IN(base + 6)) REP(2) { PH_BEGIN NormDst nd = NDST(li, 2); if (li == 0) { nd.xin = a.P.in[0]; nd.cin = a.P.in[2]; norm2_rows<42 | 64>(ws, outp, nd, li, 1, sbase, (char*)lds, wv); } else norm2_rows<42>(ws, outp, nd, li, 1, sbase, (char*)lds, wv); SEAM(base + 6); }
        if (IN(base + 7) || IN(base + 8)) {
            const unsigned* cnt = (const unsigned*)(ws0 + WS_CTL) + CW_CNT + li * 32 * CS;
            __syncthreads();
            if (tid_opaque(wv) == 0) { int acc = 0; for (int e = 0; e < 32; ++e) { sbase[e] = acc; acc += (int)((cnt[e * CS] + 255u) / 256u); } sbase[32] = acc; }
            __syncthreads();
            if (IN(base + 7)) REP(7) { PH_BEGIN SchedMoe<true> S; S.init(ws + WS_HX, wb + WB_GU + (size_t)li * 32 * 1024 * 1024 * 2, 1024, sbase, cnt, (const int*)(ws + WS_LIST)); EpiMoe1 E{(u16*)(ws + WS_R1 + R1_ACT)};
                g8::gemm_phase<EpiMoe1, SchedMoe<true>>(ldsl, 1024, S, E, wv); SEAM(base + 7); }
            if (IN(base + 8)) REP(8) { PH_BEGIN SchedMoe<false> S; S.init(ws + WS_R1 + R1_ACT, wb + WB_DN + (size_t)li * 32 * 1024 * 512 * 2, 512, sbase, cnt, (const int*)(ws + WS_LIST)); EpiMoe2 E{(u16*)(ws + WS_YB)};
                g8::gemm_phase<EpiMoe2, SchedMoe<false>>(ldsl, 512, S, E, wv); SEAM(base + 8); }
        }
    }

    {
        constexpr int li = 3; constexpr int base = 1 + li * 10, j = li >> 1;
#define PH_BEGIN size_t zoff_ = 0; asm volatile("" : "+s"(zoff_)); unsigned char* ws = ws0 + zoff_; unsigned char* wb = ws + WS_WB; const float* sm = (const float*)(ws + WS_SMALL); float* X = (float*)(ws + WS_X); const float* mod = (const float*)(ws + WS_MOD); (void)wb; (void)sm; (void)X; (void)mod;
        if ((li & 1) == 0) {
            if (IN(base + 0)) REP(1) { PH_BEGIN NormDst nd = NDST(li, 1); if (li == 0) { nd.xin = a.P.in[0]; nd.cin = a.P.in[2]; norm2_rows<4 | 64>(ws, outp, nd, li, 0, sbase, (char*)lds, wv); } else norm2_rows<5>(ws, outp, nd, li, 0, sbase, (char*)lds, wv); SEAM(base + 0); }
            if (IN(base + 1)) REP(3) { PH_BEGIN SchedS5 S; S.init(ws + WS_R1 + R1_UH, wb + WB_W1 + (size_t)j * 64 * 256 * 256 * 2, 256); EpiS5a E{(float*)(ws + WS_R1 + R1_S)};
                g8::gemm_phase<EpiS5a, SchedS5>(ldsl, 256, S, E, wv); SEAM(base + 1); }
            if (IN(base + 2)) REP(3) { PH_BEGIN s5_scan_phase(ws, j, wv); SEAM(base + 2); }
            if (IN(base + 3)) REP(3) { PH_BEGIN SchedS5 S; S.init(ws + WS_R1 + R1_UH, wb + WB_W2 + (size_t)j * 64 * 256 * 512 * 2, 512); EpiS5b E{(u16*)(ws + WS_ZO), (const u16*)(ws + WS_R1 + R1_UH), sm + SM_S5D + j * 1024};
                g8::gemm_phase<EpiS5b, SchedS5>(ldsl, 512, S, E, wv); SEAM(base + 3); }
            if (IN(base + 4)) REP(4) { PH_BEGIN SchedDense S; S.init(ws + WS_ZO, 1024, wb + WB_GLU + (size_t)j * 2048 * 1024 * 2, T, 2048, 1024); EpiGlu E{(u16*)(ws + WS_HX), mod, li};
                g8::gemm_phase<EpiGlu, SchedDense>(ldsl, 1024, S, E, wv); SEAM(base + 4); }
        } else {
            if (IN(base + 0)) REP(1) { PH_BEGIN const NormDst nd = NDST(li, 1); norm2_rows<3>(ws, outp, nd, li, 0, sbase, (char*)lds, wv); SEAM(base + 0); }
            if (IN(base + 1)) REP(5) { PH_BEGIN SchedDense S; S.init(ws + WS_HX, 1024, wb + WB_WIN + (size_t)j * 768 * 1024 * 2, T, 768, 1024); EpiWin E{(u16*)(ws + WS_CQ), (u16*)(ws + WS_CKV), (u16*)(ws + WS_R1 + R1_KT), (float*)(ws + WS_PS), (const float2*)(ws + WS_ROPE)};
                g8::gemm_phase<EpiWin, SchedDense>(ldsl, 1024, S, E, wv); SEAM(base + 1); }
            if (IN(base + 3)) REP(5) { PH_BEGIN
                { SchedDense S; S.init(ws + WS_CQ, QR, wb + WB_UQ + (size_t)j * 1536 * 384 * 2, T, 1536, 384); EpiQ E{(u16*)(ws + WS_R1 + R1_QT), (const float2*)(ws + WS_ROPE), (const float*)(ws + WS_PS)};
                  g8::gemm_phase<EpiQ, SchedDense>(ldsl, 384, S, E, wv); }
                { SchedDense S; S.init(ws + WS_CKV, KVR, wb + WB_UKV + (size_t)j * 2048 * 256 * 2, T, 2048, 256); EpiKV E{(u16*)(ws + WS_R1 + R1_KT), (u16*)(ws + WS_R1 + R1_VT), (const float*)(ws + WS_PS)};
                  int kk_ = 256; asm volatile("" : "+s"(kk_)); g8::gemm_phase<EpiKV, SchedDense>(ldsl, kk_, S, E, wv); }
                SEAM(base + 3); }
            if (IN(base + 4)) REP(6) { PH_BEGIN attn_phase(ws, li != 3, (char*)lds, ldsl, wv); SEAM(base + 4); }
            if (IN(base + 5)) REP(10) { PH_BEGIN SchedDense S; S.init(ws + WS_ZO, 1024, wb + WB_WO + (size_t)j * 1024 * 1024 * 2, T, 1024, 1024); EpiWo E{(u16*)(ws + WS_HX), mod, li};
                g8::gemm_phase<EpiWo, SchedDense>(ldsl, 1024, S, E, wv); SEAM(base + 5); }
        }
        if (IN(base + 6)) REP(2) { PH_BEGIN NormDst nd = NDST(li, 2); if (li == 0) { nd.xin = a.P.in[0]; nd.cin = a.P.in[2]; norm2_rows<42 | 64>(ws, outp, nd, li, 1, sbase, (char*)lds, wv); } else norm2_rows<42>(ws, outp, nd, li, 1, sbase, (char*)lds, wv); SEAM(base + 6); }
        if (IN(base + 7) || IN(base + 8)) {
            const unsigned* cnt = (const unsigned*)(ws0 + WS_CTL) + CW_CNT + li * 32 * CS;
            __syncthreads();
            if (tid_opaque(wv) == 0) { int acc = 0; for (int e = 0; e < 32; ++e) { sbase[e] = acc; acc += (int)((cnt[e * CS] + 255u) / 256u); } sbase[32] = acc; }
            __syncthreads();
            if (IN(base + 7)) REP(7) { PH_BEGIN SchedMoe<true> S; S.init(ws + WS_HX, wb + WB_GU + (size_t)li * 32 * 1024 * 1024 * 2, 1024, sbase, cnt, (const int*)(ws + WS_LIST)); EpiMoe1 E{(u16*)(ws + WS_R1 + R1_ACT)};
                g8::gemm_phase<EpiMoe1, SchedMoe<true>>(ldsl, 1024, S, E, wv); SEAM(base + 7); }
            if (IN(base + 8)) REP(8) { PH_BEGIN SchedMoe<false> S; S.init(ws + WS_R1 + R1_ACT, wb + WB_DN + (size_t)li * 32 * 1024 * 512 * 2, 512, sbase, cnt, (const int*)(ws + WS_LIST)); EpiMoe2 E{(u16*)(ws + WS_YB)};
                g8::gemm_phase<EpiMoe2, SchedMoe<false>>(ldsl, 512, S, E, wv); SEAM(base + 8); }
        }
    }

#if defined(PROBE_A)
    if (IN(41)) { xcd_barrier(bar, tid_opaque(wv));
        if (tid_opaque(wv) == 0) { const unsigned long long* ts = (const unsigned long long*)(ws0 + WS_CTL) + CW_STAMP64; unsigned long long last = ts[0], sa = 0, sb = 0;
            for (int p = 0; p <= 40; ++p) { const unsigned long long e = ts[p + 1]; if (e == 0) continue; const unsigned long long d = e - last; last = e;
                int grp; if (p == 0) grp = 0; else { const int k = (p - 1) % 10, l = (p - 1) / 10; const bool s5 = (l & 1) == 0;
                    grp = k == 0 ? 1 : k == 6 ? 2 : k == 7 ? 7 : k == 8 ? 8 : s5 ? (k == 4 ? 4 : 3) : (k == 4 ? 6 : 5); }
                if (grp == PROBE_A) sa += d; if (grp == PROBE_B) sb += d; }
            ((float*)sbase)[40] = (float)sa * 1e-5f; ((float*)sbase)[41] = 2.f + (float)sb * (1.f / 2000.f); }
        __syncthreads(); }
#endif
    if (IN(41)) { const NormDst nd = norm_dst_real(ws0, 0); norm2_rows<17>(ws0, outp, nd, 4, 0, sbase, (char*)lds, wv); }
#undef PH_BEGIN
#undef IN
#undef SEAM
}
__global__ __launch_bounds__(256) void n_post_win(Ptrs P, int j) { mla_post_rows(P.ws, j, (const float*)(P.ws + WS_YB), 768, 4, __builtin_amdgcn_readfirstlane(threadIdx.x >> 6)); }
static void gemm_naive(hipStream_t st, const void* A, int lda, const int* rowidx, const float* B, int ldb, long bstride, const int* tileexp, const int* mdyn, float* C, int ldc, int M, int N, int K) {
    NG g{}; g.A = A; g.lda = lda; g.rowidx = rowidx; g.B = B; g.ldb = ldb; g.bstride = bstride; g.tileexp = tileexp; g.mdyn = mdyn; g.C = C; g.ldc = ldc; g.M = M; g.N = N; g.K = K; g.pad = 0;
    hipLaunchKernelGGL(n_gemm<1>, dim3(N / 64, (M + 63) / 64), dim3(256), 0, st, g);
}
#ifndef REALMASK_STR
#define REALMASK_STR "111111111111111111111111111111111111111111"
#endif
extern "C" void kernel_launch(void* const* d_in, const int* in_sizes, int n_in, void* d_out, int out_size, void* d_ws, size_t ws_size, hipStream_t stream) {
    static int grid = 0;
    static const char* realmask = REALMASK_STR;
    if (grid == 0) {
        if (n_in != 30 || out_size != NB * SEQ * D || ws_size < WS_NEND) { fprintf(stderr, "kernel_launch: unexpected shapes n_in %d out %d ws %zu (need %zu)\n", n_in, out_size, ws_size, (size_t)WS_NEND); grid = -1; return; }
        int dev = 0, cus = 0, per_cu = 0;
        if (hipGetDevice(&dev) != hipSuccess || hipDeviceGetAttribute(&cus, hipDeviceAttributeMultiprocessorCount, dev) != hipSuccess) { grid = -1; return; }
        if (hipFuncSetAttribute((const void*)mk, hipFuncAttributeMaxDynamicSharedMemorySize, LDS_BYTES) != hipSuccess) { fprintf(stderr, "kernel_launch: hipFuncSetAttribute failed\n"); grid = -1; return; }
        if (hipOccupancyMaxActiveBlocksPerMultiprocessor(&per_cu, (const void*)mk, 512, LDS_BYTES) != hipSuccess || per_cu < 1) { fprintf(stderr, "kernel_launch: occupancy query says %d\n", per_cu); }
        (void)hipGetLastError();
        grid = cus;
    }
    if (grid < 0) return;
    Ptrs P{}; for (int i = 0; i < 30; ++i) P.in[i] = (const float*)d_in[i]; P.out = (float*)d_out; P.ws = (unsigned char*)d_ws;
    unsigned char* ws = P.ws;
    (void)hipMemsetAsync(ws + WS_CTL, 0, ZERO_BYTES, stream);
    int nreg = 0;
    auto real = [&](int p) { return realmask[p] == '1'; };
    auto run_mk = [&](int lo, int hi) { MkArgs a{}; a.P = P; a.lo = lo; a.hi = hi; a.bar_region = (hi - lo > 1) ? nreg++ : 0; a.pad = 0; hipLaunchKernelGGL(mk, dim3(grid), dim3(512), LDS_BYTES, stream, a); };
    const int NG_ = 4096; float* NTMP = (float*)(ws + WS_NTMP);
    int p = 0;
    while (p < NPHASE) {
        if (real(p)) { int q = p; while (q < NPHASE && real(q)) ++q; run_mk(p, q); p = q; continue; }
        if (p == 0) { hipLaunchKernelGGL(k_mod, dim3(24, 4), dim3(256), 0, stream, P); hipLaunchKernelGGL(k_init, dim3(2048), dim3(256), 0, stream, P); }
        else if (p == 41) hipLaunchKernelGGL(k_norm<17>, dim3(2048), dim3(256), 0, stream, P, 4, 0);
        else {
            const int li = (p - 1) / 10, k = (p - 1) % 10, j = li >> 1; const bool s5 = (li & 1) == 0;
            if (k == 0) { if (li == 0) hipLaunchKernelGGL(k_norm<2>, dim3(2048), dim3(256), 0, stream, P, li, 0); else hipLaunchKernelGGL(k_norm<3>, dim3(2048), dim3(256), 0, stream, P, li, 0); }
            else if (s5 && k == 1) { hipLaunchKernelGGL(n_s5, dim3(NB * SG), dim3(128), 0, stream, P, j); }
            else if (s5 && k == 3) { hipLaunchKernelGGL(n_post_s5, dim3(NG_), dim3(256), 0, stream, P, j); }
            else if (s5 && k == 4) { gemm_naive(stream, ws + WS_ZO, D, nullptr, P.in[16] + (size_t)j * 1024 * 2048, 2048, 0, nullptr, nullptr, NTMP, 2048, T, 2048, 1024); hipLaunchKernelGGL(n_post_glu, dim3(NG_), dim3(256), 0, stream, P, li); }
            else if (!s5 && k == 1) { gemm_naive(stream, ws + WS_HX, D, nullptr, P.in[17] + (size_t)j * 1024 * 704, 704, 0, nullptr, nullptr, (float*)(ws + WS_YB), 768, T, 704, 1024); }
            else if (!s5 && k == 2) { hipLaunchKernelGGL(n_post_win, dim3(2048), dim3(256), 0, stream, P, j); }
            else if (!s5 && k == 3) {
                gemm_naive(stream, ws + WS_CQ, QR, nullptr, P.in[20] + (size_t)j * 384 * 1536, 1536, 0, nullptr, nullptr, NTMP, 1536, T, 1536, 384); hipLaunchKernelGGL(n_post_q, dim3(NG_), dim3(256), 0, stream, P);
                gemm_naive(stream, ws + WS_CKV, KVR, nullptr, P.in[21] + (size_t)j * 256 * 2048, 2048, 0, nullptr, nullptr, NTMP, 2048, T, 2048, 256); hipLaunchKernelGGL(n_post_kv, dim3(NG_), dim3(256), 0, stream, P); }
            else if (!s5 && k == 4) { hipLaunchKernelGGL(n_attn, dim3(LTOT / 64, NH, NB), dim3(256), 0, stream, P); }
            else if (!s5 && k == 5) { gemm_naive(stream, ws + WS_ZO, D, nullptr, P.in[22] + (size_t)j * 1024 * 1024, 1024, 0, nullptr, nullptr, NTMP, 1024, T, 1024, 1024); hipLaunchKernelGGL(n_post_wo, dim3(NG_), dim3(256), 0, stream, P, li); }
            else if (k == 6) { hipLaunchKernelGGL(k_norm<10>, dim3(2048), dim3(256), 0, stream, P, li, 1); }
            else if (k == 7 || k == 8) {
                const int* tileexp = (const int*)(ws + WS_TILEEXP);
                hipLaunchKernelGGL(n_build, dim3(1), dim3(256), 0, stream, P, li);
                if (k == 7) { gemm_naive(stream, ws + WS_HX, D, (const int*)(ws + WS_SLOTROW), P.in[27] + (size_t)li * 32 * 1024 * 1024, 1024, 1024L * 1024, tileexp, tileexp + 512, NTMP, 1024, MAXSLOT, 1024, 1024);
                    hipLaunchKernelGGL(n_post_act2, dim3(NG_), dim3(256), 0, stream, P, (u16*)(ws + WS_R1 + R1_ACT)); }
                else { gemm_naive(stream, ws + WS_R1 + R1_ACT, 512, nullptr, P.in[28] + (size_t)li * 32 * 512 * 1024, 1024, 512L * 1024, tileexp, tileexp + 512, NTMP, 1024, MAXSLOT, 1024, 512);
                    hipLaunchKernelGGL(n_post_y, dim3(NG_), dim3(256), 0, stream, P); }
            }
        }
        ++p;
    }
}
```

```cpp
#define MK_FULL 1
#include <hip/hip_runtime.h>
#include <cstdio>
#include <cstdint>

typedef unsigned short u16;
typedef unsigned short bf16_t;

constexpr int D = 1024, NB = 16, SEQ = 2048, CTXL = 256, LTOT = 2304, T = NB * LTOT;
constexpr int SG = 64, SP = 64, SC = 16;
constexpr int QR = 384, KVR = 256, NH = 8, QKD = 192;
constexpr int NE = 32;
constexpr int MAXSLOT = 81920;
constexpr float EPS = 1e-6f;

constexpr size_t al256(size_t x) { return (x + 255) / 256 * 256; }
constexpr size_t WS_CTL = 0;
constexpr size_t CTL_BYTES = 131072;
constexpr size_t WS_MOD = WS_CTL + CTL_BYTES;
constexpr size_t MOD_BYTES = al256((size_t)4 * 17 * 6144 * 4);
constexpr size_t ZERO_BYTES = CTL_BYTES;
constexpr size_t WS_ROPE = WS_MOD + MOD_BYTES;
constexpr size_t WS_SMALL = WS_ROPE + al256((size_t)2048 * 32 * 8);
constexpr int SM_GMIX = 0, SM_GFFN = 4096, SM_S5D = 8192, SM_GQ = 10240, SM_GKV = 11008, SM_FINALG = 11520, SM_BGROUP = 12544, SM_BEXP = 12560, SM_WGROUP = 12800, SM_WEXP = 29184, SM_END = 160256;
constexpr size_t WS_X = WS_SMALL + al256((size_t)SM_END * 4);
constexpr size_t WS_HX = WS_X + (size_t)T * D * 4;
constexpr size_t WS_ZO = WS_HX + (size_t)T * D * 2;
constexpr size_t WS_CQ = WS_ZO + (size_t)T * D * 2;
constexpr size_t WS_CKV = WS_CQ + (size_t)T * QR * 2;
constexpr size_t WS_PS = WS_CKV + (size_t)T * KVR * 2;
constexpr size_t WS_SELI = WS_PS + (size_t)T * 24 * 4;
constexpr size_t WS_SELW = WS_SELI + (size_t)T * 16;
constexpr size_t WS_LIST = WS_SELW + (size_t)T * 8;
constexpr size_t WS_SLOTROW = WS_LIST + (size_t)NE * T * 4;
constexpr size_t WS_TILEEXP = WS_SLOTROW + (size_t)MAXSLOT * 4;
constexpr size_t WS_R1 = WS_TILEEXP + 4096;
constexpr size_t R1_BYTES = (size_t)MAXSLOT * 1024 * 4;
constexpr size_t WS_YB = WS_R1 + R1_BYTES;
constexpr size_t WS_WB = WS_YB + (size_t)MAXSLOT * 1024 * 2;
constexpr size_t R1_QT = 0;
constexpr size_t R1_KT = R1_QT + (size_t)NB * NH * LTOT * QKD * 2;
constexpr size_t R1_VT = R1_KT + (size_t)NB * NH * LTOT * QKD * 2;
constexpr size_t R1_ACT = 0;
constexpr size_t R1_S = 0;
constexpr size_t R1_UH = (size_t)64 * 2304 * 256 * 4;
constexpr size_t WB_GLU = 0;
constexpr size_t WB_WIN = WB_GLU + (size_t)2 * 2048 * 1024 * 2;
constexpr size_t WB_UQ = WB_WIN + (size_t)2 * 768 * 1024 * 2;
constexpr size_t WB_UKV = WB_UQ + (size_t)2 * 1536 * 384 * 2;
constexpr size_t WB_WO = WB_UKV + (size_t)2 * 2048 * 256 * 2;
constexpr size_t WB_GU = WB_WO + (size_t)2 * 1024 * 1024 * 2;
constexpr size_t WB_DN = WB_GU + (size_t)128 * 1024 * 1024 * 2;
constexpr size_t WB_W1 = WB_DN + (size_t)128 * 1024 * 512 * 2;
constexpr size_t WB_W2 = WB_W1 + (size_t)128 * 256 * 256 * 2;
constexpr size_t WB_AT = WB_W2 + (size_t)128 * 256 * 512 * 2;
constexpr size_t WB_END = WB_AT + (size_t)2 * 2 * 64 * 64 * 8;
constexpr size_t WS_END = WS_WB + WB_END;
constexpr size_t WS_NTMP = al256(WS_END);
constexpr size_t WS_NEND = WS_NTMP + (size_t)MAXSLOT * 1024 * 4;
static_assert(R1_UH + (size_t)64 * 2304 * 512 * 2 <= R1_BYTES, "R1");
static_assert(R1_VT + (size_t)NB * NH * LTOT * 128 * 2 <= R1_BYTES, "R1");
constexpr int CS = 64;
constexpr int CW_CNT = 8192;
constexpr int CW_QUEUE = 7168;
constexpr int CW_CNT_DUMMY = 16384;
constexpr int CW_STAMP64 = 12288;

__device__ __forceinline__ float bf2f(u16 v) { return __uint_as_float(((unsigned)v) << 16); }
__device__ __forceinline__ u16 f2bf(float f) { unsigned u = __float_as_uint(f); u += 0x7FFFu + ((u >> 16) & 1u); return (u16)(u >> 16); }
__device__ __forceinline__ float silu_f(float x) { return x / (1.f + __expf(-x)); }
__device__ __forceinline__ float sigmoid_f(float x) { return 1.f / (1.f + __expf(-x)); }
__device__ __forceinline__ float gelu_tanh(float x) { const float u = 0.7978845608028654f * (x + 0.044715f * x * x * x); const float e = __expf(2.f * u); const float t = 1.f - 2.f / (e + 1.f); return 0.5f * x * (1.f + t); }
__device__ __forceinline__ float wave_sum(float v) {
#pragma unroll
    for (int o = 32; o > 0; o >>= 1) v += __shfl_xor(v, o);
    return v;
}

struct Ptrs { const float* in[30]; float* out; unsigned char* ws; };
__device__ __forceinline__ int tid_opaque(int wv) { int l; asm volatile("v_mbcnt_lo_u32_b32 %0, -1, 0\n\tv_mbcnt_hi_u32_b32 %0, -1, %0" : "=v"(l)); return (wv << 6) | l; }
__device__ __forceinline__ float wave_sum_l(float v, int lane) {
#pragma unroll
    for (int o = 32; o > 0; o >>= 1) v += __int_as_float(__builtin_amdgcn_ds_bpermute((lane ^ o) << 2, __float_as_int(v)));
    return v;
}

__global__ __launch_bounds__(256) void k_mod(Ptrs P) {
    __shared__ float sc[17][64];
    const int i = blockIdx.y, col = blockIdx.x * 256 + threadIdx.x, tid = threadIdx.x;
    const float* W = P.in[4] + (size_t)i * 1024 * 6144;
    float acc[17];
#pragma unroll
    for (int r = 0; r < 17; ++r) acc[r] = 0.f;
    for (int k0 = 0; k0 < 1024; k0 += 64) {
        __syncthreads();
        for (int idx = tid; idx < 17 * 64; idx += 256) { const int r = idx >> 6, kk = idx & 63; const float v = r < 16 ? P.in[1][r * 1024 + k0 + kk] : P.in[3][k0 + kk]; sc[r][kk] = silu_f(v); }
        __syncthreads();
#pragma unroll 8
        for (int kk = 0; kk < 64; ++kk) { const float w = W[(size_t)(k0 + kk) * 6144 + col];
#pragma unroll
            for (int r = 0; r < 17; ++r) acc[r] += sc[r][kk] * w; }
    }
    float* mod = (float*)(P.ws + WS_MOD);
    const float bb = P.in[5][i * 6144 + col];
#pragma unroll
    for (int r = 0; r < 17; ++r) mod[(size_t)(i * 17 + r) * 6144 + col] = acc[r] + bb;
}
__device__ __forceinline__ void copy_small(const Ptrs& P, int t0, int nt) {
    float* sm = (float*)(P.ws + WS_SMALL);
    for (int i = t0; i < 4096; i += nt) { sm[SM_GMIX + i] = P.in[6][i]; sm[SM_GFFN + i] = P.in[7][i]; }
    for (int i = t0; i < 2048; i += nt) sm[SM_S5D + i] = P.in[15][i];
    for (int i = t0; i < 768; i += nt) sm[SM_GQ + i] = P.in[18][i];
    for (int i = t0; i < 512; i += nt) sm[SM_GKV + i] = P.in[19][i];
    for (int i = t0; i < 1024; i += nt) sm[SM_FINALG + i] = P.in[29][i];
    for (int i = t0; i < 16; i += nt) sm[SM_BGROUP + i] = P.in[24][i];
    for (int i = t0; i < 128; i += nt) sm[SM_BEXP + i] = P.in[26][i];
    for (int i = t0; i < 16384; i += nt) sm[SM_WGROUP + i] = P.in[23][i];
    for (int i = t0; i < 131072; i += nt) sm[SM_WEXP + i] = P.in[25][i];
}
__global__ __launch_bounds__(256) void k_init(Ptrs P) {
    copy_small(P, blockIdx.x * 256 + threadIdx.x, gridDim.x * 256);
    float4* X = (float4*)(P.ws + WS_X);
    const size_t n4 = (size_t)T * D / 4;
    for (size_t i = (size_t)blockIdx.x * 256 + threadIdx.x; i < n4; i += (size_t)gridDim.x * 256) {
        const size_t row = i / 256, c4 = i % 256; const int b = (int)(row / LTOT), pos = (int)(row % LTOT);
        X[i] = pos < CTXL ? ((const float4*)P.in[2])[((size_t)b * CTXL + pos) * 256 + c4] : ((const float4*)P.in[0])[((size_t)b * SEQ + (pos - CTXL)) * 256 + c4];
    }
    float2* rope = (float2*)(P.ws + WS_ROPE);
    for (int i = blockIdx.x * 256 + threadIdx.x; i < 2048 * 32; i += gridDim.x * 256) {
        const int s = i >> 5, k = i & 31, f = k & 15; const float invf = exp2f(-(float)f * (13.287712379549449f / 16.f));
        const float ang = (float)(k < 16 ? (s >> 6) : (s & 63)) * invf;
        rope[i] = make_float2(__cosf(ang), __sinf(ang));
    }
}

template <int MODE>
__device__ __forceinline__ void norm_rows(unsigned char* wsp, float* outp, int li, int which, int nwaves_blk, int* s_base, int wv) {
    struct { unsigned char* ws; float* out; } P{wsp, outp}; const float* sm = (const float*)(wsp + WS_SMALL);
    const int tidn = tid_opaque(wv); const int lane = tidn & 63, wave = tidn >> 6;
    float* X = (float*)(P.ws + WS_X);
    const float* mod = (const float*)(P.ws + WS_MOD);
    if (MODE & 1) {
        if (tidn == 0) { const unsigned* cnt = (const unsigned*)(P.ws + WS_CTL) + CW_CNT + (li - 1) * 32 * CS; int a = 0; for (int e = 0; e < 32; ++e) { s_base[e] = a; a += (int)((cnt[e * CS] + 255u) / 256u); } s_base[32] = a; }
        __syncthreads();
    }
    const bool lastl = (li == 3);
    for (int row = blockIdx.x * nwaves_blk + wave; row < T; row += gridDim.x * nwaves_blk) {
        const int b = row / LTOT, pos = row % LTOT; const bool isctx = pos < CTXL; const int r = isctx ? 16 : b;
        if ((MODE & 16) && isctx) continue;
        if ((MODE & 8) && lastl && isctx) continue;
        float4 v[4];
#pragma unroll
        for (int q = 0; q < 4; ++q) v[q] = *(const float4*)(X + (size_t)row * D + q * 256 + lane * 4);
        if (MODE & 1) {
            const bool skip = (li - 1 == 3) && isctx;
            if (!skip) {
                const int4 si = *(const int4*)(P.ws + WS_SELI + (size_t)row * 16); const float2 sw = *(const float2*)(P.ws + WS_SELW + (size_t)row * 8);
                const size_t g1 = (size_t)s_base[si.x] * 256 + si.y, g2 = (size_t)s_base[si.z] * 256 + si.w;
                const u16* YB = (const u16*)(P.ws + WS_YB);
                const float* gate = mod + (size_t)((li - 1) * 17 + r) * 6144 + 5 * 1024;
#pragma unroll
                for (int q = 0; q < 4; ++q) { const int c = q * 256 + lane * 4;
                    const uint2 ya = *(const uint2*)(YB + g1 * 1024 + c), yb = *(const uint2*)(YB + g2 * 1024 + c); const float4 gg = *(const float4*)(gate + c);
                    v[q].x += gg.x * (sw.x * bf2f((u16)(ya.x & 0xffff)) + sw.y * bf2f((u16)(yb.x & 0xffff)));
                    v[q].y += gg.y * (sw.x * bf2f((u16)(ya.x >> 16)) + sw.y * bf2f((u16)(yb.x >> 16)));
                    v[q].z += gg.z * (sw.x * bf2f((u16)(ya.y & 0xffff)) + sw.y * bf2f((u16)(yb.y & 0xffff)));
                    v[q].w += gg.w * (sw.x * bf2f((u16)(ya.y >> 16)) + sw.y * bf2f((u16)(yb.y >> 16)));
                    if (!(MODE & 16)) *(float4*)(X + (size_t)row * D + c) = v[q]; }
            }
        }
        float ss = 0.f;
#pragma unroll
        for (int q = 0; q < 4; ++q) ss += v[q].x * v[q].x + v[q].y * v[q].y + v[q].z * v[q].z + v[q].w * v[q].w;
        ss = wave_sum_l(ss, lane);
        const float rstd = rsqrtf(ss * (1.f / 1024.f) + EPS);
        if (MODE & 16) {
            float* out = P.out + ((size_t)b * SEQ + (pos - CTXL)) * D;
#pragma unroll
            for (int q = 0; q < 4; ++q) { const int c = q * 256 + lane * 4; const float4 g = *(const float4*)(sm + SM_FINALG + c);
                float4 ov = make_float4(v[q].x * rstd * g.x, v[q].y * rstd * g.y, v[q].z * rstd * g.z, v[q].w * rstd * g.w);
#if defined(PROBE_A)
                { const float da = 1.f + ((const float*)s_base)[40]; ov.x *= da; ov.y *= da; ov.z *= da; ov.w *= da; if (row == CTXL && c == 0) ov.x += ((const float*)s_base)[41]; }
#endif
                *(float4*)(out + c) = ov; }
            continue;
        }
        const float* gv = sm + (which ? SM_GFFN : SM_GMIX) + li * 1024;
        const float* sh = mod + (size_t)(li * 17 + r) * 6144 + (which ? 3 : 0) * 1024; const float* scl = sh + 1024;
        float h[16];
#pragma unroll
        for (int q = 0; q < 4; ++q) { const int c = q * 256 + lane * 4; const float4 g = *(const float4*)(gv + c), s4 = *(const float4*)(sh + c), c4 = *(const float4*)(scl + c);
            h[q * 4 + 0] = v[q].x * rstd * g.x * (1.f + c4.x) + s4.x; h[q * 4 + 1] = v[q].y * rstd * g.y * (1.f + c4.y) + s4.y;
            h[q * 4 + 2] = v[q].z * rstd * g.z * (1.f + c4.z) + s4.z; h[q * 4 + 3] = v[q].w * rstd * g.w * (1.f + c4.w) + s4.w; }
        if (MODE & 2) {
            u16* HX = (u16*)(P.ws + WS_HX);
#pragma unroll
            for (int q = 0; q < 4; ++q) { uint2 w; w.x = (unsigned)f2bf(h[q * 4]) | ((unsigned)f2bf(h[q * 4 + 1]) << 16); w.y = (unsigned)f2bf(h[q * 4 + 2]) | ((unsigned)f2bf(h[q * 4 + 3]) << 16);
                *(uint2*)(HX + (size_t)row * D + q * 256 + lane * 4) = w; }
        }
        if (MODE & 4) {
            u16* UH = (u16*)(P.ws + WS_R1 + R1_UH);
#pragma unroll
            for (int q = 0; q < 4; ++q) { const int c = q * 256 + lane * 4; const int g = c >> 4, ch = c & 15;
                uint2 w; w.x = (unsigned)f2bf(h[q * 4]) | ((unsigned)f2bf(h[q * 4 + 1]) << 16); w.y = (unsigned)f2bf(h[q * 4 + 2]) | ((unsigned)f2bf(h[q * 4 + 3]) << 16);
                *(uint2*)(UH + ((size_t)g * 2304 + b * 144 + (pos >> 4)) * 512 + (pos & 15) * 16 + ch) = w; }
        }
        if (MODE & 8) {
            const float* wg = sm + SM_WGROUP + (size_t)li * 1024 * 4;
            float lg[4] = {0.f, 0.f, 0.f, 0.f};
#pragma unroll
            for (int q = 0; q < 4; ++q)
#pragma unroll
                for (int j = 0; j < 4; ++j) { const int k = q * 256 + lane * 4 + j; const float4 w = *(const float4*)(wg + k * 4); const float hv = h[q * 4 + j];
                    lg[0] += hv * w.x; lg[1] += hv * w.y; lg[2] += hv * w.z; lg[3] += hv * w.w; }
#pragma unroll
            for (int g = 0; g < 4; ++g) lg[g] = wave_sum_l(lg[g], lane) + sm[SM_BGROUP + li * 4 + g];
            int gi = 0; float best = lg[0];
#pragma unroll
            for (int g = 1; g < 4; ++g) if (lg[g] > best) { best = lg[g]; gi = g; }
            float den = 0.f;
#pragma unroll
            for (int g = 0; g < 4; ++g) den += __expf(lg[g] - best);
            const float pg = 1.f / den;
            const float* we = sm + SM_WEXP + ((size_t)li * 4 + gi) * 1024 * 8;
            float le[8];
#pragma unroll
            for (int e = 0; e < 8; ++e) le[e] = 0.f;
#pragma unroll
            for (int q = 0; q < 4; ++q)
#pragma unroll
                for (int j = 0; j < 4; ++j) { const int k = q * 256 + lane * 4 + j; const float4 w0 = *(const float4*)(we + k * 8), w1 = *(const float4*)(we + k * 8 + 4); const float hv = h[q * 4 + j];
                    le[0] += hv * w0.x; le[1] += hv * w0.y; le[2] += hv * w0.z; le[3] += hv * w0.w; le[4] += hv * w1.x; le[5] += hv * w1.y; le[6] += hv * w1.z; le[7] += hv * w1.w; }
#pragma unroll
            for (int e = 0; e < 8; ++e) le[e] = wave_sum_l(le[e], lane) + sm[SM_BEXP + (li * 4 + gi) * 8 + e];
            int i1 = 0; float b1 = le[0];
#pragma unroll
            for (int e = 1; e < 8; ++e) if (le[e] > b1) { b1 = le[e]; i1 = e; }
            int i2 = -1; float b2 = -3.0e38f;
#pragma unroll
            for (int e = 0; e < 8; ++e) if (e != i1 && le[e] > b2) { b2 = le[e]; i2 = e; }
            if (lane == 0) {
                const float ex = __expf(b2 - b1); const float w1 = 1.f / (1.f + ex), w2 = ex / (1.f + ex);
                unsigned* cnt = (unsigned*)(P.ws + WS_CTL) + CW_CNT + li * 32 * CS; int* list = (int*)(P.ws + WS_LIST);
                const int e1 = gi * 8 + i1, e2 = gi * 8 + i2;
                const int s1 = (int)atomicAdd(&cnt[e1 * CS], 1u), s2 = (int)atomicAdd(&cnt[e2 * CS], 1u);
                list[(size_t)e1 * T + s1] = row; list[(size_t)e2 * T + s2] = row;
                *(int4*)(P.ws + WS_SELI + (size_t)row * 16) = make_int4(e1, s1, e2, s2);
                *(float2*)(P.ws + WS_SELW + (size_t)row * 8) = make_float2(pg * w1, pg * w2);
            }
        }
    }
}
template <int MODE> __global__ __launch_bounds__(256) void k_norm(Ptrs P, int li, int which) { __shared__ int sb[36]; norm_rows<MODE>(P.ws, P.out, li, which, 4, sb, __builtin_amdgcn_readfirstlane(threadIdx.x >> 6)); }

struct NG { const void* A; int lda; const int* rowidx; const float* B; int ldb; long bstride; const int* tileexp; const int* mdyn; float* C; int ldc; int M, N, K, pad; };
template <int ABF> __global__ __launch_bounds__(256) void n_gemm(NG g) {
    __shared__ float As[16][68], Bs[16][68];
    const int tm = blockIdx.y, tn = blockIdx.x, tid = threadIdx.x, tx = tid & 15, ty = tid >> 4;
    const int M = g.mdyn ? (*g.mdyn) * 256 : g.M;
    if (tm * 64 >= M) return;
    const float* B = g.B; if (g.tileexp) B += (long)g.tileexp[(tm * 64) / 256] * g.bstride;
    float acc[4][4];
#pragma unroll
    for (int i = 0; i < 4; ++i)
#pragma unroll
        for (int j = 0; j < 4; ++j) acc[i][j] = 0.f;
    const int arow = tm * 64 + (tid >> 2), ak = (tid & 3) * 4; long asrc = -1;
    if (arow < M) { const int r = g.rowidx ? g.rowidx[arow] : arow; if (r >= 0) asrc = (long)r * g.lda; }
    for (int k0 = 0; k0 < g.K; k0 += 16) {
        float a[4] = {0.f, 0.f, 0.f, 0.f};
        if (asrc >= 0) {
            if (ABF) { const uint2 w = *(const uint2*)((const u16*)g.A + asrc + k0 + ak); a[0] = bf2f((u16)(w.x & 0xffff)); a[1] = bf2f((u16)(w.x >> 16)); a[2] = bf2f((u16)(w.y & 0xffff)); a[3] = bf2f((u16)(w.y >> 16)); }
            else { const float4 w = *(const float4*)((const float*)g.A + asrc + k0 + ak); a[0] = w.x; a[1] = w.y; a[2] = w.z; a[3] = w.w; }
        }
        const float4 bv = *(const float4*)(B + (size_t)(k0 + (tid >> 4)) * g.ldb + tn * 64 + (tid & 15) * 4);
        __syncthreads();
#pragma unroll
        for (int i = 0; i < 4; ++i) As[ak + i][tid >> 2] = a[i];
        *(float4*)&Bs[tid >> 4][(tid & 15) * 4] = bv;
        __syncthreads();
#pragma unroll
        for (int kk = 0; kk < 16; ++kk) { const float4 a4 = *(const float4*)&As[kk][ty * 4], b4 = *(const float4*)&Bs[kk][tx * 4];
            const float av[4] = {a4.x, a4.y, a4.z, a4.w}, bw[4] = {b4.x, b4.y, b4.z, b4.w};
#pragma unroll
            for (int i = 0; i < 4; ++i)
#pragma unroll
                for (int j = 0; j < 4; ++j) acc[i][j] += av[i] * bw[j]; }
    }
#pragma unroll
    for (int i = 0; i < 4; ++i) { const int row = tm * 64 + ty * 4 + i; if (row < M) *(float4*)(g.C + (size_t)row * g.ldc + tn * 64 + tx * 4) = make_float4(acc[i][0], acc[i][1], acc[i][2], acc[i][3]); }
}
__device__ __forceinline__ int row_r(int row) { return (row % LTOT) < CTXL ? 16 : row / LTOT; }
__global__ __launch_bounds__(256) void n_post_glu(Ptrs P, int li) {
    float* X = (float*)(P.ws + WS_X); const float* TMP = (const float*)(P.ws + WS_NTMP); const float* mod = (const float*)(P.ws + WS_MOD);
    for (size_t i = (size_t)blockIdx.x * 256 + threadIdx.x; i < (size_t)T * D; i += (size_t)gridDim.x * 256) { const int row = (int)(i >> 10), c = (int)(i & 1023); const int r = row_r(row);
        const float val = TMP[(size_t)row * 2048 + c], gt = TMP[(size_t)row * 2048 + 1024 + c]; X[i] += mod[(size_t)(li * 17 + r) * 6144 + 2048 + c] * val * sigmoid_f(gt); }
}
__global__ __launch_bounds__(256) void n_post_wo(Ptrs P, int li) {
    float* X = (float*)(P.ws + WS_X); const float* TMP = (const float*)(P.ws + WS_NTMP); const float* mod = (const float*)(P.ws + WS_MOD);
    for (size_t i = (size_t)blockIdx.x * 256 + threadIdx.x; i < (size_t)T * D; i += (size_t)gridDim.x * 256) { const int row = (int)(i >> 10), c = (int)(i & 1023); const int r = row_r(row);
        X[i] += mod[(size_t)(li * 17 + r) * 6144 + 2048 + c] * TMP[i]; }
}
__global__ __launch_bounds__(256) void n_post_q(Ptrs P) {
    const float* TMP = (const float*)(P.ws + WS_NTMP); u16* QT = (u16*)(P.ws + WS_R1 + R1_QT); const float2* rope = (const float2*)(P.ws + WS_ROPE);
    const float scale = 0.07216878364870322f;
    for (size_t i = (size_t)blockIdx.x * 256 + threadIdx.x; i < (size_t)T * 1536; i += (size_t)gridDim.x * 256) { const int row = (int)(i / 1536), c = (int)(i % 1536); const int h = c / 192, dd = c % 192;
        const int b = row / LTOT, pos = row % LTOT; float v = TMP[i];
        if (dd >= 128 && pos >= CTXL) { const int l = dd - 128; const float pv = TMP[(size_t)row * 1536 + h * 192 + 128 + (l ^ 16)]; const float2 cs = rope[(size_t)(pos - CTXL) * 32 + (l >> 5) * 16 + (l & 15)];
            v = (l & 16) ? v * cs.x + pv * cs.y : v * cs.x - pv * cs.y; }
        QT[(((size_t)b * NH + h) * LTOT + pos) * QKD + dd] = f2bf(v * scale); }
}
__global__ __launch_bounds__(256) void n_post_kv(Ptrs P) {
    const float* TMP = (const float*)(P.ws + WS_NTMP); u16* KT = (u16*)(P.ws + WS_R1 + R1_KT); u16* VT = (u16*)(P.ws + WS_R1 + R1_VT);
    for (size_t i = (size_t)blockIdx.x * 256 + threadIdx.x; i < (size_t)T * 2048; i += (size_t)gridDim.x * 256) { const int row = (int)(i >> 11), c = (int)(i & 2047); const int h = c >> 8, dd = c & 255;
        const int b = row / LTOT, pos = row % LTOT; const u16 v = f2bf(TMP[i]);
        if (dd < 128) KT[(((size_t)b * NH + h) * LTOT + pos) * QKD + dd] = v; else VT[(((size_t)b * NH + h) * LTOT + pos) * 128 + dd - 128] = v; }
}
__global__ __launch_bounds__(256) void n_attn(Ptrs P) {
    __shared__ float Ks[32][192], Vs[32][128];
    const int qt = blockIdx.x, h = blockIdx.y, b = blockIdx.z, tid = threadIdx.x, ql = tid >> 2, part = tid & 3;
    const u16* QT = (const u16*)(P.ws + WS_R1 + R1_QT) + ((size_t)b * NH + h) * LTOT * QKD; const u16* KT = (const u16*)(P.ws + WS_R1 + R1_KT) + ((size_t)b * NH + h) * LTOT * QKD;
    const u16* VT = (const u16*)(P.ws + WS_R1 + R1_VT) + ((size_t)b * NH + h) * LTOT * 128; u16* O = (u16*)(P.ws + WS_ZO);
    const int pos = qt * 64 + ql; const int nk = (qt * 64 < CTXL) ? CTXL : LTOT;
    float q[48], o[32];
#pragma unroll
    for (int i = 0; i < 48; ++i) q[i] = bf2f(QT[(size_t)pos * QKD + part * 48 + i]);
#pragma unroll
    for (int i = 0; i < 32; ++i) o[i] = 0.f;
    float m = -1e30f, l = 0.f;
    for (int k0 = 0; k0 < nk; k0 += 32) {
        __syncthreads();
        for (int i = tid; i < 32 * 192; i += 256) Ks[i / 192][i % 192] = bf2f(KT[(size_t)k0 * QKD + i]);
        for (int i = tid; i < 32 * 128; i += 256) Vs[i / 128][i % 128] = bf2f(VT[(size_t)k0 * 128 + i]);
        __syncthreads();
        for (int kk = 0; kk < 32; ++kk) {
            float s = 0.f;
#pragma unroll
            for (int i = 0; i < 48; ++i) s += q[i] * Ks[kk][part * 48 + i];
            s += __shfl_xor(s, 1); s += __shfl_xor(s, 2);
            const float mn = fmaxf(m, s), al = __expf(m - mn), p = __expf(s - mn);
            l = l * al + p; m = mn;
#pragma unroll
            for (int i = 0; i < 32; ++i) o[i] = o[i] * al + p * Vs[kk][part * 32 + i];
        }
    }
    const float rl = 1.f / l;
#pragma unroll
    for (int i = 0; i < 32; ++i) O[((size_t)b * LTOT + pos) * D + h * 128 + part * 32 + i] = f2bf(o[i] * rl);
}
__global__ __launch_bounds__(128) void n_s5(Ptrs P, int j) {
    __shared__ float us[2][16], hre[2][64], him[2][64], Cre[2][16][64], Cim[2][16][64];
    const int b = blockIdx.x >> 6, g = blockIdx.x & 63, tid = threadIdx.x, dir = tid >> 6, p = tid & 63;
    const size_t gd = ((size_t)j * 2 + dir) * SG + g;
    const float dt = __expf(P.in[10][gd]); const float ar = P.in[8][gd * SP + p], ai = P.in[9][gd * SP + p];
    const float ldr = ar * dt, ldi = ai * dt, mag = __expf(ldr); const float abr = mag * __cosf(ldi), abi = mag * __sinf(ldi);
    const float nr = abr - 1.f, ni = abi, den = ar * ar + ai * ai; const float qr = (nr * ar + ni * ai) / den, qi = (ni * ar - nr * ai) / den;
    float bbr[16], bbi[16];
#pragma unroll
    for (int c = 0; c < 16; ++c) { const float br = P.in[11][(gd * SP + p) * SC + c], bi = P.in[12][(gd * SP + p) * SC + c]; bbr[c] = qr * br - qi * bi; bbi[c] = qr * bi + qi * br; }
    for (int i = tid; i < 2 * 16 * 64; i += 128) { const int d2 = i >> 10, c = (i >> 6) & 15, pp = i & 63; const size_t o = ((((size_t)j * 2 + d2) * SG + g) * SC + c) * SP + pp; Cre[d2][c][pp] = P.in[13][o]; Cim[d2][c][pp] = P.in[14][o]; }
    const u16* HX = (const u16*)(P.ws + WS_HX); float* Yf = (float*)(P.ws + WS_NTMP); float* Yr = Yf + (size_t)T * D;
    float hr = 0.f, hi = 0.f;
    for (int t = 0; t < LTOT; ++t) {
        __syncthreads();
        if (tid < 32) { const int d2 = tid >> 4, c = tid & 15; const int ps = d2 ? (t < CTXL ? CTXL - 1 - t : LTOT - 1 - (t - CTXL)) : t; us[d2][c] = bf2f(HX[((size_t)b * LTOT + ps) * D + g * 16 + c]); }
        __syncthreads();
        float bur = 0.f, bui = 0.f;
#pragma unroll
        for (int c = 0; c < 16; ++c) { bur += bbr[c] * us[dir][c]; bui += bbi[c] * us[dir][c]; }
        const float nhr = abr * hr - abi * hi + bur, nhi = abr * hi + abi * hr + bui; hr = nhr; hi = nhi;
        hre[dir][p] = hr; him[dir][p] = hi;
        __syncthreads();
        if (tid < 32) { const int d2 = tid >> 4, c = tid & 15; const int ps = d2 ? (t < CTXL ? CTXL - 1 - t : LTOT - 1 - (t - CTXL)) : t; float y = 0.f;
            for (int pp = 0; pp < 64; ++pp) y += Cre[d2][c][pp] * hre[d2][pp] - Cim[d2][c][pp] * him[d2][pp];
            (d2 ? Yr : Yf)[((size_t)b * LTOT + ps) * D + g * 16 + c] = y; }
    }
}
__global__ __launch_bounds__(256) void n_post_s5(Ptrs P, int j) {
    const float* Yf = (const float*)(P.ws + WS_NTMP); const float* Yr = Yf + (size_t)T * D; const u16* HX = (const u16*)(P.ws + WS_HX); u16* Z = (u16*)(P.ws + WS_ZO);
    for (size_t i = (size_t)blockIdx.x * 256 + threadIdx.x; i < (size_t)T * D; i += (size_t)gridDim.x * 256) { const int c = (int)(i & 1023);
        Z[i] = f2bf(gelu_tanh(Yf[i] + Yr[i] + P.in[15][j * 1024 + c] * bf2f(HX[i]))); }
}
__global__ __launch_bounds__(256) void n_build(Ptrs P, int li) {
    __shared__ int base[33];
    const unsigned* cnt = (const unsigned*)(P.ws + WS_CTL) + CW_CNT + li * 32 * CS; int* tileexp = (int*)(P.ws + WS_TILEEXP); int* slotrow = (int*)(P.ws + WS_SLOTROW); const int* list = (const int*)(P.ws + WS_LIST);
    if (threadIdx.x == 0) { int a = 0; for (int e = 0; e < 32; ++e) { base[e] = a; a += (int)((cnt[e * CS] + 255u) / 256u); } base[32] = a; tileexp[512] = a; }
    __syncthreads();
    for (int e = 0; e < 32; ++e) { const int nt = base[e + 1] - base[e];
        for (int t = threadIdx.x; t < nt; t += 256) tileexp[base[e] + t] = e;
        for (int s = threadIdx.x; s < nt * 256; s += 256) slotrow[base[e] * 256 + s] = s < (int)cnt[e * CS] ? list[(size_t)e * T + s] : -1; }
}
__global__ __launch_bounds__(256) void n_post_act2(Ptrs P, u16* ACT) {
    const float* TMP = (const float*)(P.ws + WS_NTMP); const int ntot = ((const int*)(P.ws + WS_TILEEXP))[512];
    for (size_t i = (size_t)blockIdx.x * 256 + threadIdx.x; i < (size_t)ntot * 256 * 512; i += (size_t)gridDim.x * 256) { const size_t gs = i >> 9; const int c = (int)(i & 511);
        ACT[i] = f2bf(silu_f(TMP[gs * 1024 + c]) * TMP[gs * 1024 + 512 + c]); }
}
__global__ __launch_bounds__(256) void n_post_y(Ptrs P) {
    const float* TMP = (const float*)(P.ws + WS_NTMP); u16* YB = (u16*)(P.ws + WS_YB); const int ntot = ((const int*)(P.ws + WS_TILEEXP))[512];
    for (size_t i = (size_t)blockIdx.x * 256 + threadIdx.x; i < (size_t)ntot * 256 * 1024; i += (size_t)gridDim.x * 256) YB[i] = f2bf(TMP[i]);
}

#define LAS __attribute__((address_space(3)))
typedef short bf16x8 __attribute__((ext_vector_type(8)));
typedef float f32x4 __attribute__((ext_vector_type(4)));
typedef unsigned u32x4 __attribute__((ext_vector_type(4)));
typedef unsigned u32x2 __attribute__((ext_vector_type(2)));
namespace g8 {
constexpr int BM = 256, BK = 64, HALF = 128, HTB = HALF * BK * 2, STAGE_BYTES = 8 * HTB, NXCD = 8, WGM = 8;
__host__ __device__ __forceinline__ int lds_byte(int r, int c) { const int st = (r >> 4) * 2 + (c >> 5), rr = r & 15, cc = c & 31, ob = rr * 64 + cc * 2; return st * 1024 + (ob ^ (((ob >> 9) & 1) << 5)); }
__host__ __device__ __forceinline__ void stage_rc(int b, int& R, int& C) { const int st = b / 1024, sb = b % 1024, swz = sb ^ (((sb >> 9) & 1) << 5); R = (st >> 1) * 16 + swz / 64; C = (st & 1) * 32 + (swz % 64) / 2; }
__host__ __device__ __forceinline__ int perm32(int rho) { const int n = rho >> 4, i = rho & 15; return 8 * (i >> 2) + 4 * n + (i & 3); }
struct Unit { int pm, pn, aux; };
struct Order {
    int nM, nN, nwg, G, c;
    __device__ __forceinline__ void init(int nM_, int nN_, int G_, int c_) { nM = nM_; nN = nN_; nwg = nM * nN; G = G_; c = c_; }
    __device__ __forceinline__ bool next(int i, int& pm, int& pn) const {
        const long L = (long)i * G + c; if (L >= nwg) return false;
        int wgid = (int)L; { const int q = nwg / NXCD, r = nwg % NXCD, xcd = wgid % NXCD, off = wgid / NXCD; wgid = (xcd < r ? xcd * (q + 1) : r * (q + 1) + (xcd - r) * q) + off; }
        const int nig = WGM * nN, gid = wgid / nig, fm = gid * WGM, gsz = (nM - fm) < WGM ? (nM - fm) : WGM;
        pm = fm + ((wgid % nig) % gsz); pn = (wgid % nig) / gsz; return true;
    }
};
__device__ __forceinline__ unsigned cvt_pk_bf16(float lo, float hi) { unsigned r; asm volatile("v_cvt_pk_bf16_f32 %0, %1, %2" : "=v"(r) : "v"(lo), "v"(hi)); return r; }

template <class Epi, class Sched>
__device__ __forceinline__ void gemm_phase(LAS unsigned char* lds, const int K, const Sched& S, const Epi& E, const int wv) {
    const int tid = tid_opaque(wv), wid = wv, lane = tid & 63, wr = wid >> 2, wc = wid & 3, fr = lane & 15, fq = lane >> 4;
    const int nt = K / BK;
    int R0, C0; stage_rc(tid * 16, R0, C0);
    unsigned voffB[2];
    { const int Rb0 = Epi::PERM ? ((R0 & ~31) + perm32(R0 & 31)) : R0;
      voffB[0] = (unsigned)(Rb0 * K + C0) * 2u; voffB[1] = voffB[0] + (unsigned)(64 * K) * 2u; }
    const size_t kstepB = (size_t)(BK * 2), hstepB = (size_t)HALF * K * 2;
    const size_t kstepA = S.a_kstep();
    const unsigned ldsw = (unsigned)wid * 1024u;
    const int aoff = lds_byte(wr * 64 + fr, fq * 8), boff = lds_byte(wc * 32 + fr, fq * 8);
#define G8_SA(b, h) (((b) * 2 + (h)) * HTB)
#define G8_SB(b, h) ((4 + (b) * 2 + (h)) * HTB)
#define G8_STAGE_B(bufoff, gbase) do { _Pragma("unroll") for (int _i = 0; _i < 2; ++_i) \
        __builtin_amdgcn_global_load_lds((const unsigned*)((const char*)(gbase) + voffB[_i]), (LAS unsigned*)(lds + (bufoff) + ldsw + _i * 8192), 16, 0, 0); } while (0)
#define G8_VI(h, i) ((Sched::NV == 1) ? 0 : ((h) * 2 + (i)))
#define G8_STAGE_A(bufoff, U, V, h, kb) do { \
        __builtin_amdgcn_global_load_lds((const unsigned*)(S.a_uptr(U, h, 0) + (size_t)(kb) + (V)[G8_VI(h, 0)]), (LAS unsigned*)(lds + (bufoff) + ldsw), 16, 0, 0); \
        __builtin_amdgcn_global_load_lds((const unsigned*)(S.a_uptr(U, h, 1) + (size_t)(kb) + (V)[G8_VI(h, 1)]), (LAS unsigned*)(lds + (bufoff) + ldsw + 8192), 16, 0, 0); } while (0)
#define G8_LDA(dst, b, h) do { _Pragma("unroll") for (int m = 0; m < 4; ++m) _Pragma("unroll") for (int k = 0; k < 2; ++k) dst[m][k] = *(const LAS bf16x8*)(lds + G8_SA(b, h) + aoff + m * 2048 + k * 1024); } while (0)
#define G8_LDB(dst, b, h) do { _Pragma("unroll") for (int n = 0; n < 2; ++n) _Pragma("unroll") for (int k = 0; k < 2; ++k) dst[n][k] = *(const LAS bf16x8*)(lds + G8_SB(b, h) + boff + n * 2048 + k * 1024); } while (0)
#define G8_MMA(ai, bj, At, Bt) do { __builtin_amdgcn_s_setprio(1); _Pragma("unroll") for (int m = 0; m < 4; ++m) _Pragma("unroll") for (int n = 0; n < 2; ++n) _Pragma("unroll") for (int k = 0; k < 2; ++k) \
        acc[ai][bj][m][n] = __builtin_amdgcn_mfma_f32_16x16x32_bf16(Bt[n][k], At[m][k], acc[ai][bj][m][n], 0, 0, 0); __builtin_amdgcn_s_setprio(0); } while (0)
#define G8_WAIT_V(n) asm volatile("s_waitcnt vmcnt(" #n ")" ::: "memory")
#define G8_WAIT_L(n) asm volatile("s_waitcnt lgkmcnt(" #n ")" ::: "memory")
#define G8_BAR __builtin_amdgcn_s_barrier()
#define G8_SCHED __builtin_amdgcn_sched_barrier(0)
    Unit cur, nxt; int ui = 0;
    if (!S.next(0, cur)) return;
    f32x4 acc[2][2][4][2];
#pragma unroll
    for (int a = 0; a < 2; ++a)
#pragma unroll
        for (int b = 0; b < 2; ++b)
#pragma unroll
            for (int m = 0; m < 4; ++m)
#pragma unroll
                for (int n = 0; n < 2; ++n) acc[a][b][m][n] = (f32x4){0.f, 0.f, 0.f, 0.f};
    bf16x8 At[4][2], B0[2][2], B1[2][2];
    unsigned cO[4], nO[4];
    S.a_voff(cur, R0, C0, cO);
    const char* cB = S.b_ptr(cur);
    G8_STAGE_B(G8_SB(0, 0), cB); G8_STAGE_A(G8_SA(0, 0), cur, cO, 0, 0); G8_STAGE_B(G8_SB(0, 1), cB + hstepB); G8_STAGE_A(G8_SA(0, 1), cur, cO, 1, 0);
    if (wr == 1) G8_BAR;
    G8_WAIT_V(4); G8_BAR;
    G8_STAGE_B(G8_SB(1, 0), cB + kstepB); G8_STAGE_A(G8_SA(1, 0), cur, cO, 0, kstepA); G8_STAGE_B(G8_SB(1, 1), cB + hstepB + kstepB);
    G8_WAIT_V(6); G8_BAR;
    for (;;) {
        const bool has_next = S.next(ui + 1, nxt);
        const char* nB = cB;
        if (has_next) { S.a_voff(nxt, R0, C0, nO); nB = S.b_ptr(nxt); }
        else { nxt = cur;
#pragma unroll
            for (int q = 0; q < 4; ++q) nO[q] = cO[q]; }
        for (int t = 0; t < nt; t += 2) {
            const bool last = (t == nt - 2);
            const size_t k1 = (size_t)(t + 1) * kstepA;
            const size_t k2 = last ? 0 : (size_t)(t + 2) * kstepA, k3 = k2 + kstepA;
            unsigned pV[4]; g8::Unit pU;
            if (last) { pU = nxt; pV[0] = nO[0]; pV[1] = nO[1]; pV[2] = nO[2]; pV[3] = nO[3]; } else { pU = cur; pV[0] = cO[0]; pV[1] = cO[1]; pV[2] = cO[2]; pV[3] = cO[3]; }
            const char* b2 = last ? nB : cB + (size_t)(t + 2) * kstepB; const char* b3 = b2 + kstepB;
            G8_LDB(B0, 0, 0); G8_SCHED; G8_LDA(At, 0, 0); G8_STAGE_A(G8_SA(1, 1), cur, cO, 1, k1);
            G8_WAIT_L(8); G8_BAR; G8_WAIT_L(0); G8_MMA(0, 0, At, B0); G8_BAR; G8_SCHED;
            G8_LDB(B1, 0, 1); G8_STAGE_B(G8_SB(0, 0), b2);
            G8_BAR; G8_WAIT_L(0); G8_MMA(0, 1, At, B1); G8_BAR;
            G8_LDA(At, 0, 1); G8_STAGE_A(G8_SA(0, 0), pU, pV, 0, k2);
            G8_BAR; G8_WAIT_L(0); G8_MMA(1, 0, At, B0); G8_BAR; G8_SCHED;
            G8_STAGE_B(G8_SB(0, 1), b2 + hstepB);
            G8_WAIT_V(6); G8_BAR; G8_MMA(1, 1, At, B1); G8_BAR;
            G8_LDB(B0, 1, 0); G8_SCHED; G8_LDA(At, 1, 0); G8_STAGE_A(G8_SA(0, 1), pU, pV, 1, k2);
            G8_WAIT_L(8); G8_BAR; G8_WAIT_L(0); G8_MMA(0, 0, At, B0); G8_BAR; G8_SCHED;
            G8_LDB(B1, 1, 1); G8_STAGE_B(G8_SB(1, 0), b3);
            G8_BAR; G8_WAIT_L(0); G8_MMA(0, 1, At, B1); G8_BAR;
            G8_LDA(At, 1, 1); G8_STAGE_A(G8_SA(1, 0), pU, pV, 0, k3);
            G8_BAR; G8_WAIT_L(0); G8_MMA(1, 0, At, B0); G8_BAR; G8_SCHED;
            G8_STAGE_B(G8_SB(1, 1), b3 + hstepB);
            G8_WAIT_V(6); G8_BAR; G8_MMA(1, 1, At, B1); G8_BAR;
        }
        E(acc, cur, wr, wc, fr, fq);
        if (!has_next) break;
#pragma unroll
        for (int a = 0; a < 2; ++a)
#pragma unroll
            for (int b = 0; b < 2; ++b)
#pragma unroll
                for (int m = 0; m < 4; ++m)
#pragma unroll
                    for (int n = 0; n < 2; ++n) acc[a][b][m][n] = (f32x4){0.f, 0.f, 0.f, 0.f};
        cur = nxt; cB = nB; ++ui;
#pragma unroll
        for (int q = 0; q < 4; ++q) cO[q] = nO[q];
    }
    G8_WAIT_V(0);
    if (wr == 0) G8_BAR;
    G8_BAR;
#undef G8_SA
#undef G8_SB
#undef G8_STAGE_A
#undef G8_VI
#undef G8_STAGE_B
#undef G8_LDA
#undef G8_LDB
#undef G8_MMA
#undef G8_WAIT_V
#undef G8_WAIT_L
#undef G8_BAR
#undef G8_SCHED
}
}
struct SchedDense {
    g8::Order ord; const char* A; unsigned lda2; const char* Bt; int K;
    __device__ __forceinline__ void init(const void* A_, int lda, const void* Bt_, int M, int N, int K_) { A = (const char*)A_; lda2 = (unsigned)lda * 2u; Bt = (const char*)Bt_; K = K_; ord.init(M / 256, N / 256, (int)gridDim.x, (int)blockIdx.x); }
    __device__ __forceinline__ bool next(int i, g8::Unit& u) const { u.aux = 0; return ord.next(i, u.pm, u.pn); }
    static constexpr int NV = 1;
    __device__ __forceinline__ size_t a_kstep() const { return 128; }
    __device__ __forceinline__ const char* a_uptr(const g8::Unit& u, int h, int i) const { return A + (size_t)(u.pm * 256 + h * 128 + i * 64) * lda2; }
    __device__ __forceinline__ void a_voff(const g8::Unit& u, int R0, int C0, unsigned (&o)[4]) const { o[0] = (unsigned)R0 * lda2 + C0 * 2; }
    __device__ __forceinline__ const char* b_ptr(const g8::Unit& u) const { return Bt + (size_t)u.pn * 256 * K * 2; }
};
struct SchedS5 {
    g8::Order ord; const char* A; const char* W; int K;
    __device__ __forceinline__ void init(const void* A_, const void* W_, int K_) { A = (const char*)A_; W = (const char*)W_; K = K_; ord.init(576, 1, (int)gridDim.x, (int)blockIdx.x); }
    __device__ __forceinline__ bool next(int i, g8::Unit& u) const { int pmx, pn; if (!ord.next(i, pmx, pn)) return false; u.aux = pmx / 9; u.pm = pmx % 9; u.pn = 0; return true; }
    static constexpr int NV = 1;
    __device__ __forceinline__ size_t a_kstep() const { return 128; }
    __device__ __forceinline__ const char* a_uptr(const g8::Unit& u, int h, int i) const { return A + (size_t)(u.aux * 2304 + u.pm * 256 + h * 128 + i * 64) * 1024; }
    __device__ __forceinline__ void a_voff(const g8::Unit& u, int R0, int C0, unsigned (&o)[4]) const { o[0] = (unsigned)R0 * 1024u + C0 * 2; }
    __device__ __forceinline__ const char* b_ptr(const g8::Unit& u) const { return W + (size_t)u.aux * 256 * K * 2; }
};
template <bool GATHER> struct SchedMoe {
    g8::Order ord; const char* A; const char* W; int K; const int* sbase; const unsigned* cnt; const int* list; size_t wstride;
    __device__ __forceinline__ void init(const void* A_, const void* W_, int K_, const int* sbase_, const unsigned* cnt_, const int* list_) {
        A = (const char*)A_; W = (const char*)W_; K = K_; sbase = sbase_; cnt = cnt_; list = list_; wstride = (size_t)1024 * K * 2; ord.init(sbase_[32], 4, (int)gridDim.x, (int)blockIdx.x); }
    __device__ __forceinline__ bool next(int i, g8::Unit& u) const { if (!ord.next(i, u.pm, u.pn)) return false; int e = 0;
        for (int k = 1; k < 32; ++k) e = (u.pm >= sbase[k]) ? k : e;
        u.aux = e; return true; }
    static constexpr int NV = GATHER ? 4 : 1;
    __device__ __forceinline__ size_t a_kstep() const { return 128; }
    __device__ __forceinline__ const char* a_uptr(const g8::Unit& u, int h, int i) const { return GATHER ? A : A + (size_t)(u.pm * 256 + h * 128 + i * 64) * 1024; }
    __device__ __forceinline__ void a_voff(const g8::Unit& u, int R0, int C0, unsigned (&o)[4]) const {
        if (GATHER) {
            const int e = u.aux; const int s0 = (u.pm - sbase[e]) * 256 + R0; const int n = (int)cnt[e * CS]; const int* l = list + (size_t)e * T;
#pragma unroll
            for (int q = 0; q < 4; ++q) { const int a = s0 + q * 64; o[q] = (unsigned)l[a < n ? a : 0] * 2048u + C0 * 2; }
        } else o[0] = (unsigned)R0 * 1024u + C0 * 2; }
    __device__ __forceinline__ const char* b_ptr(const g8::Unit& u) const { return W + (size_t)u.aux * wstride + (size_t)u.pn * 256 * K * 2; }
};

#define EPI_LOOP_AM for (int ai = 0; ai < 2; ++ai) _Pragma("unroll") for (int m = 0; m < 4; ++m)
struct EpiS5a {
    static constexpr bool PERM = true; u16* S;
    __device__ __forceinline__ void operator()(const f32x4 (&acc)[2][2][4][2], const g8::Unit& u, int wr, int wc, int fr, int fq) const {
        u16* base = S + ((size_t)u.aux * 2304 + (size_t)u.pm * 256 + wr * 64 + fr) * 256 + wc * 32 + 8 * fq;
#pragma unroll
        EPI_LOOP_AM { u16* rowp = base + (size_t)(ai * 128 + m * 16) * 256;
#pragma unroll
            for (int bj = 0; bj < 2; ++bj) { const f32x4 a0 = acc[ai][bj][m][0], a1 = acc[ai][bj][m][1];
                u32x4 w; w.x = g8::cvt_pk_bf16(a0[0], a0[1]); w.y = g8::cvt_pk_bf16(a0[2], a0[3]); w.z = g8::cvt_pk_bf16(a1[0], a1[1]); w.w = g8::cvt_pk_bf16(a1[2], a1[3]);
                *(u32x4*)(rowp + bj * 128) = w; } }
    }
};
struct EpiS5b {
    static constexpr bool PERM = true; u16* Z;
    __device__ __forceinline__ void operator()(const f32x4 (&acc)[2][2][4][2], const g8::Unit& u, int wr, int wc, int fr, int fq) const {
        const int g = u.aux; const int ch0 = (fq & 1) * 8;
#pragma unroll
        EPI_LOOP_AM { const int rowin = u.pm * 256 + ai * 128 + wr * 64 + m * 16 + fr;
#pragma unroll
            for (int bj = 0; bj < 2; ++bj) { const int c0 = bj * 128 + wc * 32 + fq * 8; const int t = c0 >> 4;
                const f32x4 a0 = acc[ai][bj][m][0], a1 = acc[ai][bj][m][1];
                u32x4 w; w.x = g8::cvt_pk_bf16(gelu_tanh(a0[0]), gelu_tanh(a0[1])); w.y = g8::cvt_pk_bf16(gelu_tanh(a0[2]), gelu_tanh(a0[3]));
                w.z = g8::cvt_pk_bf16(gelu_tanh(a1[0]), gelu_tanh(a1[1])); w.w = g8::cvt_pk_bf16(gelu_tanh(a1[2]), gelu_tanh(a1[3]));
                *(u32x4*)(Z + ((size_t)rowin * 16 + t) * 1024 + g * 16 + ch0) = w; } }
    }
};
struct EpiGlu {
    static constexpr bool PERM = true; u16* DL; const float* mod; int li;
    __device__ __forceinline__ void operator()(const f32x4 (&acc)[2][2][4][2], const g8::Unit& u, int wr, int wc, int fr, int fq) const {
        const int r = (u.pm % 9 == 0) ? 16 : u.pm / 9; const float* gate = mod + (size_t)(li * 17 + r) * 6144 + 2048;
        const int j0 = u.pn * 128 + wc * 32 + fq * 8;
        const f32x4 g0 = *(const f32x4*)(gate + j0), g1 = *(const f32x4*)(gate + j0 + 4);
#pragma unroll
        EPI_LOOP_AM { const size_t row = (size_t)u.pm * 256 + ai * 128 + wr * 64 + m * 16 + fr;
            const f32x4 v0 = acc[ai][0][m][0], v1 = acc[ai][0][m][1], t0 = acc[ai][1][m][0], t1 = acc[ai][1][m][1];
            u32x4 w; w.x = g8::cvt_pk_bf16(g0[0] * v0[0] * sigmoid_f(t0[0]), g0[1] * v0[1] * sigmoid_f(t0[1])); w.y = g8::cvt_pk_bf16(g0[2] * v0[2] * sigmoid_f(t0[2]), g0[3] * v0[3] * sigmoid_f(t0[3]));
            w.z = g8::cvt_pk_bf16(g1[0] * v1[0] * sigmoid_f(t1[0]), g1[1] * v1[1] * sigmoid_f(t1[1])); w.w = g8::cvt_pk_bf16(g1[2] * v1[2] * sigmoid_f(t1[2]), g1[3] * v1[3] * sigmoid_f(t1[3]));
            *(u32x4*)(DL + row * 1024 + j0) = w; }
    }
};
struct EpiF32 {
    static constexpr bool PERM = false; float* C; int ldc;
    __device__ __forceinline__ void operator()(const f32x4 (&acc)[2][2][4][2], const g8::Unit& u, int wr, int wc, int fr, int fq) const {
        float* base = C + ((size_t)u.pm * 256 + wr * 64 + fr) * ldc + u.pn * 256 + wc * 32 + 4 * fq;
#pragma unroll
        EPI_LOOP_AM { float* rowp = base + (size_t)(ai * 128 + m * 16) * ldc;
#pragma unroll
            for (int bj = 0; bj < 2; ++bj)
#pragma unroll
                for (int n = 0; n < 2; ++n) *(f32x4*)(rowp + bj * 128 + n * 16) = acc[ai][bj][m][n]; }
    }
};
__device__ __forceinline__ float rstd_from_ps(const float* PS, size_t row, int first4, int n4, float inv_n) {
    float s = 0.f;
#pragma unroll
    for (int q = 0; q < 3; ++q) if (q < n4) { const f32x4 v = *(const f32x4*)(PS + row * 24 + (first4 + q) * 4); s += (v[0] + v[1]) + (v[2] + v[3]); }
    return rsqrtf(s * inv_n + EPS);
}
struct EpiWin {
    static constexpr bool PERM = false; u16* CQ; u16* CKV; u16* KT; float* PS; const float2* rope;
    __device__ __forceinline__ void operator()(const f32x4 (&acc)[2][2][4][2], const g8::Unit& u, int wr, int wc, int fr, int fq) const {
        const int b = u.pm / 9, pt = u.pm % 9; const int lane = fr + 16 * fq;
#pragma unroll
        EPI_LOOP_AM { const int pos = pt * 256 + ai * 128 + wr * 64 + m * 16 + fr; const size_t row = (size_t)u.pm * 256 + ai * 128 + wr * 64 + m * 16 + fr;
#pragma unroll
            for (int bj = 0; bj < 2; ++bj) { const f32x4 a0 = acc[ai][bj][m][0], a1 = acc[ai][bj][m][1]; const int cg = u.pn * 256 + bj * 128;
                if (cg < 640) {
                    float s = (a0[0] * a0[0] + a0[1] * a0[1]) + (a0[2] * a0[2] + a0[3] * a0[3]) + (a1[0] * a1[0] + a1[1] * a1[1]) + (a1[2] * a1[2] + a1[3] * a1[3]);
                    s += __int_as_float(__builtin_amdgcn_ds_bpermute((lane ^ 16) << 2, __float_as_int(s))); s += __int_as_float(__builtin_amdgcn_ds_bpermute((lane ^ 32) << 2, __float_as_int(s)));
                    if (fq == 0) PS[row * 24 + (u.pn * 2 + bj) * 4 + wc] = s;
                    u16* dst = cg < 384 ? CQ + row * QR + cg + wc * 32 + fq * 4 : CKV + row * KVR + (cg - 384) + wc * 32 + fq * 4;
                    u32x2 w0, w1; w0.x = g8::cvt_pk_bf16(a0[0], a0[1]); w0.y = g8::cvt_pk_bf16(a0[2], a0[3]); w1.x = g8::cvt_pk_bf16(a1[0], a1[1]); w1.y = g8::cvt_pk_bf16(a1[2], a1[3]);
                    *(u32x2*)dst = w0; *(u32x2*)(dst + 16) = w1;
                } else if (wc < 2) {
                    f32x4 x0 = a0, x1 = a1;
                    if (pos >= CTXL) { const float2* rp = rope + (size_t)(pos - CTXL) * 32 + wc * 16 + fq * 4;
#pragma unroll
                        for (int q = 0; q < 4; ++q) { const float2 cs = rp[q]; x0[q] = a0[q] * cs.x - a1[q] * cs.y; x1[q] = a1[q] * cs.x + a0[q] * cs.y; } }
                    u32x2 w0, w1; w0.x = g8::cvt_pk_bf16(x0[0], x0[1]); w0.y = g8::cvt_pk_bf16(x0[2], x0[3]); w1.x = g8::cvt_pk_bf16(x1[0], x1[1]); w1.y = g8::cvt_pk_bf16(x1[2], x1[3]);
#pragma unroll
                    for (int h = 0; h < NH; ++h) { u16* dst = KT + ((((size_t)b * NH + h) * 6 + 4 + wc) * LTOT + pos) * 32 + fq * 4; *(u32x2*)dst = w0; *(u32x2*)(dst + 16) = w1; }
                } } }
    }
};
struct EpiQ {
    static constexpr bool PERM = false; u16* QT; const float2* rope; const float* PS; int dry;
    __device__ __forceinline__ void operator()(const f32x4 (&acc)[2][2][4][2], const g8::Unit& u, int wr, int wc, int fr, int fq) const {
        if (dry) return;
        const int b = u.pm / 9, pt = u.pm % 9;
#pragma unroll
        EPI_LOOP_AM { const int pos = pt * 256 + ai * 128 + wr * 64 + m * 16 + fr; const float scale = 0.07216878364870322f * rstd_from_ps(PS, (size_t)u.pm * 256 + ai * 128 + wr * 64 + m * 16 + fr, 0, 3, 1.f / 384.f);
#pragma unroll
            for (int bj = 0; bj < 2; ++bj) { const int g32 = u.pn * 8 + bj * 4 + wc; const int h = g32 / 6, part = g32 % 6;
                f32x4 a = acc[ai][bj][m][0], bq = acc[ai][bj][m][1];
                if (part >= 4 && pos >= CTXL) { const float2* rp = rope + (size_t)(pos - CTXL) * 32 + (part - 4) * 16 + fq * 4;
#pragma unroll
                    for (int q = 0; q < 4; ++q) { const float2 cs = rp[q]; const float x0 = a[q], x1 = bq[q]; a[q] = x0 * cs.x - x1 * cs.y; bq[q] = x1 * cs.x + x0 * cs.y; } }
                u16* dst = QT + ((((size_t)b * NH + h) * 6 + part) * LTOT + pos) * 32 + fq * 4;
                u32x2 w0, w1; w0.x = g8::cvt_pk_bf16(a[0] * scale, a[1] * scale); w0.y = g8::cvt_pk_bf16(a[2] * scale, a[3] * scale);
                w1.x = g8::cvt_pk_bf16(bq[0] * scale, bq[1] * scale); w1.y = g8::cvt_pk_bf16(bq[2] * scale, bq[3] * scale);
                *(u32x2*)dst = w0; *(u32x2*)(dst + 16) = w1; } }
    }
};
struct EpiKV {
    static constexpr bool PERM = true; u16* KT; u16* VT; const float* PS; int dry;
    __device__ __forceinline__ void operator()(const f32x4 (&acc)[2][2][4][2], const g8::Unit& u, int wr, int wc, int fr, int fq) const {
        if (dry) return;
        const int b = u.pm / 9, pt = u.pm % 9, h = u.pn;
#pragma unroll
        EPI_LOOP_AM { const int pos = pt * 256 + ai * 128 + wr * 64 + m * 16 + fr; const size_t bh = (size_t)b * NH + h; const float rs = rstd_from_ps(PS, (size_t)u.pm * 256 + ai * 128 + wr * 64 + m * 16 + fr, 3, 2, 1.f / 256.f);
#pragma unroll
            for (int bj = 0; bj < 2; ++bj) { const f32x4 a0 = acc[ai][bj][m][0] * rs, a1 = acc[ai][bj][m][1] * rs;
                u32x4 w; w.x = g8::cvt_pk_bf16(a0[0], a0[1]); w.y = g8::cvt_pk_bf16(a0[2], a0[3]); w.z = g8::cvt_pk_bf16(a1[0], a1[1]); w.w = g8::cvt_pk_bf16(a1[2], a1[3]);
                u16* dst = bj == 0 ? KT + ((bh * 6 + wc) * LTOT + pos) * 32 + fq * 8 : VT + ((bh * 4 + wc) * LTOT + pos) * 32 + fq * 8;
                *(u32x4*)dst = w; } }
    }
};
struct EpiWo {
    static constexpr bool PERM = true; u16* DL; const float* mod; int li;
    __device__ __forceinline__ void operator()(const f32x4 (&acc)[2][2][4][2], const g8::Unit& u, int wr, int wc, int fr, int fq) const {
        const int r = (u.pm % 9 == 0) ? 16 : u.pm / 9; const float* gate = mod + (size_t)(li * 17 + r) * 6144 + 2048;
        f32x4 gg[2][2];
#pragma unroll
        for (int bj = 0; bj < 2; ++bj)
#pragma unroll
            for (int n = 0; n < 2; ++n) gg[bj][n] = *(const f32x4*)(gate + u.pn * 256 + bj * 128 + wc * 32 + fq * 8 + n * 4);
#pragma unroll
        EPI_LOOP_AM { const size_t row = (size_t)u.pm * 256 + ai * 128 + wr * 64 + m * 16 + fr;
#pragma unroll
            for (int bj = 0; bj < 2; ++bj) { const f32x4 a0 = acc[ai][bj][m][0] * gg[bj][0], a1 = acc[ai][bj][m][1] * gg[bj][1];
                u32x4 w; w.x = g8::cvt_pk_bf16(a0[0], a0[1]); w.y = g8::cvt_pk_bf16(a0[2], a0[3]); w.z = g8::cvt_pk_bf16(a1[0], a1[1]); w.w = g8::cvt_pk_bf16(a1[2], a1[3]);
                *(u32x4*)(DL + row * 1024 + u.pn * 256 + bj * 128 + wc * 32 + fq * 8) = w; } }
    }
};
struct EpiMoe1 {
    static constexpr bool PERM = true; u16* ACT;
    __device__ __forceinline__ void operator()(const f32x4 (&acc)[2][2][4][2], const g8::Unit& u, int wr, int wc, int fr, int fq) const {
        const int j0 = u.pn * 128 + wc * 32 + fq * 8;
#pragma unroll
        EPI_LOOP_AM { const size_t gs = (size_t)u.pm * 256 + ai * 128 + wr * 64 + m * 16 + fr;
            const f32x4 g0 = acc[ai][0][m][0], g1 = acc[ai][0][m][1], u0 = acc[ai][1][m][0], u1 = acc[ai][1][m][1];
            u32x4 w; w.x = g8::cvt_pk_bf16(silu_f(g0[0]) * u0[0], silu_f(g0[1]) * u0[1]); w.y = g8::cvt_pk_bf16(silu_f(g0[2]) * u0[2], silu_f(g0[3]) * u0[3]);
            w.z = g8::cvt_pk_bf16(silu_f(g1[0]) * u1[0], silu_f(g1[1]) * u1[1]); w.w = g8::cvt_pk_bf16(silu_f(g1[2]) * u1[2], silu_f(g1[3]) * u1[3]);
            *(u32x4*)(ACT + gs * 512 + j0) = w; }
    }
};
struct EpiMoe2 {
    static constexpr bool PERM = true; u16* YB;
    __device__ __forceinline__ void operator()(const f32x4 (&acc)[2][2][4][2], const g8::Unit& u, int wr, int wc, int fr, int fq) const {
#pragma unroll
        EPI_LOOP_AM { const size_t gs = (size_t)u.pm * 256 + ai * 128 + wr * 64 + m * 16 + fr;
#pragma unroll
            for (int bj = 0; bj < 2; ++bj) { const f32x4 a0 = acc[ai][bj][m][0], a1 = acc[ai][bj][m][1];
                u32x4 w; w.x = g8::cvt_pk_bf16(a0[0], a0[1]); w.y = g8::cvt_pk_bf16(a0[2], a0[3]); w.z = g8::cvt_pk_bf16(a1[0], a1[1]); w.w = g8::cvt_pk_bf16(a1[2], a1[3]);
                *(u32x4*)(YB + gs * 1024 + u.pn * 256 + bj * 128 + wc * 32 + fq * 8) = w; } }
    }
};
namespace at {
typedef short s16x4 __attribute__((ext_vector_type(4)));
typedef float f32x16 __attribute__((ext_vector_type(16)));
constexpr int KVBLK = 64, QBLK = 32, NW = 8;
constexpr int SHM_V = KVBLK * 128 * 2, SHM_K = KVBLK * QKD * 2, NBUF = 3, SHM_ATTN = NBUF * SHM_V + NBUF * SHM_K + NW * 64 * 4;
constexpr float SCALE = 1.0f;
constexpr float THR = 8.f;
#define KSWZ(row, colB) ((row) * 384 + ((colB) ^ (((row) & 7) << 4)))
#define SBAR() __builtin_amdgcn_sched_barrier(0)
__device__ __forceinline__ int crow(int r, int hi) { return (r & 3) + 8 * (r >> 2) + 4 * hi; }
__device__ __forceinline__ unsigned cvtpk(float lo, float hi) { unsigned r; asm volatile("v_cvt_pk_bf16_f32 %0, %1, %2" : "=v"(r) : "v"(lo), "v"(hi)); return r; }
__device__ __forceinline__ void partialSM(f32x16& p0, f32x16& p1, float& m_reg, float& mn, float& alpha) {
    constexpr float C = SCALE * 1.4426950408889634f;
    float pmax = p0[0];
#pragma unroll
    for (int r = 1; r < 16; ++r) pmax = fmaxf(pmax, p0[r]);
#pragma unroll
    for (int r = 0; r < 16; ++r) pmax = fmaxf(pmax, p1[r]);
    { auto rr = __builtin_amdgcn_permlane32_swap(__float_as_uint(pmax), __float_as_uint(pmax), false, false); pmax = fmaxf(__uint_as_float(rr[0]), __uint_as_float(rr[1])); }
    if (__builtin_expect(__all(pmax - m_reg <= THR / SCALE), 1)) { mn = m_reg; alpha = 1.f; }
    else { mn = fmaxf(m_reg, pmax); alpha = __builtin_amdgcn_exp2f((m_reg - mn) * C); m_reg = mn; }
    const float mnC = -mn * C;
#pragma unroll
    for (int r = 0; r < 16; ++r) p0[r] = fmaf(p0[r], C, mnC);
#pragma unroll
    for (int r = 0; r < 16; ++r) p1[r] = fmaf(p1[r], C, mnC);
#pragma unroll
    for (int r = 0; r < 16; ++r) p0[r] = __builtin_amdgcn_exp2f(p0[r]);
}
__device__ __forceinline__ void finishSM(f32x16& p0, f32x16& p1, float alpha, float& l_reg, bf16x8& pa0, bf16x8& pa1, bf16x8& pa2, bf16x8& pa3) {
#pragma unroll
    for (int r = 0; r < 16; ++r) p1[r] = __builtin_amdgcn_exp2f(p1[r]);
    float ps = 0;
#pragma unroll
    for (int r = 0; r < 16; ++r) ps += p0[r];
#pragma unroll
    for (int r = 0; r < 16; ++r) ps += p1[r];
    { auto rr = __builtin_amdgcn_permlane32_swap(__float_as_uint(ps), __float_as_uint(ps), false, false); ps = __uint_as_float(rr[0]) + __uint_as_float(rr[1]); }
    l_reg = l_reg * alpha + ps;
#define PK4(P, BASE, OUT) do { unsigned a0 = cvtpk(P[BASE + 0], P[BASE + 1]), a1 = cvtpk(P[BASE + 2], P[BASE + 3]);   \
    unsigned b0 = cvtpk(P[BASE + 4], P[BASE + 5]), b1 = cvtpk(P[BASE + 6], P[BASE + 7]);                              \
    auto r0 = __builtin_amdgcn_permlane32_swap(a0, b0, false, false); auto r1 = __builtin_amdgcn_permlane32_swap(a1, b1, false, false); \
    u32x4 w = {r0[0], r1[0], r0[1], r1[1]}; OUT = *reinterpret_cast<bf16x8*>(&w); } while (0)
    PK4(p0, 0, pa0); PK4(p0, 8, pa1); PK4(p1, 0, pa2); PK4(p1, 8, pa3);
#undef PK4
}
#define KRD(x0, x1, kb, a) do { asm volatile("ds_read_b128 %0, %1 offset:%2" : "=v"(x0) : "v"(kb), "i"((a) * 128) : "memory"); \
                                asm volatile("ds_read_b128 %0, %1 offset:%2" : "=v"(x1) : "v"(kb), "i"((a) * 128 + 32 * 384) : "memory"); } while (0)
#define KWT(n, x0, x1) asm volatile("s_waitcnt lgkmcnt(" #n ")" : "+v"(x0), "+v"(x1) :: "memory")
#define KMM(x0, x1, q) do { p0 = __builtin_amdgcn_mfma_f32_32x32x16_bf16(x0, q, p0, 0, 0, 0); p1 = __builtin_amdgcn_mfma_f32_32x32x16_bf16(x1, q, p1, 0, 0, 0); } while (0)
__device__ __forceinline__ void qkt(f32x16& p0, f32x16& p1, int kb0, int kb1, int kb2, int kb3, const bf16x8* qr) {
    p0 = f32x16{}; p1 = f32x16{};
    bf16x8 a0, a1, b0, b1, c0, c1;
    KRD(a0, a1, kb0, 0); KRD(b0, b1, kb1, 0); KRD(c0, c1, kb2, 0);
    KWT(4, a0, a1); KMM(a0, a1, qr[0]);
    KWT(2, b0, b1); KMM(b0, b1, qr[1]);  KRD(a0, a1, kb3, 0);
    KWT(2, c0, c1); KMM(c0, c1, qr[2]);  KRD(b0, b1, kb0, 1);
    KWT(2, a0, a1); KMM(a0, a1, qr[3]);  KRD(c0, c1, kb1, 1);
    KWT(2, b0, b1); KMM(b0, b1, qr[4]);  KRD(a0, a1, kb2, 1);
    KWT(2, c0, c1); KMM(c0, c1, qr[5]);  KRD(b0, b1, kb3, 1);
    KWT(2, a0, a1); KMM(a0, a1, qr[6]);  KRD(c0, c1, kb0, 2);
    KWT(2, b0, b1); KMM(b0, b1, qr[7]);  KRD(a0, a1, kb1, 2);
    KWT(2, c0, c1); KMM(c0, c1, qr[8]);  KRD(b0, b1, kb2, 2);
    KWT(2, a0, a1); KMM(a0, a1, qr[9]);  KRD(c0, c1, kb3, 2);
    KWT(2, b0, b1); KMM(b0, b1, qr[10]);
    KWT(0, c0, c1); KMM(c0, c1, qr[11]);
}
#undef KRD
#undef KWT
#undef KMM
__device__ __forceinline__ int v_st(int k, int c) { const int kk = (k & ~0xC) | ((k & 4) << 1) | ((k & 8) >> 1); return ((kk >> 3) * 4 + (c >> 5)) * 512 + ((kk & 7) * 32 + (c & 31)) * 2; }
__device__ __forceinline__ int v_rd_base(int lane) { return ((lane & 3) << 3) | (((lane >> 2) & 3) << 6) | (((lane >> 4) & 1) << 5) | (((lane >> 5) & 1) << 8); }
constexpr int v_rd_off(int d0, int ks, int half) { return d0 * 512 + ks * 4096 + half * 2048; }
template <int OFF> __device__ __forceinline__ s16x4 tr_read(int vb) { s16x4 r; asm volatile("ds_read_b64_tr_b16 %0, %1 offset:%2" : "=&v"(r) : "v"(vb), "i"(OFF) : "memory"); return r; }
struct VFr { s16x4 l0, h0, l1, h1, l2, h2, l3, h3; };
template <int D0> __device__ __forceinline__ void pv_rd(VFr& f, int vb) {
    f.l0 = tr_read<v_rd_off(D0, 0, 0)>(vb); f.h0 = tr_read<v_rd_off(D0, 0, 1)>(vb); f.l1 = tr_read<v_rd_off(D0, 1, 0)>(vb); f.h1 = tr_read<v_rd_off(D0, 1, 1)>(vb);
    f.l2 = tr_read<v_rd_off(D0, 2, 0)>(vb); f.h2 = tr_read<v_rd_off(D0, 2, 1)>(vb); f.l3 = tr_read<v_rd_off(D0, 3, 0)>(vb); f.h3 = tr_read<v_rd_off(D0, 3, 1)>(vb);
}
#define VWT(n, f) asm volatile("s_waitcnt lgkmcnt(" #n ")" : "+v"(f.l0), "+v"(f.h0), "+v"(f.l1), "+v"(f.h1), "+v"(f.l2), "+v"(f.h2), "+v"(f.l3), "+v"(f.h3) :: "memory")
__device__ __forceinline__ void pv_mm(f32x16& od, const VFr& f, bf16x8 pa0, bf16x8 pa1, bf16x8 pa2, bf16x8 pa3) {
#define PK(L, H) (bf16x8){L[0], L[1], L[2], L[3], H[0], H[1], H[2], H[3]}
    od = __builtin_amdgcn_mfma_f32_32x32x16_bf16(pa0, PK(f.l0, f.h0), od, 0, 0, 0);
    od = __builtin_amdgcn_mfma_f32_32x32x16_bf16(pa1, PK(f.l1, f.h1), od, 0, 0, 0);
    od = __builtin_amdgcn_mfma_f32_32x32x16_bf16(pa2, PK(f.l2, f.h2), od, 0, 0, 0);
    od = __builtin_amdgcn_mfma_f32_32x32x16_bf16(pa3, PK(f.l3, f.h3), od, 0, 0, 0);
#undef PK
}
__device__ __forceinline__ void pv_d0(f32x16* o, int vb, bf16x8 pa0, bf16x8 pa1, bf16x8 pa2, bf16x8 pa3) {
    VFr fa, fb;
    pv_rd<0>(fa, vb);
    pv_rd<1>(fb, vb); VWT(8, fa); pv_mm(o[0], fa, pa0, pa1, pa2, pa3);
    pv_rd<2>(fa, vb); VWT(8, fb); pv_mm(o[1], fb, pa0, pa1, pa2, pa3);
    pv_rd<3>(fb, vb); VWT(8, fa); pv_mm(o[2], fa, pa0, pa1, pa2, pa3);
                      VWT(0, fb); pv_mm(o[3], fb, pa0, pa1, pa2, pa3);
}
#undef VWT
__device__ __forceinline__ void attn_body(const u16* __restrict__ Qb, const u16* __restrict__ Kh, const u16* __restrict__ Vh, u16* __restrict__ Ob, int ldo, int qpos0, int seq, char* lds, LAS unsigned char* ldsl, int wv) {
    const int tid = tid_opaque(wv), wid = wv, lane = tid & 63, r32 = lane & 31, hi = lane >> 5;
    char* V_lds = lds; char* K_lds = lds + NBUF * SHM_V;
    float* ws = (float*)(lds + NBUF * SHM_V + NBUF * SHM_K) + wid * 64; float* li_l = ws; float* al_l = ws + 32;
    float m_reg = -1e30f, l_reg = 0; f32x16 o[4] = {}; bf16x8 qr[12];
    const u16* Qw = Qb + (long)(qpos0 + wid * QBLK + r32) * 32 + hi * 8;
#pragma unroll
    for (int d0 = 0; d0 < 12; ++d0) qr[d0] = *reinterpret_cast<const bf16x8*>(Qw + (long)(d0 >> 1) * (LTOT * 32) + (d0 & 1) * 16);
    unsigned kof[3], vof[2];
#pragma unroll
    for (int i = 0; i < 3; ++i) { const int p = (wid + 8 * i) * 64 + lane, row = p / 24, slot = p % 24; const int colB = (slot * 16) ^ ((row & 7) << 4); kof[i] = (unsigned)((colB >> 6) * (LTOT * 64) + row * 64 + (colB & 63)); }
#pragma unroll
    for (int i = 0; i < 2; ++i) { const int ob = (wid + 8 * i) * 1024 + lane * 16, sub = ob >> 9, within = (ob & 511) >> 1; const int kk = (sub >> 2) * 8 + (within >> 5);
        const int k = (kk & ~0xC) | ((kk & 4) << 1) | ((kk & 8) >> 1), col = (sub & 3) * 32 + (within & 31); vof[i] = (unsigned)((col >> 5) * (LTOT * 64) + k * 64 + (col & 31) * 2); }
    const char* Kg = (const char*)Kh; const char* Vg = (const char*)Vh;
#define DMA(t, bK, bV) do { _Pragma("unroll") for (int i_ = 0; i_ < 3; ++i_) __builtin_amdgcn_global_load_lds((const unsigned*)(Kg + (size_t)(t) * (KVBLK * 64) + kof[i_]), (LAS unsigned*)(ldsl + NBUF * SHM_V + (bK) + (wid + 8 * i_) * 1024), 16, 0, 0); \
    _Pragma("unroll") for (int i_ = 0; i_ < 2; ++i_) __builtin_amdgcn_global_load_lds((const unsigned*)(Vg + (size_t)(t) * (KVBLK * 64) + vof[i_]), (LAS unsigned*)(ldsl + (bV) + (wid + 8 * i_) * 1024), 16, 0, 0); } while (0)
    const int vb0 = (int)(uintptr_t)V_lds + v_rd_base(lane);
    const int kx = (r32 & 7) << 4, kl = (int)(uintptr_t)K_lds + r32 * 384;
    const int kbs0 = kl + ((0 * 32 + hi * 16) ^ kx), kbs1 = kl + ((1 * 32 + hi * 16) ^ kx), kbs2 = kl + ((2 * 32 + hi * 16) ^ kx), kbs3 = kl + ((3 * 32 + hi * 16) ^ kx);
#define RESC(a) do { if (__any((a) < 1.f)) { if (hi == 0) al_l[r32] = (a); asm volatile("s_waitcnt lgkmcnt(0)" ::: "memory"); \
    _Pragma("unroll") for (int d = 0; d < 4; ++d) _Pragma("unroll") for (int r = 0; r < 16; ++r) o[d][r] *= al_l[crow(r, hi)]; } } while (0)
    f32x16 p0, p1; float mn, al; bf16x8 pa0, pa1, pa2, pa3; const int NT = seq / KVBLK;
    int b0 = 0, b1 = 1, b2 = 2;
    DMA(0, 0, 0); DMA(1, SHM_K, SHM_V);
    asm volatile("s_waitcnt vmcnt(5)" ::: "memory"); __builtin_amdgcn_s_barrier(); asm volatile("" ::: "memory");
    for (int j = 0; j < NT; ++j) {
        if (j + 2 < NT) DMA(j + 2, b2 * SHM_K, b2 * SHM_V);
        SBAR(); qkt(p0, p1, kbs0 + b0 * SHM_K, kbs1 + b0 * SHM_K, kbs2 + b0 * SHM_K, kbs3 + b0 * SHM_K, qr);
        partialSM(p0, p1, m_reg, mn, al); RESC(al);
        finishSM(p0, p1, al, l_reg, pa0, pa1, pa2, pa3); SBAR();
        pv_d0(o, vb0 + b0 * SHM_V, pa0, pa1, pa2, pa3);
        if (j + 2 < NT) asm volatile("s_waitcnt vmcnt(5)" ::: "memory"); else asm volatile("s_waitcnt vmcnt(0)" ::: "memory");
        asm volatile("s_waitcnt lgkmcnt(0)" ::: "memory"); __builtin_amdgcn_s_barrier(); asm volatile("" ::: "memory");
        { const int t_ = b0; b0 = b1; b1 = b2; b2 = t_; }
    }
    if (hi == 0) li_l[r32] = l_reg; asm volatile("s_waitcnt lgkmcnt(0)" ::: "memory");
    float rli[16];
#pragma unroll
    for (int r = 0; r < 16; ++r) rli[r] = __builtin_amdgcn_rcpf(li_l[crow(r, hi)]);
    u16* Ow = Ob + (long)(wid * QBLK) * ldo;
#pragma unroll
    for (int r = 0; r < 16; ++r) { const int orow = crow(r, hi);
#pragma unroll
        for (int d0 = 0; d0 < 4; ++d0) Ow[(long)orow * ldo + d0 * 32 + r32] = f2bf(o[d0][r] * rli[r]); }
#undef DMA
#undef RESC
}
#undef KSWZ
#undef SBAR
}
struct NormDst { u16* X; u16* HX; u16* UH; unsigned* cnt; int* list; unsigned char* seli; unsigned char* selw; const float* xin; const float* cin; };
__device__ __forceinline__ NormDst norm_dst_real(unsigned char* ws, int li) {
    NormDst d; d.X = (u16*)(ws + WS_X); d.HX = (u16*)(ws + WS_HX); d.UH = (u16*)(ws + WS_R1 + R1_UH); d.cnt = (unsigned*)(ws + WS_CTL) + CW_CNT + li * 32 * CS; d.list = (int*)(ws + WS_LIST); d.seli = ws + WS_SELI; d.selw = ws + WS_SELW; d.xin = nullptr; d.cin = nullptr; return d; }
__device__ __forceinline__ NormDst norm_dst_dummy(unsigned char* ws) {
    NormDst d; unsigned char* t = ws + WS_NTMP; d.X = (u16*)t; d.HX = (u16*)(t + (size_t)T * D * 4); d.UH = d.HX; d.cnt = (unsigned*)(ws + WS_CTL) + CW_CNT_DUMMY; d.list = (int*)(t + (size_t)T * D * 4 + (size_t)64 * 2304 * 512 * 2);
    d.seli = (unsigned char*)(d.list + (size_t)64 * T); d.selw = d.seli + (size_t)T * 16; d.xin = nullptr; d.cin = nullptr; return d; }
__device__ __forceinline__ float wave_sum_dpp(float v) {
    v += __int_as_float(__builtin_amdgcn_update_dpp(0, __float_as_int(v), 0x111, 0xF, 0xF, true));
    v += __int_as_float(__builtin_amdgcn_update_dpp(0, __float_as_int(v), 0x112, 0xF, 0xF, true));
    v += __int_as_float(__builtin_amdgcn_update_dpp(0, __float_as_int(v), 0x114, 0xF, 0xF, true));
    v += __int_as_float(__builtin_amdgcn_update_dpp(0, __float_as_int(v), 0x118, 0xF, 0xF, true));
    v += __int_as_float(__builtin_amdgcn_update_dpp(0, __float_as_int(v), 0x142, 0xA, 0xF, false));
    v += __int_as_float(__builtin_amdgcn_update_dpp(0, __float_as_int(v), 0x143, 0xC, 0xF, false));
    return __int_as_float(__builtin_amdgcn_readlane(__float_as_int(v), 63));
}
__device__ __forceinline__ float bperm(float v, int srclane) { return __int_as_float(__builtin_amdgcn_ds_bpermute(srclane << 2, __float_as_int(v))); }
template <int MODE>
__device__ __forceinline__ void norm2_rows(unsigned char* ws, float* outp, const NormDst d, int li, int which, int* s_base, char* lds, int wv) {
    const float* sm = (const float*)(ws + WS_SMALL);
    const int tidn = tid_opaque(wv); const int lane = tidn & 63, wave = wv;
    const u16* X = (const u16*)(ws + WS_X);
    const float* mod = (const float*)(ws + WS_MOD);
    float* WG = (float*)lds;
    u16* WE = (u16*)(lds + 16384);
    __syncthreads();
    if (MODE & 1) { if (tidn == 0) { const unsigned* cnt = (const unsigned*)(ws + WS_CTL) + CW_CNT + (li - 1) * 32 * CS; int a = 0; for (int e = 0; e < 32; ++e) { s_base[e] = a; a += (int)((cnt[e * CS] + 255u) / 256u); } s_base[32] = a; } }
    if (MODE & 8) {
        const float* wg = sm + SM_WGROUP + (size_t)li * 4096; const float* we = sm + SM_WEXP + (size_t)li * 32768;
#pragma unroll 2
        for (int k = tidn; k < 1024; k += 512) { const int pk = ((k >> 8) * 4 + (k & 3)) * 64 + ((k >> 2) & 63); *(float4*)(WG + 4 * pk) = *(const float4*)(wg + 4 * k); }
#pragma unroll 8
        for (int i = tidn; i < 4096; i += 512) { const int g = i >> 10, k = i & 1023; const int pk = ((k >> 8) * 4 + (k & 3)) * 64 + ((k >> 2) & 63);
            const float4 v0 = *(const float4*)(we + (size_t)i * 8), v1 = *(const float4*)(we + (size_t)i * 8 + 4);
            u32x4 w; w.x = g8::cvt_pk_bf16(v0.x, v0.y); w.y = g8::cvt_pk_bf16(v0.z, v0.w); w.z = g8::cvt_pk_bf16(v1.x, v1.y); w.w = g8::cvt_pk_bf16(v1.z, v1.w);
            *(u32x4*)(WE + ((size_t)g * 1024 + pk) * 8) = w; }
    }
    __syncthreads();
    const bool lastl = (li == 3);
    const int rstride = 1; const u16* YB = (const u16*)(ws + WS_YB); const u16* DL = (const u16*)(ws + WS_HX);
    float4 vA[4], vB[4]; int4 siA = make_int4(0, 0, 0, 0), siB = siA; float2 swA = make_float2(0.f, 0.f), swB = swA; uint2 dlA[4], dlB[4], yaB[4], ybB[4];
#define NR_LOAD_A(rw) do { if ((rw) < rowend) { if (MODE & 64) { const int b_ = (rw) / LTOT, p_ = (rw) % LTOT; const float* xs_ = p_ < CTXL ? d.cin + ((size_t)b_ * CTXL + p_) * D : d.xin + ((size_t)b_ * SEQ + (p_ - CTXL)) * D; \
            _Pragma("unroll") for (int q = 0; q < 4; ++q) vA[q] = *(const float4*)(xs_ + q * 256 + lane * 4); } \
        else { _Pragma("unroll") for (int q = 0; q < 4; ++q) { const uint2 xb_ = *(const uint2*)(X + (size_t)(rw) * D + q * 256 + lane * 4); vA[q] = make_float4(__uint_as_float(xb_.x << 16), __uint_as_float(xb_.x & 0xffff0000u), __uint_as_float(xb_.y << 16), __uint_as_float(xb_.y & 0xffff0000u)); } } \
        if (MODE & 1) { siA = *(const int4*)(ws + WS_SELI + (size_t)(rw) * 16); swA = *(const float2*)(ws + WS_SELW + (size_t)(rw) * 8); } \
        if (MODE & 32) { _Pragma("unroll") for (int q = 0; q < 4; ++q) dlA[q] = *(const uint2*)(DL + (size_t)(rw) * D + q * 256 + lane * 4); } } } while (0)
#define NR_A_TO_B(rw) do { _Pragma("unroll") for (int q = 0; q < 4; ++q) { vB[q] = vA[q]; dlB[q] = dlA[q]; } siB = siA; swB = swA; \
        if ((MODE & 1) && (rw) < rowend && !((li - 1 == 3) && ((rw) % LTOT) < CTXL)) { const size_t g1 = (size_t)s_base[siB.x] * 256 + siB.y, g2 = (size_t)s_base[siB.z] * 256 + siB.w; \
            _Pragma("unroll") for (int q = 0; q < 4; ++q) { yaB[q] = *(const uint2*)(YB + g1 * 1024 + q * 256 + lane * 4); ybB[q] = *(const uint2*)(YB + g2 * 1024 + q * 256 + lane * 4); } } } while (0)
    const int nwv = gridDim.x * 8, nper = (T + nwv - 1) / nwv; const int row0 = (blockIdx.x * 8 + wave) * nper; const int rowend = row0 + nper < T ? row0 + nper : T;
    NR_LOAD_A(row0); NR_A_TO_B(row0); NR_LOAD_A(row0 + rstride);
    int rec_e1 = 0, rec_e2 = 0, rec_row = -1; float rec_w1 = 0.f, rec_w2 = 0.f; int it = -1;
    float4 gvr[4], shr[4], sclr[4], gater[4]; int rcur = -1;
#pragma unroll
    for (int q = 0; q < 4; ++q) { gvr[q] = *(const float4*)(sm + ((MODE & 16) ? SM_FINALG : (which ? SM_GFFN : SM_GMIX) + li * 1024) + q * 256 + lane * 4); shr[q] = sclr[q] = gater[q] = make_float4(0.f, 0.f, 0.f, 0.f); }
    for (int row = row0; row < rowend; row += rstride) {
        ++it;
        const int b = row / LTOT, pos = row % LTOT; const bool isctx = pos < CTXL; const int r = isctx ? 16 : b;
        if (r != rcur) { rcur = r;
#pragma unroll
            for (int q = 0; q < 4; ++q) { const int c = q * 256 + lane * 4;
                if (!(MODE & 16)) { const float* sh_ = mod + (size_t)(li * 17 + r) * 6144 + (which ? 3 : 0) * 1024; shr[q] = *(const float4*)(sh_ + c); sclr[q] = *(const float4*)(sh_ + 1024 + c); }
                if (MODE & 1) gater[q] = *(const float4*)(mod + (size_t)((li - 1) * 17 + r) * 6144 + 5 * 1024 + c); } }
        float4 v[4]; uint2 ya[4], yb[4], dl[4]; const float2 sw = swB;
#pragma unroll
        for (int q = 0; q < 4; ++q) { v[q] = vB[q]; ya[q] = yaB[q]; yb[q] = ybB[q]; dl[q] = dlB[q]; }
        NR_A_TO_B(row + rstride); NR_LOAD_A(row + 2 * rstride);
        if ((MODE & 16) && isctx) continue;
        if ((MODE & 8) && lastl && isctx) continue;
        if (MODE & 1) {
            const bool skip = (li - 1 == 3) && isctx;
            if (!skip) {
#pragma unroll
                for (int q = 0; q < 4; ++q) { const int c = q * 256 + lane * 4; const float4 gg = gater[q];
                    v[q].x += gg.x * (sw.x * bf2f((u16)(ya[q].x & 0xffff)) + sw.y * bf2f((u16)(yb[q].x & 0xffff)));
                    v[q].y += gg.y * (sw.x * bf2f((u16)(ya[q].x >> 16)) + sw.y * bf2f((u16)(yb[q].x >> 16)));
                    v[q].z += gg.z * (sw.x * bf2f((u16)(ya[q].y & 0xffff)) + sw.y * bf2f((u16)(yb[q].y & 0xffff)));
                    v[q].w += gg.w * (sw.x * bf2f((u16)(ya[q].y >> 16)) + sw.y * bf2f((u16)(yb[q].y >> 16)));
                    if (!(MODE & 16)) { uint2 xw; xw.x = g8::cvt_pk_bf16(v[q].x, v[q].y); xw.y = g8::cvt_pk_bf16(v[q].z, v[q].w); *(uint2*)(d.X + (size_t)row * D + c) = xw; } }
            }
        }
        if (MODE & 32) {
#pragma unroll
            for (int q = 0; q < 4; ++q) { const int c = q * 256 + lane * 4;
                v[q].x += bf2f((u16)(dl[q].x & 0xffff)); v[q].y += bf2f((u16)(dl[q].x >> 16)); v[q].z += bf2f((u16)(dl[q].y & 0xffff)); v[q].w += bf2f((u16)(dl[q].y >> 16));
                uint2 xw; xw.x = g8::cvt_pk_bf16(v[q].x, v[q].y); xw.y = g8::cvt_pk_bf16(v[q].z, v[q].w); *(uint2*)(d.X + (size_t)row * D + c) = xw; }
        }
        float ss = 0.f;
#pragma unroll
        for (int q = 0; q < 4; ++q) ss += v[q].x * v[q].x + v[q].y * v[q].y + v[q].z * v[q].z + v[q].w * v[q].w;
        ss = wave_sum_dpp(ss);
        const float rstd = rsqrtf(ss * (1.f / 1024.f) + EPS);
        if (MODE & 16) {
            float* out = outp + ((size_t)b * SEQ + (pos - CTXL)) * D;
#pragma unroll
            for (int q = 0; q < 4; ++q) { const int c = q * 256 + lane * 4; const float4 g = gvr[q];
                *(float4*)(out + c) = make_float4(v[q].x * rstd * g.x, v[q].y * rstd * g.y, v[q].z * rstd * g.z, v[q].w * rstd * g.w); }
            continue;
        }
        float h[16];
#pragma unroll
        for (int q = 0; q < 4; ++q) { const float4 g = gvr[q], s4 = shr[q], c4 = sclr[q];
            h[q * 4 + 0] = v[q].x * rstd * g.x * (1.f + c4.x) + s4.x; h[q * 4 + 1] = v[q].y * rstd * g.y * (1.f + c4.y) + s4.y;
            h[q * 4 + 2] = v[q].z * rstd * g.z * (1.f + c4.z) + s4.z; h[q * 4 + 3] = v[q].w * rstd * g.w * (1.f + c4.w) + s4.w; }
        if (MODE & 2) {
#pragma unroll
            for (int q = 0; q < 4; ++q) { uint2 w; w.x = g8::cvt_pk_bf16(h[q * 4], h[q * 4 + 1]); w.y = g8::cvt_pk_bf16(h[q * 4 + 2], h[q * 4 + 3]);
                *(uint2*)(d.HX + (size_t)row * D + q * 256 + lane * 4) = w; }
        }
        if (MODE & 4) {
#pragma unroll
            for (int q = 0; q < 4; ++q) { const int c = q * 256 + lane * 4; const int g = c >> 4, ch = c & 15;
                uint2 w; w.x = g8::cvt_pk_bf16(h[q * 4], h[q * 4 + 1]); w.y = g8::cvt_pk_bf16(h[q * 4 + 2], h[q * 4 + 3]);
                *(uint2*)(d.UH + ((size_t)g * 2304 + b * 144 + (pos >> 4)) * 512 + (pos & 15) * 16 + ch) = w; }
        }
        if (MODE & 8) {
            float lg[4] = {0.f, 0.f, 0.f, 0.f};
#pragma unroll
            for (int q = 0; q < 4; ++q)
#pragma unroll
                for (int j = 0; j < 4; ++j) { const float4 w = *(const float4*)(WG + ((q * 4 + j) * 64 + lane) * 4); const float hv = h[q * 4 + j];
                    lg[0] += hv * w.x; lg[1] += hv * w.y; lg[2] += hv * w.z; lg[3] += hv * w.w; }
#pragma unroll
            for (int g = 0; g < 4; ++g) lg[g] = wave_sum_dpp(lg[g]);
#pragma unroll
            for (int g = 0; g < 4; ++g) lg[g] += sm[SM_BGROUP + li * 4 + g];
            int gi = 0; float best = lg[0];
#pragma unroll
            for (int g = 1; g < 4; ++g) if (lg[g] > best) { best = lg[g]; gi = g; }
            float den = 0.f;
#pragma unroll
            for (int g = 0; g < 4; ++g) den += __expf(lg[g] - best);
            const float pg = 1.f / den;
            const u16* wes = WE + (size_t)gi * 8192;
            float le[8];
#pragma unroll
            for (int e = 0; e < 8; ++e) le[e] = 0.f;
#pragma unroll
            for (int q = 0; q < 4; ++q)
#pragma unroll
                for (int j = 0; j < 4; ++j) { const u32x4 w = *(const u32x4*)(wes + ((q * 4 + j) * 64 + lane) * 8); const float hv = h[q * 4 + j];
                    le[0] += hv * __uint_as_float(w.x << 16); le[1] += hv * __uint_as_float(w.x & 0xffff0000u); le[2] += hv * __uint_as_float(w.y << 16); le[3] += hv * __uint_as_float(w.y & 0xffff0000u);
                    le[4] += hv * __uint_as_float(w.z << 16); le[5] += hv * __uint_as_float(w.z & 0xffff0000u); le[6] += hv * __uint_as_float(w.w << 16); le[7] += hv * __uint_as_float(w.w & 0xffff0000u); }
#pragma unroll
            for (int e = 0; e < 8; ++e) le[e] = wave_sum_dpp(le[e]);
#pragma unroll
            for (int e = 0; e < 8; ++e) le[e] += sm[SM_BEXP + (li * 4 + gi) * 8 + e];
            int i1 = 0; float b1 = le[0];
#pragma unroll
            for (int e = 1; e < 8; ++e) if (le[e] > b1) { b1 = le[e]; i1 = e; }
            int i2 = -1; float b2 = -3.0e38f;
#pragma unroll
            for (int e = 0; e < 8; ++e) if (e != i1 && le[e] > b2) { b2 = le[e]; i2 = e; }
            { const float ex = __expf(b2 - b1); const float w1 = 1.f / (1.f + ex), w2 = ex / (1.f + ex);
              if (lane == it) { rec_e1 = gi * 8 + i1; rec_e2 = gi * 8 + i2; rec_w1 = pg * w1; rec_w2 = pg * w2; rec_row = row; } }
        }
    }
    if (MODE & 8) {
        if (rec_row >= 0) {
            const int s1 = (int)atomicAdd(&d.cnt[rec_e1 * CS], 1u), s2 = (int)atomicAdd(&d.cnt[rec_e2 * CS], 1u);
            d.list[(size_t)rec_e1 * T + s1] = rec_row; d.list[(size_t)rec_e2 * T + s2] = rec_row;
            *(int4*)(d.seli + (size_t)rec_row * 16) = make_int4(rec_e1, s1, rec_e2, s2);
            *(float2*)(d.selw + (size_t)rec_row * 8) = make_float2(rec_w1, rec_w2);
        }
    }
#undef NR_LOAD_A
#undef NR_A_TO_B
}
#define XB_TMO      128
#define XB_XCNT(j)  (256  + 64 * (j))
#define XB_XSUB(j)  (1280 + 64 * (j))
#define XB_XGEN(j)  (2304 + 64 * (j))
#define XB_TOP      3328
#define XB_TOPGEN   3392
#define XCD_BAR_WORDS 3456
#define XB_SPIN_CAP (1u << 18)
__device__ __forceinline__ unsigned xb_ld(unsigned* p)              { return __hip_atomic_load(p, __ATOMIC_RELAXED, __HIP_MEMORY_SCOPE_AGENT); }
__device__ __forceinline__ unsigned xb_add(unsigned* p, unsigned v) { return __hip_atomic_fetch_add(p, v, __ATOMIC_RELAXED, __HIP_MEMORY_SCOPE_AGENT); }
__device__ __forceinline__ unsigned xb_xcc_id() { return (unsigned)__builtin_amdgcn_s_getreg((3 << 11) | 20) & 0xFu; }
#define XB_SPIN(cond, bar) do { unsigned _sp = 0; while (cond) { __builtin_amdgcn_s_sleep(1); \
    if ((++_sp & 255u) == 0u) { if (xb_ld(&(bar)[XB_TMO])) break; if (_sp > XB_SPIN_CAP) { atomicAdd(&(bar)[XB_TMO], 1u); break; } } } } while (0)
struct XcdBarrier { unsigned* bar; unsigned x; volatile LAS unsigned* st; };
__device__ __forceinline__ XcdBarrier xcd_barrier_post(unsigned* bar, volatile LAS unsigned* st) {
    XcdBarrier b; b.bar = bar; b.x = xb_xcc_id(); b.st = st;
    if (threadIdx.x == 0) (void)xb_add(&bar[XB_XCNT(b.x)], 1u);
    return b;
}
__device__ __forceinline__ void xcd_barrier_complete(unsigned* bar, unsigned x, unsigned& nloc, unsigned& nx) {
    const unsigned G = gridDim.x * gridDim.y * gridDim.z;
    unsigned sum, cnt, mine, sp = 0u;
    for (;;) {
        sum = 0u; cnt = 0u; mine = 0u;
#pragma unroll
        for (unsigned j = 0; j < 16; ++j) { const unsigned c = xb_ld(&bar[XB_XCNT(j)]); sum += c; cnt += (c > 0u) ? 1u : 0u; mine = (j == x) ? c : mine; }
        if (sum == G) break;
        __builtin_amdgcn_s_sleep(1);
        if ((++sp & 255u) == 0u) { if (xb_ld(&bar[XB_TMO])) break; if (sp > XB_SPIN_CAP) { atomicAdd(&bar[XB_TMO], 1u); break; } }
    }
    nloc = mine > 0u ? mine : 1u; nx = cnt > 0u ? cnt : 1u;
}
__device__ __forceinline__ void xcd_barrier(const XcdBarrier& b, const int tid) {
    asm volatile("s_waitcnt vmcnt(0)" ::: "memory");
    __syncthreads();
    if (tid == 0) {
        unsigned* bar = b.bar;
        __builtin_amdgcn_s_waitcnt(0);
        unsigned nloc = b.st[0], nx = b.st[1];
        if (nloc == 0u) { xcd_barrier_complete(bar, b.x, nloc, nx); b.st[0] = nloc; b.st[1] = nx; }
        const unsigned old = xb_add(&bar[XB_XSUB(b.x)], 1u);
        const unsigned gen = old / nloc;
        if (old + 1u == (gen + 1u) * nloc) {
            __builtin_amdgcn_fence(__ATOMIC_RELEASE, "agent");
            asm volatile("s_waitcnt vmcnt(0)" ::: "memory");
            const unsigned og = xb_add(&bar[XB_TOP], 1u);
            const unsigned tg = og / nx;
            if (og + 1u == (tg + 1u) * nx) xb_add(&bar[XB_TOPGEN], 1u);
            else XB_SPIN(xb_ld(&bar[XB_TOPGEN]) == tg, bar);
            __builtin_amdgcn_fence(__ATOMIC_ACQUIRE, "agent");
            xb_add(&bar[XB_XGEN(b.x)], 1u);
            asm volatile("s_waitcnt vmcnt(0)" ::: "memory");
        } else {
            XB_SPIN(xb_ld(&bar[XB_XGEN(b.x)]) == gen, bar);
            __builtin_amdgcn_fence(__ATOMIC_ACQUIRE, "agent");
            asm volatile("s_waitcnt vmcnt(0)" ::: "memory");
        }
    }
    __syncthreads();
}

struct CvtSeg { int in_idx, nmat, K, N, NP, map; size_t dst_off; int g_idx; };
__device__ __forceinline__ void cvt_tile(const float* __restrict__ src, u16* __restrict__ dst, int K, int N, int NP, int map, int t, LAS unsigned* slab, int lane, const float* __restrict__ gvec) {
    const int kt_n = K / 64, nt_n = N / 64, per = kt_n * nt_n;
    const int mat = t / per, rem = t % per, nt = rem / kt_n, kt = rem % kt_n;
    const float* s = src + ((size_t)mat * K + (size_t)kt * 64) * N + nt * 64 + lane;
    float v[64];
#pragma unroll
    for (int k = 0; k < 64; ++k) v[k] = s[(size_t)k * N];
    if (gvec) { const float* gk = gvec + (size_t)mat * K + kt * 64;
#pragma unroll
        for (int k = 0; k < 64; ++k) v[k] *= gk[k]; }
#pragma unroll
    for (int q = 0; q < 8; ++q) { u32x4 w; w.x = g8::cvt_pk_bf16(v[q * 8], v[q * 8 + 1]); w.y = g8::cvt_pk_bf16(v[q * 8 + 2], v[q * 8 + 3]); w.z = g8::cvt_pk_bf16(v[q * 8 + 4], v[q * 8 + 5]); w.w = g8::cvt_pk_bf16(v[q * 8 + 6], v[q * 8 + 7]);
        *(LAS u32x4*)(slab + lane * 36 + q * 4) = w; }
#pragma unroll
    for (int i = 0; i < 8; ++i) { const int rl = i * 8 + (lane >> 3); const u32x4 w = *(const LAS u32x4*)(slab + rl * 36 + (lane & 7) * 4);
        const int n = nt * 64 + rl; int np = n;
        if (map) { const int half = N / 2; const int which = n >= half ? 1 : 0; const int j = n - which * half; np = (j / 128) * 256 + which * 128 + (j % 128); }
        *(u32x4*)(dst + ((size_t)mat * NP + np) * K + kt * 64 + (lane & 7) * 8) = w; }
}
__device__ __forceinline__ void mod_task(const Ptrs& P, char* lds, int task) {
    float* sc = (float*)lds;
    float* mod = (float*)(P.ws + WS_MOD);
    const int tid = threadIdx.x, cq = tid & 63, kg = tid >> 6;
    __syncthreads();
    for (int idx = tid; idx < 17 * 1024; idx += 512) { const int r = idx >> 10, kk = idx & 1023; const float v = r < 16 ? P.in[1][r * 1024 + kk] : P.in[3][kk]; sc[idx] = silu_f(v); }
    __syncthreads();
    const int i = task / 24, cc = task % 24; const int col = cc * 256 + cq * 4;
    const float* W = P.in[4] + ((size_t)i * 1024 + kg * 128) * 6144 + col;
    f32x4 acc[17];
#pragma unroll
    for (int r = 0; r < 17; ++r) acc[r] = (f32x4){0.f, 0.f, 0.f, 0.f};
#pragma unroll 8
    for (int kk = 0; kk < 128; ++kk) { const f32x4 w = *(const f32x4*)(W + (size_t)kk * 6144);
#pragma unroll
        for (int r = 0; r < 17; ++r) acc[r] += w * sc[r * 1024 + kg * 128 + kk]; }
    float* red2 = sc;
    __syncthreads();
#pragma unroll
    for (int pass = 0; pass < 2; ++pass) {
#pragma unroll
        for (int r = 0; r < 9; ++r) if (pass * 9 + r < 17) *(f32x4*)(red2 + ((kg * 9 + r) * 256 + cq * 4)) = acc[pass * 9 + r < 17 ? pass * 9 + r : 0];
        __syncthreads();
        for (int idx = tid; idx < 9 * 256; idx += 512) { const int rr = idx >> 8, c = idx & 255, r = pass * 9 + rr;
            if (r < 17) { float s = P.in[5][i * 6144 + cc * 256 + c];
#pragma unroll
                for (int g = 0; g < 8; ++g) s += red2[(g * 9 + rr) * 256 + c];
                mod[(size_t)(i * 17 + r) * 6144 + cc * 256 + c] = s; } }
        __syncthreads();
    }
}
__device__ __forceinline__ void s5_prep(const Ptrs& P, int j, int g, char* lds) {
    float2* Apow = (float2*)lds;
    float2* Bb = Apow + 2 * 64 * 17;
    float2* Cc = Bb + 2 * 64 * 16;
    float* Kt = (float*)(Cc + 2 * 16 * 64);
    const int tid = threadIdx.x;
    __syncthreads();
    if (tid < 128) { const int dir = tid >> 6, p = tid & 63; const size_t gd = ((size_t)j * 2 + dir) * SG + g;
        const float dt = __expf(P.in[10][gd]); const float ar = P.in[8][gd * SP + p], ai = P.in[9][gd * SP + p]; const float ldr = ar * dt, ldi = ai * dt;
        for (int tau = 0; tau <= 16; ++tau) { const float mag = __expf(ldr * (float)tau), ang = ldi * (float)tau; Apow[(dir * 64 + p) * 17 + tau] = make_float2(mag * __cosf(ang), mag * __sinf(ang)); }
        const float2 ab = Apow[(dir * 64 + p) * 17 + 1]; const float nr = ab.x - 1.f, ni = ab.y, den = ar * ar + ai * ai; const float qr = (nr * ar + ni * ai) / den, qi = (ni * ar - nr * ai) / den;
        for (int c = 0; c < 16; ++c) { const float br = P.in[11][(gd * SP + p) * SC + c], bi = P.in[12][(gd * SP + p) * SC + c]; Bb[(dir * 64 + p) * 16 + c] = make_float2(qr * br - qi * bi, qr * bi + qi * br); }
        ((float2*)(P.ws + WS_WB + WB_AT))[gd * SP + p] = Apow[(dir * 64 + p) * 17 + 16];
    }
    for (int i = tid; i < 2 * 16 * 64; i += 512) { const int d2 = i >> 10, c = (i >> 6) & 15, pp = i & 63; const size_t o = ((((size_t)j * 2 + d2) * SG + g) * SC + c) * SP + pp; Cc[i] = make_float2(P.in[13][o], P.in[14][o]); }
    __syncthreads();
    for (int idx = tid; idx < 8192; idx += 512) { const int dir = idx >> 12, tau = (idx >> 8) & 15, c = (idx >> 4) & 15, c2 = idx & 15; float s = 0.f;
        for (int p = 0; p < 64; ++p) { const float2 cc = Cc[(dir * 16 + c) * 64 + p], aa = Apow[(dir * 64 + p) * 17 + tau], bb = Bb[(dir * 64 + p) * 16 + c2];
            const float xr = aa.x * bb.x - aa.y * bb.y, xi = aa.x * bb.y + aa.y * bb.x; s += cc.x * xr - cc.y * xi; }
        Kt[idx] = s; }
    __syncthreads();
    u16* W1 = (u16*)(P.ws + WS_WB + WB_W1) + ((size_t)j * 64 + g) * 256 * 256; u16* W2 = (u16*)(P.ws + WS_WB + WB_W2) + ((size_t)j * 64 + g) * 256 * 512;
    for (int idx = tid; idx < 256 * 32; idx += 512) { const int row = idx >> 5, s8 = idx & 31; const int t = row >> 4, c = row & 15, s = s8 >> 1, cb = (s8 & 1) * 8;
        float v[8];
#pragma unroll
        for (int q = 0; q < 8; ++q) { const int c2 = cb + q;
            v[q] = s < t ? Kt[((0 * 16 + (t - s)) * 16 + c) * 16 + c2] : s > t ? Kt[((1 * 16 + (s - t)) * 16 + c) * 16 + c2] : Kt[((0 * 16 + 0) * 16 + c) * 16 + c2] + Kt[((1 * 16 + 0) * 16 + c) * 16 + c2] + (c2 == c ? P.in[15][j * 1024 + g * 16 + c] : 0.f); }
        u32x4 w; w.x = g8::cvt_pk_bf16(v[0], v[1]); w.y = g8::cvt_pk_bf16(v[2], v[3]); w.z = g8::cvt_pk_bf16(v[4], v[5]); w.w = g8::cvt_pk_bf16(v[6], v[7]);
        *(u32x4*)(W2 + (size_t)row * 512 + s8 * 8) = w; }
    for (int idx = tid; idx < 256 * 128; idx += 512) { const int row = idx >> 7, dp = idx & 127; const int dir = dp >> 6, p = dp & 63, t = row >> 4, c = row & 15;
        const float2 cc = Cc[(dir * 16 + c) * 64 + p], aa = Apow[(dir * 64 + p) * 17 + (dir ? 16 - t : t + 1)];
        const float gr = cc.x * aa.x - cc.y * aa.y, gi = cc.x * aa.y + cc.y * aa.x;
        *(unsigned*)(W2 + (size_t)row * 512 + 256 + dir * 128 + 2 * p) = g8::cvt_pk_bf16(gr, -gi); }
    for (int idx = tid; idx < 256 * 32; idx += 512) { const int n = idx >> 5, s8 = idx & 31; const int dir = n >> 7, p = (n >> 1) & 63, ri = n & 1, s = s8 >> 1, cb = (s8 & 1) * 8;
        const float2 aa = Apow[(dir * 64 + p) * 17 + (dir ? s : 15 - s)];
        float v[8];
#pragma unroll
        for (int q = 0; q < 8; ++q) { const float2 bb = Bb[(dir * 64 + p) * 16 + cb + q]; v[q] = ri ? aa.x * bb.y + aa.y * bb.x : aa.x * bb.x - aa.y * bb.y; }
        u32x4 w; w.x = g8::cvt_pk_bf16(v[0], v[1]); w.y = g8::cvt_pk_bf16(v[2], v[3]); w.z = g8::cvt_pk_bf16(v[4], v[5]); w.w = g8::cvt_pk_bf16(v[6], v[7]);
        *(u32x4*)(W1 + (size_t)n * 256 + s8 * 8) = w; }
    __syncthreads();
}
__device__ __forceinline__ void prologue_phase(const Ptrs& P, char* lds, const int parts) {
    if (parts & 1) {
        copy_small(P, blockIdx.x * 512 + threadIdx.x, gridDim.x * 512);
        float2* rope = (float2*)(P.ws + WS_ROPE);
        for (int i = blockIdx.x * 512 + threadIdx.x; i < 2048 * 32; i += gridDim.x * 512) { const int s = i >> 5, k = i & 31, f = k & 15; const float invf = exp2f(-(float)f * (13.287712379549449f / 16.f));
            const float ang = (float)(k < 16 ? (s >> 6) : (s & 63)) * invf; rope[i] = make_float2(__cosf(ang), __sinf(ang)); }
        unsigned char* wb = P.ws + WS_WB;
        for (int i = blockIdx.x * 512 + threadIdx.x; i < 2 * 64 * 1024 / 8; i += gridDim.x * 512) { const int mat = i / 8192, r = i % 8192; *(u32x4*)((u16*)(wb + WB_WIN) + ((size_t)mat * 768 + 704) * 1024 + (size_t)r * 8) = (u32x4){0u, 0u, 0u, 0u}; }
    }
    if (parts & 2) for (int task = blockIdx.x; task < 96; task += gridDim.x) mod_task(P, lds, task);
    if (parts & 4) for (int idx = (int)blockIdx.x - 96; idx >= 0 && idx < 128; idx += gridDim.x) s5_prep(P, idx >> 6, idx & 63, lds);
    if (parts & 24) {
        const CvtSeg seg[7] = { {16, 2, 1024, 2048, 2048, 1, WB_GLU, -1}, {17, 2, 1024, 704, 768, 0, WB_WIN, -1}, {20, 2, 384, 1536, 1536, 0, WB_UQ, 18}, {21, 2, 256, 2048, 2048, 0, WB_UKV, 19}, {22, 2, 1024, 1024, 1024, 0, WB_WO, -1},
                                {27, 128, 1024, 1024, 1024, 1, WB_GU, -1}, {28, 128, 512, 1024, 1024, 0, WB_DN, -1} };
        __syncthreads();
        const int lane = threadIdx.x & 63, wv = threadIdx.x >> 6;
        LAS unsigned* slab = (LAS unsigned*)((LAS unsigned char*)lds) + wv * (64 * 36);
        unsigned* qhead = (unsigned*)(P.ws + WS_CTL) + CW_QUEUE + ((parts >> 5) & 7) * 64;
        int tstart[8]; tstart[0] = 0;
#pragma unroll
        for (int s = 0; s < 7; ++s) tstart[s + 1] = tstart[s] + seg[s].nmat * (seg[s].K / 64) * (seg[s].N / 64);
        const int ntot = tstart[7], nchunk = (ntot + 7) / 8;
        for (;;) {
            unsigned c = 0; if (lane == 0) c = atomicAdd(qhead, 1u);
            c = (unsigned)__builtin_amdgcn_readfirstlane((int)c);
            if ((int)c >= nchunk) break;
            for (int t = (int)c * 8; t < (int)c * 8 + 8 && t < ntot; ++t) {
                int s = 0;
#pragma unroll
                for (int k = 1; k < 7; ++k) s = (t >= tstart[k]) ? k : s;
                int in_idx = 0, K = 0, N = 0, NP = 0, map = 0, t0 = 0, gi = -1; size_t doff = 0;
#pragma unroll
                for (int k = 0; k < 7; ++k) if (s == k) { in_idx = seg[k].in_idx; K = seg[k].K; N = seg[k].N; NP = seg[k].NP; map = seg[k].map; doff = seg[k].dst_off; t0 = tstart[k]; gi = seg[k].g_idx; }
                cvt_tile(P.in[in_idx], (u16*)(P.ws + WS_WB + doff), K, N, NP, map, t - t0, slab, lane, gi >= 0 ? P.in[gi] : nullptr);
            }
        }
        __syncthreads();
    }
}
__device__ __forceinline__ void s5_scan_phase(unsigned char* wsp, int j, int wv) {
    struct { unsigned char* ws; } P{wsp};
    const int tids = tid_opaque(wv); const int lane = tids & 63;
    const u16* S = (const u16*)(P.ws + WS_R1 + R1_S); u16* UH = (u16*)(P.ws + WS_R1 + R1_UH); const float2* AT = (const float2*)(P.ws + WS_WB + WB_AT);
    for (int task = blockIdx.x * 8 + (tids >> 6); task < 2048; task += gridDim.x * 8) {
        const int g = task >> 5, b = (task >> 1) & 15, dir = task & 1;
        const float2 a = AT[(((size_t)j * 2 + dir) * SG + g) * SP + lane];
        const u16* sp = S + ((size_t)g * 2304 + b * 144) * 256 + dir * 128 + 2 * lane; u16* hp = UH + ((size_t)g * 2304 + b * 144) * 512 + 256 + dir * 128 + 2 * lane;
        float hr = 0.f, hi = 0.f;
        for (int s0 = 0; s0 < 144; s0 += 16) {
            float2 sv[16];
#pragma unroll
            for (int k = 0; k < 16; ++k) { const int st = s0 + k; const int n = dir ? (st < 16 ? 15 - st : 159 - st) : st; const unsigned sb_ = *(const unsigned*)(sp + (size_t)n * 256); sv[k] = make_float2(__uint_as_float(sb_ << 16), __uint_as_float(sb_ & 0xffff0000u)); }
#pragma unroll
            for (int k = 0; k < 16; ++k) { const int st = s0 + k; const int n = dir ? (st < 16 ? 15 - st : 159 - st) : st;
                *(unsigned*)(hp + (size_t)n * 512) = g8::cvt_pk_bf16(hr, hi);
                const float nr = a.x * hr - a.y * hi + sv[k].x, ni = a.x * hi + a.y * hr + sv[k].y; hr = nr; hi = ni; }
        }
    }
}
__device__ __forceinline__ void mla_post_rows(unsigned char* wsp, int j, const float* Pm, int stride, int nwaves_blk, int wv) {
    struct { unsigned char* ws; } P{wsp}; const float* sm = (const float*)(wsp + WS_SMALL);
    const int tidp = tid_opaque(wv); const int lane = tidp & 63, wave = tidp >> 6;
    u16* CQ = (u16*)(P.ws + WS_CQ); u16* CKV = (u16*)(P.ws + WS_CKV); u16* KT = (u16*)(P.ws + WS_R1 + R1_KT); const float2* rope = (const float2*)(P.ws + WS_ROPE);
    for (int row = blockIdx.x * nwaves_blk + wave; row < T; row += gridDim.x * nwaves_blk) {
        const float* t = Pm + (size_t)row * stride; const int b = row / LTOT, pos = row % LTOT;
        float q[6]; float ss = 0.f;
#pragma unroll
        for (int i = 0; i < 6; ++i) { q[i] = t[i * 64 + lane]; ss += q[i] * q[i]; }
        ss = wave_sum_l(ss, lane); float rstd = rsqrtf(ss * (1.f / 384.f) + EPS);
#pragma unroll
        for (int i = 0; i < 6; ++i) CQ[(size_t)row * QR + i * 64 + lane] = f2bf(q[i] * rstd * sm[SM_GQ + j * QR + i * 64 + lane]);
        float k[4]; ss = 0.f;
#pragma unroll
        for (int i = 0; i < 4; ++i) { k[i] = t[384 + i * 64 + lane]; ss += k[i] * k[i]; }
        ss = wave_sum_l(ss, lane); rstd = rsqrtf(ss * (1.f / 256.f) + EPS);
#pragma unroll
        for (int i = 0; i < 4; ++i) CKV[(size_t)row * KVR + i * 64 + lane] = f2bf(k[i] * rstd * sm[SM_GKV + j * KVR + i * 64 + lane]);
        float v = t[640 + lane];
        if (pos >= CTXL) { const float pv = t[640 + (lane ^ 16)]; const float2 cs = rope[(size_t)(pos - CTXL) * 32 + (lane >> 5) * 16 + (lane & 15)];
            v = (lane & 16) ? v * cs.x + pv * cs.y : v * cs.x - pv * cs.y; }
        const u16 kb = f2bf(v);
#pragma unroll
        for (int h = 0; h < NH; ++h) KT[(((size_t)b * NH + h) * LTOT + pos) * QKD + 128 + lane] = kb;
    }
}
__device__ __forceinline__ void attn_phase(unsigned char* wsp, bool ctx_out, char* lds, LAS unsigned char* ldsl, int wv) {
    struct { unsigned char* ws; } P{wsp};
    const u16* QT = (const u16*)(P.ws + WS_R1 + R1_QT); const u16* KT = (const u16*)(P.ws + WS_R1 + R1_KT); const u16* VT = (const u16*)(P.ws + WS_R1 + R1_VT); u16* O = (u16*)(P.ws + WS_ZO);
    const int nunits = ctx_out ? 1152 : 1024;
    for (int u = blockIdx.x; u < nunits; u += gridDim.x) {
        int bh, qt, seq;
        if (u < 1024) { const int xcd = u & 7, k = u >> 3; bh = xcd * 16 + (k >> 3); qt = 1 + (k & 7); seq = LTOT; } else { bh = u - 1024; qt = 0; seq = CTXL; }
        const int b = bh >> 3, h = bh & 7;
        at::attn_body(QT + (size_t)bh * LTOT * QKD, KT + (size_t)bh * LTOT * QKD, VT + (size_t)bh * LTOT * 128, O + ((size_t)b * LTOT + qt * 256) * D + h * 128, D, qt * 256, seq, lds, ldsl, wv);
    }
}
constexpr int LDS_MISC = g8::STAGE_BYTES;
constexpr int LDS_BYTES = g8::STAGE_BYTES + 1024;
constexpr int NPHASE = 42;
struct MkArgs { Ptrs P; int lo, hi, bar_region, pad; };
__device__ __forceinline__ int lo_opq(int v) { asm volatile("" : "+s"(v)); return v; }
__global__ void __launch_bounds__(512, 2) mk(MkArgs a) {
    extern __shared__ __attribute__((aligned(16))) unsigned char lds[];
    LAS unsigned char* ldsl = (LAS unsigned char*)lds;
    volatile LAS unsigned* misc = (volatile LAS unsigned*)(ldsl + LDS_MISC);
    int* sbase = (int*)(lds + LDS_MISC + 64);
    const int wv = __builtin_amdgcn_readfirstlane(threadIdx.x >> 6);
    if (threadIdx.x < 4) misc[threadIdx.x] = 0u;
    __syncthreads();
#if defined(MK_FULL)
    const bool use_bar = true;
#else
    const bool use_bar = (a.hi - a.lo) > 1;
#endif
    unsigned char* ws = a.P.ws; float* outp = a.P.out;
    XcdBarrier bar; bar.bar = (unsigned*)(ws + WS_CTL) + a.bar_region * XCD_BAR_WORDS; bar.x = 0; bar.st = misc;
    if (use_bar) bar = xcd_barrier_post((unsigned*)(ws + WS_CTL) + a.bar_region * XCD_BAR_WORDS, misc);
    const int lo = a.lo, hi = a.hi;
#if defined(MK_FULL)
#define IN(k) (true)
#else
#define IN(k) (lo_opq(lo) <= (k) && (k) < lo_opq(hi))
#endif
#ifndef REP_GROUP
#define REP_GROUP (-1)
#define REP_N 1
#endif
#define NDST(li, g) (((g) == REP_GROUP && rep_ + 1 < REP_N) ? norm_dst_dummy(ws) : norm_dst_real(ws, li))
#if defined(REP_DRY)
#define EPI_DRY ((rep_ + 1 < REP_N) ? 1 : 0)
#else
#define EPI_DRY 0
#endif
#define REP(g) for (int rep_ = 0; rep_ < ((g) == REP_GROUP ? REP_N : 1); ++rep_)
#if defined(PROBE_A)
#define STAMP(s) do { if (blockIdx.x == 0 && tid_opaque(wv) == 0) ((unsigned long long*)(ws0 + WS_CTL))[CW_STAMP64 + (s)] = __builtin_amdgcn_s_memrealtime(); } while (0)
#else
#define STAMP(s) do { } while (0)
#endif
#define SEAM(k) do { if (IN((k) + 1)) xcd_barrier(bar, tid_opaque(wv)); STAMP((k) + 1); } while (0)
    unsigned char* const ws0 = ws;
    STAMP(0);
#ifndef PRO_PART
#define PRO_PART 31
#endif
    if (IN(0)) REP(0) { prologue_phase(a.P, (char*)lds, (rep_ + 1 < ((0) == REP_GROUP ? REP_N : 1)) ? (PRO_PART | ((rep_ + 1) << 5)) : 31); SEAM(0); }

    {
        constexpr int li = 0; constexpr int base = 1 + li * 10, j = li >> 1;
#define PH_BEGIN size_t zoff_ = 0; asm volatile("" : "+s"(zoff_)); unsigned char* ws = ws0 + zoff_; unsigned char* wb = ws + WS_WB; const float* sm = (const float*)(ws + WS_SMALL); float* X = (float*)(ws + WS_X); const float* mod = (const float*)(ws + WS_MOD); (void)wb; (void)sm; (void)X; (void)mod;
        if ((li & 1) == 0) {
            if (IN(base + 0)) REP(1) { PH_BEGIN NormDst nd = NDST(li, 1); if (li == 0) { nd.xin = a.P.in[0]; nd.cin = a.P.in[2]; norm2_rows<4 | 64>(ws, outp, nd, li, 0, sbase, (char*)lds, wv); } else norm2_rows<5>(ws, outp, nd, li, 0, sbase, (char*)lds, wv); SEAM(base + 0); }
            if (IN(base + 1)) REP(3) { PH_BEGIN SchedS5 S; S.init(ws + WS_R1 + R1_UH, wb + WB_W1 + (size_t)j * 64 * 256 * 256 * 2, 256); EpiS5a E{(u16*)(ws + WS_R1 + R1_S)};
                g8::gemm_phase<EpiS5a, SchedS5>(ldsl, 256, S, E, wv); SEAM(base + 1); }
            if (IN(base + 2)) REP(3) { PH_BEGIN s5_scan_phase(ws, j, wv); SEAM(base + 2); }
            if (IN(base + 3)) REP(3) { PH_BEGIN SchedS5 S; S.init(ws + WS_R1 + R1_UH, wb + WB_W2 + (size_t)j * 64 * 256 * 512 * 2, 512); EpiS5b E{(u16*)(ws + WS_ZO)};
                g8::gemm_phase<EpiS5b, SchedS5>(ldsl, 512, S, E, wv); SEAM(base + 3); }
            if (IN(base + 4)) REP(4) { PH_BEGIN SchedDense S; S.init(ws + WS_ZO, 1024, wb + WB_GLU + (size_t)j * 2048 * 1024 * 2, T, 2048, 1024); EpiGlu E{(u16*)(ws + WS_HX), mod, li};
                g8::gemm_phase<EpiGlu, SchedDense>(ldsl, 1024, S, E, wv); SEAM(base + 4); }
        } else {
            if (IN(base + 0)) REP(1) { PH_BEGIN const NormDst nd = NDST(li, 1); norm2_rows<3>(ws, outp, nd, li, 0, sbase, (char*)lds, wv); SEAM(base + 0); }
            if (IN(base + 1)) REP(11) { PH_BEGIN SchedDense S; S.init(ws + WS_HX, 1024, wb + WB_WIN + (size_t)j * 768 * 1024 * 2, T, 768, 1024); EpiWin E{(u16*)(ws + WS_CQ), (u16*)(ws + WS_CKV), (u16*)(ws + WS_R1 + R1_KT), (float*)(ws + WS_PS), (const float2*)(ws + WS_ROPE)};
                g8::gemm_phase<EpiWin, SchedDense>(ldsl, 1024, S, E, wv); SEAM(base + 1); }
            if (IN(base + 3)) REP(5) { PH_BEGIN
                { SchedDense S; S.init(ws + WS_CQ, QR, wb + WB_UQ + (size_t)j * 1536 * 384 * 2, T, 1536, 384); EpiQ E{(u16*)(ws + WS_R1 + R1_QT), (const float2*)(ws + WS_ROPE), (const float*)(ws + WS_PS), EPI_DRY};
                  g8::gemm_phase<EpiQ, SchedDense>(ldsl, 384, S, E, wv); }
                { SchedDense S; S.init(ws + WS_CKV, KVR, wb + WB_UKV + (size_t)j * 2048 * 256 * 2, T, 2048, 256); EpiKV E{(u16*)(ws + WS_R1 + R1_KT), (u16*)(ws + WS_R1 + R1_VT), (const float*)(ws + WS_PS), EPI_DRY};
                  int kk_ = 256; asm volatile("" : "+s"(kk_)); g8::gemm_phase<EpiKV, SchedDense>(ldsl, kk_, S, E, wv); }
                SEAM(base + 3); }
            if (IN(base + 4)) REP(6) { PH_BEGIN attn_phase(ws, li != 3, (char*)lds, ldsl, wv); SEAM(base + 4); }
            if (IN(base + 5)) REP(10) { PH_BEGIN SchedDense S; S.init(ws + WS_ZO, 1024, wb + WB_WO + (size_t)j * 1024 * 1024 * 2, T, 1024, 1024); EpiWo E{(u16*)(ws + WS_HX), mod, li};
                g8::gemm_phase<EpiWo, SchedDense>(ldsl, 1024, S, E, wv); SEAM(base + 5); }
        }
        if (IN(base + 6)) REP(2) { PH_BEGIN NormDst nd = NDST(li, 2); if (li == 0) { nd.xin = a.P.in[0]; nd.cin = a.P.in[2]; norm2_rows<42 | 64>(ws, outp, nd, li, 1, sbase, (char*)lds, wv); } else norm2_rows<42>(ws, outp, nd, li, 1, sbase, (char*)lds, wv); SEAM(base + 6); }
        if (IN(base + 7) || IN(base + 8)) {
            const unsigned* cnt = (const unsigned*)(ws0 + WS_CTL) + CW_CNT + li * 32 * CS;
            __syncthreads();
            if (tid_opaque(wv) == 0) { int acc = 0; for (int e = 0; e < 32; ++e) { sbase[e] = acc; acc += (int)((cnt[e * CS] + 255u) / 256u); } sbase[32] = acc; }
            __syncthreads();
            if (IN(base + 7)) REP(7) { PH_BEGIN SchedMoe<true> S; S.init(ws + WS_HX, wb + WB_GU + (size_t)li * 32 * 1024 * 1024 * 2, 1024, sbase, cnt, (const int*)(ws + WS_LIST)); EpiMoe1 E{(u16*)(ws + WS_R1 + R1_ACT)};
                g8::gemm_phase<EpiMoe1, SchedMoe<true>>(ldsl, 1024, S, E, wv); SEAM(base + 7); }
            if (IN(base + 8)) REP(8) { PH_BEGIN SchedMoe<false> S; S.init(ws + WS_R1 + R1_ACT, wb + WB_DN + (size_t)li * 32 * 1024 * 512 * 2, 512, sbase, cnt, (const int*)(ws + WS_LIST)); EpiMoe2 E{(u16*)(ws + WS_YB)};
                g8::gemm_phase<EpiMoe2, SchedMoe<false>>(ldsl, 512, S, E, wv); SEAM(base + 8); }
        }
    }

    {
        constexpr int li = 1; constexpr int base = 1 + li * 10, j = li >> 1;
#define PH_BEGIN size_t zoff_ = 0; asm volatile("" : "+s"(zoff_)); unsigned char* ws = ws0 + zoff_; unsigned char* wb = ws + WS_WB; const float* sm = (const float*)(ws + WS_SMALL); float* X = (float*)(ws + WS_X); const float* mod = (const float*)(ws + WS_MOD); (void)wb; (void)sm; (void)X; (void)mod;
        if ((li & 1) == 0) {
            if (IN(base + 0)) REP(1) { PH_BEGIN NormDst nd = NDST(li, 1); if (li == 0) { nd.xin = a.P.in[0]; nd.cin = a.P.in[2]; norm2_rows<4 | 64>(ws, outp, nd, li, 0, sbase, (char*)lds, wv); } else norm2_rows<5>(ws, outp, nd, li, 0, sbase, (char*)lds, wv); SEAM(base + 0); }
            if (IN(base + 1)) REP(3) { PH_BEGIN SchedS5 S; S.init(ws + WS_R1 + R1_UH, wb + WB_W1 + (size_t)j * 64 * 256 * 256 * 2, 256); EpiS5a E{(u16*)(ws + WS_R1 + R1_S)};
                g8::gemm_phase<EpiS5a, SchedS5>(ldsl, 256, S, E, wv); SEAM(base + 1); }
            if (IN(base + 2)) REP(3) { PH_BEGIN s5_scan_phase(ws, j, wv); SEAM(base + 2); }
            if (IN(base + 3)) REP(3) { PH_BEGIN SchedS5 S; S.init(ws + WS_R1 + R1_UH, wb + WB_W2 + (size_t)j * 64 * 256 * 512 * 2, 512); EpiS5b E{(u16*)(ws + WS_ZO)};
                g8::gemm_phase<EpiS5b, SchedS5>(ldsl, 512, S, E, wv); SEAM(base + 3); }
            if (IN(base + 4)) REP(4) { PH_BEGIN SchedDense S; S.init(ws + WS_ZO, 1024, wb + WB_GLU + (size_t)j * 2048 * 1024 * 2, T, 2048, 1024); EpiGlu E{(u16*)(ws + WS_HX), mod, li};
                g8::gemm_phase<EpiGlu, SchedDense>(ldsl, 1024, S, E, wv); SEAM(base + 4); }
        } else {
            if (IN(base + 0)) REP(1) { PH_BEGIN const NormDst nd = NDST(li, 1); norm2_rows<3>(ws, outp, nd, li, 0, sbase, (char*)lds, wv); SEAM(base + 0); }
            if (IN(base + 1)) REP(11) { PH_BEGIN SchedDense S; S.init(ws + WS_HX, 1024, wb + WB_WIN + (size_t)j * 768 * 1024 * 2, T, 768, 1024); EpiWin E{(u16*)(ws + WS_CQ), (u16*)(ws + WS_CKV), (u16*)(ws + WS_R1 + R1_KT), (float*)(ws + WS_PS), (const float2*)(ws + WS_ROPE)};
                g8::gemm_phase<EpiWin, SchedDense>(ldsl, 1024, S, E, wv); SEAM(base + 1); }
            if (IN(base + 3)) REP(5) { PH_BEGIN
                { SchedDense S; S.init(ws + WS_CQ, QR, wb + WB_UQ + (size_t)j * 1536 * 384 * 2, T, 1536, 384); EpiQ E{(u16*)(ws + WS_R1 + R1_QT), (const float2*)(ws + WS_ROPE), (const float*)(ws + WS_PS), EPI_DRY};
                  g8::gemm_phase<EpiQ, SchedDense>(ldsl, 384, S, E, wv); }
                { SchedDense S; S.init(ws + WS_CKV, KVR, wb + WB_UKV + (size_t)j * 2048 * 256 * 2, T, 2048, 256); EpiKV E{(u16*)(ws + WS_R1 + R1_KT), (u16*)(ws + WS_R1 + R1_VT), (const float*)(ws + WS_PS), EPI_DRY};
                  int kk_ = 256; asm volatile("" : "+s"(kk_)); g8::gemm_phase<EpiKV, SchedDense>(ldsl, kk_, S, E, wv); }
                SEAM(base + 3); }
            if (IN(base + 4)) REP(6) { PH_BEGIN attn_phase(ws, li != 3, (char*)lds, ldsl, wv); SEAM(base + 4); }
            if (IN(base + 5)) REP(10) { PH_BEGIN SchedDense S; S.init(ws + WS_ZO, 1024, wb + WB_WO + (size_t)j * 1024 * 1024 * 2, T, 1024, 1024); EpiWo E{(u16*)(ws + WS_HX), mod, li};
                g8::gemm_phase<EpiWo, SchedDense>(ldsl, 1024, S, E, wv); SEAM(base + 5); }
        }
        if (IN(base + 6)) REP(2) { PH_BEGIN NormDst nd = NDST(li, 2); if (li == 0) { nd.xin = a.P.in[0]; nd.cin = a.P.in[2]; norm2_rows<42 | 64>(ws, outp, nd, li, 1, sbase, (char*)lds, wv); } else norm2_rows<42>(ws, outp, nd, li, 1, sbase, (char*)lds, wv); SEAM(base + 6); }
        if (IN(base + 7) || IN(base + 8)) {
            const unsigned* cnt = (const unsigned*)(ws0 + WS_CTL) + CW_CNT + li * 32 * CS;
            __syncthreads();
            if (tid_opaque(wv) == 0) { int acc = 0; for (int e = 0; e < 32; ++e) { sbase[e] = acc; acc += (int)((cnt[e * CS] + 255u) / 256u); } sbase[32] = acc; }
            __syncthreads();
            if (IN(base + 7)) REP(7) { PH_BEGIN SchedMoe<true> S; S.init(ws + WS_HX, wb + WB_GU + (size_t)li * 32 * 1024 * 1024 * 2, 1024, sbase, cnt, (const int*)(ws + WS_LIST)); EpiMoe1 E{(u16*)(ws + WS_R1 + R1_ACT)};
                g8::gemm_phase<EpiMoe1, SchedMoe<true>>(ldsl, 1024, S, E, wv); SEAM(base + 7); }
            if (IN(base + 8)) REP(8) { PH_BEGIN SchedMoe<false> S; S.init(ws + WS_R1 + R1_ACT, wb + WB_DN + (size_t)li * 32 * 1024 * 512 * 2, 512, sbase, cnt, (const int*)(ws + WS_LIST)); EpiMoe2 E{(u16*)(ws + WS_YB)};
                g8::gemm_phase<EpiMoe2, SchedMoe<false>>(ldsl, 512, S, E, wv); SEAM(base + 8); }
        }
    }

    {
        constexpr int li = 2; constexpr int base = 1 + li * 10, j = li >> 1;
#define PH_BEGIN size_t zoff_ = 0; asm volatile("" : "+s"(zoff_)); unsigned char* ws = ws0 + zoff_; unsigned char* wb = ws + WS_WB; const float* sm = (const float*)(ws + WS_SMALL); float* X = (float*)(ws + WS_X); const float* mod = (const float*)(ws + WS_MOD); (void)wb; (void)sm; (void)X; (void)mod;
        if ((li & 1) == 0) {
            if (IN(base + 0)) REP(1) { PH_BEGIN NormDst nd = NDST(li, 1); if (li == 0) { nd.xin = a.P.in[0]; nd.cin = a.P.in[2]; norm2_rows<4 | 64>(ws, outp, nd, li, 0, sbase, (char*)lds, wv); } else norm2_rows<5>(ws, outp, nd, li, 0, sbase, (char*)lds, wv); SEAM(base + 0); }
            if (IN(base + 1)) REP(3) { PH_BEGIN SchedS5 S; S.init(ws + WS_R1 + R1_UH, wb + WB_W1 + (size_t)j * 64 * 256 * 256 * 2, 256); EpiS5a E{(u16*)(ws + WS_R1 + R1_S)};
                g8::gemm_phase<EpiS5a, SchedS5>(ldsl, 256, S, E, wv); SEAM(base + 1); }
            if (IN(base + 2)) REP(3) { PH_BEGIN s5_scan_phase(ws, j, wv); SEAM(base + 2); }
            if (IN(base + 3)) REP(3) { PH_BEGIN SchedS5 S; S.init(ws + WS_R1 + R1_UH, wb + WB_W2 + (size_t)j * 64 * 256 * 512 * 2, 512); EpiS5b E{(u16*)(ws + WS_ZO)};
                g8::gemm_phase<EpiS5b, SchedS5>(ldsl, 512, S, E, wv); SEAM(base + 3); }
            if (IN(base + 4)) REP(4) { PH_BEGIN SchedDense S; S.init(ws + WS_ZO, 1024, wb + WB_GLU + (size_t)j * 2048 * 1024 * 2, T, 2048, 1024); EpiGlu E{(u16*)(ws + WS_HX), mod, li};
                g8::gemm_phase<EpiGlu, SchedDense>(ldsl, 1024, S, E, wv); SEAM(base + 4); }
        } else {
            if (IN(base + 0)) REP(1) { PH_BEGIN const NormDst nd = NDST(li, 1); norm2_rows<3>(ws, outp, nd, li, 0, sbase, (char*)lds, wv); SEAM(base + 0); }
            if (IN(base + 1)) REP(11) { PH_BEGIN SchedDense S; S.init(ws + WS_HX, 1024, wb + WB_WIN + (size_t)j * 768 * 1024 * 2, T, 768, 1024); EpiWin E{(u16*)(ws + WS_CQ), (u16*)(ws + WS_CKV), (u16*)(ws + WS_R1 + R1_KT), (float*)(ws + WS_PS), (const float2*)(ws + WS_ROPE)};
                g8::gemm_phase<EpiWin, SchedDense>(ldsl, 1024, S, E, wv); SEAM(base + 1); }
            if (IN(base + 3)) REP(5) { PH_BEGIN
                { SchedDense S; S.init(ws + WS_CQ, QR, wb + WB_UQ + (size_t)j * 1536 * 384 * 2, T, 1536, 384); EpiQ E{(u16*)(ws + WS_R1 + R1_QT), (const float2*)(ws + WS_ROPE), (const float*)(ws + WS_PS), EPI_DRY};
                  g8::gemm_phase<EpiQ, SchedDense>(ldsl, 384, S, E, wv); }
                { SchedDense S; S.init(ws + WS_CKV, KVR, wb + WB_UKV + (size_t)j * 2048 * 256 * 2, T, 2048, 256); EpiKV E{(u16*)(ws + WS_R1 + R1_KT), (u16*)(ws + WS_R1 + R1_VT), (const float*)(ws + WS_PS), EPI_DRY};
                  int kk_ = 256; asm volatile("" : "+s"(kk_)); g8::gemm_phase<EpiKV, SchedDense>(ldsl, kk_, S, E, wv); }
                SEAM(base + 3); }
            if (IN(base + 4)) REP(6) { PH_BEGIN attn_phase(ws, li != 3, (char*)lds, ldsl, wv); SEAM(base + 4); }
            if (IN(base + 5)) REP(10) { PH_BEGIN SchedDense S; S.init(ws + WS_ZO, 1024, wb + WB_WO + (size_t)j * 1024 * 1024 * 2, T, 1024, 1024); EpiWo E{(u16*)(ws + WS_HX), mod, li};
                g8::gemm_phase<EpiWo, SchedDense>(ldsl, 1024, S, E, wv); SEAM(base + 5); }
        }
        if (IN(base + 6)) REP(2) { PH_BEGIN NormDst nd = NDST(li, 2); if (li == 0) { nd.xin = a.P.in[0]; nd.cin = a.P.in[2]; norm2_rows<42 | 64>(ws, outp, nd, li, 1, sbase, (char*)lds, wv); } else norm2_rows<42>(ws, outp, nd, li, 1, sbase, (char*)lds, wv); SEAM(base + 6); }
        if (IN(base + 7) || IN(base + 8)) {
            const unsigned* cnt = (const unsigned*)(ws0 + WS_CTL) + CW_CNT + li * 32 * CS;
            __syncthreads();
            if (tid_opaque(wv) == 0) { int acc = 0; for (int e = 0; e < 32; ++e) { sbase[e] = acc; acc += (int)((cnt[e * CS] + 255u) / 256u); } sbase[32] = acc; }
            __syncthreads();
            if (IN(base + 7)) REP(7) { PH_BEGIN SchedMoe<true> S; S.init(ws + WS_HX, wb + WB_GU + (size_t)li * 32 * 1024 * 1024 * 2, 1024, sbase, cnt, (const int*)(ws + WS_LIST)); EpiMoe1 E{(u16*)(ws + WS_R1 + R1_ACT)};
                g8::gemm_phase<EpiMoe1, SchedMoe<true>>(ldsl, 1024, S, E, wv); SEAM(base + 7); }
            if (IN(base + 8)) REP(8) { PH_BEGIN SchedMoe<false> S; S.init(ws + WS_R1 + R1_ACT, wb + WB_DN + (size_t)li * 32 * 1024 * 512 * 2, 512, sbase, cnt, (const int*)(ws + WS_LIST)); EpiMoe2 E{(u16*)(ws + WS_YB)};
                g8::gemm_phase<EpiMoe2, SchedMoe<false>>(ldsl, 512, S, E, wv); SEAM(base + 8); }
        }
    }

    {
        constexpr int li = 3; constexpr int base = 1 + li * 10, j = li >> 1;
#define PH_BEGIN size_t zoff_ = 0; asm volatile("" : "+s"(zoff_)); unsigned char* ws = ws0 + zoff_; unsigned char* wb = ws + WS_WB; const float* sm = (const float*)(ws + WS_SMALL); float* X = (float*)(ws + WS_X); const float* mod = (const float*)(ws + WS_MOD); (void)wb; (void)sm; (void)X; (void)mod;
        if ((li & 1) == 0) {
            if (IN(base + 0)) REP(1) { PH_BEGIN NormDst nd = NDST(li, 1); if (li == 0) { nd.xin = a.P.in[0]; nd.cin = a.P.in[2]; norm2_rows<4 | 64>(ws, outp, nd, li, 0, sbase, (char*)lds, wv); } else norm2_rows<5>(ws, outp, nd, li, 0, sbase, (char*)lds, wv); SEAM(base + 0); }
            if (IN(base + 1)) REP(3) { PH_BEGIN SchedS5 S; S.init(ws + WS_R1 + R1_UH, wb + WB_W1 + (size_t)j * 64 * 256 * 256 * 2, 256); EpiS5a E{(u16*)(ws + WS_R1 + R1_S)};
                g8::gemm_phase<EpiS5a, SchedS5>(ldsl, 256, S, E, wv); SEAM(base + 1); }
            if (IN(base + 2)) REP(3) { PH_BEGIN s5_scan_phase(ws, j, wv); SEAM(base + 2); }
            if (IN(base + 3)) REP(3) { PH_BEGIN SchedS5 S; S.init(ws + WS_R1 + R1_UH, wb + WB_W2 + (size_t)j * 64 * 256 * 512 * 2, 512); EpiS5b E{(u16*)(ws + WS_ZO)};
                g8::gemm_phase<EpiS5b, SchedS5>(ldsl, 512, S, E, wv); SEAM(base + 3); }
            if (IN(base + 4)) REP(4) { PH_BEGIN SchedDense S; S.init(ws + WS_ZO, 1024, wb + WB_GLU + (size_t)j * 2048 * 1024 * 2, T, 2048, 1024); EpiGlu E{(u16*)(ws + WS_HX), mod, li};
                g8::gemm_phase<EpiGlu, SchedDense>(ldsl, 1024, S, E, wv); SEAM(base + 4); }
        } else {
            if (IN(base + 0)) REP(1) { PH_BEGIN const NormDst nd = NDST(li, 1); norm2_rows<3>(ws, outp, nd, li, 0, sbase, (char*)lds, wv); SEAM(base + 0); }
            if (IN(base + 1)) REP(11) { PH_BEGIN SchedDense S; S.init(ws + WS_HX, 1024, wb + WB_WIN + (size_t)j * 768 * 1024 * 2, T, 768, 1024); EpiWin E{(u16*)(ws + WS_CQ), (u16*)(ws + WS_CKV), (u16*)(ws + WS_R1 + R1_KT), (float*)(ws + WS_PS), (const float2*)(ws + WS_ROPE)};
                g8::gemm_phase<EpiWin, SchedDense>(ldsl, 1024, S, E, wv); SEAM(base + 1); }
            if (IN(base + 3)) REP(5) { PH_BEGIN
                { SchedDense S; S.init(ws + WS_CQ, QR, wb + WB_UQ + (size_t)j * 1536 * 384 * 2, T, 1536, 384); EpiQ E{(u16*)(ws + WS_R1 + R1_QT), (const float2*)(ws + WS_ROPE), (const float*)(ws + WS_PS), EPI_DRY};
                  g8::gemm_phase<EpiQ, SchedDense>(ldsl, 384, S, E, wv); }
                { SchedDense S; S.init(ws + WS_CKV, KVR, wb + WB_UKV + (size_t)j * 2048 * 256 * 2, T, 2048, 256); EpiKV E{(u16*)(ws + WS_R1 + R1_KT), (u16*)(ws + WS_R1 + R1_VT), (const float*)(ws + WS_PS), EPI_DRY};
                  int kk_ = 256; asm volatile("" : "+s"(kk_)); g8::gemm_phase<EpiKV, SchedDense>(ldsl, kk_, S, E, wv); }
                SEAM(base + 3); }
            if (IN(base + 4)) REP(6) { PH_BEGIN attn_phase(ws, li != 3, (char*)lds, ldsl, wv); SEAM(base + 4); }
            if (IN(base + 5)) REP(10) { PH_BEGIN SchedDense S; S.init(ws + WS_ZO, 1024, wb + WB_WO + (size_t)j * 1024 * 1024 * 2, T, 1024, 1024); EpiWo E{(u16*)(ws + WS_HX), mod, li};
                g8::gemm_phase<EpiWo, SchedDense>(ldsl, 1024, S, E, wv); SEAM(base + 5); }
        }
        if (IN(base + 6)) REP(2) { PH_BEGIN NormDst nd = NDST(li, 2); if (li == 0) { nd.xin = a.P.in[0]; nd.cin = a.P.in[2]; norm2_rows<42 | 64>(ws, outp, nd, li, 1, sbase, (char*)lds, wv); } else norm2_rows<42>(ws, outp, nd, li, 1, sbase, (char*)lds, wv); SEAM(base + 6); }
        if (IN(base + 7) || IN(base + 8)) {
            const unsigned* cnt = (const unsigned*)(ws0 + WS_CTL) + CW_CNT + li * 32 * CS;
            __syncthreads();
            if (tid_opaque(wv) == 0) { int acc = 0; for (int e = 0; e < 32; ++e) { sbase[e] = acc; acc += (int)((cnt[e * CS] + 255u) / 256u); } sbase[32] = acc; }
            __syncthreads();
            if (IN(base + 7)) REP(7) { PH_BEGIN SchedMoe<true> S; S.init(ws + WS_HX, wb + WB_GU + (size_t)li * 32 * 1024 * 1024 * 2, 1024, sbase, cnt, (const int*)(ws + WS_LIST)); EpiMoe1 E{(u16*)(ws + WS_R1 + R1_ACT)};
                g8::gemm_phase<EpiMoe1, SchedMoe<true>>(ldsl, 1024, S, E, wv); SEAM(base + 7); }
            if (IN(base + 8)) REP(8) { PH_BEGIN SchedMoe<false> S; S.init(ws + WS_R1 + R1_ACT, wb + WB_DN + (size_t)li * 32 * 1024 * 512 * 2, 512, sbase, cnt, (const int*)(ws + WS_LIST)); EpiMoe2 E{(u16*)(ws + WS_YB)};
                g8::gemm_phase<EpiMoe2, SchedMoe<false>>(ldsl, 512, S, E, wv); SEAM(base + 8); }
        }
    }

#if defined(PROBE_A)
    if (IN(41)) { xcd_barrier(bar, tid_opaque(wv));
        if (tid_opaque(wv) == 0) { const unsigned long long* ts = (const unsigned long long*)(ws0 + WS_CTL) + CW_STAMP64; unsigned long long last = ts[0], sa = 0, sb = 0;
            for (int p = 0; p <= 40; ++p) { const unsigned long long e = ts[p + 1]; if (e == 0) continue; const unsigned long long d = e - last; last = e;
                int grp; if (p == 0) grp = 0; else { const int k = (p - 1) % 10, l = (p - 1) / 10; const bool s5 = (l & 1) == 0;
                    grp = k == 0 ? 1 : k == 6 ? 2 : k == 7 ? 7 : k == 8 ? 8 : s5 ? (k == 4 ? 4 : 3) : (k == 4 ? 6 : 5); }
                if (grp == PROBE_A) sa += d; if (grp == PROBE_B) sb += d; }
            ((float*)sbase)[40] = (float)sa * 1e-5f; ((float*)sbase)[41] = 2.f + (float)sb * (1.f / 2000.f); }
        __syncthreads(); }
#endif
    if (IN(41)) { const NormDst nd = norm_dst_real(ws0, 0); norm2_rows<17>(ws0, outp, nd, 4, 0, sbase, (char*)lds, wv); }
#undef PH_BEGIN
#undef IN
#undef SEAM
}
__global__ __launch_bounds__(256) void n_post_win(Ptrs P, int j) { mla_post_rows(P.ws, j, (const float*)(P.ws + WS_YB), 768, 4, __builtin_amdgcn_readfirstlane(threadIdx.x >> 6)); }
static void gemm_naive(hipStream_t st, const void* A, int lda, const int* rowidx, const float* B, int ldb, long bstride, const int* tileexp, const int* mdyn, float* C, int ldc, int M, int N, int K) {
    NG g{}; g.A = A; g.lda = lda; g.rowidx = rowidx; g.B = B; g.ldb = ldb; g.bstride = bstride; g.tileexp = tileexp; g.mdyn = mdyn; g.C = C; g.ldc = ldc; g.M = M; g.N = N; g.K = K; g.pad = 0;
    hipLaunchKernelGGL(n_gemm<1>, dim3(N / 64, (M + 63) / 64), dim3(256), 0, st, g);
}
#ifndef REALMASK_STR
#define REALMASK_STR "111111111111111111111111111111111111111111"
#endif
extern "C" void kernel_launch(void* const* d_in, const int* in_sizes, int n_in, void* d_out, int out_size, void* d_ws, size_t ws_size, hipStream_t stream) {
    static int grid = 0;
    static const char* realmask = REALMASK_STR;
    if (grid == 0) {
        if (n_in != 30 || out_size != NB * SEQ * D || ws_size < WS_NEND) { fprintf(stderr, "kernel_launch: unexpected shapes n_in %d out %d ws %zu (need %zu)\n", n_in, out_size, ws_size, (size_t)WS_NEND); grid = -1; return; }
        int dev = 0, cus = 0, per_cu = 0;
        if (hipGetDevice(&dev) != hipSuccess || hipDeviceGetAttribute(&cus, hipDeviceAttributeMultiprocessorCount, dev) != hipSuccess) { grid = -1; return; }
        if (hipFuncSetAttribute((const void*)mk, hipFuncAttributeMaxDynamicSharedMemorySize, LDS_BYTES) != hipSuccess) { fprintf(stderr, "kernel_launch: hipFuncSetAttribute failed\n"); grid = -1; return; }
        if (hipOccupancyMaxActiveBlocksPerMultiprocessor(&per_cu, (const void*)mk, 512, LDS_BYTES) != hipSuccess || per_cu < 1) { fprintf(stderr, "kernel_launch: occupancy query says %d\n", per_cu); }
        (void)hipGetLastError();
        grid = cus;
    }
    if (grid < 0) return;
    Ptrs P{}; for (int i = 0; i < 30; ++i) P.in[i] = (const float*)d_in[i]; P.out = (float*)d_out; P.ws = (unsigned char*)d_ws;
    unsigned char* ws = P.ws;
    (void)hipMemsetAsync(ws + WS_CTL, 0, ZERO_BYTES, stream);
    int nreg = 0;
    auto real = [&](int p) { return realmask[p] == '1'; };
    auto run_mk = [&](int lo, int hi) { MkArgs a{}; a.P = P; a.lo = lo; a.hi = hi; a.bar_region = (hi - lo > 1) ? nreg++ : 0; a.pad = 0; hipLaunchKernelGGL(mk, dim3(grid), dim3(512), LDS_BYTES, stream, a); };
    const int NG_ = 4096; float* NTMP = (float*)(ws + WS_NTMP);
    int p = 0;
    while (p < NPHASE) {
        if (real(p)) { int q = p; while (q < NPHASE && real(q)) ++q; run_mk(p, q); p = q; continue; }
        if (p == 0) { hipLaunchKernelGGL(k_mod, dim3(24, 4), dim3(256), 0, stream, P); hipLaunchKernelGGL(k_init, dim3(2048), dim3(256), 0, stream, P); }
        else if (p == 41) hipLaunchKernelGGL(k_norm<17>, dim3(2048), dim3(256), 0, stream, P, 4, 0);
        else {
            const int li = (p - 1) / 10, k = (p - 1) % 10, j = li >> 1; const bool s5 = (li & 1) == 0;
            if (k == 0) { if (li == 0) hipLaunchKernelGGL(k_norm<2>, dim3(2048), dim3(256), 0, stream, P, li, 0); else hipLaunchKernelGGL(k_norm<3>, dim3(2048), dim3(256), 0, stream, P, li, 0); }
            else if (s5 && k == 1) { hipLaunchKernelGGL(n_s5, dim3(NB * SG), dim3(128), 0, stream, P, j); }
            else if (s5 && k == 3) { hipLaunchKernelGGL(n_post_s5, dim3(NG_), dim3(256), 0, stream, P, j); }
            else if (s5 && k == 4) { gemm_naive(stream, ws + WS_ZO, D, nullptr, P.in[16] + (size_t)j * 1024 * 2048, 2048, 0, nullptr, nullptr, NTMP, 2048, T, 2048, 1024); hipLaunchKernelGGL(n_post_glu, dim3(NG_), dim3(256), 0, stream, P, li); }
            else if (!s5 && k == 1) { gemm_naive(stream, ws + WS_HX, D, nullptr, P.in[17] + (size_t)j * 1024 * 704, 704, 0, nullptr, nullptr, (float*)(ws + WS_YB), 768, T, 704, 1024); }
            else if (!s5 && k == 2) { hipLaunchKernelGGL(n_post_win, dim3(2048), dim3(256), 0, stream, P, j); }
            else if (!s5 && k == 3) {
                gemm_naive(stream, ws + WS_CQ, QR, nullptr, P.in[20] + (size_t)j * 384 * 1536, 1536, 0, nullptr, nullptr, NTMP, 1536, T, 1536, 384); hipLaunchKernelGGL(n_post_q, dim3(NG_), dim3(256), 0, stream, P);
                gemm_naive(stream, ws + WS_CKV, KVR, nullptr, P.in[21] + (size_t)j * 256 * 2048, 2048, 0, nullptr, nullptr, NTMP, 2048, T, 2048, 256); hipLaunchKernelGGL(n_post_kv, dim3(NG_), dim3(256), 0, stream, P); }
            else if (!s5 && k == 4) { hipLaunchKernelGGL(n_attn, dim3(LTOT / 64, NH, NB), dim3(256), 0, stream, P); }
            else if (!s5 && k == 5) { gemm_naive(stream, ws + WS_ZO, D, nullptr, P.in[22] + (size_t)j * 1024 * 1024, 1024, 0, nullptr, nullptr, NTMP, 1024, T, 1024, 1024); hipLaunchKernelGGL(n_post_wo, dim3(NG_), dim3(256), 0, stream, P, li); }
            else if (k == 6) { hipLaunchKernelGGL(k_norm<10>, dim3(2048), dim3(256), 0, stream, P, li, 1); }
            else if (k == 7 || k == 8) {
                const int* tileexp = (const int*)(ws + WS_TILEEXP);
                hipLaunchKernelGGL(n_build, dim3(1), dim3(256), 0, stream, P, li);
                if (k == 7) { gemm_naive(stream, ws + WS_HX, D, (const int*)(ws + WS_SLOTROW), P.in[27] + (size_t)li * 32 * 1024 * 1024, 1024, 1024L * 1024, tileexp, tileexp + 512, NTMP, 1024, MAXSLOT, 1024, 1024);
                    hipLaunchKernelGGL(n_post_act2, dim3(NG_), dim3(256), 0, stream, P, (u16*)(ws + WS_R1 + R1_ACT)); }
                else { gemm_naive(stream, ws + WS_R1 + R1_ACT, 512, nullptr, P.in[28] + (size_t)li * 32 * 512 * 1024, 1024, 512L * 1024, tileexp, tileexp + 512, NTMP, 1024, MAXSLOT, 1024, 512);
                    hipLaunchKernelGGL(n_post_y, dim3(NG_), dim3(256), 0, stream, P); }
            }
        }
        ++p;
    }
}
```

```cpp
#define MK_FULL 1
#include <hip/hip_runtime.h>
#include <cstdio>
#include <cstdint>

typedef unsigned short u16;
typedef unsigned short bf16_t;

constexpr int D = 1024, NB = 16, SEQ = 2048, CTXL = 256, LTOT = 2304, T = NB * LTOT;
constexpr int SG = 64, SP = 64, SC = 16;
constexpr int QR = 384, KVR = 256, NH = 8, QKD = 192;
constexpr int NE = 32;
constexpr int MAXSLOT = 81920;
constexpr float EPS = 1e-6f;

constexpr size_t al256(size_t x) { return (x + 255) / 256 * 256; }
constexpr size_t WS_CTL = 0;
constexpr size_t CTL_BYTES = 131072;
constexpr size_t WS_MOD = WS_CTL + CTL_BYTES;
constexpr size_t MOD_BYTES = al256((size_t)4 * 17 * 6144 * 4);
constexpr size_t ZERO_BYTES = CTL_BYTES;
constexpr size_t WS_ROPE = WS_MOD + MOD_BYTES;
constexpr size_t WS_SMALL = WS_ROPE + al256((size_t)2048 * 32 * 8);
constexpr int SM_GMIX = 0, SM_GFFN = 4096, SM_S5D = 8192, SM_GQ = 10240, SM_GKV = 11008, SM_FINALG = 11520, SM_BGROUP = 12544, SM_BEXP = 12560, SM_WGROUP = 12800, SM_WEXP = 29184, SM_END = 160256;
constexpr size_t WS_X = WS_SMALL + al256((size_t)SM_END * 4);
constexpr size_t WS_HX = WS_X + (size_t)T * D * 4;
constexpr size_t WS_ZO = WS_HX + (size_t)T * D * 2;
constexpr size_t WS_CQ = WS_ZO + (size_t)T * D * 2;
constexpr size_t WS_CKV = WS_CQ + (size_t)T * QR * 2;
constexpr size_t WS_PS = WS_CKV + (size_t)T * KVR * 2;
constexpr size_t WS_KR = WS_PS + (size_t)T * 24 * 4;
constexpr size_t WS_SELI = WS_KR + (size_t)NB * 2 * LTOT * 32 * 2;
constexpr size_t WS_SELW = WS_SELI + (size_t)T * 16;
constexpr size_t WS_LIST = WS_SELW + (size_t)T * 8;
constexpr size_t WS_SLOTROW = WS_LIST + (size_t)NE * T * 4;
constexpr size_t WS_TILEEXP = WS_SLOTROW + (size_t)MAXSLOT * 4;
constexpr size_t WS_R1 = WS_TILEEXP + 4096;
constexpr size_t R1_BYTES = (size_t)MAXSLOT * 1024 * 4;
constexpr size_t WS_YB = WS_R1 + R1_BYTES;
constexpr size_t WS_WB = WS_YB + (size_t)MAXSLOT * 1024 * 2;
constexpr size_t R1_QT = 0;
constexpr size_t R1_KT = R1_QT + (size_t)NB * NH * LTOT * QKD * 2;
constexpr size_t R1_VT = R1_KT + (size_t)NB * NH * LTOT * QKD * 2;
constexpr size_t R1_ACT = 0;
constexpr size_t R1_S = 0;
constexpr size_t R1_UH = (size_t)64 * 2304 * 256 * 4;
constexpr size_t WB_GLU = 0;
constexpr size_t WB_WIN = WB_GLU + (size_t)2 * 2048 * 1024 * 2;
constexpr size_t WB_UQ = WB_WIN + (size_t)2 * 768 * 1024 * 2;
constexpr size_t WB_UKV = WB_UQ + (size_t)2 * 1536 * 384 * 2;
constexpr size_t WB_WO = WB_UKV + (size_t)2 * 2048 * 256 * 2;
constexpr size_t WB_GU = WB_WO + (size_t)2 * 1024 * 1024 * 2;
constexpr size_t WB_DN = WB_GU + (size_t)128 * 1024 * 1024 * 2;
constexpr size_t WB_W1 = WB_DN + (size_t)128 * 1024 * 512 * 2;
constexpr size_t WB_W2 = WB_W1 + (size_t)128 * 256 * 256 * 2;
constexpr size_t WB_AT = WB_W2 + (size_t)128 * 256 * 512 * 2;
constexpr size_t WB_END = WB_AT + (size_t)2 * 2 * 64 * 64 * 8;
constexpr size_t WS_END = WS_WB + WB_END;
constexpr size_t WS_NTMP = al256(WS_END);
constexpr size_t WS_NEND = WS_NTMP + (size_t)MAXSLOT * 1024 * 4;
static_assert(R1_UH + (size_t)64 * 2304 * 512 * 2 <= R1_BYTES, "R1");
static_assert(R1_VT + (size_t)NB * NH * LTOT * 128 * 2 <= R1_BYTES, "R1");
constexpr int CS = 64;
constexpr int CW_CNT = 8192;
constexpr int CW_QUEUE = 7168;
constexpr int CW_CNT_DUMMY = 16384;
constexpr int CW_STAMP64 = 12288;

__device__ __forceinline__ float bf2f(u16 v) { return __uint_as_float(((unsigned)v) << 16); }
__device__ __forceinline__ u16 f2bf(float f) { unsigned u = __float_as_uint(f); u += 0x7FFFu + ((u >> 16) & 1u); return (u16)(u >> 16); }
__device__ __forceinline__ float silu_f(float x) { return x / (1.f + __expf(-x)); }
__device__ __forceinline__ float sigmoid_f(float x) { return 1.f / (1.f + __expf(-x)); }
__device__ __forceinline__ float gelu_tanh(float x) { const float u = 0.7978845608028654f * (x + 0.044715f * x * x * x); const float e = __expf(2.f * u); const float t = 1.f - 2.f / (e + 1.f); return 0.5f * x * (1.f + t); }
__device__ __forceinline__ float wave_sum(float v) {
#pragma unroll
    for (int o = 32; o > 0; o >>= 1) v += __shfl_xor(v, o);
    return v;
}

struct Ptrs { const float* in[30]; float* out; unsigned char* ws; };
__device__ __forceinline__ int tid_opaque(int wv) { int l; asm volatile("v_mbcnt_lo_u32_b32 %0, -1, 0\n\tv_mbcnt_hi_u32_b32 %0, -1, %0" : "=v"(l)); return (wv << 6) | l; }
__device__ __forceinline__ float wave_sum_l(float v, int lane) {
#pragma unroll
    for (int o = 32; o > 0; o >>= 1) v += __int_as_float(__builtin_amdgcn_ds_bpermute((lane ^ o) << 2, __float_as_int(v)));
    return v;
}

__global__ __launch_bounds__(256) void k_mod(Ptrs P) {
    __shared__ float sc[17][64];
    const int i = blockIdx.y, col = blockIdx.x * 256 + threadIdx.x, tid = threadIdx.x;
    const float* W = P.in[4] + (size_t)i * 1024 * 6144;
    float acc[17];
#pragma unroll
    for (int r = 0; r < 17; ++r) acc[r] = 0.f;
    for (int k0 = 0; k0 < 1024; k0 += 64) {
        __syncthreads();
        for (int idx = tid; idx < 17 * 64; idx += 256) { const int r = idx >> 6, kk = idx & 63; const float v = r < 16 ? P.in[1][r * 1024 + k0 + kk] : P.in[3][k0 + kk]; sc[r][kk] = silu_f(v); }
        __syncthreads();
#pragma unroll 8
        for (int kk = 0; kk < 64; ++kk) { const float w = W[(size_t)(k0 + kk) * 6144 + col];
#pragma unroll
            for (int r = 0; r < 17; ++r) acc[r] += sc[r][kk] * w; }
    }
    float* mod = (float*)(P.ws + WS_MOD);
    const float bb = P.in[5][i * 6144 + col];
#pragma unroll
    for (int r = 0; r < 17; ++r) mod[(size_t)(i * 17 + r) * 6144 + col] = acc[r] + bb;
}
__device__ __forceinline__ void copy_small(const Ptrs& P, int t0, int nt) {
    float* sm = (float*)(P.ws + WS_SMALL);
    for (int i = t0; i < 4096; i += nt) { sm[SM_GMIX + i] = P.in[6][i]; sm[SM_GFFN + i] = P.in[7][i]; }
    for (int i = t0; i < 2048; i += nt) sm[SM_S5D + i] = P.in[15][i];
    for (int i = t0; i < 768; i += nt) sm[SM_GQ + i] = P.in[18][i];
    for (int i = t0; i < 512; i += nt) sm[SM_GKV + i] = P.in[19][i];
    for (int i = t0; i < 1024; i += nt) sm[SM_FINALG + i] = P.in[29][i];
    for (int i = t0; i < 16; i += nt) sm[SM_BGROUP + i] = P.in[24][i];
    for (int i = t0; i < 128; i += nt) sm[SM_BEXP + i] = P.in[26][i];
    for (int i = t0; i < 16384; i += nt) sm[SM_WGROUP + i] = P.in[23][i];
    for (int i = t0; i < 131072; i += nt) sm[SM_WEXP + i] = P.in[25][i];
}
__global__ __launch_bounds__(256) void k_init(Ptrs P) {
    copy_small(P, blockIdx.x * 256 + threadIdx.x, gridDim.x * 256);
    float4* X = (float4*)(P.ws + WS_X);
    const size_t n4 = (size_t)T * D / 4;
    for (size_t i = (size_t)blockIdx.x * 256 + threadIdx.x; i < n4; i += (size_t)gridDim.x * 256) {
        const size_t row = i / 256, c4 = i % 256; const int b = (int)(row / LTOT), pos = (int)(row % LTOT);
        X[i] = pos < CTXL ? ((const float4*)P.in[2])[((size_t)b * CTXL + pos) * 256 + c4] : ((const float4*)P.in[0])[((size_t)b * SEQ + (pos - CTXL)) * 256 + c4];
    }
    float2* rope = (float2*)(P.ws + WS_ROPE);
    for (int i = blockIdx.x * 256 + threadIdx.x; i < 2048 * 32; i += gridDim.x * 256) {
        const int s = i >> 5, k = i & 31, f = k & 15; const float invf = exp2f(-(float)f * (13.287712379549449f / 16.f));
        const float ang = (float)(k < 16 ? (s >> 6) : (s & 63)) * invf;
        rope[i] = make_float2(__cosf(ang), __sinf(ang));
    }
}

template <int MODE>
__device__ __forceinline__ void norm_rows(unsigned char* wsp, float* outp, int li, int which, int nwaves_blk, int* s_base, int wv) {
    struct { unsigned char* ws; float* out; } P{wsp, outp}; const float* sm = (const float*)(wsp + WS_SMALL);
    const int tidn = tid_opaque(wv); const int lane = tidn & 63, wave = tidn >> 6;
    float* X = (float*)(P.ws + WS_X);
    const float* mod = (const float*)(P.ws + WS_MOD);
    if (MODE & 1) {
        if (tidn == 0) { const unsigned* cnt = (const unsigned*)(P.ws + WS_CTL) + CW_CNT + (li - 1) * 32 * CS; int a = 0; for (int e = 0; e < 32; ++e) { s_base[e] = a; a += (int)((cnt[e * CS] + 255u) / 256u); } s_base[32] = a; }
        __syncthreads();
    }
    const bool lastl = (li == 3);
    for (int row = blockIdx.x * nwaves_blk + wave; row < T; row += gridDim.x * nwaves_blk) {
        const int b = row / LTOT, pos = row % LTOT; const bool isctx = pos < CTXL; const int r = isctx ? 16 : b;
        if ((MODE & 16) && isctx) continue;
        if ((MODE & 8) && lastl && isctx) continue;
        float4 v[4];
#pragma unroll
        for (int q = 0; q < 4; ++q) v[q] = *(const float4*)(X + (size_t)row * D + q * 256 + lane * 4);
        if (MODE & 1) {
            const bool skip = (li - 1 == 3) && isctx;
            if (!skip) {
                const int4 si = *(const int4*)(P.ws + WS_SELI + (size_t)row * 16); const float2 sw = *(const float2*)(P.ws + WS_SELW + (size_t)row * 8);
                const size_t g1 = (size_t)s_base[si.x] * 256 + si.y, g2 = (size_t)s_base[si.z] * 256 + si.w;
                const u16* YB = (const u16*)(P.ws + WS_YB);
                const float* gate = mod + (size_t)((li - 1) * 17 + r) * 6144 + 5 * 1024;
#pragma unroll
                for (int q = 0; q < 4; ++q) { const int c = q * 256 + lane * 4;
                    const uint2 ya = *(const uint2*)(YB + g1 * 1024 + c), yb = *(const uint2*)(YB + g2 * 1024 + c); const float4 gg = *(const float4*)(gate + c);
                    v[q].x += gg.x * (sw.x * bf2f((u16)(ya.x & 0xffff)) + sw.y * bf2f((u16)(yb.x & 0xffff)));
                    v[q].y += gg.y * (sw.x * bf2f((u16)(ya.x >> 16)) + sw.y * bf2f((u16)(yb.x >> 16)));
                    v[q].z += gg.z * (sw.x * bf2f((u16)(ya.y & 0xffff)) + sw.y * bf2f((u16)(yb.y & 0xffff)));
                    v[q].w += gg.w * (sw.x * bf2f((u16)(ya.y >> 16)) + sw.y * bf2f((u16)(yb.y >> 16)));
                    if (!(MODE & 16)) *(float4*)(X + (size_t)row * D + c) = v[q]; }
            }
        }
        float ss = 0.f;
#pragma unroll
        for (int q = 0; q < 4; ++q) ss += v[q].x * v[q].x + v[q].y * v[q].y + v[q].z * v[q].z + v[q].w * v[q].w;
        ss = wave_sum_l(ss, lane);
        const float rstd = rsqrtf(ss * (1.f / 1024.f) + EPS);
        if (MODE & 16) {
            float* out = P.out + ((size_t)b * SEQ + (pos - CTXL)) * D;
#pragma unroll
            for (int q = 0; q < 4; ++q) { const int c = q * 256 + lane * 4; const float4 g = *(const float4*)(sm + SM_FINALG + c);
                float4 ov = make_float4(v[q].x * rstd * g.x, v[q].y * rstd * g.y, v[q].z * rstd * g.z, v[q].w * rstd * g.w);
#if defined(PROBE_A)
                { const float da = 1.f + ((const float*)s_base)[40]; ov.x *= da; ov.y *= da; ov.z *= da; ov.w *= da; if (row == CTXL && c == 0) ov.x += ((const float*)s_base)[41]; }
#endif
                *(float4*)(out + c) = ov; }
            continue;
        }
        const float* gv = sm + (which ? SM_GFFN : SM_GMIX) + li * 1024;
        const float* sh = mod + (size_t)(li * 17 + r) * 6144 + (which ? 3 : 0) * 1024; const float* scl = sh + 1024;
        float h[16];
#pragma unroll
        for (int q = 0; q < 4; ++q) { const int c = q * 256 + lane * 4; const float4 g = *(const float4*)(gv + c), s4 = *(const float4*)(sh + c), c4 = *(const float4*)(scl + c);
            h[q * 4 + 0] = v[q].x * rstd * g.x * (1.f + c4.x) + s4.x; h[q * 4 + 1] = v[q].y * rstd * g.y * (1.f + c4.y) + s4.y;
            h[q * 4 + 2] = v[q].z * rstd * g.z * (1.f + c4.z) + s4.z; h[q * 4 + 3] = v[q].w * rstd * g.w * (1.f + c4.w) + s4.w; }
        if (MODE & 2) {
            u16* HX = (u16*)(P.ws + WS_HX);
#pragma unroll
            for (int q = 0; q < 4; ++q) { uint2 w; w.x = (unsigned)f2bf(h[q * 4]) | ((unsigned)f2bf(h[q * 4 + 1]) << 16); w.y = (unsigned)f2bf(h[q * 4 + 2]) | ((unsigned)f2bf(h[q * 4 + 3]) << 16);
                *(uint2*)(HX + (size_t)row * D + q * 256 + lane * 4) = w; }
        }
        if (MODE & 4) {
            u16* UH = (u16*)(P.ws + WS_R1 + R1_UH);
#pragma unroll
            for (int q = 0; q < 4; ++q) { const int c = q * 256 + lane * 4; const int g = c >> 4, ch = c & 15;
                uint2 w; w.x = (unsigned)f2bf(h[q * 4]) | ((unsigned)f2bf(h[q * 4 + 1]) << 16); w.y = (unsigned)f2bf(h[q * 4 + 2]) | ((unsigned)f2bf(h[q * 4 + 3]) << 16);
                *(uint2*)(UH + ((size_t)g * 2304 + b * 144 + (pos >> 4)) * 512 + (pos & 15) * 16 + ch) = w; }
        }
        if (MODE & 8) {
            const float* wg = sm + SM_WGROUP + (size_t)li * 1024 * 4;
            float lg[4] = {0.f, 0.f, 0.f, 0.f};
#pragma unroll
            for (int q = 0; q < 4; ++q)
#pragma unroll
                for (int j = 0; j < 4; ++j) { const int k = q * 256 + lane * 4 + j; const float4 w = *(const float4*)(wg + k * 4); const float hv = h[q * 4 + j];
                    lg[0] += hv * w.x; lg[1] += hv * w.y; lg[2] += hv * w.z; lg[3] += hv * w.w; }
#pragma unroll
            for (int g = 0; g < 4; ++g) lg[g] = wave_sum_l(lg[g], lane) + sm[SM_BGROUP + li * 4 + g];
            int gi = 0; float best = lg[0];
#pragma unroll
            for (int g = 1; g < 4; ++g) if (lg[g] > best) { best = lg[g]; gi = g; }
            float den = 0.f;
#pragma unroll
            for (int g = 0; g < 4; ++g) den += __expf(lg[g] - best);
            const float pg = 1.f / den;
            const float* we = sm + SM_WEXP + ((size_t)li * 4 + gi) * 1024 * 8;
            float le[8];
#pragma unroll
            for (int e = 0; e < 8; ++e) le[e] = 0.f;
#pragma unroll
            for (int q = 0; q < 4; ++q)
#pragma unroll
                for (int j = 0; j < 4; ++j) { const int k = q * 256 + lane * 4 + j; const float4 w0 = *(const float4*)(we + k * 8), w1 = *(const float4*)(we + k * 8 + 4); const float hv = h[q * 4 + j];
                    le[0] += hv * w0.x; le[1] += hv * w0.y; le[2] += hv * w0.z; le[3] += hv * w0.w; le[4] += hv * w1.x; le[5] += hv * w1.y; le[6] += hv * w1.z; le[7] += hv * w1.w; }
#pragma unroll
            for (int e = 0; e < 8; ++e) le[e] = wave_sum_l(le[e], lane) + sm[SM_BEXP + (li * 4 + gi) * 8 + e];
            int i1 = 0; float b1 = le[0];
#pragma unroll
            for (int e = 1; e < 8; ++e) if (le[e] > b1) { b1 = le[e]; i1 = e; }
            int i2 = -1; float b2 = -3.0e38f;
#pragma unroll
            for (int e = 0; e < 8; ++e) if (e != i1 && le[e] > b2) { b2 = le[e]; i2 = e; }
            if (lane == 0) {
                const float ex = __expf(b2 - b1); const float w1 = 1.f / (1.f + ex), w2 = ex / (1.f + ex);
                unsigned* cnt = (unsigned*)(P.ws + WS_CTL) + CW_CNT + li * 32 * CS; int* list = (int*)(P.ws + WS_LIST);
                const int e1 = gi * 8 + i1, e2 = gi * 8 + i2;
                const int s1 = (int)atomicAdd(&cnt[e1 * CS], 1u), s2 = (int)atomicAdd(&cnt[e2 * CS], 1u);
                list[(size_t)e1 * T + s1] = row; list[(size_t)e2 * T + s2] = row;
                *(int4*)(P.ws + WS_SELI + (size_t)row * 16) = make_int4(e1, s1, e2, s2);
                *(float2*)(P.ws + WS_SELW + (size_t)row * 8) = make_float2(pg * w1, pg * w2);
            }
        }
    }
}
template <int MODE> __global__ __launch_bounds__(256) void k_norm(Ptrs P, int li, int which) { __shared__ int sb[36]; norm_rows<MODE>(P.ws, P.out, li, which, 4, sb, __builtin_amdgcn_readfirstlane(threadIdx.x >> 6)); }

struct NG { const void* A; int lda; const int* rowidx; const float* B; int ldb; long bstride; const int* tileexp; const int* mdyn; float* C; int ldc; int M, N, K, pad; };
template <int ABF> __global__ __launch_bounds__(256) void n_gemm(NG g) {
    __shared__ float As[16][68], Bs[16][68];
    const int tm = blockIdx.y, tn = blockIdx.x, tid = threadIdx.x, tx = tid & 15, ty = tid >> 4;
    const int M = g.mdyn ? (*g.mdyn) * 256 : g.M;
    if (tm * 64 >= M) return;
    const float* B = g.B; if (g.tileexp) B += (long)g.tileexp[(tm * 64) / 256] * g.bstride;
    float acc[4][4];
#pragma unroll
    for (int i = 0; i < 4; ++i)
#pragma unroll
        for (int j = 0; j < 4; ++j) acc[i][j] = 0.f;
    const int arow = tm * 64 + (tid >> 2), ak = (tid & 3) * 4; long asrc = -1;
    if (arow < M) { const int r = g.rowidx ? g.rowidx[arow] : arow; if (r >= 0) asrc = (long)r * g.lda; }
    for (int k0 = 0; k0 < g.K; k0 += 16) {
        float a[4] = {0.f, 0.f, 0.f, 0.f};
        if (asrc >= 0) {
            if (ABF) { const uint2 w = *(const uint2*)((const u16*)g.A + asrc + k0 + ak); a[0] = bf2f((u16)(w.x & 0xffff)); a[1] = bf2f((u16)(w.x >> 16)); a[2] = bf2f((u16)(w.y & 0xffff)); a[3] = bf2f((u16)(w.y >> 16)); }
            else { const float4 w = *(const float4*)((const float*)g.A + asrc + k0 + ak); a[0] = w.x; a[1] = w.y; a[2] = w.z; a[3] = w.w; }
        }
        const float4 bv = *(const float4*)(B + (size_t)(k0 + (tid >> 4)) * g.ldb + tn * 64 + (tid & 15) * 4);
        __syncthreads();
#pragma unroll
        for (int i = 0; i < 4; ++i) As[ak + i][tid >> 2] = a[i];
        *(float4*)&Bs[tid >> 4][(tid & 15) * 4] = bv;
        __syncthreads();
#pragma unroll
        for (int kk = 0; kk < 16; ++kk) { const float4 a4 = *(const float4*)&As[kk][ty * 4], b4 = *(const float4*)&Bs[kk][tx * 4];
            const float av[4] = {a4.x, a4.y, a4.z, a4.w}, bw[4] = {b4.x, b4.y, b4.z, b4.w};
#pragma unroll
            for (int i = 0; i < 4; ++i)
#pragma unroll
                for (int j = 0; j < 4; ++j) acc[i][j] += av[i] * bw[j]; }
    }
#pragma unroll
    for (int i = 0; i < 4; ++i) { const int row = tm * 64 + ty * 4 + i; if (row < M) *(float4*)(g.C + (size_t)row * g.ldc + tn * 64 + tx * 4) = make_float4(acc[i][0], acc[i][1], acc[i][2], acc[i][3]); }
}
__device__ __forceinline__ int row_r(int row) { return (row % LTOT) < CTXL ? 16 : row / LTOT; }
__global__ __launch_bounds__(256) void n_post_glu(Ptrs P, int li) {
    float* X = (float*)(P.ws + WS_X); const float* TMP = (const float*)(P.ws + WS_NTMP); const float* mod = (const float*)(P.ws + WS_MOD);
    for (size_t i = (size_t)blockIdx.x * 256 + threadIdx.x; i < (size_t)T * D; i += (size_t)gridDim.x * 256) { const int row = (int)(i >> 10), c = (int)(i & 1023); const int r = row_r(row);
        const float val = TMP[(size_t)row * 2048 + c], gt = TMP[(size_t)row * 2048 + 1024 + c]; X[i] += mod[(size_t)(li * 17 + r) * 6144 + 2048 + c] * val * sigmoid_f(gt); }
}
__global__ __launch_bounds__(256) void n_post_wo(Ptrs P, int li) {
    float* X = (float*)(P.ws + WS_X); const float* TMP = (const float*)(P.ws + WS_NTMP); const float* mod = (const float*)(P.ws + WS_MOD);
    for (size_t i = (size_t)blockIdx.x * 256 + threadIdx.x; i < (size_t)T * D; i += (size_t)gridDim.x * 256) { const int row = (int)(i >> 10), c = (int)(i & 1023); const int r = row_r(row);
        X[i] += mod[(size_t)(li * 17 + r) * 6144 + 2048 + c] * TMP[i]; }
}
__global__ __launch_bounds__(256) void n_post_q(Ptrs P) {
    const float* TMP = (const float*)(P.ws + WS_NTMP); u16* QT = (u16*)(P.ws + WS_R1 + R1_QT); const float2* rope = (const float2*)(P.ws + WS_ROPE);
    const float scale = 0.07216878364870322f;
    for (size_t i = (size_t)blockIdx.x * 256 + threadIdx.x; i < (size_t)T * 1536; i += (size_t)gridDim.x * 256) { const int row = (int)(i / 1536), c = (int)(i % 1536); const int h = c / 192, dd = c % 192;
        const int b = row / LTOT, pos = row % LTOT; float v = TMP[i];
        if (dd >= 128 && pos >= CTXL) { const int l = dd - 128; const float pv = TMP[(size_t)row * 1536 + h * 192 + 128 + (l ^ 16)]; const float2 cs = rope[(size_t)(pos - CTXL) * 32 + (l >> 5) * 16 + (l & 15)];
            v = (l & 16) ? v * cs.x + pv * cs.y : v * cs.x - pv * cs.y; }
        QT[(((size_t)b * NH + h) * LTOT + pos) * QKD + dd] = f2bf(v * scale); }
}
__global__ __launch_bounds__(256) void n_post_kv(Ptrs P) {
    const float* TMP = (const float*)(P.ws + WS_NTMP); u16* KT = (u16*)(P.ws + WS_R1 + R1_KT); u16* VT = (u16*)(P.ws + WS_R1 + R1_VT);
    for (size_t i = (size_t)blockIdx.x * 256 + threadIdx.x; i < (size_t)T * 2048; i += (size_t)gridDim.x * 256) { const int row = (int)(i >> 11), c = (int)(i & 2047); const int h = c >> 8, dd = c & 255;
        const int b = row / LTOT, pos = row % LTOT; const u16 v = f2bf(TMP[i]);
        if (dd < 128) KT[(((size_t)b * NH + h) * LTOT + pos) * QKD + dd] = v; else VT[(((size_t)b * NH + h) * LTOT + pos) * 128 + dd - 128] = v; }
}
__global__ __launch_bounds__(256) void n_attn(Ptrs P) {
    __shared__ float Ks[32][192], Vs[32][128];
    const int qt = blockIdx.x, h = blockIdx.y, b = blockIdx.z, tid = threadIdx.x, ql = tid >> 2, part = tid & 3;
    const u16* QT = (const u16*)(P.ws + WS_R1 + R1_QT) + ((size_t)b * NH + h) * LTOT * QKD; const u16* KT = (const u16*)(P.ws + WS_R1 + R1_KT) + ((size_t)b * NH + h) * LTOT * QKD;
    const u16* VT = (const u16*)(P.ws + WS_R1 + R1_VT) + ((size_t)b * NH + h) * LTOT * 128; u16* O = (u16*)(P.ws + WS_ZO);
    const int pos = qt * 64 + ql; const int nk = (qt * 64 < CTXL) ? CTXL : LTOT;
    float q[48], o[32];
#pragma unroll
    for (int i = 0; i < 48; ++i) q[i] = bf2f(QT[(size_t)pos * QKD + part * 48 + i]);
#pragma unroll
    for (int i = 0; i < 32; ++i) o[i] = 0.f;
    float m = -1e30f, l = 0.f;
    for (int k0 = 0; k0 < nk; k0 += 32) {
        __syncthreads();
        for (int i = tid; i < 32 * 192; i += 256) Ks[i / 192][i % 192] = bf2f(KT[(size_t)k0 * QKD + i]);
        for (int i = tid; i < 32 * 128; i += 256) Vs[i / 128][i % 128] = bf2f(VT[(size_t)k0 * 128 + i]);
        __syncthreads();
        for (int kk = 0; kk < 32; ++kk) {
            float s = 0.f;
#pragma unroll
            for (int i = 0; i < 48; ++i) s += q[i] * Ks[kk][part * 48 + i];
            s += __shfl_xor(s, 1); s += __shfl_xor(s, 2);
            const float mn = fmaxf(m, s), al = __expf(m - mn), p = __expf(s - mn);
            l = l * al + p; m = mn;
#pragma unroll
            for (int i = 0; i < 32; ++i) o[i] = o[i] * al + p * Vs[kk][part * 32 + i];
        }
    }
    const float rl = 1.f / l;
#pragma unroll
    for (int i = 0; i < 32; ++i) O[((size_t)b * LTOT + pos) * D + h * 128 + part * 32 + i] = f2bf(o[i] * rl);
}
__global__ __launch_bounds__(128) void n_s5(Ptrs P, int j) {
    __shared__ float us[2][16], hre[2][64], him[2][64], Cre[2][16][64], Cim[2][16][64];
    const int b = blockIdx.x >> 6, g = blockIdx.x & 63, tid = threadIdx.x, dir = tid >> 6, p = tid & 63;
    const size_t gd = ((size_t)j * 2 + dir) * SG + g;
    const float dt = __expf(P.in[10][gd]); const float ar = P.in[8][gd * SP + p], ai = P.in[9][gd * SP + p];
    const float ldr = ar * dt, ldi = ai * dt, mag = __expf(ldr); const float abr = mag * __cosf(ldi), abi = mag * __sinf(ldi);
    const float nr = abr - 1.f, ni = abi, den = ar * ar + ai * ai; const float qr = (nr * ar + ni * ai) / den, qi = (ni * ar - nr * ai) / den;
    float bbr[16], bbi[16];
#pragma unroll
    for (int c = 0; c < 16; ++c) { const float br = P.in[11][(gd * SP + p) * SC + c], bi = P.in[12][(gd * SP + p) * SC + c]; bbr[c] = qr * br - qi * bi; bbi[c] = qr * bi + qi * br; }
    for (int i = tid; i < 2 * 16 * 64; i += 128) { const int d2 = i >> 10, c = (i >> 6) & 15, pp = i & 63; const size_t o = ((((size_t)j * 2 + d2) * SG + g) * SC + c) * SP + pp; Cre[d2][c][pp] = P.in[13][o]; Cim[d2][c][pp] = P.in[14][o]; }
    const u16* HX = (const u16*)(P.ws + WS_HX); float* Yf = (float*)(P.ws + WS_NTMP); float* Yr = Yf + (size_t)T * D;
    float hr = 0.f, hi = 0.f;
    for (int t = 0; t < LTOT; ++t) {
        __syncthreads();
        if (tid < 32) { const int d2 = tid >> 4, c = tid & 15; const int ps = d2 ? (t < CTXL ? CTXL - 1 - t : LTOT - 1 - (t - CTXL)) : t; us[d2][c] = bf2f(HX[((size_t)b * LTOT + ps) * D + g * 16 + c]); }
        __syncthreads();
        float bur = 0.f, bui = 0.f;
#pragma unroll
        for (int c = 0; c < 16; ++c) { bur += bbr[c] * us[dir][c]; bui += bbi[c] * us[dir][c]; }
        const float nhr = abr * hr - abi * hi + bur, nhi = abr * hi + abi * hr + bui; hr = nhr; hi = nhi;
        hre[dir][p] = hr; him[dir][p] = hi;
        __syncthreads();
        if (tid < 32) { const int d2 = tid >> 4, c = tid & 15; const int ps = d2 ? (t < CTXL ? CTXL - 1 - t : LTOT - 1 - (t - CTXL)) : t; float y = 0.f;
            for (int pp = 0; pp < 64; ++pp) y += Cre[d2][c][pp] * hre[d2][pp] - Cim[d2][c][pp] * him[d2][pp];
            (d2 ? Yr : Yf)[((size_t)b * LTOT + ps) * D + g * 16 + c] = y; }
    }
}
__global__ __launch_bounds__(256) void n_post_s5(Ptrs P, int j) {
    const float* Yf = (const float*)(P.ws + WS_NTMP); const float* Yr = Yf + (size_t)T * D; const u16* HX = (const u16*)(P.ws + WS_HX); u16* Z = (u16*)(P.ws + WS_ZO);
    for (size_t i = (size_t)blockIdx.x * 256 + threadIdx.x; i < (size_t)T * D; i += (size_t)gridDim.x * 256) { const int c = (int)(i & 1023);
        Z[i] = f2bf(gelu_tanh(Yf[i] + Yr[i] + P.in[15][j * 1024 + c] * bf2f(HX[i]))); }
}
__global__ __launch_bounds__(256) void n_build(Ptrs P, int li) {
    __shared__ int base[33];
    const unsigned* cnt = (const unsigned*)(P.ws + WS_CTL) + CW_CNT + li * 32 * CS; int* tileexp = (int*)(P.ws + WS_TILEEXP); int* slotrow = (int*)(P.ws + WS_SLOTROW); const int* list = (const int*)(P.ws + WS_LIST);
    if (threadIdx.x == 0) { int a = 0; for (int e = 0; e < 32; ++e) { base[e] = a; a += (int)((cnt[e * CS] + 255u) / 256u); } base[32] = a; tileexp[512] = a; }
    __syncthreads();
    for (int e = 0; e < 32; ++e) { const int nt = base[e + 1] - base[e];
        for (int t = threadIdx.x; t < nt; t += 256) tileexp[base[e] + t] = e;
        for (int s = threadIdx.x; s < nt * 256; s += 256) slotrow[base[e] * 256 + s] = s < (int)cnt[e * CS] ? list[(size_t)e * T + s] : -1; }
}
__global__ __launch_bounds__(256) void n_post_act2(Ptrs P, u16* ACT) {
    const float* TMP = (const float*)(P.ws + WS_NTMP); const int ntot = ((const int*)(P.ws + WS_TILEEXP))[512];
    for (size_t i = (size_t)blockIdx.x * 256 + threadIdx.x; i < (size_t)ntot * 256 * 512; i += (size_t)gridDim.x * 256) { const size_t gs = i >> 9; const int c = (int)(i & 511);
        ACT[i] = f2bf(silu_f(TMP[gs * 1024 + c]) * TMP[gs * 1024 + 512 + c]); }
}
__global__ __launch_bounds__(256) void n_post_y(Ptrs P) {
    const float* TMP = (const float*)(P.ws + WS_NTMP); u16* YB = (u16*)(P.ws + WS_YB); const int ntot = ((const int*)(P.ws + WS_TILEEXP))[512];
    for (size_t i = (size_t)blockIdx.x * 256 + threadIdx.x; i < (size_t)ntot * 256 * 1024; i += (size_t)gridDim.x * 256) YB[i] = f2bf(TMP[i]);
}

#define LAS __attribute__((address_space(3)))
typedef short bf16x8 __attribute__((ext_vector_type(8)));
typedef float f32x4 __attribute__((ext_vector_type(4)));
typedef unsigned u32x4 __attribute__((ext_vector_type(4)));
typedef unsigned u32x2 __attribute__((ext_vector_type(2)));
namespace g8 {
constexpr int BM = 256, BK = 64, HALF = 128, HTB = HALF * BK * 2, STAGE_BYTES = 8 * HTB, NXCD = 8, WGM = 8;
__host__ __device__ __forceinline__ int lds_byte(int r, int c) { const int st = (r >> 4) * 2 + (c >> 5), rr = r & 15, cc = c & 31, ob = rr * 64 + cc * 2; return st * 1024 + (ob ^ (((ob >> 9) & 1) << 5)); }
__host__ __device__ __forceinline__ void stage_rc(int b, int& R, int& C) { const int st = b / 1024, sb = b % 1024, swz = sb ^ (((sb >> 9) & 1) << 5); R = (st >> 1) * 16 + swz / 64; C = (st & 1) * 32 + (swz % 64) / 2; }
__host__ __device__ __forceinline__ int perm32(int rho) { const int n = rho >> 4, i = rho & 15; return 8 * (i >> 2) + 4 * n + (i & 3); }
struct Unit { int pm, pn, aux; };
struct Order {
    int nM, nN, nwg, G, c;
    __device__ __forceinline__ void init(int nM_, int nN_, int G_, int c_) { nM = nM_; nN = nN_; nwg = nM * nN; G = G_; c = c_; }
    __device__ __forceinline__ bool next(int i, int& pm, int& pn) const {
        const long L = (long)i * G + c; if (L >= nwg) return false;
        int wgid = (int)L; { const int q = nwg / NXCD, r = nwg % NXCD, xcd = wgid % NXCD, off = wgid / NXCD; wgid = (xcd < r ? xcd * (q + 1) : r * (q + 1) + (xcd - r) * q) + off; }
        const int nig = WGM * nN, gid = wgid / nig, fm = gid * WGM, gsz = (nM - fm) < WGM ? (nM - fm) : WGM;
        pm = fm + ((wgid % nig) % gsz); pn = (wgid % nig) / gsz; return true;
    }
};
__device__ __forceinline__ unsigned cvt_pk_bf16(float lo, float hi) { unsigned r; asm volatile("v_cvt_pk_bf16_f32 %0, %1, %2" : "=v"(r) : "v"(lo), "v"(hi)); return r; }

template <class Epi, class Sched>
__device__ __forceinline__ void gemm_phase(LAS unsigned char* lds, const int K, const Sched& S, const Epi& E, const int wv) {
    const int tid = tid_opaque(wv), wid = wv, lane = tid & 63, wr = wid >> 2, wc = wid & 3, fr = lane & 15, fq = lane >> 4;
    const int nt = K / BK;
    int R0, C0; stage_rc(tid * 16, R0, C0);
    unsigned voffB[2];
    { const int Rb0 = Epi::PERM ? ((R0 & ~31) + perm32(R0 & 31)) : R0;
      voffB[0] = (unsigned)(Rb0 * K + C0) * 2u; voffB[1] = voffB[0] + (unsigned)(64 * K) * 2u; }
    const size_t kstepB = (size_t)(BK * 2), hstepB = (size_t)HALF * K * 2;
    const size_t kstepA = S.a_kstep();
    const unsigned ldsw = (unsigned)wid * 1024u;
    const int aoff = lds_byte(wr * 64 + fr, fq * 8), boff = lds_byte(wc * 32 + fr, fq * 8);
#define G8_SA(b, h) (((b) * 2 + (h)) * HTB)
#define G8_SB(b, h) ((4 + (b) * 2 + (h)) * HTB)
#define G8_STAGE_B(bufoff, gbase) do { _Pragma("unroll") for (int _i = 0; _i < 2; ++_i) \
        __builtin_amdgcn_global_load_lds((const unsigned*)((const char*)(gbase) + voffB[_i]), (LAS unsigned*)(lds + (bufoff) + ldsw + _i * 8192), 16, 0, 0); } while (0)
#define G8_VI(h, i) ((Sched::NV == 1) ? 0 : ((h) * 2 + (i)))
#define G8_STAGE_A(bufoff, U, V, h, kb) do { \
        __builtin_amdgcn_global_load_lds((const unsigned*)(S.a_uptr(U, h, 0) + (size_t)(kb) + (V)[G8_VI(h, 0)]), (LAS unsigned*)(lds + (bufoff) + ldsw), 16, 0, 0); \
        __builtin_amdgcn_global_load_lds((const unsigned*)(S.a_uptr(U, h, 1) + (size_t)(kb) + (V)[G8_VI(h, 1)]), (LAS unsigned*)(lds + (bufoff) + ldsw + 8192), 16, 0, 0); } while (0)
#define G8_LDA(dst, b, h) do { _Pragma("unroll") for (int m = 0; m < 4; ++m) _Pragma("unroll") for (int k = 0; k < 2; ++k) dst[m][k] = *(const LAS bf16x8*)(lds + G8_SA(b, h) + aoff + m * 2048 + k * 1024); } while (0)
#define G8_LDB(dst, b, h) do { _Pragma("unroll") for (int n = 0; n < 2; ++n) _Pragma("unroll") for (int k = 0; k < 2; ++k) dst[n][k] = *(const LAS bf16x8*)(lds + G8_SB(b, h) + boff + n * 2048 + k * 1024); } while (0)
#define G8_MMA(ai, bj, At, Bt) do { __builtin_amdgcn_s_setprio(1); _Pragma("unroll") for (int m = 0; m < 4; ++m) _Pragma("unroll") for (int n = 0; n < 2; ++n) _Pragma("unroll") for (int k = 0; k < 2; ++k) \
        acc[ai][bj][m][n] = __builtin_amdgcn_mfma_f32_16x16x32_bf16(Bt[n][k], At[m][k], acc[ai][bj][m][n], 0, 0, 0); __builtin_amdgcn_s_setprio(0); } while (0)
#define G8_WAIT_V(n) asm volatile("s_waitcnt vmcnt(" #n ")" ::: "memory")
#define G8_WAIT_L(n) asm volatile("s_waitcnt lgkmcnt(" #n ")" ::: "memory")
#define G8_BAR __builtin_amdgcn_s_barrier()
#define G8_SCHED __builtin_amdgcn_sched_barrier(0)
    Unit cur, nxt; int ui = 0;
    if (!S.next(0, cur)) return;
    f32x4 acc[2][2][4][2];
#pragma unroll
    for (int a = 0; a < 2; ++a)
#pragma unroll
        for (int b = 0; b < 2; ++b)
#pragma unroll
            for (int m = 0; m < 4; ++m)
#pragma unroll
                for (int n = 0; n < 2; ++n) acc[a][b][m][n] = (f32x4){0.f, 0.f, 0.f, 0.f};
    bf16x8 At[4][2], B0[2][2], B1[2][2];
    unsigned cO[4], nO[4];
    S.a_voff(cur, R0, C0, cO);
    const char* cB = S.b_ptr(cur);
    G8_STAGE_B(G8_SB(0, 0), cB); G8_STAGE_A(G8_SA(0, 0), cur, cO, 0, 0); G8_STAGE_B(G8_SB(0, 1), cB + hstepB); G8_STAGE_A(G8_SA(0, 1), cur, cO, 1, 0);
    if (wr == 1) G8_BAR;
    G8_WAIT_V(4); G8_BAR;
    G8_STAGE_B(G8_SB(1, 0), cB + kstepB); G8_STAGE_A(G8_SA(1, 0), cur, cO, 0, kstepA); G8_STAGE_B(G8_SB(1, 1), cB + hstepB + kstepB);
    G8_WAIT_V(6); G8_BAR;
    for (;;) {
        const bool has_next = S.next(ui + 1, nxt);
        const char* nB = cB;
        if (has_next) { S.a_voff(nxt, R0, C0, nO); nB = S.b_ptr(nxt); }
        else { nxt = cur;
#pragma unroll
            for (int q = 0; q < 4; ++q) nO[q] = cO[q]; }
        for (int t = 0; t < nt; t += 2) {
            const bool last = (t == nt - 2);
            const size_t k1 = (size_t)(t + 1) * kstepA;
            const size_t k2 = last ? 0 : (size_t)(t + 2) * kstepA, k3 = k2 + kstepA;
            unsigned pV[4]; g8::Unit pU;
            if (last) { pU = nxt; pV[0] = nO[0]; pV[1] = nO[1]; pV[2] = nO[2]; pV[3] = nO[3]; } else { pU = cur; pV[0] = cO[0]; pV[1] = cO[1]; pV[2] = cO[2]; pV[3] = cO[3]; }
            const char* b2 = last ? nB : cB + (size_t)(t + 2) * kstepB; const char* b3 = b2 + kstepB;
            G8_LDB(B0, 0, 0); G8_SCHED; G8_LDA(At, 0, 0); G8_STAGE_A(G8_SA(1, 1), cur, cO, 1, k1);
            G8_WAIT_L(8); G8_BAR; G8_WAIT_L(0); G8_MMA(0, 0, At, B0); G8_BAR; G8_SCHED;
            G8_LDB(B1, 0, 1); G8_STAGE_B(G8_SB(0, 0), b2);
            G8_BAR; G8_WAIT_L(0); G8_MMA(0, 1, At, B1); G8_BAR;
            G8_LDA(At, 0, 1); G8_STAGE_A(G8_SA(0, 0), pU, pV, 0, k2);
            G8_BAR; G8_WAIT_L(0); G8_MMA(1, 0, At, B0); G8_BAR; G8_SCHED;
            G8_STAGE_B(G8_SB(0, 1), b2 + hstepB);
            G8_WAIT_V(6); G8_BAR; G8_MMA(1, 1, At, B1); G8_BAR;
            G8_LDB(B0, 1, 0); G8_SCHED; G8_LDA(At, 1, 0); G8_STAGE_A(G8_SA(0, 1), pU, pV, 1, k2);
            G8_WAIT_L(8); G8_BAR; G8_WAIT_L(0); G8_MMA(0, 0, At, B0); G8_BAR; G8_SCHED;
            G8_LDB(B1, 1, 1); G8_STAGE_B(G8_SB(1, 0), b3);
            G8_BAR; G8_WAIT_L(0); G8_MMA(0, 1, At, B1); G8_BAR;
            G8_LDA(At, 1, 1); G8_STAGE_A(G8_SA(1, 0), pU, pV, 0, k3);
            G8_BAR; G8_WAIT_L(0); G8_MMA(1, 0, At, B0); G8_BAR; G8_SCHED;
            G8_STAGE_B(G8_SB(1, 1), b3 + hstepB);
            G8_WAIT_V(6); G8_BAR; G8_MMA(1, 1, At, B1); G8_BAR;
        }
        E(acc, cur, wr, wc, fr, fq);
        if (!has_next) break;
#pragma unroll
        for (int a = 0; a < 2; ++a)
#pragma unroll
            for (int b = 0; b < 2; ++b)
#pragma unroll
                for (int m = 0; m < 4; ++m)
#pragma unroll
                    for (int n = 0; n < 2; ++n) acc[a][b][m][n] = (f32x4){0.f, 0.f, 0.f, 0.f};
        cur = nxt; cB = nB; ++ui;
#pragma unroll
        for (int q = 0; q < 4; ++q) cO[q] = nO[q];
    }
    G8_WAIT_V(0);
    if (wr == 0) G8_BAR;
    G8_BAR;
#undef G8_SA
#undef G8_SB
#undef G8_STAGE_A
#undef G8_VI
#undef G8_STAGE_B
#undef G8_LDA
#undef G8_LDB
#undef G8_MMA
#undef G8_WAIT_V
#undef G8_WAIT_L
#undef G8_BAR
#undef G8_SCHED
}
}
struct SchedDense {
    g8::Order ord; const char* A; unsigned lda2; const char* Bt; int K;
    __device__ __forceinline__ void init(const void* A_, int lda, const void* Bt_, int M, int N, int K_) { A = (const char*)A_; lda2 = (unsigned)lda * 2u; Bt = (const char*)Bt_; K = K_; ord.init(M / 256, N / 256, (int)gridDim.x, (int)blockIdx.x); }
    __device__ __forceinline__ bool next(int i, g8::Unit& u) const { u.aux = 0; return ord.next(i, u.pm, u.pn); }
    static constexpr int NV = 1;
    __device__ __forceinline__ size_t a_kstep() const { return 128; }
    __device__ __forceinline__ const char* a_uptr(const g8::Unit& u, int h, int i) const { return A + (size_t)(u.pm * 256 + h * 128 + i * 64) * lda2; }
    __device__ __forceinline__ void a_voff(const g8::Unit& u, int R0, int C0, unsigned (&o)[4]) const { o[0] = (unsigned)R0 * lda2 + C0 * 2; }
    __device__ __forceinline__ const char* b_ptr(const g8::Unit& u) const { return Bt + (size_t)u.pn * 256 * K * 2; }
};
struct SchedS5 {
    g8::Order ord; const char* A; const char* W; int K;
    __device__ __forceinline__ void init(const void* A_, const void* W_, int K_) { A = (const char*)A_; W = (const char*)W_; K = K_; ord.init(576, 1, (int)gridDim.x, (int)blockIdx.x); }
    __device__ __forceinline__ bool next(int i, g8::Unit& u) const { int pmx, pn; if (!ord.next(i, pmx, pn)) return false; u.aux = pmx / 9; u.pm = pmx % 9; u.pn = 0; return true; }
    static constexpr int NV = 1;
    __device__ __forceinline__ size_t a_kstep() const { return 128; }
    __device__ __forceinline__ const char* a_uptr(const g8::Unit& u, int h, int i) const { return A + (size_t)(u.aux * 2304 + u.pm * 256 + h * 128 + i * 64) * 1024; }
    __device__ __forceinline__ void a_voff(const g8::Unit& u, int R0, int C0, unsigned (&o)[4]) const { o[0] = (unsigned)R0 * 1024u + C0 * 2; }
    __device__ __forceinline__ const char* b_ptr(const g8::Unit& u) const { return W + (size_t)u.aux * 256 * K * 2; }
};
template <bool GATHER> struct SchedMoe {
    g8::Order ord; const char* A; const char* W; int K; const int* sbase; const unsigned* cnt; const int* list; size_t wstride;
    __device__ __forceinline__ void init(const void* A_, const void* W_, int K_, const int* sbase_, const unsigned* cnt_, const int* list_) {
        A = (const char*)A_; W = (const char*)W_; K = K_; sbase = sbase_; cnt = cnt_; list = list_; wstride = (size_t)1024 * K * 2; ord.init(sbase_[32], 4, (int)gridDim.x, (int)blockIdx.x); }
    __device__ __forceinline__ bool next(int i, g8::Unit& u) const { if (!ord.next(i, u.pm, u.pn)) return false; int e = 0;
        for (int k = 1; k < 32; ++k) e = (u.pm >= sbase[k]) ? k : e;
        u.aux = e; return true; }
    static constexpr int NV = GATHER ? 4 : 1;
    __device__ __forceinline__ size_t a_kstep() const { return 128; }
    __device__ __forceinline__ const char* a_uptr(const g8::Unit& u, int h, int i) const { return GATHER ? A : A + (size_t)(u.pm * 256 + h * 128 + i * 64) * 1024; }
    __device__ __forceinline__ void a_voff(const g8::Unit& u, int R0, int C0, unsigned (&o)[4]) const {
        if (GATHER) {
            const int e = u.aux; const int s0 = (u.pm - sbase[e]) * 256 + R0; const int n = (int)cnt[e * CS]; const int* l = list + (size_t)e * T;
#pragma unroll
            for (int q = 0; q < 4; ++q) { const int a = s0 + q * 64; o[q] = (unsigned)l[a < n ? a : 0] * 2048u + C0 * 2; }
        } else o[0] = (unsigned)R0 * 1024u + C0 * 2; }
    __device__ __forceinline__ const char* b_ptr(const g8::Unit& u) const { return W + (size_t)u.aux * wstride + (size_t)u.pn * 256 * K * 2; }
};

#define EPI_LOOP_AM for (int ai = 0; ai < 2; ++ai) _Pragma("unroll") for (int m = 0; m < 4; ++m)
struct EpiS5a {
    static constexpr bool PERM = true; u16* S;
    __device__ __forceinline__ void operator()(const f32x4 (&acc)[2][2][4][2], const g8::Unit& u, int wr, int wc, int fr, int fq) const {
        u16* base = S + ((size_t)u.aux * 2304 + (size_t)u.pm * 256 + wr * 64 + fr) * 256 + wc * 32 + 8 * fq;
#pragma unroll
        EPI_LOOP_AM { u16* rowp = base + (size_t)(ai * 128 + m * 16) * 256;
#pragma unroll
            for (int bj = 0; bj < 2; ++bj) { const f32x4 a0 = acc[ai][bj][m][0], a1 = acc[ai][bj][m][1];
                u32x4 w; w.x = g8::cvt_pk_bf16(a0[0], a0[1]); w.y = g8::cvt_pk_bf16(a0[2], a0[3]); w.z = g8::cvt_pk_bf16(a1[0], a1[1]); w.w = g8::cvt_pk_bf16(a1[2], a1[3]);
                *(u32x4*)(rowp + bj * 128) = w; } }
    }
};
struct EpiS5b {
    static constexpr bool PERM = true; u16* Z;
    __device__ __forceinline__ void operator()(const f32x4 (&acc)[2][2][4][2], const g8::Unit& u, int wr, int wc, int fr, int fq) const {
        const int g = u.aux; const int ch0 = (fq & 1) * 8;
#pragma unroll
        EPI_LOOP_AM { const int rowin = u.pm * 256 + ai * 128 + wr * 64 + m * 16 + fr;
#pragma unroll
            for (int bj = 0; bj < 2; ++bj) { const int c0 = bj * 128 + wc * 32 + fq * 8; const int t = c0 >> 4;
                const f32x4 a0 = acc[ai][bj][m][0], a1 = acc[ai][bj][m][1];
                u32x4 w; w.x = g8::cvt_pk_bf16(gelu_tanh(a0[0]), gelu_tanh(a0[1])); w.y = g8::cvt_pk_bf16(gelu_tanh(a0[2]), gelu_tanh(a0[3]));
                w.z = g8::cvt_pk_bf16(gelu_tanh(a1[0]), gelu_tanh(a1[1])); w.w = g8::cvt_pk_bf16(gelu_tanh(a1[2]), gelu_tanh(a1[3]));
                *(u32x4*)(Z + ((size_t)rowin * 16 + t) * 1024 + g * 16 + ch0) = w; } }
    }
};
struct EpiGlu {
    static constexpr bool PERM = true; u16* DL; const float* mod; int li;
    __device__ __forceinline__ void operator()(const f32x4 (&acc)[2][2][4][2], const g8::Unit& u, int wr, int wc, int fr, int fq) const {
        const int r = (u.pm % 9 == 0) ? 16 : u.pm / 9; const float* gate = mod + (size_t)(li * 17 + r) * 6144 + 2048;
        const int j0 = u.pn * 128 + wc * 32 + fq * 8;
        const f32x4 g0 = *(const f32x4*)(gate + j0), g1 = *(const f32x4*)(gate + j0 + 4);
#pragma unroll
        EPI_LOOP_AM { const size_t row = (size_t)u.pm * 256 + ai * 128 + wr * 64 + m * 16 + fr;
            const f32x4 v0 = acc[ai][0][m][0], v1 = acc[ai][0][m][1], t0 = acc[ai][1][m][0], t1 = acc[ai][1][m][1];
            u32x4 w; w.x = g8::cvt_pk_bf16(g0[0] * v0[0] * sigmoid_f(t0[0]), g0[1] * v0[1] * sigmoid_f(t0[1])); w.y = g8::cvt_pk_bf16(g0[2] * v0[2] * sigmoid_f(t0[2]), g0[3] * v0[3] * sigmoid_f(t0[3]));
            w.z = g8::cvt_pk_bf16(g1[0] * v1[0] * sigmoid_f(t1[0]), g1[1] * v1[1] * sigmoid_f(t1[1])); w.w = g8::cvt_pk_bf16(g1[2] * v1[2] * sigmoid_f(t1[2]), g1[3] * v1[3] * sigmoid_f(t1[3]));
            *(u32x4*)(DL + row * 1024 + j0) = w; }
    }
};
struct EpiF32 {
    static constexpr bool PERM = false; float* C; int ldc;
    __device__ __forceinline__ void operator()(const f32x4 (&acc)[2][2][4][2], const g8::Unit& u, int wr, int wc, int fr, int fq) const {
        float* base = C + ((size_t)u.pm * 256 + wr * 64 + fr) * ldc + u.pn * 256 + wc * 32 + 4 * fq;
#pragma unroll
        EPI_LOOP_AM { float* rowp = base + (size_t)(ai * 128 + m * 16) * ldc;
#pragma unroll
            for (int bj = 0; bj < 2; ++bj)
#pragma unroll
                for (int n = 0; n < 2; ++n) *(f32x4*)(rowp + bj * 128 + n * 16) = acc[ai][bj][m][n]; }
    }
};
__device__ __forceinline__ float rstd_from_ps(const float* PS, size_t row, int first4, int n4, float inv_n) {
    float s = 0.f;
#pragma unroll
    for (int q = 0; q < 3; ++q) if (q < n4) { const f32x4 v = *(const f32x4*)(PS + row * 24 + (first4 + q) * 4); s += (v[0] + v[1]) + (v[2] + v[3]); }
    return rsqrtf(s * inv_n + EPS);
}
struct EpiWin {
    static constexpr bool PERM = false; u16* CQ; u16* CKV; u16* KT; float* PS; const float2* rope;
    __device__ __forceinline__ void operator()(const f32x4 (&acc)[2][2][4][2], const g8::Unit& u, int wr, int wc, int fr, int fq) const {
        const int b = u.pm / 9, pt = u.pm % 9; const int lane = fr + 16 * fq;
#pragma unroll
        EPI_LOOP_AM { const int pos = pt * 256 + ai * 128 + wr * 64 + m * 16 + fr; const size_t row = (size_t)u.pm * 256 + ai * 128 + wr * 64 + m * 16 + fr;
#pragma unroll
            for (int bj = 0; bj < 2; ++bj) { const f32x4 a0 = acc[ai][bj][m][0], a1 = acc[ai][bj][m][1]; const int cg = u.pn * 256 + bj * 128;
                if (cg < 640) {
                    float s = (a0[0] * a0[0] + a0[1] * a0[1]) + (a0[2] * a0[2] + a0[3] * a0[3]) + (a1[0] * a1[0] + a1[1] * a1[1]) + (a1[2] * a1[2] + a1[3] * a1[3]);
                    s += __int_as_float(__builtin_amdgcn_ds_bpermute((lane ^ 16) << 2, __float_as_int(s))); s += __int_as_float(__builtin_amdgcn_ds_bpermute((lane ^ 32) << 2, __float_as_int(s)));
                    if (fq == 0) PS[row * 24 + (u.pn * 2 + bj) * 4 + wc] = s;
                    u16* dst = cg < 384 ? CQ + row * QR + cg + wc * 32 + fq * 4 : CKV + row * KVR + (cg - 384) + wc * 32 + fq * 4;
                    u32x2 w0, w1; w0.x = g8::cvt_pk_bf16(a0[0], a0[1]); w0.y = g8::cvt_pk_bf16(a0[2], a0[3]); w1.x = g8::cvt_pk_bf16(a1[0], a1[1]); w1.y = g8::cvt_pk_bf16(a1[2], a1[3]);
                    *(u32x2*)dst = w0; *(u32x2*)(dst + 16) = w1;
                } else if (wc < 2) {
                    f32x4 x0 = a0, x1 = a1;
                    if (pos >= CTXL) { const float2* rp = rope + (size_t)(pos - CTXL) * 32 + wc * 16 + fq * 4;
#pragma unroll
                        for (int q = 0; q < 4; ++q) { const float2 cs = rp[q]; x0[q] = a0[q] * cs.x - a1[q] * cs.y; x1[q] = a1[q] * cs.x + a0[q] * cs.y; } }
                    u32x2 w0, w1; w0.x = g8::cvt_pk_bf16(x0[0], x0[1]); w0.y = g8::cvt_pk_bf16(x0[2], x0[3]); w1.x = g8::cvt_pk_bf16(x1[0], x1[1]); w1.y = g8::cvt_pk_bf16(x1[2], x1[3]);
                    { u16* dst = KT + (((size_t)b * 2 + wc) * LTOT + pos) * 32 + fq * 4; *(u32x2*)dst = w0; *(u32x2*)(dst + 16) = w1; }
                } } }
    }
};
struct EpiQ {
    static constexpr bool PERM = false; u16* QT; const float2* rope; const float* PS; int dry;
    __device__ __forceinline__ void operator()(const f32x4 (&acc)[2][2][4][2], const g8::Unit& u, int wr, int wc, int fr, int fq) const {
        if (dry) return;
        const int b = u.pm / 9, pt = u.pm % 9;
#pragma unroll
        EPI_LOOP_AM { const int pos = pt * 256 + ai * 128 + wr * 64 + m * 16 + fr; const float scale = 0.07216878364870322f * rstd_from_ps(PS, (size_t)u.pm * 256 + ai * 128 + wr * 64 + m * 16 + fr, 0, 3, 1.f / 384.f);
#pragma unroll
            for (int bj = 0; bj < 2; ++bj) { const int g32 = u.pn * 8 + bj * 4 + wc; const int h = g32 / 6, part = g32 % 6;
                f32x4 a = acc[ai][bj][m][0], bq = acc[ai][bj][m][1];
                if (part >= 4 && pos >= CTXL) { const float2* rp = rope + (size_t)(pos - CTXL) * 32 + (part - 4) * 16 + fq * 4;
#pragma unroll
                    for (int q = 0; q < 4; ++q) { const float2 cs = rp[q]; const float x0 = a[q], x1 = bq[q]; a[q] = x0 * cs.x - x1 * cs.y; bq[q] = x1 * cs.x + x0 * cs.y; } }
                u16* dst = QT + ((((size_t)b * NH + h) * 6 + part) * LTOT + pos) * 32 + fq * 4;
                u32x2 w0, w1; w0.x = g8::cvt_pk_bf16(a[0] * scale, a[1] * scale); w0.y = g8::cvt_pk_bf16(a[2] * scale, a[3] * scale);
                w1.x = g8::cvt_pk_bf16(bq[0] * scale, bq[1] * scale); w1.y = g8::cvt_pk_bf16(bq[2] * scale, bq[3] * scale);
                *(u32x2*)dst = w0; *(u32x2*)(dst + 16) = w1; } }
    }
};
struct EpiKV {
    static constexpr bool PERM = true; u16* KT; u16* VT; const float* PS; int dry;
    __device__ __forceinline__ void operator()(const f32x4 (&acc)[2][2][4][2], const g8::Unit& u, int wr, int wc, int fr, int fq) const {
        if (dry) return;
        const int b = u.pm / 9, pt = u.pm % 9, h = u.pn;
#pragma unroll
        EPI_LOOP_AM { const int pos = pt * 256 + ai * 128 + wr * 64 + m * 16 + fr; const size_t bh = (size_t)b * NH + h; const float rs = rstd_from_ps(PS, (size_t)u.pm * 256 + ai * 128 + wr * 64 + m * 16 + fr, 3, 2, 1.f / 256.f);
#pragma unroll
            for (int bj = 0; bj < 2; ++bj) { const f32x4 a0 = acc[ai][bj][m][0] * rs, a1 = acc[ai][bj][m][1] * rs;
                u32x4 w; w.x = g8::cvt_pk_bf16(a0[0], a0[1]); w.y = g8::cvt_pk_bf16(a0[2], a0[3]); w.z = g8::cvt_pk_bf16(a1[0], a1[1]); w.w = g8::cvt_pk_bf16(a1[2], a1[3]);
                u16* dst = bj == 0 ? KT + ((bh * 6 + wc) * LTOT + pos) * 32 + fq * 8 : VT + ((bh * 4 + wc) * LTOT + pos) * 32 + fq * 8;
                *(u32x4*)dst = w; } }
    }
};
struct EpiWo {
    static constexpr bool PERM = true; u16* DL; const float* mod; int li;
    __device__ __forceinline__ void operator()(const f32x4 (&acc)[2][2][4][2], const g8::Unit& u, int wr, int wc, int fr, int fq) const {
        const int r = (u.pm % 9 == 0) ? 16 : u.pm / 9; const float* gate = mod + (size_t)(li * 17 + r) * 6144 + 2048;
        f32x4 gg[2][2];
#pragma unroll
        for (int bj = 0; bj < 2; ++bj)
#pragma unroll
            for (int n = 0; n < 2; ++n) gg[bj][n] = *(const f32x4*)(gate + u.pn * 256 + bj * 128 + wc * 32 + fq * 8 + n * 4);
#pragma unroll
        EPI_LOOP_AM { const size_t row = (size_t)u.pm * 256 + ai * 128 + wr * 64 + m * 16 + fr;
#pragma unroll
            for (int bj = 0; bj < 2; ++bj) { const f32x4 a0 = acc[ai][bj][m][0] * gg[bj][0], a1 = acc[ai][bj][m][1] * gg[bj][1];
                u32x4 w; w.x = g8::cvt_pk_bf16(a0[0], a0[1]); w.y = g8::cvt_pk_bf16(a0[2], a0[3]); w.z = g8::cvt_pk_bf16(a1[0], a1[1]); w.w = g8::cvt_pk_bf16(a1[2], a1[3]);
                *(u32x4*)(DL + row * 1024 + u.pn * 256 + bj * 128 + wc * 32 + fq * 8) = w; } }
    }
};
struct EpiMoe1 {
    static constexpr bool PERM = true; u16* ACT; int dry;
    __device__ __forceinline__ void operator()(const f32x4 (&acc)[2][2][4][2], const g8::Unit& u, int wr, int wc, int fr, int fq) const {
        if (dry) return;
        const int j0 = u.pn * 128 + wc * 32 + fq * 8;
#pragma unroll
        EPI_LOOP_AM { const size_t gs = (size_t)u.pm * 256 + ai * 128 + wr * 64 + m * 16 + fr;
            const f32x4 g0 = acc[ai][0][m][0], g1 = acc[ai][0][m][1], u0 = acc[ai][1][m][0], u1 = acc[ai][1][m][1];
            u32x4 w; w.x = g8::cvt_pk_bf16(silu_f(g0[0]) * u0[0], silu_f(g0[1]) * u0[1]); w.y = g8::cvt_pk_bf16(silu_f(g0[2]) * u0[2], silu_f(g0[3]) * u0[3]);
            w.z = g8::cvt_pk_bf16(silu_f(g1[0]) * u1[0], silu_f(g1[1]) * u1[1]); w.w = g8::cvt_pk_bf16(silu_f(g1[2]) * u1[2], silu_f(g1[3]) * u1[3]);
            *(u32x4*)(ACT + gs * 512 + j0) = w; }
    }
};
struct EpiMoe2 {
    static constexpr bool PERM = true; u16* YB; int dry;
    __device__ __forceinline__ void operator()(const f32x4 (&acc)[2][2][4][2], const g8::Unit& u, int wr, int wc, int fr, int fq) const {
        if (dry) return;
#pragma unroll
        EPI_LOOP_AM { const size_t gs = (size_t)u.pm * 256 + ai * 128 + wr * 64 + m * 16 + fr;
#pragma unroll
            for (int bj = 0; bj < 2; ++bj) { const f32x4 a0 = acc[ai][bj][m][0], a1 = acc[ai][bj][m][1];
                u32x4 w; w.x = g8::cvt_pk_bf16(a0[0], a0[1]); w.y = g8::cvt_pk_bf16(a0[2], a0[3]); w.z = g8::cvt_pk_bf16(a1[0], a1[1]); w.w = g8::cvt_pk_bf16(a1[2], a1[3]);
                *(u32x4*)(YB + gs * 1024 + u.pn * 256 + bj * 128 + wc * 32 + fq * 8) = w; } }
    }
};
namespace at {
typedef short s16x4 __attribute__((ext_vector_type(4)));
typedef float f32x16 __attribute__((ext_vector_type(16)));
constexpr int KVBLK = 64, QBLK = 32, NW = 8;
constexpr int SHM_V = KVBLK * 128 * 2, SHM_K = KVBLK * QKD * 2, NBUF = 3, SHM_ATTN = NBUF * SHM_V + NBUF * SHM_K + NW * 64 * 4;
constexpr float SCALE = 1.0f;
constexpr float THR = 8.f;
#define KSWZ(row, colB) ((row) * 384 + ((colB) ^ (((row) & 7) << 4)))
#define SBAR() __builtin_amdgcn_sched_barrier(0)
__device__ __forceinline__ int crow(int r, int hi) { return (r & 3) + 8 * (r >> 2) + 4 * hi; }
__device__ __forceinline__ unsigned cvtpk(float lo, float hi) { unsigned r; asm volatile("v_cvt_pk_bf16_f32 %0, %1, %2" : "=v"(r) : "v"(lo), "v"(hi)); return r; }
__device__ __forceinline__ void partialSM(f32x16& p0, f32x16& p1, float& m_reg, float& mn, float& alpha) {
    constexpr float C = SCALE * 1.4426950408889634f;
    float pmax = p0[0];
#pragma unroll
    for (int r = 1; r < 16; ++r) pmax = fmaxf(pmax, p0[r]);
#pragma unroll
    for (int r = 0; r < 16; ++r) pmax = fmaxf(pmax, p1[r]);
    { auto rr = __builtin_amdgcn_permlane32_swap(__float_as_uint(pmax), __float_as_uint(pmax), false, false); pmax = fmaxf(__uint_as_float(rr[0]), __uint_as_float(rr[1])); }
    if (__builtin_expect(__all(pmax - m_reg <= THR / SCALE), 1)) { mn = m_reg; alpha = 1.f; }
    else { mn = fmaxf(m_reg, pmax); alpha = __builtin_amdgcn_exp2f((m_reg - mn) * C); m_reg = mn; }
    const float mnC = -mn * C;
#pragma unroll
    for (int r = 0; r < 16; ++r) p0[r] = fmaf(p0[r], C, mnC);
#pragma unroll
    for (int r = 0; r < 16; ++r) p1[r] = fmaf(p1[r], C, mnC);
#pragma unroll
    for (int r = 0; r < 16; ++r) p0[r] = __builtin_amdgcn_exp2f(p0[r]);
}
__device__ __forceinline__ void finishSM(f32x16& p0, f32x16& p1, float alpha, float& l_reg, bf16x8& pa0, bf16x8& pa1, bf16x8& pa2, bf16x8& pa3) {
#pragma unroll
    for (int r = 0; r < 16; ++r) p1[r] = __builtin_amdgcn_exp2f(p1[r]);
    float ps = 0;
#pragma unroll
    for (int r = 0; r < 16; ++r) ps += p0[r];
#pragma unroll
    for (int r = 0; r < 16; ++r) ps += p1[r];
    { auto rr = __builtin_amdgcn_permlane32_swap(__float_as_uint(ps), __float_as_uint(ps), false, false); ps = __uint_as_float(rr[0]) + __uint_as_float(rr[1]); }
    l_reg = l_reg * alpha + ps;
#define PK4(P, BASE, OUT) do { unsigned a0 = cvtpk(P[BASE + 0], P[BASE + 1]), a1 = cvtpk(P[BASE + 2], P[BASE + 3]);   \
    unsigned b0 = cvtpk(P[BASE + 4], P[BASE + 5]), b1 = cvtpk(P[BASE + 6], P[BASE + 7]);                              \
    auto r0 = __builtin_amdgcn_permlane32_swap(a0, b0, false, false); auto r1 = __builtin_amdgcn_permlane32_swap(a1, b1, false, false); \
    u32x4 w = {r0[0], r1[0], r0[1], r1[1]}; OUT = *reinterpret_cast<bf16x8*>(&w); } while (0)
    PK4(p0, 0, pa0); PK4(p0, 8, pa1); PK4(p1, 0, pa2); PK4(p1, 8, pa3);
#undef PK4
}
#define KRD(x0, x1, kb, a) do { asm volatile("ds_read_b128 %0, %1 offset:%2" : "=v"(x0) : "v"(kb), "i"((a) * 128) : "memory"); \
                                asm volatile("ds_read_b128 %0, %1 offset:%2" : "=v"(x1) : "v"(kb), "i"((a) * 128 + 32 * 384) : "memory"); } while (0)
#define KWT(n, x0, x1) asm volatile("s_waitcnt lgkmcnt(" #n ")" : "+v"(x0), "+v"(x1) :: "memory")
#define KMM(x0, x1, q) do { p0 = __builtin_amdgcn_mfma_f32_32x32x16_bf16(x0, q, p0, 0, 0, 0); p1 = __builtin_amdgcn_mfma_f32_32x32x16_bf16(x1, q, p1, 0, 0, 0); } while (0)
__device__ __forceinline__ void qkt(f32x16& p0, f32x16& p1, int kb0, int kb1, int kb2, int kb3, const bf16x8* qr) {
    p0 = f32x16{}; p1 = f32x16{};
    bf16x8 a0, a1, b0, b1, c0, c1;
    KRD(a0, a1, kb0, 0); KRD(b0, b1, kb1, 0); KRD(c0, c1, kb2, 0);
    KWT(4, a0, a1); KMM(a0, a1, qr[0]);
    KWT(2, b0, b1); KMM(b0, b1, qr[1]);  KRD(a0, a1, kb3, 0);
    KWT(2, c0, c1); KMM(c0, c1, qr[2]);  KRD(b0, b1, kb0, 1);
    KWT(2, a0, a1); KMM(a0, a1, qr[3]);  KRD(c0, c1, kb1, 1);
    KWT(2, b0, b1); KMM(b0, b1, qr[4]);  KRD(a0, a1, kb2, 1);
    KWT(2, c0, c1); KMM(c0, c1, qr[5]);  KRD(b0, b1, kb3, 1);
    KWT(2, a0, a1); KMM(a0, a1, qr[6]);  KRD(c0, c1, kb0, 2);
    KWT(2, b0, b1); KMM(b0, b1, qr[7]);  KRD(a0, a1, kb1, 2);
    KWT(2, c0, c1); KMM(c0, c1, qr[8]);  KRD(b0, b1, kb2, 2);
    KWT(2, a0, a1); KMM(a0, a1, qr[9]);  KRD(c0, c1, kb3, 2);
    KWT(2, b0, b1); KMM(b0, b1, qr[10]);
    KWT(0, c0, c1); KMM(c0, c1, qr[11]);
}
#undef KRD
#undef KWT
#undef KMM
__device__ __forceinline__ int v_st(int k, int c) { const int kk = (k & ~0xC) | ((k & 4) << 1) | ((k & 8) >> 1); return ((kk >> 3) * 4 + (c >> 5)) * 512 + ((kk & 7) * 32 + (c & 31)) * 2; }
__device__ __forceinline__ int v_rd_base(int lane) { return ((lane & 3) << 3) | (((lane >> 2) & 3) << 6) | (((lane >> 4) & 1) << 5) | (((lane >> 5) & 1) << 8); }
constexpr int v_rd_off(int d0, int ks, int half) { return d0 * 512 + ks * 4096 + half * 2048; }
template <int OFF> __device__ __forceinline__ s16x4 tr_read(int vb) { s16x4 r; asm volatile("ds_read_b64_tr_b16 %0, %1 offset:%2" : "=&v"(r) : "v"(vb), "i"(OFF) : "memory"); return r; }
struct VFr { s16x4 l0, h0, l1, h1, l2, h2, l3, h3; };
template <int D0> __device__ __forceinline__ void pv_rd(VFr& f, int vb) {
    f.l0 = tr_read<v_rd_off(D0, 0, 0)>(vb); f.h0 = tr_read<v_rd_off(D0, 0, 1)>(vb); f.l1 = tr_read<v_rd_off(D0, 1, 0)>(vb); f.h1 = tr_read<v_rd_off(D0, 1, 1)>(vb);
    f.l2 = tr_read<v_rd_off(D0, 2, 0)>(vb); f.h2 = tr_read<v_rd_off(D0, 2, 1)>(vb); f.l3 = tr_read<v_rd_off(D0, 3, 0)>(vb); f.h3 = tr_read<v_rd_off(D0, 3, 1)>(vb);
}
#define VWT(n, f) asm volatile("s_waitcnt lgkmcnt(" #n ")" : "+v"(f.l0), "+v"(f.h0), "+v"(f.l1), "+v"(f.h1), "+v"(f.l2), "+v"(f.h2), "+v"(f.l3), "+v"(f.h3) :: "memory")
__device__ __forceinline__ void pv_mm(f32x16& od, const VFr& f, bf16x8 pa0, bf16x8 pa1, bf16x8 pa2, bf16x8 pa3) {
#define PK(L, H) (bf16x8){L[0], L[1], L[2], L[3], H[0], H[1], H[2], H[3]}
    od = __builtin_amdgcn_mfma_f32_32x32x16_bf16(pa0, PK(f.l0, f.h0), od, 0, 0, 0);
    od = __builtin_amdgcn_mfma_f32_32x32x16_bf16(pa1, PK(f.l1, f.h1), od, 0, 0, 0);
    od = __builtin_amdgcn_mfma_f32_32x32x16_bf16(pa2, PK(f.l2, f.h2), od, 0, 0, 0);
    od = __builtin_amdgcn_mfma_f32_32x32x16_bf16(pa3, PK(f.l3, f.h3), od, 0, 0, 0);
#undef PK
}
__device__ __forceinline__ void pv_d0(f32x16* o, int vb, bf16x8 pa0, bf16x8 pa1, bf16x8 pa2, bf16x8 pa3) {
    VFr fa, fb;
    pv_rd<0>(fa, vb);
    pv_rd<1>(fb, vb); VWT(8, fa); pv_mm(o[0], fa, pa0, pa1, pa2, pa3);
    pv_rd<2>(fa, vb); VWT(8, fb); pv_mm(o[1], fb, pa0, pa1, pa2, pa3);
    pv_rd<3>(fb, vb); VWT(8, fa); pv_mm(o[2], fa, pa0, pa1, pa2, pa3);
                      VWT(0, fb); pv_mm(o[3], fb, pa0, pa1, pa2, pa3);
}
#undef VWT
__device__ __forceinline__ void attn_body(const u16* __restrict__ Qb, const u16* __restrict__ Kh, const u16* __restrict__ Vh, const u16* __restrict__ KRb, u16* __restrict__ Ob, int ldo, int qpos0, int seq, char* lds, LAS unsigned char* ldsl, int wv) {
    const int tid = tid_opaque(wv), wid = wv, lane = tid & 63, r32 = lane & 31, hi = lane >> 5;
    char* V_lds = lds; char* K_lds = lds + NBUF * SHM_V;
    float* ws = (float*)(lds + NBUF * SHM_V + NBUF * SHM_K) + wid * 64; float* li_l = ws; float* al_l = ws + 32;
    float m_reg = -1e30f, l_reg = 0; f32x16 o[4] = {}; bf16x8 qr[12];
    const u16* Qw = Qb + (long)(qpos0 + wid * QBLK + r32) * 32 + hi * 8;
#pragma unroll
    for (int d0 = 0; d0 < 12; ++d0) qr[d0] = *reinterpret_cast<const bf16x8*>(Qw + (long)(d0 >> 1) * (LTOT * 32) + (d0 & 1) * 16);
    const char* ksrc[3]; unsigned vof[2];
#pragma unroll
    for (int i = 0; i < 3; ++i) { const int p = (wid + 8 * i) * 64 + lane, row = p / 24, slot = p % 24; const int colB = (slot * 16) ^ ((row & 7) << 4); const int dg = colB >> 6;
        ksrc[i] = (dg < 4 ? (const char*)Kh + (size_t)dg * (LTOT * 64) : (const char*)KRb + (size_t)(dg - 4) * (LTOT * 64)) + row * 64 + (colB & 63); }
#pragma unroll
    for (int i = 0; i < 2; ++i) { const int ob = (wid + 8 * i) * 1024 + lane * 16, sub = ob >> 9, within = (ob & 511) >> 1; const int kk = (sub >> 2) * 8 + (within >> 5);
        const int k = (kk & ~0xC) | ((kk & 4) << 1) | ((kk & 8) >> 1), col = (sub & 3) * 32 + (within & 31); vof[i] = (unsigned)((col >> 5) * (LTOT * 64) + k * 64 + (col & 31) * 2); }
    const char* Vg = (const char*)Vh;
#define DMA(t, bK, bV) do { _Pragma("unroll") for (int i_ = 0; i_ < 3; ++i_) __builtin_amdgcn_global_load_lds((const unsigned*)(ksrc[i_] + (size_t)(t) * (KVBLK * 64)), (LAS unsigned*)(ldsl + NBUF * SHM_V + (bK) + (wid + 8 * i_) * 1024), 16, 0, 0); \
    _Pragma("unroll") for (int i_ = 0; i_ < 2; ++i_) __builtin_amdgcn_global_load_lds((const unsigned*)(Vg + (size_t)(t) * (KVBLK * 64) + vof[i_]), (LAS unsigned*)(ldsl + (bV) + (wid + 8 * i_) * 1024), 16, 0, 0); } while (0)
    const int vb0 = (int)(uintptr_t)V_lds + v_rd_base(lane);
    const int kx = (r32 & 7) << 4, kl = (int)(uintptr_t)K_lds + r32 * 384;
    const int kbs0 = kl + ((0 * 32 + hi * 16) ^ kx), kbs1 = kl + ((1 * 32 + hi * 16) ^ kx), kbs2 = kl + ((2 * 32 + hi * 16) ^ kx), kbs3 = kl + ((3 * 32 + hi * 16) ^ kx);
#define RESC(a) do { if (__any((a) < 1.f)) { if (hi == 0) al_l[r32] = (a); asm volatile("s_waitcnt lgkmcnt(0)" ::: "memory"); \
    _Pragma("unroll") for (int d = 0; d < 4; ++d) _Pragma("unroll") for (int r = 0; r < 16; ++r) o[d][r] *= al_l[crow(r, hi)]; } } while (0)
    f32x16 p0, p1; float mn, al; bf16x8 pa0, pa1, pa2, pa3; const int NT = seq / KVBLK;
    int b0 = 0, b1 = 1, b2 = 2;
    DMA(0, 0, 0); DMA(1, SHM_K, SHM_V);
    asm volatile("s_waitcnt vmcnt(5)" ::: "memory"); __builtin_amdgcn_s_barrier(); asm volatile("" ::: "memory");
    for (int j = 0; j < NT; ++j) {
        if (j + 2 < NT) DMA(j + 2, b2 * SHM_K, b2 * SHM_V);
        SBAR(); qkt(p0, p1, kbs0 + b0 * SHM_K, kbs1 + b0 * SHM_K, kbs2 + b0 * SHM_K, kbs3 + b0 * SHM_K, qr);
        partialSM(p0, p1, m_reg, mn, al); RESC(al);
        finishSM(p0, p1, al, l_reg, pa0, pa1, pa2, pa3); SBAR();
        pv_d0(o, vb0 + b0 * SHM_V, pa0, pa1, pa2, pa3);
        if (j + 2 < NT) asm volatile("s_waitcnt vmcnt(5)" ::: "memory"); else asm volatile("s_waitcnt vmcnt(0)" ::: "memory");
        asm volatile("s_waitcnt lgkmcnt(0)" ::: "memory"); __builtin_amdgcn_s_barrier(); asm volatile("" ::: "memory");
        { const int t_ = b0; b0 = b1; b1 = b2; b2 = t_; }
    }
    if (hi == 0) li_l[r32] = l_reg; asm volatile("s_waitcnt lgkmcnt(0)" ::: "memory");
    float rli[16];
#pragma unroll
    for (int r = 0; r < 16; ++r) rli[r] = __builtin_amdgcn_rcpf(li_l[crow(r, hi)]);
    u16* Ow = Ob + (long)(wid * QBLK) * ldo;
#pragma unroll
    for (int r = 0; r < 16; ++r) { const int orow = crow(r, hi);
#pragma unroll
        for (int d0 = 0; d0 < 4; ++d0) Ow[(long)orow * ldo + d0 * 32 + r32] = f2bf(o[d0][r] * rli[r]); }
#undef DMA
#undef RESC
}
#undef KSWZ
#undef SBAR
}
struct NormDst { u16* X; u16* HX; u16* UH; unsigned* cnt; int* list; unsigned char* seli; unsigned char* selw; const float* xin; const float* cin; };
__device__ __forceinline__ NormDst norm_dst_real(unsigned char* ws, int li) {
    NormDst d; d.X = (u16*)(ws + WS_X); d.HX = (u16*)(ws + WS_HX); d.UH = (u16*)(ws + WS_R1 + R1_UH); d.cnt = (unsigned*)(ws + WS_CTL) + CW_CNT + li * 32 * CS; d.list = (int*)(ws + WS_LIST); d.seli = ws + WS_SELI; d.selw = ws + WS_SELW; d.xin = nullptr; d.cin = nullptr; return d; }
__device__ __forceinline__ NormDst norm_dst_dummy(unsigned char* ws) {
    NormDst d; unsigned char* t = ws + WS_NTMP; d.X = (u16*)t; d.HX = (u16*)(t + (size_t)T * D * 4); d.UH = d.HX; d.cnt = (unsigned*)(ws + WS_CTL) + CW_CNT_DUMMY; d.list = (int*)(t + (size_t)T * D * 4 + (size_t)64 * 2304 * 512 * 2);
    d.seli = (unsigned char*)(d.list + (size_t)64 * T); d.selw = d.seli + (size_t)T * 16; d.xin = nullptr; d.cin = nullptr; return d; }
__device__ __forceinline__ float wave_sum_dpp(float v) {
    v += __int_as_float(__builtin_amdgcn_update_dpp(0, __float_as_int(v), 0x111, 0xF, 0xF, true));
    v += __int_as_float(__builtin_amdgcn_update_dpp(0, __float_as_int(v), 0x112, 0xF, 0xF, true));
    v += __int_as_float(__builtin_amdgcn_update_dpp(0, __float_as_int(v), 0x114, 0xF, 0xF, true));
    v += __int_as_float(__builtin_amdgcn_update_dpp(0, __float_as_int(v), 0x118, 0xF, 0xF, true));
    v += __int_as_float(__builtin_amdgcn_update_dpp(0, __float_as_int(v), 0x142, 0xA, 0xF, false));
    v += __int_as_float(__builtin_amdgcn_update_dpp(0, __float_as_int(v), 0x143, 0xC, 0xF, false));
    return __int_as_float(__builtin_amdgcn_readlane(__float_as_int(v), 63));
}
__device__ __forceinline__ float bperm(float v, int srclane) { return __int_as_float(__builtin_amdgcn_ds_bpermute(srclane << 2, __float_as_int(v))); }
template <int MODE>
__device__ __forceinline__ void norm2_rows(unsigned char* ws, float* outp, const NormDst d, int li, int which, int* s_base, char* lds, int wv) {
    const float* sm = (const float*)(ws + WS_SMALL);
    const int tidn = tid_opaque(wv); const int lane = tidn & 63, wave = wv;
    const u16* X = (const u16*)(ws + WS_X);
    const float* mod = (const float*)(ws + WS_MOD);
    float* WG = (float*)lds;
    u16* WE = (u16*)(lds + 16384);
    __syncthreads();
    if (MODE & 1) { if (tidn == 0) { const unsigned* cnt = (const unsigned*)(ws + WS_CTL) + CW_CNT + (li - 1) * 32 * CS; int a = 0; for (int e = 0; e < 32; ++e) { s_base[e] = a; a += (int)((cnt[e * CS] + 255u) / 256u); } s_base[32] = a; } }
    if (MODE & 8) {
        const float* wg = sm + SM_WGROUP + (size_t)li * 4096; const float* we = sm + SM_WEXP + (size_t)li * 32768;
#pragma unroll 2
        for (int k = tidn; k < 1024; k += 512) { const int pk = ((k >> 8) * 4 + (k & 3)) * 64 + ((k >> 2) & 63); *(float4*)(WG + 4 * pk) = *(const float4*)(wg + 4 * k); }
#pragma unroll 8
        for (int i = tidn; i < 4096; i += 512) { const int g = i >> 10, k = i & 1023; const int pk = ((k >> 8) * 4 + (k & 3)) * 64 + ((k >> 2) & 63);
            const float4 v0 = *(const float4*)(we + (size_t)i * 8), v1 = *(const float4*)(we + (size_t)i * 8 + 4);
            u32x4 w; w.x = g8::cvt_pk_bf16(v0.x, v0.y); w.y = g8::cvt_pk_bf16(v0.z, v0.w); w.z = g8::cvt_pk_bf16(v1.x, v1.y); w.w = g8::cvt_pk_bf16(v1.z, v1.w);
            *(u32x4*)(WE + ((size_t)g * 1024 + pk) * 8) = w; }
    }
    __syncthreads();
    const bool lastl = (li == 3);
    const int rstride = 1; const u16* YB = (const u16*)(ws + WS_YB); const u16* DL = (const u16*)(ws + WS_HX);
    float4 vA[4], vB[4]; int4 siA = make_int4(0, 0, 0, 0), siB = siA; float2 swA = make_float2(0.f, 0.f), swB = swA; uint2 dlA[4], dlB[4], yaB[4], ybB[4];
#define NR_LOAD_A(rw) do { if ((rw) < rowend) { if (MODE & 64) { const int b_ = (rw) / LTOT, p_ = (rw) % LTOT; const float* xs_ = p_ < CTXL ? d.cin + ((size_t)b_ * CTXL + p_) * D : d.xin + ((size_t)b_ * SEQ + (p_ - CTXL)) * D; \
            _Pragma("unroll") for (int q = 0; q < 4; ++q) vA[q] = *(const float4*)(xs_ + q * 256 + lane * 4); } \
        else { _Pragma("unroll") for (int q = 0; q < 4; ++q) { const uint2 xb_ = *(const uint2*)(X + (size_t)(rw) * D + q * 256 + lane * 4); vA[q] = make_float4(__uint_as_float(xb_.x << 16), __uint_as_float(xb_.x & 0xffff0000u), __uint_as_float(xb_.y << 16), __uint_as_float(xb_.y & 0xffff0000u)); } } \
        if (MODE & 1) { siA = *(const int4*)(ws + WS_SELI + (size_t)(rw) * 16); swA = *(const float2*)(ws + WS_SELW + (size_t)(rw) * 8); } \
        if (MODE & 32) { _Pragma("unroll") for (int q = 0; q < 4; ++q) dlA[q] = *(const uint2*)(DL + (size_t)(rw) * D + q * 256 + lane * 4); } } } while (0)
#define NR_A_TO_B(rw) do { _Pragma("unroll") for (int q = 0; q < 4; ++q) { vB[q] = vA[q]; dlB[q] = dlA[q]; } siB = siA; swB = swA; \
        if ((MODE & 1) && (rw) < rowend && !((li - 1 == 3) && ((rw) % LTOT) < CTXL)) { const size_t g1 = (size_t)s_base[siB.x] * 256 + siB.y, g2 = (size_t)s_base[siB.z] * 256 + siB.w; \
            _Pragma("unroll") for (int q = 0; q < 4; ++q) { yaB[q] = *(const uint2*)(YB + g1 * 1024 + q * 256 + lane * 4); ybB[q] = *(const uint2*)(YB + g2 * 1024 + q * 256 + lane * 4); } } } while (0)
    const int nwv = gridDim.x * 8, nper = (T + nwv - 1) / nwv; const int row0 = (blockIdx.x * 8 + wave) * nper; const int rowend = row0 + nper < T ? row0 + nper : T;
    NR_LOAD_A(row0); NR_A_TO_B(row0); NR_LOAD_A(row0 + rstride);
    int rec_e1 = 0, rec_e2 = 0, rec_row = -1; float rec_w1 = 0.f, rec_w2 = 0.f; int it = -1;
    float4 gvr[4], shr[4], sclr[4], gater[4]; int rcur = -1;
#pragma unroll
    for (int q = 0; q < 4; ++q) { gvr[q] = *(const float4*)(sm + ((MODE & 16) ? SM_FINALG : (which ? SM_GFFN : SM_GMIX) + li * 1024) + q * 256 + lane * 4); shr[q] = sclr[q] = gater[q] = make_float4(0.f, 0.f, 0.f, 0.f); }
    for (int row = row0; row < rowend; row += rstride) {
        ++it;
        const int b = row / LTOT, pos = row % LTOT; const bool isctx = pos < CTXL; const int r = isctx ? 16 : b;
        if (r != rcur) { rcur = r;
#pragma unroll
            for (int q = 0; q < 4; ++q) { const int c = q * 256 + lane * 4;
                if (!(MODE & 16)) { const float* sh_ = mod + (size_t)(li * 17 + r) * 6144 + (which ? 3 : 0) * 1024; shr[q] = *(const float4*)(sh_ + c); sclr[q] = *(const float4*)(sh_ + 1024 + c); }
                if (MODE & 1) gater[q] = *(const float4*)(mod + (size_t)((li - 1) * 17 + r) * 6144 + 5 * 1024 + c); } }
        float4 v[4]; uint2 ya[4], yb[4], dl[4]; const float2 sw = swB;
#pragma unroll
        for (int q = 0; q < 4; ++q) { v[q] = vB[q]; ya[q] = yaB[q]; yb[q] = ybB[q]; dl[q] = dlB[q]; }
        NR_A_TO_B(row + rstride); NR_LOAD_A(row + 2 * rstride);
        if ((MODE & 16) && isctx) continue;
        if ((MODE & 8) && lastl && isctx) continue;
        if (MODE & 1) {
            const bool skip = (li - 1 == 3) && isctx;
            if (!skip) {
#pragma unroll
                for (int q = 0; q < 4; ++q) { const int c = q * 256 + lane * 4; const float4 gg = gater[q];
                    v[q].x += gg.x * (sw.x * bf2f((u16)(ya[q].x & 0xffff)) + sw.y * bf2f((u16)(yb[q].x & 0xffff)));
                    v[q].y += gg.y * (sw.x * bf2f((u16)(ya[q].x >> 16)) + sw.y * bf2f((u16)(yb[q].x >> 16)));
                    v[q].z += gg.z * (sw.x * bf2f((u16)(ya[q].y & 0xffff)) + sw.y * bf2f((u16)(yb[q].y & 0xffff)));
                    v[q].w += gg.w * (sw.x * bf2f((u16)(ya[q].y >> 16)) + sw.y * bf2f((u16)(yb[q].y >> 16)));
                    if (!(MODE & 16)) { uint2 xw; xw.x = g8::cvt_pk_bf16(v[q].x, v[q].y); xw.y = g8::cvt_pk_bf16(v[q].z, v[q].w); *(uint2*)(d.X + (size_t)row * D + c) = xw; } }
            }
        }
        if (MODE & 32) {
#pragma unroll
            for (int q = 0; q < 4; ++q) { const int c = q * 256 + lane * 4;
                v[q].x += bf2f((u16)(dl[q].x & 0xffff)); v[q].y += bf2f((u16)(dl[q].x >> 16)); v[q].z += bf2f((u16)(dl[q].y & 0xffff)); v[q].w += bf2f((u16)(dl[q].y >> 16));
                uint2 xw; xw.x = g8::cvt_pk_bf16(v[q].x, v[q].y); xw.y = g8::cvt_pk_bf16(v[q].z, v[q].w); *(uint2*)(d.X + (size_t)row * D + c) = xw; }
        }
        float ss = 0.f;
#pragma unroll
        for (int q = 0; q < 4; ++q) ss += v[q].x * v[q].x + v[q].y * v[q].y + v[q].z * v[q].z + v[q].w * v[q].w;
        ss = wave_sum_dpp(ss);
        const float rstd = rsqrtf(ss * (1.f / 1024.f) + EPS);
        if (MODE & 16) {
            float* out = outp + ((size_t)b * SEQ + (pos - CTXL)) * D;
#pragma unroll
            for (int q = 0; q < 4; ++q) { const int c = q * 256 + lane * 4; const float4 g = gvr[q];
                *(float4*)(out + c) = make_float4(v[q].x * rstd * g.x, v[q].y * rstd * g.y, v[q].z * rstd * g.z, v[q].w * rstd * g.w); }
            continue;
        }
        float h[16];
#pragma unroll
        for (int q = 0; q < 4; ++q) { const float4 g = gvr[q], s4 = shr[q], c4 = sclr[q];
            h[q * 4 + 0] = v[q].x * rstd * g.x * (1.f + c4.x) + s4.x; h[q * 4 + 1] = v[q].y * rstd * g.y * (1.f + c4.y) + s4.y;
            h[q * 4 + 2] = v[q].z * rstd * g.z * (1.f + c4.z) + s4.z; h[q * 4 + 3] = v[q].w * rstd * g.w * (1.f + c4.w) + s4.w; }
        if (MODE & 2) {
#pragma unroll
            for (int q = 0; q < 4; ++q) { uint2 w; w.x = g8::cvt_pk_bf16(h[q * 4], h[q * 4 + 1]); w.y = g8::cvt_pk_bf16(h[q * 4 + 2], h[q * 4 + 3]);
                *(uint2*)(d.HX + (size_t)row * D + q * 256 + lane * 4) = w; }
        }
        if (MODE & 4) {
#pragma unroll
            for (int q = 0; q < 4; ++q) { const int c = q * 256 + lane * 4; const int g = c >> 4, ch = c & 15;
                uint2 w; w.x = g8::cvt_pk_bf16(h[q * 4], h[q * 4 + 1]); w.y = g8::cvt_pk_bf16(h[q * 4 + 2], h[q * 4 + 3]);
                *(uint2*)(d.UH + ((size_t)g * 2304 + b * 144 + (pos >> 4)) * 512 + (pos & 15) * 16 + ch) = w; }
        }
        if (MODE & 8) {
            float lg[4] = {0.f, 0.f, 0.f, 0.f};
#pragma unroll
            for (int q = 0; q < 4; ++q)
#pragma unroll
                for (int j = 0; j < 4; ++j) { const float4 w = *(const float4*)(WG + ((q * 4 + j) * 64 + lane) * 4); const float hv = h[q * 4 + j];
                    lg[0] += hv * w.x; lg[1] += hv * w.y; lg[2] += hv * w.z; lg[3] += hv * w.w; }
#pragma unroll
            for (int g = 0; g < 4; ++g) lg[g] = wave_sum_dpp(lg[g]);
#pragma unroll
            for (int g = 0; g < 4; ++g) lg[g] += sm[SM_BGROUP + li * 4 + g];
            int gi = 0; float best = lg[0];
#pragma unroll
            for (int g = 1; g < 4; ++g) if (lg[g] > best) { best = lg[g]; gi = g; }
            float den = 0.f;
#pragma unroll
            for (int g = 0; g < 4; ++g) den += __expf(lg[g] - best);
            const float pg = 1.f / den;
            const u16* wes = WE + (size_t)gi * 8192;
            float le[8];
#pragma unroll
            for (int e = 0; e < 8; ++e) le[e] = 0.f;
#pragma unroll
            for (int q = 0; q < 4; ++q)
#pragma unroll
                for (int j = 0; j < 4; ++j) { const u32x4 w = *(const u32x4*)(wes + ((q * 4 + j) * 64 + lane) * 8); const float hv = h[q * 4 + j];
                    le[0] += hv * __uint_as_float(w.x << 16); le[1] += hv * __uint_as_float(w.x & 0xffff0000u); le[2] += hv * __uint_as_float(w.y << 16); le[3] += hv * __uint_as_float(w.y & 0xffff0000u);
                    le[4] += hv * __uint_as_float(w.z << 16); le[5] += hv * __uint_as_float(w.z & 0xffff0000u); le[6] += hv * __uint_as_float(w.w << 16); le[7] += hv * __uint_as_float(w.w & 0xffff0000u); }
#pragma unroll
            for (int e = 0; e < 8; ++e) le[e] = wave_sum_dpp(le[e]);
#pragma unroll
            for (int e = 0; e < 8; ++e) le[e] += sm[SM_BEXP + (li * 4 + gi) * 8 + e];
            int i1 = 0; float b1 = le[0];
#pragma unroll
            for (int e = 1; e < 8; ++e) if (le[e] > b1) { b1 = le[e]; i1 = e; }
            int i2 = -1; float b2 = -3.0e38f;
#pragma unroll
            for (int e = 0; e < 8; ++e) if (e != i1 && le[e] > b2) { b2 = le[e]; i2 = e; }
            { const float ex = __expf(b2 - b1); const float w1 = 1.f / (1.f + ex), w2 = ex / (1.f + ex);
              if (lane == it) { rec_e1 = gi * 8 + i1; rec_e2 = gi * 8 + i2; rec_w1 = pg * w1; rec_w2 = pg * w2; rec_row = row; } }
        }
    }
    if (MODE & 8) {
        if (rec_row >= 0) {
            const int s1 = (int)atomicAdd(&d.cnt[rec_e1 * CS], 1u), s2 = (int)atomicAdd(&d.cnt[rec_e2 * CS], 1u);
            d.list[(size_t)rec_e1 * T + s1] = rec_row; d.list[(size_t)rec_e2 * T + s2] = rec_row;
            *(int4*)(d.seli + (size_t)rec_row * 16) = make_int4(rec_e1, s1, rec_e2, s2);
            *(float2*)(d.selw + (size_t)rec_row * 8) = make_float2(rec_w1, rec_w2);
        }
    }
#undef NR_LOAD_A
#undef NR_A_TO_B
}
#define XB_TMO      128
#define XB_XCNT(j)  (256  + 64 * (j))
#define XB_XSUB(j)  (1280 + 64 * (j))
#define XB_XGEN(j)  (2304 + 64 * (j))
#define XB_TOP      3328
#define XB_TOPGEN   3392
#define XCD_BAR_WORDS 3456
#define XB_SPIN_CAP (1u << 18)
__device__ __forceinline__ unsigned xb_ld(unsigned* p)              { return __hip_atomic_load(p, __ATOMIC_RELAXED, __HIP_MEMORY_SCOPE_AGENT); }
__device__ __forceinline__ unsigned xb_add(unsigned* p, unsigned v) { return __hip_atomic_fetch_add(p, v, __ATOMIC_RELAXED, __HIP_MEMORY_SCOPE_AGENT); }
__device__ __forceinline__ unsigned xb_xcc_id() { return (unsigned)__builtin_amdgcn_s_getreg((3 << 11) | 20) & 0xFu; }
#define XB_SPIN(cond, bar) do { unsigned _sp = 0; while (cond) { __builtin_amdgcn_s_sleep(1); \
    if ((++_sp & 255u) == 0u) { if (xb_ld(&(bar)[XB_TMO])) break; if (_sp > XB_SPIN_CAP) { atomicAdd(&(bar)[XB_TMO], 1u); break; } } } } while (0)
struct XcdBarrier { unsigned* bar; unsigned x; volatile LAS unsigned* st; };
__device__ __forceinline__ XcdBarrier xcd_barrier_post(unsigned* bar, volatile LAS unsigned* st) {
    XcdBarrier b; b.bar = bar; b.x = xb_xcc_id(); b.st = st;
    if (threadIdx.x == 0) (void)xb_add(&bar[XB_XCNT(b.x)], 1u);
    return b;
}
__device__ __forceinline__ void xcd_barrier_complete(unsigned* bar, unsigned x, unsigned& nloc, unsigned& nx) {
    const unsigned G = gridDim.x * gridDim.y * gridDim.z;
    unsigned sum, cnt, mine, sp = 0u;
    for (;;) {
        sum = 0u; cnt = 0u; mine = 0u;
#pragma unroll
        for (unsigned j = 0; j < 16; ++j) { const unsigned c = xb_ld(&bar[XB_XCNT(j)]); sum += c; cnt += (c > 0u) ? 1u : 0u; mine = (j == x) ? c : mine; }
        if (sum == G) break;
        __builtin_amdgcn_s_sleep(1);
        if ((++sp & 255u) == 0u) { if (xb_ld(&bar[XB_TMO])) break; if (sp > XB_SPIN_CAP) { atomicAdd(&bar[XB_TMO], 1u); break; } }
    }
    nloc = mine > 0u ? mine : 1u; nx = cnt > 0u ? cnt : 1u;
}
__device__ __forceinline__ void xcd_barrier(const XcdBarrier& b, const int tid) {
    asm volatile("s_waitcnt vmcnt(0)" ::: "memory");
    __syncthreads();
    if (tid == 0) {
        unsigned* bar = b.bar;
        __builtin_amdgcn_s_waitcnt(0);
        unsigned nloc = b.st[0], nx = b.st[1];
        if (nloc == 0u) { xcd_barrier_complete(bar, b.x, nloc, nx); b.st[0] = nloc; b.st[1] = nx; }
        const unsigned old = xb_add(&bar[XB_XSUB(b.x)], 1u);
        const unsigned gen = old / nloc;
        if (old + 1u == (gen + 1u) * nloc) {
            __builtin_amdgcn_fence(__ATOMIC_RELEASE, "agent");
            asm volatile("s_waitcnt vmcnt(0)" ::: "memory");
            const unsigned og = xb_add(&bar[XB_TOP], 1u);
            const unsigned tg = og / nx;
            if (og + 1u == (tg + 1u) * nx) xb_add(&bar[XB_TOPGEN], 1u);
            else XB_SPIN(xb_ld(&bar[XB_TOPGEN]) == tg, bar);
            __builtin_amdgcn_fence(__ATOMIC_ACQUIRE, "agent");
            xb_add(&bar[XB_XGEN(b.x)], 1u);
            asm volatile("s_waitcnt vmcnt(0)" ::: "memory");
        } else {
            XB_SPIN(xb_ld(&bar[XB_XGEN(b.x)]) == gen, bar);
            __builtin_amdgcn_fence(__ATOMIC_ACQUIRE, "agent");
            asm volatile("s_waitcnt vmcnt(0)" ::: "memory");
        }
    }
    __syncthreads();
}

struct CvtSeg { int in_idx, nmat, K, N, NP, map; size_t dst_off; int g_idx; };
__device__ __forceinline__ void cvt_tile(const float* __restrict__ src, u16* __restrict__ dst, int K, int N, int NP, int map, int t, LAS unsigned* slab, int lane, const float* __restrict__ gvec) {
    const int kt_n = K / 64, nt_n = N / 64, per = kt_n * nt_n;
    const int mat = t / per, rem = t % per, nt = rem / kt_n, kt = rem % kt_n;
    const float* s = src + ((size_t)mat * K + (size_t)kt * 64) * N + nt * 64 + lane;
    float v[64];
#pragma unroll
    for (int k = 0; k < 64; ++k) v[k] = s[(size_t)k * N];
    if (gvec) { const float* gk = gvec + (size_t)mat * K + kt * 64;
#pragma unroll
        for (int k = 0; k < 64; ++k) v[k] *= gk[k]; }
#pragma unroll
    for (int q = 0; q < 8; ++q) { u32x4 w; w.x = g8::cvt_pk_bf16(v[q * 8], v[q * 8 + 1]); w.y = g8::cvt_pk_bf16(v[q * 8 + 2], v[q * 8 + 3]); w.z = g8::cvt_pk_bf16(v[q * 8 + 4], v[q * 8 + 5]); w.w = g8::cvt_pk_bf16(v[q * 8 + 6], v[q * 8 + 7]);
        *(LAS u32x4*)(slab + lane * 36 + q * 4) = w; }
#pragma unroll
    for (int i = 0; i < 8; ++i) { const int rl = i * 8 + (lane >> 3); const u32x4 w = *(const LAS u32x4*)(slab + rl * 36 + (lane & 7) * 4);
        const int n = nt * 64 + rl; int np = n;
        if (map) { const int half = N / 2; const int which = n >= half ? 1 : 0; const int j = n - which * half; np = (j / 128) * 256 + which * 128 + (j % 128); }
        *(u32x4*)(dst + ((size_t)mat * NP + np) * K + kt * 64 + (lane & 7) * 8) = w; }
}
__device__ __forceinline__ void mod_task(const Ptrs& P, char* lds, int task) {
    float* sc = (float*)lds;
    float* mod = (float*)(P.ws + WS_MOD);
    const int tid = threadIdx.x, cq = tid & 63, kg = tid >> 6;
    __syncthreads();
    for (int idx = tid; idx < 17 * 1024; idx += 512) { const int r = idx >> 10, kk = idx & 1023; const float v = r < 16 ? P.in[1][r * 1024 + kk] : P.in[3][kk]; sc[idx] = silu_f(v); }
    __syncthreads();
    const int i = task / 24, cc = task % 24; const int col = cc * 256 + cq * 4;
    const float* W = P.in[4] + ((size_t)i * 1024 + kg * 128) * 6144 + col;
    f32x4 acc[17];
#pragma unroll
    for (int r = 0; r < 17; ++r) acc[r] = (f32x4){0.f, 0.f, 0.f, 0.f};
#pragma unroll 8
    for (int kk = 0; kk < 128; ++kk) { const f32x4 w = *(const f32x4*)(W + (size_t)kk * 6144);
#pragma unroll
        for (int r = 0; r < 17; ++r) acc[r] += w * sc[r * 1024 + kg * 128 + kk]; }
    float* red2 = sc;
    __syncthreads();
#pragma unroll
    for (int pass = 0; pass < 2; ++pass) {
#pragma unroll
        for (int r = 0; r < 9; ++r) if (pass * 9 + r < 17) *(f32x4*)(red2 + ((kg * 9 + r) * 256 + cq * 4)) = acc[pass * 9 + r < 17 ? pass * 9 + r : 0];
        __syncthreads();
        for (int idx = tid; idx < 9 * 256; idx += 512) { const int rr = idx >> 8, c = idx & 255, r = pass * 9 + rr;
            if (r < 17) { float s = P.in[5][i * 6144 + cc * 256 + c];
#pragma unroll
                for (int g = 0; g < 8; ++g) s += red2[(g * 9 + rr) * 256 + c];
                mod[(size_t)(i * 17 + r) * 6144 + cc * 256 + c] = s; } }
        __syncthreads();
    }
}
__device__ __forceinline__ void s5_prep(const Ptrs& P, int j, int g, char* lds) {
    float2* Apow = (float2*)lds;
    float2* Bb = Apow + 2 * 64 * 17;
    float2* Cc = Bb + 2 * 64 * 16;
    float* Kt = (float*)(Cc + 2 * 16 * 64);
    const int tid = threadIdx.x;
    __syncthreads();
    if (tid < 128) { const int dir = tid >> 6, p = tid & 63; const size_t gd = ((size_t)j * 2 + dir) * SG + g;
        const float dt = __expf(P.in[10][gd]); const float ar = P.in[8][gd * SP + p], ai = P.in[9][gd * SP + p]; const float ldr = ar * dt, ldi = ai * dt;
        for (int tau = 0; tau <= 16; ++tau) { const float mag = __expf(ldr * (float)tau), ang = ldi * (float)tau; Apow[(dir * 64 + p) * 17 + tau] = make_float2(mag * __cosf(ang), mag * __sinf(ang)); }
        const float2 ab = Apow[(dir * 64 + p) * 17 + 1]; const float nr = ab.x - 1.f, ni = ab.y, den = ar * ar + ai * ai; const float qr = (nr * ar + ni * ai) / den, qi = (ni * ar - nr * ai) / den;
        for (int c = 0; c < 16; ++c) { const float br = P.in[11][(gd * SP + p) * SC + c], bi = P.in[12][(gd * SP + p) * SC + c]; Bb[(dir * 64 + p) * 16 + c] = make_float2(qr * br - qi * bi, qr * bi + qi * br); }
        ((float2*)(P.ws + WS_WB + WB_AT))[gd * SP + p] = Apow[(dir * 64 + p) * 17 + 16];
    }
    for (int i = tid; i < 2 * 16 * 64; i += 512) { const int d2 = i >> 10, c = (i >> 6) & 15, pp = i & 63; const size_t o = ((((size_t)j * 2 + d2) * SG + g) * SC + c) * SP + pp; Cc[i] = make_float2(P.in[13][o], P.in[14][o]); }
    __syncthreads();
    for (int idx = tid; idx < 8192; idx += 512) { const int dir = idx >> 12, tau = (idx >> 8) & 15, c = (idx >> 4) & 15, c2 = idx & 15; float s = 0.f;
        for (int p = 0; p < 64; ++p) { const float2 cc = Cc[(dir * 16 + c) * 64 + p], aa = Apow[(dir * 64 + p) * 17 + tau], bb = Bb[(dir * 64 + p) * 16 + c2];
            const float xr = aa.x * bb.x - aa.y * bb.y, xi = aa.x * bb.y + aa.y * bb.x; s += cc.x * xr - cc.y * xi; }
        Kt[idx] = s; }
    __syncthreads();
    u16* W1 = (u16*)(P.ws + WS_WB + WB_W1) + ((size_t)j * 64 + g) * 256 * 256; u16* W2 = (u16*)(P.ws + WS_WB + WB_W2) + ((size_t)j * 64 + g) * 256 * 512;
    for (int idx = tid; idx < 256 * 32; idx += 512) { const int row = idx >> 5, s8 = idx & 31; const int t = row >> 4, c = row & 15, s = s8 >> 1, cb = (s8 & 1) * 8;
        float v[8];
#pragma unroll
        for (int q = 0; q < 8; ++q) { const int c2 = cb + q;
            v[q] = s < t ? Kt[((0 * 16 + (t - s)) * 16 + c) * 16 + c2] : s > t ? Kt[((1 * 16 + (s - t)) * 16 + c) * 16 + c2] : Kt[((0 * 16 + 0) * 16 + c) * 16 + c2] + Kt[((1 * 16 + 0) * 16 + c) * 16 + c2] + (c2 == c ? P.in[15][j * 1024 + g * 16 + c] : 0.f); }
        u32x4 w; w.x = g8::cvt_pk_bf16(v[0], v[1]); w.y = g8::cvt_pk_bf16(v[2], v[3]); w.z = g8::cvt_pk_bf16(v[4], v[5]); w.w = g8::cvt_pk_bf16(v[6], v[7]);
        *(u32x4*)(W2 + (size_t)row * 512 + s8 * 8) = w; }
    for (int idx = tid; idx < 256 * 128; idx += 512) { const int row = idx >> 7, dp = idx & 127; const int dir = dp >> 6, p = dp & 63, t = row >> 4, c = row & 15;
        const float2 cc = Cc[(dir * 16 + c) * 64 + p], aa = Apow[(dir * 64 + p) * 17 + (dir ? 16 - t : t + 1)];
        const float gr = cc.x * aa.x - cc.y * aa.y, gi = cc.x * aa.y + cc.y * aa.x;
        *(unsigned*)(W2 + (size_t)row * 512 + 256 + dir * 128 + 2 * p) = g8::cvt_pk_bf16(gr, -gi); }
    for (int idx = tid; idx < 256 * 32; idx += 512) { const int n = idx >> 5, s8 = idx & 31; const int dir = n >> 7, p = (n >> 1) & 63, ri = n & 1, s = s8 >> 1, cb = (s8 & 1) * 8;
        const float2 aa = Apow[(dir * 64 + p) * 17 + (dir ? s : 15 - s)];
        float v[8];
#pragma unroll
        for (int q = 0; q < 8; ++q) { const float2 bb = Bb[(dir * 64 + p) * 16 + cb + q]; v[q] = ri ? aa.x * bb.y + aa.y * bb.x : aa.x * bb.x - aa.y * bb.y; }
        u32x4 w; w.x = g8::cvt_pk_bf16(v[0], v[1]); w.y = g8::cvt_pk_bf16(v[2], v[3]); w.z = g8::cvt_pk_bf16(v[4], v[5]); w.w = g8::cvt_pk_bf16(v[6], v[7]);
        *(u32x4*)(W1 + (size_t)n * 256 + s8 * 8) = w; }
    __syncthreads();
}
__device__ __forceinline__ void prologue_phase(const Ptrs& P, char* lds, const int parts) {
    if (parts & 1) {
        copy_small(P, blockIdx.x * 512 + threadIdx.x, gridDim.x * 512);
        float2* rope = (float2*)(P.ws + WS_ROPE);
        for (int i = blockIdx.x * 512 + threadIdx.x; i < 2048 * 32; i += gridDim.x * 512) { const int s = i >> 5, k = i & 31, f = k & 15; const float invf = exp2f(-(float)f * (13.287712379549449f / 16.f));
            const float ang = (float)(k < 16 ? (s >> 6) : (s & 63)) * invf; rope[i] = make_float2(__cosf(ang), __sinf(ang)); }
        unsigned char* wb = P.ws + WS_WB;
        for (int i = blockIdx.x * 512 + threadIdx.x; i < 2 * 64 * 1024 / 8; i += gridDim.x * 512) { const int mat = i / 8192, r = i % 8192; *(u32x4*)((u16*)(wb + WB_WIN) + ((size_t)mat * 768 + 704) * 1024 + (size_t)r * 8) = (u32x4){0u, 0u, 0u, 0u}; }
    }
    if (parts & 2) for (int task = blockIdx.x; task < 96; task += gridDim.x) mod_task(P, lds, task);
    if (parts & 4) for (int idx = (int)blockIdx.x - 96; idx >= 0 && idx < 128; idx += gridDim.x) s5_prep(P, idx >> 6, idx & 63, lds);
    if (parts & 24) {
        const CvtSeg seg[7] = { {16, 2, 1024, 2048, 2048, 1, WB_GLU, -1}, {17, 2, 1024, 704, 768, 0, WB_WIN, -1}, {20, 2, 384, 1536, 1536, 0, WB_UQ, 18}, {21, 2, 256, 2048, 2048, 0, WB_UKV, 19}, {22, 2, 1024, 1024, 1024, 0, WB_WO, -1},
                                {27, 128, 1024, 1024, 1024, 1, WB_GU, -1}, {28, 128, 512, 1024, 1024, 0, WB_DN, -1} };
        __syncthreads();
        const int lane = threadIdx.x & 63, wv = threadIdx.x >> 6;
        LAS unsigned* slab = (LAS unsigned*)((LAS unsigned char*)lds) + wv * (64 * 36);
        unsigned* qhead = (unsigned*)(P.ws + WS_CTL) + CW_QUEUE + ((parts >> 5) & 7) * 64;
        int tstart[8]; tstart[0] = 0;
#pragma unroll
        for (int s = 0; s < 7; ++s) tstart[s + 1] = tstart[s] + seg[s].nmat * (seg[s].K / 64) * (seg[s].N / 64);
        const int ntot = tstart[7], nchunk = (ntot + 7) / 8;
        for (;;) {
            unsigned c = 0; if (lane == 0) c = atomicAdd(qhead, 1u);
            c = (unsigned)__builtin_amdgcn_readfirstlane((int)c);
            if ((int)c >= nchunk) break;
            for (int t = (int)c * 8; t < (int)c * 8 + 8 && t < ntot; ++t) {
                int s = 0;
#pragma unroll
                for (int k = 1; k < 7; ++k) s = (t >= tstart[k]) ? k : s;
                int in_idx = 0, K = 0, N = 0, NP = 0, map = 0, t0 = 0, gi = -1; size_t doff = 0;
#pragma unroll
                for (int k = 0; k < 7; ++k) if (s == k) { in_idx = seg[k].in_idx; K = seg[k].K; N = seg[k].N; NP = seg[k].NP; map = seg[k].map; doff = seg[k].dst_off; t0 = tstart[k]; gi = seg[k].g_idx; }
                cvt_tile(P.in[in_idx], (u16*)(P.ws + WS_WB + doff), K, N, NP, map, t - t0, slab, lane, gi >= 0 ? P.in[gi] : nullptr);
            }
        }
        __syncthreads();
    }
}
__device__ __forceinline__ void s5_scan_phase(unsigned char* wsp, int j, int wv) {
    struct { unsigned char* ws; } P{wsp};
    const int tids = tid_opaque(wv); const int lane = tids & 63;
    const u16* S = (const u16*)(P.ws + WS_R1 + R1_S); u16* UH = (u16*)(P.ws + WS_R1 + R1_UH); const float2* AT = (const float2*)(P.ws + WS_WB + WB_AT);
    for (int task = blockIdx.x * 8 + (tids >> 6); task < 2048; task += gridDim.x * 8) {
        const int g = task >> 5, b = (task >> 1) & 15, dir = task & 1;
        const float2 a = AT[(((size_t)j * 2 + dir) * SG + g) * SP + lane];
        const u16* sp = S + ((size_t)g * 2304 + b * 144) * 256 + dir * 128 + 2 * lane; u16* hp = UH + ((size_t)g * 2304 + b * 144) * 512 + 256 + dir * 128 + 2 * lane;
        float hr = 0.f, hi = 0.f;
        for (int s0 = 0; s0 < 144; s0 += 16) {
            float2 sv[16];
#pragma unroll
            for (int k = 0; k < 16; ++k) { const int st = s0 + k; const int n = dir ? (st < 16 ? 15 - st : 159 - st) : st; const unsigned sb_ = *(const unsigned*)(sp + (size_t)n * 256); sv[k] = make_float2(__uint_as_float(sb_ << 16), __uint_as_float(sb_ & 0xffff0000u)); }
#pragma unroll
            for (int k = 0; k < 16; ++k) { const int st = s0 + k; const int n = dir ? (st < 16 ? 15 - st : 159 - st) : st;
                *(unsigned*)(hp + (size_t)n * 512) = g8::cvt_pk_bf16(hr, hi);
                const float nr = a.x * hr - a.y * hi + sv[k].x, ni = a.x * hi + a.y * hr + sv[k].y; hr = nr; hi = ni; }
        }
    }
}
__device__ __forceinline__ void mla_post_rows(unsigned char* wsp, int j, const float* Pm, int stride, int nwaves_blk, int wv) {
    struct { unsigned char* ws; } P{wsp}; const float* sm = (const float*)(wsp + WS_SMALL);
    const int tidp = tid_opaque(wv); const int lane = tidp & 63, wave = tidp >> 6;
    u16* CQ = (u16*)(P.ws + WS_CQ); u16* CKV = (u16*)(P.ws + WS_CKV); u16* KT = (u16*)(P.ws + WS_R1 + R1_KT); const float2* rope = (const float2*)(P.ws + WS_ROPE);
    for (int row = blockIdx.x * nwaves_blk + wave; row < T; row += gridDim.x * nwaves_blk) {
        const float* t = Pm + (size_t)row * stride; const int b = row / LTOT, pos = row % LTOT;
        float q[6]; float ss = 0.f;
#pragma unroll
        for (int i = 0; i < 6; ++i) { q[i] = t[i * 64 + lane]; ss += q[i] * q[i]; }
        ss = wave_sum_l(ss, lane); float rstd = rsqrtf(ss * (1.f / 384.f) + EPS);
#pragma unroll
        for (int i = 0; i < 6; ++i) CQ[(size_t)row * QR + i * 64 + lane] = f2bf(q[i] * rstd * sm[SM_GQ + j * QR + i * 64 + lane]);
        float k[4]; ss = 0.f;
#pragma unroll
        for (int i = 0; i < 4; ++i) { k[i] = t[384 + i * 64 + lane]; ss += k[i] * k[i]; }
        ss = wave_sum_l(ss, lane); rstd = rsqrtf(ss * (1.f / 256.f) + EPS);
#pragma unroll
        for (int i = 0; i < 4; ++i) CKV[(size_t)row * KVR + i * 64 + lane] = f2bf(k[i] * rstd * sm[SM_GKV + j * KVR + i * 64 + lane]);
        float v = t[640 + lane];
        if (pos >= CTXL) { const float pv = t[640 + (lane ^ 16)]; const float2 cs = rope[(size_t)(pos - CTXL) * 32 + (lane >> 5) * 16 + (lane & 15)];
            v = (lane & 16) ? v * cs.x + pv * cs.y : v * cs.x - pv * cs.y; }
        const u16 kb = f2bf(v);
#pragma unroll
        for (int h = 0; h < NH; ++h) KT[(((size_t)b * NH + h) * LTOT + pos) * QKD + 128 + lane] = kb;
    }
}
__device__ __forceinline__ void attn_phase(unsigned char* wsp, bool ctx_out, char* lds, LAS unsigned char* ldsl, int wv) {
    struct { unsigned char* ws; } P{wsp};
    const u16* QT = (const u16*)(P.ws + WS_R1 + R1_QT); const u16* KT = (const u16*)(P.ws + WS_R1 + R1_KT); const u16* VT = (const u16*)(P.ws + WS_R1 + R1_VT); u16* O = (u16*)(P.ws + WS_ZO);
    const int nunits = ctx_out ? 1152 : 1024;
    for (int u = blockIdx.x; u < nunits; u += gridDim.x) {
        int bh, qt, seq;
        if (u < 1024) { const int xcd = u & 7, k = u >> 3; bh = xcd * 16 + (k >> 3); qt = 1 + (k & 7); seq = LTOT; } else { bh = u - 1024; qt = 0; seq = CTXL; }
        const int b = bh >> 3, h = bh & 7;
        at::attn_body(QT + (size_t)bh * LTOT * QKD, KT + (size_t)bh * LTOT * QKD, VT + (size_t)bh * LTOT * 128, (const u16*)(P.ws + WS_KR) + (size_t)b * 2 * LTOT * 32, O + ((size_t)b * LTOT + qt * 256) * D + h * 128, D, qt * 256, seq, lds, ldsl, wv);
    }
}
constexpr int LDS_MISC = g8::STAGE_BYTES;
constexpr int LDS_BYTES = g8::STAGE_BYTES + 1024;
constexpr int NPHASE = 42;
struct MkArgs { Ptrs P; int lo, hi, bar_region, pad; };
__device__ __forceinline__ int lo_opq(int v) { asm volatile("" : "+s"(v)); return v; }
__global__ void __launch_bounds__(512, 2) mk(MkArgs a) {
    extern __shared__ __attribute__((aligned(16))) unsigned char lds[];
    LAS unsigned char* ldsl = (LAS unsigned char*)lds;
    volatile LAS unsigned* misc = (volatile LAS unsigned*)(ldsl + LDS_MISC);
    int* sbase = (int*)(lds + LDS_MISC + 64);
    const int wv = __builtin_amdgcn_readfirstlane(threadIdx.x >> 6);
    if (threadIdx.x < 4) misc[threadIdx.x] = 0u;
    __syncthreads();
#if defined(MK_FULL)
    const bool use_bar = true;
#else
    const bool use_bar = (a.hi - a.lo) > 1;
#endif
    unsigned char* ws = a.P.ws; float* outp = a.P.out;
    XcdBarrier bar; bar.bar = (unsigned*)(ws + WS_CTL) + a.bar_region * XCD_BAR_WORDS; bar.x = 0; bar.st = misc;
    if (use_bar) bar = xcd_barrier_post((unsigned*)(ws + WS_CTL) + a.bar_region * XCD_BAR_WORDS, misc);
    const int lo = a.lo, hi = a.hi;
#if defined(MK_FULL)
#define IN(k) (true)
#else
#define IN(k) (lo_opq(lo) <= (k) && (k) < lo_opq(hi))
#endif
#ifndef REP_GROUP
#define REP_GROUP (-1)
#define REP_N 1
#endif
#define NDST(li, g) (((g) == REP_GROUP && rep_ + 1 < REP_N) ? norm_dst_dummy(ws) : norm_dst_real(ws, li))
#if defined(REP_DRY)
#define EPI_DRYG(g) (((g) == REP_GROUP && rep_ + 1 < REP_N) ? 1 : 0)
#else
#define EPI_DRYG(g) 0
#endif
#define REP(g) for (int rep_ = 0; rep_ < ((g) == REP_GROUP ? REP_N : 1); ++rep_)
#if defined(PROBE_A)
#define STAMP(s) do { if (blockIdx.x == 0 && tid_opaque(wv) == 0) ((unsigned long long*)(ws0 + WS_CTL))[CW_STAMP64 + (s)] = __builtin_amdgcn_s_memrealtime(); } while (0)
#else
#define STAMP(s) do { } while (0)
#endif
#define SEAM(k) do { if (IN((k) + 1)) xcd_barrier(bar, tid_opaque(wv)); STAMP((k) + 1); } while (0)
    unsigned char* const ws0 = ws;
    STAMP(0);
#ifndef PRO_PART
#define PRO_PART 31
#endif
    if (IN(0)) REP(0) { prologue_phase(a.P, (char*)lds, (rep_ + 1 < ((0) == REP_GROUP ? REP_N : 1)) ? (PRO_PART | ((rep_ + 1) << 5)) : 31); SEAM(0); }

    {
        constexpr int li = 0; constexpr int base = 1 + li * 10, j = li >> 1;
#define PH_BEGIN size_t zoff_ = 0; asm volatile("" : "+s"(zoff_)); unsigned char* ws = ws0 + zoff_; unsigned char* wb = ws + WS_WB; const float* sm = (const float*)(ws + WS_SMALL); float* X = (float*)(ws + WS_X); const float* mod = (const float*)(ws + WS_MOD); (void)wb; (void)sm; (void)X; (void)mod;
        if ((li & 1) == 0) {
            if (IN(base + 0)) REP(1) { PH_BEGIN NormDst nd = NDST(li, 1); if (li == 0) { nd.xin = a.P.in[0]; nd.cin = a.P.in[2]; norm2_rows<4 | 64>(ws, outp, nd, li, 0, sbase, (char*)lds, wv); } else norm2_rows<5>(ws, outp, nd, li, 0, sbase, (char*)lds, wv); SEAM(base + 0); }
            if (IN(base + 1)) REP(3) { PH_BEGIN SchedS5 S; S.init(ws + WS_R1 + R1_UH, wb + WB_W1 + (size_t)j * 64 * 256 * 256 * 2, 256); EpiS5a E{(u16*)(ws + WS_R1 + R1_S)};
                g8::gemm_phase<EpiS5a, SchedS5>(ldsl, 256, S, E, wv); SEAM(base + 1); }
            if (IN(base + 2)) REP(3) { PH_BEGIN s5_scan_phase(ws, j, wv); SEAM(base + 2); }
            if (IN(base + 3)) REP(3) { PH_BEGIN SchedS5 S; S.init(ws + WS_R1 + R1_UH, wb + WB_W2 + (size_t)j * 64 * 256 * 512 * 2, 512); EpiS5b E{(u16*)(ws + WS_ZO)};
                g8::gemm_phase<EpiS5b, SchedS5>(ldsl, 512, S, E, wv); SEAM(base + 3); }
            if (IN(base + 4)) REP(4) { PH_BEGIN SchedDense S; S.init(ws + WS_ZO, 1024, wb + WB_GLU + (size_t)j * 2048 * 1024 * 2, T, 2048, 1024); EpiGlu E{(u16*)(ws + WS_HX), mod, li};
                g8::gemm_phase<EpiGlu, SchedDense>(ldsl, 1024, S, E, wv); SEAM(base + 4); }
        } else {
            if (IN(base + 0)) REP(1) { PH_BEGIN const NormDst nd = NDST(li, 1); norm2_rows<3>(ws, outp, nd, li, 0, sbase, (char*)lds, wv); SEAM(base + 0); }
            if (IN(base + 1)) REP(11) { PH_BEGIN SchedDense S; S.init(ws + WS_HX, 1024, wb + WB_WIN + (size_t)j * 768 * 1024 * 2, T, 768, 1024); EpiWin E{(u16*)(ws + WS_CQ), (u16*)(ws + WS_CKV), (u16*)(ws + WS_KR), (float*)(ws + WS_PS), (const float2*)(ws + WS_ROPE)};
                g8::gemm_phase<EpiWin, SchedDense>(ldsl, 1024, S, E, wv); SEAM(base + 1); }
            if (IN(base + 3)) REP(5) { PH_BEGIN
                { SchedDense S; S.init(ws + WS_CQ, QR, wb + WB_UQ + (size_t)j * 1536 * 384 * 2, T, 1536, 384); EpiQ E{(u16*)(ws + WS_R1 + R1_QT), (const float2*)(ws + WS_ROPE), (const float*)(ws + WS_PS), EPI_DRYG(5)};
                  g8::gemm_phase<EpiQ, SchedDense>(ldsl, 384, S, E, wv); }
                { SchedDense S; S.init(ws + WS_CKV, KVR, wb + WB_UKV + (size_t)j * 2048 * 256 * 2, T, 2048, 256); EpiKV E{(u16*)(ws + WS_R1 + R1_KT), (u16*)(ws + WS_R1 + R1_VT), (const float*)(ws + WS_PS), EPI_DRYG(5)};
                  int kk_ = 256; asm volatile("" : "+s"(kk_)); g8::gemm_phase<EpiKV, SchedDense>(ldsl, kk_, S, E, wv); }
                SEAM(base + 3); }
            if (IN(base + 4)) REP(6) { PH_BEGIN attn_phase(ws, li != 3, (char*)lds, ldsl, wv); SEAM(base + 4); }
            if (IN(base + 5)) REP(10) { PH_BEGIN SchedDense S; S.init(ws + WS_ZO, 1024, wb + WB_WO + (size_t)j * 1024 * 1024 * 2, T, 1024, 1024); EpiWo E{(u16*)(ws + WS_HX), mod, li};
                g8::gemm_phase<EpiWo, SchedDense>(ldsl, 1024, S, E, wv); SEAM(base + 5); }
        }
        if (IN(base + 6)) REP(2) { PH_BEGIN NormDst nd = NDST(li, 2); if (li == 0) { nd.xin = a.P.in[0]; nd.cin = a.P.in[2]; norm2_rows<42 | 64>(ws, outp, nd, li, 1, sbase, (char*)lds, wv); } else norm2_rows<42>(ws, outp, nd, li, 1, sbase, (char*)lds, wv); SEAM(base + 6); }
        if (IN(base + 7) || IN(base + 8)) {
            const unsigned* cnt = (const unsigned*)(ws0 + WS_CTL) + CW_CNT + li * 32 * CS;
            __syncthreads();
            if (tid_opaque(wv) == 0) { int acc = 0; for (int e = 0; e < 32; ++e) { sbase[e] = acc; acc += (int)((cnt[e * CS] + 255u) / 256u); } sbase[32] = acc; }
            __syncthreads();
            if (IN(base + 7)) REP(7) { PH_BEGIN SchedMoe<true> S; S.init(ws + WS_HX, wb + WB_GU + (size_t)li * 32 * 1024 * 1024 * 2, 1024, sbase, cnt, (const int*)(ws + WS_LIST)); EpiMoe1 E{(u16*)(ws + WS_R1 + R1_ACT), EPI_DRYG(7)};
                g8::gemm_phase<EpiMoe1, SchedMoe<true>>(ldsl, 1024, S, E, wv); SEAM(base + 7); }
            if (IN(base + 8)) REP(8) { PH_BEGIN SchedMoe<false> S; S.init(ws + WS_R1 + R1_ACT, wb + WB_DN + (size_t)li * 32 * 1024 * 512 * 2, 512, sbase, cnt, (const int*)(ws + WS_LIST)); EpiMoe2 E{(u16*)(ws + WS_YB), EPI_DRYG(8)};
                g8::gemm_phase<EpiMoe2, SchedMoe<false>>(ldsl, 512, S, E, wv); SEAM(base + 8); }
        }
    }

    {
        constexpr int li = 1; constexpr int base = 1 + li * 10, j = li >> 1;
#define PH_BEGIN size_t zoff_ = 0; asm volatile("" : "+s"(zoff_)); unsigned char* ws = ws0 + zoff_; unsigned char* wb = ws + WS_WB; const float* sm = (const float*)(ws + WS_SMALL); float* X = (float*)(ws + WS_X); const float* mod = (const float*)(ws + WS_MOD); (void)wb; (void)sm; (void)X; (void)mod;
        if ((li & 1) == 0) {
            if (IN(base + 0)) REP(1) { PH_BEGIN NormDst nd = NDST(li, 1); if (li == 0) { nd.xin = a.P.in[0]; nd.cin = a.P.in[2]; norm2_rows<4 | 64>(ws, outp, nd, li, 0, sbase, (char*)lds, wv); } else norm2_rows<5>(ws, outp, nd, li, 0, sbase, (char*)lds, wv); SEAM(base + 0); }
            if (IN(base + 1)) REP(3) { PH_BEGIN SchedS5 S; S.init(ws + WS_R1 + R1_UH, wb + WB_W1 + (size_t)j * 64 * 256 * 256 * 2, 256); EpiS5a E{(u16*)(ws + WS_R1 + R1_S)};
                g8::gemm_phase<EpiS5a, SchedS5>(ldsl, 256, S, E, wv); SEAM(base + 1); }
            if (IN(base + 2)) REP(3) { PH_BEGIN s5_scan_phase(ws, j, wv); SEAM(base + 2); }
            if (IN(base + 3)) REP(3) { PH_BEGIN SchedS5 S; S.init(ws + WS_R1 + R1_UH, wb + WB_W2 + (size_t)j * 64 * 256 * 512 * 2, 512); EpiS5b E{(u16*)(ws + WS_ZO)};
                g8::gemm_phase<EpiS5b, SchedS5>(ldsl, 512, S, E, wv); SEAM(base + 3); }
            if (IN(base + 4)) REP(4) { PH_BEGIN SchedDense S; S.init(ws + WS_ZO, 1024, wb + WB_GLU + (size_t)j * 2048 * 1024 * 2, T, 2048, 1024); EpiGlu E{(u16*)(ws + WS_HX), mod, li};
                g8::gemm_phase<EpiGlu, SchedDense>(ldsl, 1024, S, E, wv); SEAM(base + 4); }
        } else {
            if (IN(base + 0)) REP(1) { PH_BEGIN const NormDst nd = NDST(li, 1); norm2_rows<3>(ws, outp, nd, li, 0, sbase, (char*)lds, wv); SEAM(base + 0); }
            if (IN(base + 1)) REP(11) { PH_BEGIN SchedDense S; S.init(ws + WS_HX, 1024, wb + WB_WIN + (size_t)j * 768 * 1024 * 2, T, 768, 1024); EpiWin E{(u16*)(ws + WS_CQ), (u16*)(ws + WS_CKV), (u16*)(ws + WS_KR), (float*)(ws + WS_PS), (const float2*)(ws + WS_ROPE)};
                g8::gemm_phase<EpiWin, SchedDense>(ldsl, 1024, S, E, wv); SEAM(base + 1); }
            if (IN(base + 3)) REP(5) { PH_BEGIN
                { SchedDense S; S.init(ws + WS_CQ, QR, wb + WB_UQ + (size_t)j * 1536 * 384 * 2, T, 1536, 384); EpiQ E{(u16*)(ws + WS_R1 + R1_QT), (const float2*)(ws + WS_ROPE), (const float*)(ws + WS_PS), EPI_DRYG(5)};
                  g8::gemm_phase<EpiQ, SchedDense>(ldsl, 384, S, E, wv); }
                { SchedDense S; S.init(ws + WS_CKV, KVR, wb + WB_UKV + (size_t)j * 2048 * 256 * 2, T, 2048, 256); EpiKV E{(u16*)(ws + WS_R1 + R1_KT), (u16*)(ws + WS_R1 + R1_VT), (const float*)(ws + WS_PS), EPI_DRYG(5)};
                  int kk_ = 256; asm volatile("" : "+s"(kk_)); g8::gemm_phase<EpiKV, SchedDense>(ldsl, kk_, S, E, wv); }
                SEAM(base + 3); }
            if (IN(base + 4)) REP(6) { PH_BEGIN attn_phase(ws, li != 3, (char*)lds, ldsl, wv); SEAM(base + 4); }
            if (IN(base + 5)) REP(10) { PH_BEGIN SchedDense S; S.init(ws + WS_ZO, 1024, wb + WB_WO + (size_t)j * 1024 * 1024 * 2, T, 1024, 1024); EpiWo E{(u16*)(ws + WS_HX), mod, li};
                g8::gemm_phase<EpiWo, SchedDense>(ldsl, 1024, S, E, wv); SEAM(base + 5); }
        }
        if (IN(base + 6)) REP(2) { PH_BEGIN NormDst nd = NDST(li, 2); if (li == 0) { nd.xin = a.P.in[0]; nd.cin = a.P.in[2]; norm2_rows<42 | 64>(ws, outp, nd, li, 1, sbase, (char*)lds, wv); } else norm2_rows<42>(ws, outp, nd, li, 1, sbase, (char*)lds, wv); SEAM(base + 6); }
        if (IN(base + 7) || IN(base + 8)) {
            const unsigned* cnt = (const unsigned*)(ws0 + WS_CTL) + CW_CNT + li * 32 * CS;
            __syncthreads();
            if (tid_opaque(wv) == 0) { int acc = 0; for (int e = 0; e < 32; ++e) { sbase[e] = acc; acc += (int)((cnt[e * CS] + 255u) / 256u); } sbase[32] = acc; }
            __syncthreads();
            if (IN(base + 7)) REP(7) { PH_BEGIN SchedMoe<true> S; S.init(ws + WS_HX, wb + WB_GU + (size_t)li * 32 * 1024 * 1024 * 2, 1024, sbase, cnt, (const int*)(ws + WS_LIST)); EpiMoe1 E{(u16*)(ws + WS_R1 + R1_ACT), EPI_DRYG(7)};
                g8::gemm_phase<EpiMoe1, SchedMoe<true>>(ldsl, 1024, S, E, wv); SEAM(base + 7); }
            if (IN(base + 8)) REP(8) { PH_BEGIN SchedMoe<false> S; S.init(ws + WS_R1 + R1_ACT, wb + WB_DN + (size_t)li * 32 * 1024 * 512 * 2, 512, sbase, cnt, (const int*)(ws + WS_LIST)); EpiMoe2 E{(u16*)(ws + WS_YB), EPI_DRYG(8)};
                g8::gemm_phase<EpiMoe2, SchedMoe<false>>(ldsl, 512, S, E, wv); SEAM(base + 8); }
        }
    }

    {
        constexpr int li = 2; constexpr int base = 1 + li * 10, j = li >> 1;
#define PH_BEGIN size_t zoff_ = 0; asm volatile("" : "+s"(zoff_)); unsigned char* ws = ws0 + zoff_; unsigned char* wb = ws + WS_WB; const float* sm = (const float*)(ws + WS_SMALL); float* X = (float*)(ws + WS_X); const float* mod = (const float*)(ws + WS_MOD); (void)wb; (void)sm; (void)X; (void)mod;
        if ((li & 1) == 0) {
            if (IN(base + 0)) REP(1) { PH_BEGIN NormDst nd = NDST(li, 1); if (li == 0) { nd.xin = a.P.in[0]; nd.cin = a.P.in[2]; norm2_rows<4 | 64>(ws, outp, nd, li, 0, sbase, (char*)lds, wv); } else norm2_rows<5>(ws, outp, nd, li, 0, sbase, (char*)lds, wv); SEAM(base + 0); }
            if (IN(base + 1)) REP(3) { PH_BEGIN SchedS5 S; S.init(ws + WS_R1 + R1_UH, wb + WB_W1 + (size_t)j * 64 * 256 * 256 * 2, 256); EpiS5a E{(u16*)(ws + WS_R1 + R1_S)};
                g8::gemm_phase<EpiS5a, SchedS5>(ldsl, 256, S, E, wv); SEAM(base + 1); }
            if (IN(base + 2)) REP(3) { PH_BEGIN s5_scan_phase(ws, j, wv); SEAM(base + 2); }
            if (IN(base + 3)) REP(3) { PH_BEGIN SchedS5 S; S.init(ws + WS_R1 + R1_UH, wb + WB_W2 + (size_t)j * 64 * 256 * 512 * 2, 512); EpiS5b E{(u16*)(ws + WS_ZO)};
                g8::gemm_phase<EpiS5b, SchedS5>(ldsl, 512, S, E, wv); SEAM(base + 3); }
            if (IN(base + 4)) REP(4) { PH_BEGIN SchedDense S; S.init(ws + WS_ZO, 1024, wb + WB_GLU + (size_t)j * 2048 * 1024 * 2, T, 2048, 1024); EpiGlu E{(u16*)(ws + WS_HX), mod, li};
                g8::gemm_phase<EpiGlu, SchedDense>(ldsl, 1024, S, E, wv); SEAM(base + 4); }
        } else {
            if (IN(base + 0)) REP(1) { PH_BEGIN const NormDst nd = NDST(li, 1); norm2_rows<3>(ws, outp, nd, li, 0, sbase, (char*)lds, wv); SEAM(base + 0); }
            if (IN(base + 1)) REP(11) { PH_BEGIN SchedDense S; S.init(ws + WS_HX, 1024, wb + WB_WIN + (size_t)j * 768 * 1024 * 2, T, 768, 1024); EpiWin E{(u16*)(ws + WS_CQ), (u16*)(ws + WS_CKV), (u16*)(ws + WS_KR), (float*)(ws + WS_PS), (const float2*)(ws + WS_ROPE)};
                g8::gemm_phase<EpiWin, SchedDense>(ldsl, 1024, S, E, wv); SEAM(base + 1); }
            if (IN(base + 3)) REP(5) { PH_BEGIN
                { SchedDense S; S.init(ws + WS_CQ, QR, wb + WB_UQ + (size_t)j * 1536 * 384 * 2, T, 1536, 384); EpiQ E{(u16*)(ws + WS_R1 + R1_QT), (const float2*)(ws + WS_ROPE), (const float*)(ws + WS_PS), EPI_DRYG(5)};
                  g8::gemm_phase<EpiQ, SchedDense>(ldsl, 384, S, E, wv); }
                { SchedDense S; S.init(ws + WS_CKV, KVR, wb + WB_UKV + (size_t)j * 2048 * 256 * 2, T, 2048, 256); EpiKV E{(u16*)(ws + WS_R1 + R1_KT), (u16*)(ws + WS_R1 + R1_VT), (const float*)(ws + WS_PS), EPI_DRYG(5)};
                  int kk_ = 256; asm volatile("" : "+s"(kk_)); g8::gemm_phase<EpiKV, SchedDense>(ldsl, kk_, S, E, wv); }
                SEAM(base + 3); }
            if (IN(base + 4)) REP(6) { PH_BEGIN attn_phase(ws, li != 3, (char*)lds, ldsl, wv); SEAM(base + 4); }
            if (IN(base + 5)) REP(10) { PH_BEGIN SchedDense S; S.init(ws + WS_ZO, 1024, wb + WB_WO + (size_t)j * 1024 * 1024 * 2, T, 1024, 1024); EpiWo E{(u16*)(ws + WS_HX), mod, li};
                g8::gemm_phase<EpiWo, SchedDense>(ldsl, 1024, S, E, wv); SEAM(base + 5); }
        }
        if (IN(base + 6)) REP(2) { PH_BEGIN NormDst nd = NDST(li, 2); if (li == 0) { nd.xin = a.P.in[0]; nd.cin = a.P.in[2]; norm2_rows<42 | 64>(ws, outp, nd, li, 1, sbase, (char*)lds, wv); } else norm2_rows<42>(ws, outp, nd, li, 1, sbase, (char*)lds, wv); SEAM(base + 6); }
        if (IN(base + 7) || IN(base + 8)) {
            const unsigned* cnt = (const unsigned*)(ws0 + WS_CTL) + CW_CNT + li * 32 * CS;
            __syncthreads();
            if (tid_opaque(wv) == 0) { int acc = 0; for (int e = 0; e < 32; ++e) { sbase[e] = acc; acc += (int)((cnt[e * CS] + 255u) / 256u); } sbase[32] = acc; }
            __syncthreads();
            if (IN(base + 7)) REP(7) { PH_BEGIN SchedMoe<true> S; S.init(ws + WS_HX, wb + WB_GU + (size_t)li * 32 * 1024 * 1024 * 2, 1024, sbase, cnt, (const int*)(ws + WS_LIST)); EpiMoe1 E{(u16*)(ws + WS_R1 + R1_ACT), EPI_DRYG(7)};
                g8::gemm_phase<EpiMoe1, SchedMoe<true>>(ldsl, 1024, S, E, wv); SEAM(base + 7); }
            if (IN(base + 8)) REP(8) { PH_BEGIN SchedMoe<false> S; S.init(ws + WS_R1 + R1_ACT, wb + WB_DN + (size_t)li * 32 * 1024 * 512 * 2, 512, sbase, cnt, (const int*)(ws + WS_LIST)); EpiMoe2 E{(u16*)(ws + WS_YB), EPI_DRYG(8)};
                g8::gemm_phase<EpiMoe2, SchedMoe<false>>(ldsl, 512, S, E, wv); SEAM(base + 8); }
        }
    }

    {
        constexpr int li = 3; constexpr int base = 1 + li * 10, j = li >> 1;
#define PH_BEGIN size_t zoff_ = 0; asm volatile("" : "+s"(zoff_)); unsigned char* ws = ws0 + zoff_; unsigned char* wb = ws + WS_WB; const float* sm = (const float*)(ws + WS_SMALL); float* X = (float*)(ws + WS_X); const float* mod = (const float*)(ws + WS_MOD); (void)wb; (void)sm; (void)X; (void)mod;
        if ((li & 1) == 0) {
            if (IN(base + 0)) REP(1) { PH_BEGIN NormDst nd = NDST(li, 1); if (li == 0) { nd.xin = a.P.in[0]; nd.cin = a.P.in[2]; norm2_rows<4 | 64>(ws, outp, nd, li, 0, sbase, (char*)lds, wv); } else norm2_rows<5>(ws, outp, nd, li, 0, sbase, (char*)lds, wv); SEAM(base + 0); }
            if (IN(base + 1)) REP(3) { PH_BEGIN SchedS5 S; S.init(ws + WS_R1 + R1_UH, wb + WB_W1 + (size_t)j * 64 * 256 * 256 * 2, 256); EpiS5a E{(u16*)(ws + WS_R1 + R1_S)};
                g8::gemm_phase<EpiS5a, SchedS5>(ldsl, 256, S, E, wv); SEAM(base + 1); }
            if (IN(base + 2)) REP(3) { PH_BEGIN s5_scan_phase(ws, j, wv); SEAM(base + 2); }
            if (IN(base + 3)) REP(3) { PH_BEGIN SchedS5 S; S.init(ws + WS_R1 + R1_UH, wb + WB_W2 + (size_t)j * 64 * 256 * 512 * 2, 512); EpiS5b E{(u16*)(ws + WS_ZO)};
                g8::gemm_phase<EpiS5b, SchedS5>(ldsl, 512, S, E, wv); SEAM(base + 3); }
            if (IN(base + 4)) REP(4) { PH_BEGIN SchedDense S; S.init(ws + WS_ZO, 1024, wb + WB_GLU + (size_t)j * 2048 * 1024 * 2, T, 2048, 1024); EpiGlu E{(u16*)(ws + WS_HX), mod, li};
                g8::gemm_phase<EpiGlu, SchedDense>(ldsl, 1024, S, E, wv); SEAM(base + 4); }
        } else {
            if (IN(base + 0)) REP(1) { PH_BEGIN const NormDst nd = NDST(li, 1); norm2_rows<3>(ws, outp, nd, li, 0, sbase, (char*)lds, wv); SEAM(base + 0); }
            if (IN(base + 1)) REP(11) { PH_BEGIN SchedDense S; S.init(ws + WS_HX, 1024, wb + WB_WIN + (size_t)j * 768 * 1024 * 2, T, 768, 1024); EpiWin E{(u16*)(ws + WS_CQ), (u16*)(ws + WS_CKV), (u16*)(ws + WS_KR), (float*)(ws + WS_PS), (const float2*)(ws + WS_ROPE)};
                g8::gemm_phase<EpiWin, SchedDense>(ldsl, 1024, S, E, wv); SEAM(base + 1); }
            if (IN(base + 3)) REP(5) { PH_BEGIN
                { SchedDense S; S.init(ws + WS_CQ, QR, wb + WB_UQ + (size_t)j * 1536 * 384 * 2, T, 1536, 384); EpiQ E{(u16*)(ws + WS_R1 + R1_QT), (const float2*)(ws + WS_ROPE), (const float*)(ws + WS_PS), EPI_DRYG(5)};
                  g8::gemm_phase<EpiQ, SchedDense>(ldsl, 384, S, E, wv); }
                { SchedDense S; S.init(ws + WS_CKV, KVR, wb + WB_UKV + (size_t)j * 2048 * 256 * 2, T, 2048, 256); EpiKV E{(u16*)(ws + WS_R1 + R1_KT), (u16*)(ws + WS_R1 + R1_VT), (const float*)(ws + WS_PS), EPI_DRYG(5)};
                  int kk_ = 256; asm volatile("" : "+s"(kk_)); g8::gemm_phase<EpiKV, SchedDense>(ldsl, kk_, S, E, wv); }
                SEAM(base + 3); }
            if (IN(base + 4)) REP(6) { PH_BEGIN attn_phase(ws, li != 3, (char*)lds, ldsl, wv); SEAM(base + 4); }
            if (IN(base + 5)) REP(10) { PH_BEGIN SchedDense S; S.init(ws + WS_ZO, 1024, wb + WB_WO + (size_t)j * 1024 * 1024 * 2, T, 1024, 1024); EpiWo E{(u16*)(ws + WS_HX), mod, li};
                g8::gemm_phase<EpiWo, SchedDense>(ldsl, 1024, S, E, wv); SEAM(base + 5); }
        }
        if (IN(base + 6)) REP(2) { PH_BEGIN NormDst nd = NDST(li, 2); if (li == 0) { nd.xin = a.P.in[0]; nd.cin = a.P.in[2]; norm2_rows<42 | 64>(ws, outp, nd, li, 1, sbase, (char*)lds, wv); } else norm2_rows<42>(ws, outp, nd, li, 1, sbase, (char*)lds, wv); SEAM(base + 6); }
        if (IN(base + 7) || IN(base + 8)) {
            const unsigned* cnt = (const unsigned*)(ws0 + WS_CTL) + CW_CNT + li * 32 * CS;
            __syncthreads();
            if (tid_opaque(wv) == 0) { int acc = 0; for (int e = 0; e < 32; ++e) { sbase[e] = acc; acc += (int)((cnt[e * CS] + 255u) / 256u); } sbase[32] = acc; }
            __syncthreads();
            if (IN(base + 7)) REP(7) { PH_BEGIN SchedMoe<true> S; S.init(ws + WS_HX, wb + WB_GU + (size_t)li * 32 * 1024 * 1024 * 2, 1024, sbase, cnt, (const int*)(ws + WS_LIST)); EpiMoe1 E{(u16*)(ws + WS_R1 + R1_ACT), EPI_DRYG(7)};
                g8::gemm_phase<EpiMoe1, SchedMoe<true>>(ldsl, 1024, S, E, wv); SEAM(base + 7); }
            if (IN(base + 8)) REP(8) { PH_BEGIN SchedMoe<false> S; S.init(ws + WS_R1 + R1_ACT, wb + WB_DN + (size_t)li * 32 * 1024 * 512 * 2, 512, sbase, cnt, (const int*)(ws + WS_LIST)); EpiMoe2 E{(u16*)(ws + WS_YB), EPI_DRYG(8)};
                g8::gemm_phase<EpiMoe2, SchedMoe<false>>(ldsl, 512, S, E, wv); SEAM(base + 8); }
        }
    }

#if defined(PROBE_A)
    if (IN(41)) { xcd_barrier(bar, tid_opaque(wv));
        if (tid_opaque(wv) == 0) { const unsigned long long* ts = (const unsigned long long*)(ws0 + WS_CTL) + CW_STAMP64; unsigned long long last = ts[0], sa = 0, sb = 0;
            for (int p = 0; p <= 40; ++p) { const unsigned long long e = ts[p + 1]; if (e == 0) continue; const unsigned long long d = e - last; last = e;
                int grp; if (p == 0) grp = 0; else { const int k = (p - 1) % 10, l = (p - 1) / 10; const bool s5 = (l & 1) == 0;
                    grp = k == 0 ? 1 : k == 6 ? 2 : k == 7 ? 7 : k == 8 ? 8 : s5 ? (k == 4 ? 4 : 3) : (k == 4 ? 6 : 5); }
                if (grp == PROBE_A) sa += d; if (grp == PROBE_B) sb += d; }
            ((float*)sbase)[40] = (float)sa * 1e-5f; ((float*)sbase)[41] = 2.f + (float)sb * (1.f / 2000.f); }
        __syncthreads(); }
#endif
    if (IN(41)) { const NormDst nd = norm_dst_real(ws0, 0); norm2_rows<17>(ws0, outp, nd, 4, 0, sbase, (char*)lds, wv); }
#undef PH_BEGIN
#undef IN
#undef SEAM
}
__global__ __launch_bounds__(256) void n_post_win(Ptrs P, int j) { mla_post_rows(P.ws, j, (const float*)(P.ws + WS_YB), 768, 4, __builtin_amdgcn_readfirstlane(threadIdx.x >> 6)); }
static void gemm_naive(hipStream_t st, const void* A, int lda, const int* rowidx, const float* B, int ldb, long bstride, const int* tileexp, const int* mdyn, float* C, int ldc, int M, int N, int K) {
    NG g{}; g.A = A; g.lda = lda; g.rowidx = rowidx; g.B = B; g.ldb = ldb; g.bstride = bstride; g.tileexp = tileexp; g.mdyn = mdyn; g.C = C; g.ldc = ldc; g.M = M; g.N = N; g.K = K; g.pad = 0;
    hipLaunchKernelGGL(n_gemm<1>, dim3(N / 64, (M + 63) / 64), dim3(256), 0, st, g);
}
#ifndef REALMASK_STR
#define REALMASK_STR "111111111111111111111111111111111111111111"
#endif
extern "C" void kernel_launch(void* const* d_in, const int* in_sizes, int n_in, void* d_out, int out_size, void* d_ws, size_t ws_size, hipStream_t stream) {
    static int grid = 0;
    static const char* realmask = REALMASK_STR;
    if (grid == 0) {
        if (n_in != 30 || out_size != NB * SEQ * D || ws_size < WS_NEND) { fprintf(stderr, "kernel_launch: unexpected shapes n_in %d out %d ws %zu (need %zu)\n", n_in, out_size, ws_size, (size_t)WS_NEND); grid = -1; return; }
        int dev = 0, cus = 0, per_cu = 0;
        if (hipGetDevice(&dev) != hipSuccess || hipDeviceGetAttribute(&cus, hipDeviceAttributeMultiprocessorCount, dev) != hipSuccess) { grid = -1; return; }
        if (hipFuncSetAttribute((const void*)mk, hipFuncAttributeMaxDynamicSharedMemorySize, LDS_BYTES) != hipSuccess) { fprintf(stderr, "kernel_launch: hipFuncSetAttribute failed\n"); grid = -1; return; }
        if (hipOccupancyMaxActiveBlocksPerMultiprocessor(&per_cu, (const void*)mk, 512, LDS_BYTES) != hipSuccess || per_cu < 1) { fprintf(stderr, "kernel_launch: occupancy query says %d\n", per_cu); }
        (void)hipGetLastError();
        grid = cus;
    }
    if (grid < 0) return;
    Ptrs P{}; for (int i = 0; i < 30; ++i) P.in[i] = (const float*)d_in[i]; P.out = (float*)d_out; P.ws = (unsigned char*)d_ws;
    unsigned char* ws = P.ws;
    (void)hipMemsetAsync(ws + WS_CTL, 0, ZERO_BYTES, stream);
    int nreg = 0;
    auto real = [&](int p) { return realmask[p] == '1'; };
    auto run_mk = [&](int lo, int hi) { MkArgs a{}; a.P = P; a.lo = lo; a.hi = hi; a.bar_region = (hi - lo > 1) ? nreg++ : 0; a.pad = 0; hipLaunchKernelGGL(mk, dim3(grid), dim3(512), LDS_BYTES, stream, a); };
    const int NG_ = 4096; float* NTMP = (float*)(ws + WS_NTMP);
    int p = 0;
    while (p < NPHASE) {
        if (real(p)) { int q = p; while (q < NPHASE && real(q)) ++q; run_mk(p, q); p = q; continue; }
        if (p == 0) { hipLaunchKernelGGL(k_mod, dim3(24, 4), dim3(256), 0, stream, P); hipLaunchKernelGGL(k_init, dim3(2048), dim3(256), 0, stream, P); }
        else if (p == 41) hipLaunchKernelGGL(k_norm<17>, dim3(2048), dim3(256), 0, stream, P, 4, 0);
        else {
            const int li = (p - 1) / 10, k = (p - 1) % 10, j = li >> 1; const bool s5 = (li & 1) == 0;
            if (k == 0) { if (li == 0) hipLaunchKernelGGL(k_norm<2>, dim3(2048), dim3(256), 0, stream, P, li, 0); else hipLaunchKernelGGL(k_norm<3>, dim3(2048), dim3(256), 0, stream, P, li, 0); }
            else if (s5 && k == 1) { hipLaunchKernelGGL(n_s5, dim3(NB * SG), dim3(128), 0, stream, P, j); }
            else if (s5 && k == 3) { hipLaunchKernelGGL(n_post_s5, dim3(NG_), dim3(256), 0, stream, P, j); }
            else if (s5 && k == 4) { gemm_naive(stream, ws + WS_ZO, D, nullptr, P.in[16] + (size_t)j * 1024 * 2048, 2048, 0, nullptr, nullptr, NTMP, 2048, T, 2048, 1024); hipLaunchKernelGGL(n_post_glu, dim3(NG_), dim3(256), 0, stream, P, li); }
            else if (!s5 && k == 1) { gemm_naive(stream, ws + WS_HX, D, nullptr, P.in[17] + (size_t)j * 1024 * 704, 704, 0, nullptr, nullptr, (float*)(ws + WS_YB), 768, T, 704, 1024); }
            else if (!s5 && k == 2) { hipLaunchKernelGGL(n_post_win, dim3(2048), dim3(256), 0, stream, P, j); }
            else if (!s5 && k == 3) {
                gemm_naive(stream, ws + WS_CQ, QR, nullptr, P.in[20] + (size_t)j * 384 * 1536, 1536, 0, nullptr, nullptr, NTMP, 1536, T, 1536, 384); hipLaunchKernelGGL(n_post_q, dim3(NG_), dim3(256), 0, stream, P);
                gemm_naive(stream, ws + WS_CKV, KVR, nullptr, P.in[21] + (size_t)j * 256 * 2048, 2048, 0, nullptr, nullptr, NTMP, 2048, T, 2048, 256); hipLaunchKernelGGL(n_post_kv, dim3(NG_), dim3(256), 0, stream, P); }
            else if (!s5 && k == 4) { hipLaunchKernelGGL(n_attn, dim3(LTOT / 64, NH, NB), dim3(256), 0, stream, P); }
            else if (!s5 && k == 5) { gemm_naive(stream, ws + WS_ZO, D, nullptr, P.in[22] + (size_t)j * 1024 * 1024, 1024, 0, nullptr, nullptr, NTMP, 1024, T, 1024, 1024); hipLaunchKernelGGL(n_post_wo, dim3(NG_), dim3(256), 0, stream, P, li); }
            else if (k == 6) { hipLaunchKernelGGL(k_norm<10>, dim3(2048), dim3(256), 0, stream, P, li, 1); }
            else if (k == 7 || k == 8) {
                const int* tileexp = (const int*)(ws + WS_TILEEXP);
                hipLaunchKernelGGL(n_build, dim3(1), dim3(256), 0, stream, P, li);
                if (k == 7) { gemm_naive(stream, ws + WS_HX, D, (const int*)(ws + WS_SLOTROW), P.in[27] + (size_t)li * 32 * 1024 * 1024, 1024, 1024L * 1024, tileexp, tileexp + 512, NTMP, 1024, MAXSLOT, 1024, 1024);
                    hipLaunchKernelGGL(n_post_act2, dim3(NG_), dim3(256), 0, stream, P, (u16*)(ws + WS_R1 + R1_ACT)); }
                else { gemm_naive(stream, ws + WS_R1 + R1_ACT, 512, nullptr, P.in[28] + (size_t)li * 32 * 512 * 1024, 1024, 512L * 1024, tileexp, tileexp + 512, NTMP, 1024, MAXSLOT, 1024, 512);
                    hipLaunchKernelGGL(n_post_y, dim3(NG_), dim3(256), 0, stream, P); }
            }
        }
        ++p;
    }
}
```
